# Optimizing an MI355X kernel written in HIP

```python
import math
import jax
import jax.numpy as jnp
from jax import lax
import numpy as np

D_MODEL = 2048
BATCH = 16
SEQ = 256
DEPTH = 4
DEC_BATCH = 2
DEC_SEQ = 4096
PAST_LEN = 256

GRID_W = 64
BLOCK = 128
EPS = 1e-6
ROPE_BASE = 10000.0

HEAD_DIM = 128
A_HEADS = 4
A_KV_HEADS = 2
A_GROUP = A_HEADS // A_KV_HEADS
A_WINDOW = 128
B_HEADS = 4
B_HALF = HEAD_DIM // 2
C_HEADS = 16
C_HEAD_DIM = 64
C_INNER = C_HEADS * C_HEAD_DIM
C_GROUPS = 2
C_HPG = C_HEADS // C_GROUPS
C_STATE = 128
C_CONV = 5
C_CHUNK = 128
C_CONV_CH = C_INNER + 2 * C_GROUPS * C_STATE

A_Q = A_HEADS * HEAD_DIM
A_KV = A_KV_HEADS * HEAD_DIM
B_QKV = B_HEADS * HEAD_DIM
PROJ_SIZES = (A_Q, A_KV, A_KV, B_QKV, B_QKV, B_QKV, C_INNER, C_CONV_CH, 2 * C_HEADS)
IN_COLS = sum(PROJ_SIZES)
MIX_W = A_Q + B_QKV + C_INNER
FF = (8 * D_MODEL + 3 * 256 - 1) // (3 * 256) * 256
N_MOD = 6

kernel_name = 'hybrid_diffusion_prefix_trunk_step'


def rmsnorm(x, g):
    xf = x.astype(jnp.float32)
    y = xf * lax.rsqrt(jnp.mean(xf * xf, axis=-1, keepdims=True) + EPS)
    return (y * g.astype(jnp.float32)).astype(x.dtype)


def adaln(cond, w, bias):
    m = jax.nn.silu(cond) @ w + bias
    return jnp.split(m[..., None, :], N_MOD, axis=-1)


def split_projection(p):
    cuts, acc = [], 0
    for size in PROJ_SIZES[:-1]:
        acc += size
        cuts.append(acc)
    return jnp.split(p, cuts, axis=-1)


def axial_rope_tables(n, rot_dim):
    rows = n // GRID_W
    row = jnp.repeat(jnp.arange(rows), GRID_W).astype(jnp.float32)
    col = (jnp.arange(rows * GRID_W) % GRID_W).astype(jnp.float32)
    quarter = rot_dim // 4
    inv = ROPE_BASE ** (-jnp.arange(quarter, dtype=jnp.float32) / quarter)
    ang = jnp.concatenate([row[:, None] * inv, col[:, None] * inv], axis=-1)
    return jnp.cos(ang), jnp.sin(ang)


def apply_rope(x, cos, sin):
    half = x.shape[-1] // 2
    shape = (cos.shape[0],) + (1,) * (x.ndim - 3) + (half,)
    cos, sin = cos.reshape(shape), sin.reshape(shape)
    xf = x.astype(jnp.float32)
    x1, x2 = xf[..., :half], xf[..., half:]
    return jnp.concatenate([x1 * cos - x2 * sin, x1 * sin + x2 * cos], axis=-1).astype(x.dtype)


def sweep_query_blocks(fn, q):
    b, n = q.shape[:2]
    nb = n // BLOCK
    qb = jnp.moveaxis(q.reshape((b, nb, BLOCK) + q.shape[2:]), 1, 0)
    out = jnp.moveaxis(lax.map(fn, qb), 0, 1)
    return out.reshape((b, n) + out.shape[3:])


def sink_attention(q, k, v, sink):
    b, m = q.shape[:2]
    qg = q.reshape(b, m, A_KV_HEADS, A_GROUP, HEAD_DIM)
    s = jnp.einsum('bqkgd,bskd->bkgqs', qg, k, preferred_element_type=jnp.float32) * (HEAD_DIM ** -0.5)
    snk = jnp.broadcast_to(sink.astype(jnp.float32).reshape(1, A_KV_HEADS, A_GROUP, 1, 1), s.shape[:-1] + (1,))
    p = jax.nn.softmax(jnp.concatenate([s, snk], axis=-1), axis=-1)[..., :-1]
    o = jnp.einsum('bkgqs,bskd->bqkgd', p.astype(v.dtype), v)
    return o.reshape(b, m, A_HEADS, HEAD_DIM)


def banded_window_attention(q, k, v, k_ctx, v_ctx, sink):
    b, n = q.shape[:2]
    nb = n // BLOCK
    n_ctx = k_ctx.shape[1]
    scale = HEAD_DIM ** -0.5
    qb = q.reshape(b, nb, BLOCK, A_KV_HEADS, A_GROUP, HEAD_DIM)
    pad = ((0, 0), (BLOCK, BLOCK), (0, 0), (0, 0))
    idx = jnp.arange(nb)[:, None] * BLOCK + jnp.arange(3 * BLOCK)[None, :]
    kw = jnp.pad(k, pad)[:, idx]
    vw = jnp.pad(v, pad)[:, idx]
    qpos = idx[:, BLOCK:2 * BLOCK]
    kpos = idx[:, None, :]
    mask = (jnp.abs(qpos[:, :, None] - kpos) <= A_WINDOW) & (kpos >= BLOCK) & (kpos < n + BLOCK)
    s_lat = jnp.einsum('bnqkgd,bnskd->bnkgqs', qb, kw, preferred_element_type=jnp.float32) * scale
    s_lat = jnp.where(mask[None, :, None, None], s_lat, -jnp.inf)
    s_ctx = jnp.einsum('bnqkgd,bckd->bnkgqc', qb, k_ctx, preferred_element_type=jnp.float32) * scale
    snk = jnp.broadcast_to(sink.astype(jnp.float32).reshape(1, 1, A_KV_HEADS, A_GROUP, 1, 1), s_lat.shape[:-1] + (1,))
    p = jax.nn.softmax(jnp.concatenate([s_lat, s_ctx, snk], axis=-1), axis=-1)
    w = 3 * BLOCK
    o = (jnp.einsum('bnkgqs,bnskd->bnqkgd', p[..., :w].astype(v.dtype), vw)
         + jnp.einsum('bnkgqc,bckd->bnqkgd', p[..., w:w + n_ctx].astype(v.dtype), v_ctx))
    return o.reshape(b, n, A_HEADS, HEAD_DIM)


def diff_attention(q, keys, vals, lam):
    s = jnp.concatenate([jnp.einsum('bqhjd,bshjd->bhjqs', q, k, preferred_element_type=jnp.float32)
                         for k in keys], axis=-1) * (B_HALF ** -0.5)
    p = jax.nn.softmax(s, axis=-1)
    w = p[:, :, 0] - lam * p[:, :, 1]
    o, off = 0, 0
    for v in vals:
        sl = v.shape[1]
        o = o + jnp.einsum('bhqs,bshd->bqhd', w[..., off:off + sl].astype(v.dtype), v)
        off += sl
    return o


def depthwise_conv_centred(x, w, bias):
    y = lax.conv_general_dilated(x, w[:, None, :].astype(x.dtype), window_strides=(1,),
                                 padding=[(C_CONV // 2, C_CONV // 2)],
                                 dimension_numbers=('NWC', 'WIO', 'NWC'),
                                 feature_group_count=x.shape[-1])
    return y + bias.astype(x.dtype)


def ssd_chunked_scan(x, dt, a, bm, cm, h0):
    b, t = x.shape[:2]
    nc = t // C_CHUNK
    x = x.reshape(b, nc, C_CHUNK, C_GROUPS, C_HPG, C_HEAD_DIM)
    dt = dt.reshape(b, nc, C_CHUNK, C_GROUPS, C_HPG)
    bm = bm.reshape(b, nc, C_CHUNK, C_GROUPS, C_STATE)
    cm = cm.reshape(b, nc, C_CHUNK, C_GROUPS, C_STATE)
    cum = jnp.cumsum(dt * a.reshape(C_GROUPS, C_HPG), axis=2)
    seg = cum[:, :, :, None] - cum[:, :, None, :]
    tri = jnp.tril(jnp.ones((C_CHUNK, C_CHUNK), bool))[:, :, None, None]
    decay = jnp.exp(jnp.where(tri, seg, -jnp.inf))
    cb = jnp.einsum('bclgn,bcsgn->bclsg', cm, bm)
    wts = cb[..., None] * decay * dt[:, :, None]
    y_diag = jnp.einsum('bclsgh,bcsghp->bclghp', wts, x)
    to_end = jnp.exp(cum[:, :, -1:] - cum) * dt
    states = jnp.einsum('bclgn,bclgh,bclghp->bcghpn', bm, to_end, x)
    chunk_decay = jnp.exp(cum[:, :, -1])

    def step(h, inp):
        s_c, d_c = inp
        return d_c[..., None, None] * h + s_c, h

    h0g = h0.reshape(b, C_GROUPS, C_HPG, C_HEAD_DIM, C_STATE)
    h_last, h_prev = lax.scan(step, h0g, (jnp.moveaxis(states, 1, 0), jnp.moveaxis(chunk_decay, 1, 0)))
    h_prev = jnp.moveaxis(h_prev, 0, 1)
    y_off = jnp.einsum('bclgn,bcghpn->bclghp', cm, h_prev) * jnp.exp(cum)[..., None]
    y = (y_diag + y_off).reshape(b, t, C_HEADS, C_HEAD_DIM)
    return y, h_last.reshape(b, C_HEADS, C_HEAD_DIM, C_STATE)


def ssd_mixer(z, xbc, dt_raw, lw, h0f, h0b):
    b, n = z.shape[:2]
    f32 = jnp.float32
    xbc = jax.nn.silu(depthwise_conv_centred(xbc, lw['conv_w'], lw['conv_b'])).astype(f32)
    x = xbc[..., :C_INNER].reshape(b, n, C_HEADS, C_HEAD_DIM)
    bm = xbc[..., C_INNER:C_INNER + C_GROUPS * C_STATE].reshape(b, n, C_GROUPS, C_STATE)
    cm = xbc[..., C_INNER + C_GROUPS * C_STATE:].reshape(b, n, C_GROUPS, C_STATE)
    dt = jax.nn.softplus(dt_raw.astype(f32).reshape(b, n, 2, C_HEADS) + lw['dt_bias'].astype(f32))
    a = -jnp.exp(lw['a_log'].astype(f32))
    rev = lambda t: jnp.flip(t, axis=1)
    y_f, h_f = ssd_chunked_scan(x, dt[:, :, 0], a[0], bm, cm, h0f.astype(f32))
    y_b, h_b = ssd_chunked_scan(rev(x), rev(dt[:, :, 1]), a[1], rev(bm), rev(cm), h0b.astype(f32))
    y = y_f + rev(y_b) + lw['d_skip'].astype(f32)[:, None] * x
    y = y.reshape(b, n, C_INNER) * jax.nn.silu(z.astype(f32))
    yg = y.reshape(b, n, C_GROUPS, C_INNER // C_GROUPS)
    yg = yg * lax.rsqrt(jnp.mean(yg * yg, axis=-1, keepdims=True) + EPS)
    y = yg.reshape(b, n, C_INNER) * lw['ssm_norm'].astype(f32)
    return y.astype(z.dtype), h_f, h_b


def lambda_init(layer):
    return 0.8 - 0.6 * math.exp(-0.3 * layer)


def trunk_layer(h, cond, lw, lam_init, ctx_cache):
    b, n = h.shape[:2]
    sh1, sc1, g1, sh2, sc2, g2 = adaln(cond, lw['w_ada'], lw['b_ada'])
    u = rmsnorm(h, lw['norm_mix']) * (1 + sc1) + sh1
    qa, ka, va, qd, kd, vd, z, xbc, dt_raw = split_projection(u @ lw['w_in'])
    qa = qa.reshape(b, n, A_HEADS, HEAD_DIM)
    ka = ka.reshape(b, n, A_KV_HEADS, HEAD_DIM)
    va = va.reshape(b, n, A_KV_HEADS, HEAD_DIM)
    qd = qd.reshape(b, n, B_HEADS, 2, B_HALF)
    kd = kd.reshape(b, n, B_HEADS, 2, B_HALF)
    vd = vd.reshape(b, n, B_HEADS, HEAD_DIM)
    lv = lw['diff_lambda'].astype(jnp.float32)
    lam = jnp.exp(jnp.sum(lv[0] * lv[1])) - jnp.exp(jnp.sum(lv[2] * lv[3])) + lam_init
    sink = lw['attn_sink']
    if ctx_cache is None:
        oa = sweep_query_blocks(lambda qi: sink_attention(qi, ka, va, sink), qa)
        od = sweep_query_blocks(lambda qi: diff_attention(qi, (kd,), (vd,), lam), qd)
        h0f = jnp.zeros((b, C_HEADS, C_HEAD_DIM, C_STATE), jnp.float32)
        h0b = h0f
    else:
        ck_a, cv_a, ck_d, cv_d, h0f, h0b = ctx_cache
        cos_a, sin_a = axial_rope_tables(n, HEAD_DIM)
        cos_d, sin_d = axial_rope_tables(n, B_HALF)
        qa_r = apply_rope(qa, cos_a, sin_a)
        ka_r = apply_rope(ka, cos_a, sin_a)
        qd_r = apply_rope(qd, cos_d, sin_d)
        kd_r = apply_rope(kd, cos_d, sin_d)
        oa = banded_window_attention(qa_r, ka_r, va, ck_a, cv_a, sink)
        ck_d = ck_d.reshape(b, ck_d.shape[1], B_HEADS, 2, B_HALF)
        od = sweep_query_blocks(lambda qi: diff_attention(qi, (kd_r, ck_d), (vd, cv_d), lam), qd_r)
    od = rmsnorm(od, lw['diff_norm']) * (1.0 - lam_init)
    oc, hf, hb = ssd_mixer(z, xbc, dt_raw, lw, h0f, h0b)
    mixed = jnp.concatenate([oa.reshape(b, n, A_Q), od.reshape(b, n, B_QKV), oc], axis=-1) @ lw['w_out']
    h = h + g1 * mixed
    u = rmsnorm(h, lw['norm_ffn']) * (1 + sc2) + sh2
    gate, up = jnp.split(u @ lw['w_gate_up'], 2, axis=-1)
    h = h + g2 * ((jax.nn.silu(gate) * up) @ lw['w_down'])
    if ctx_cache is None:
        return h, (ka, va, kd.reshape(b, n, B_HEADS, HEAD_DIM), vd, hf.astype(h.dtype), hb.astype(h.dtype))
    return h, None


def setup_inputs(seed: int = 0) -> dict:
    key = jax.random.key(seed)
    ks = jax.random.split(key, 32)
    f32 = jnp.float32
    nrm = lambda k, shape, scale: jax.random.normal(k, shape, f32) * scale
    dt0 = jnp.exp(jax.random.uniform(ks[20], (DEPTH, 2, C_HEADS), f32) * (math.log(0.1) - math.log(0.001)) + math.log(0.001))
    return {
        'x_prompt': nrm(ks[0], (BATCH, SEQ, D_MODEL), 1.0),
        'x_sample': nrm(ks[1], (DEC_BATCH, DEC_SEQ, D_MODEL), 1.0),
        'cache_attn_k': nrm(ks[2], (DEC_BATCH, DEPTH, PAST_LEN, A_KV_HEADS, HEAD_DIM), 1.0),
        'cache_attn_v': nrm(ks[3], (DEC_BATCH, DEPTH, PAST_LEN, A_KV_HEADS, HEAD_DIM), 1.0),
        'cache_diff_k': nrm(ks[4], (DEC_BATCH, DEPTH, PAST_LEN, B_HEADS, HEAD_DIM), 1.0),
        'cache_diff_v': nrm(ks[5], (DEC_BATCH, DEPTH, PAST_LEN, B_HEADS, HEAD_DIM), 1.0),
        'state_ssm_fwd': nrm(ks[6], (DEC_BATCH, DEPTH, C_HEADS, C_HEAD_DIM, C_STATE), 0.1),
        'state_ssm_bwd': nrm(ks[7], (DEC_BATCH, DEPTH, C_HEADS, C_HEAD_DIM, C_STATE), 0.1),
        'c': nrm(ks[8], (DEC_BATCH, D_MODEL), 1.0),
        'c_ctx': nrm(ks[9], (D_MODEL,), 1.0),
        'w_ada': nrm(ks[10], (DEPTH, D_MODEL, N_MOD * D_MODEL), 0.5 * D_MODEL ** -0.5),
        'b_ada': nrm(ks[11], (DEPTH, N_MOD * D_MODEL), 0.01),
        'norm_mix': 1.0 + nrm(ks[12], (DEPTH, D_MODEL), 0.01),
        'norm_ffn': 1.0 + nrm(ks[13], (DEPTH, D_MODEL), 0.01),
        'w_in': nrm(ks[14], (DEPTH, D_MODEL, IN_COLS), D_MODEL ** -0.5),
        'attn_sink': nrm(ks[15], (DEPTH, A_HEADS), 0.5),
        'diff_lambda': nrm(ks[16], (DEPTH, 4, B_HALF), 0.1),
        'diff_norm': 1.0 + nrm(ks[17], (DEPTH, HEAD_DIM), 0.01),
        'conv_w': nrm(ks[18], (DEPTH, C_CONV, C_CONV_CH), C_CONV ** -0.5),
        'conv_b': nrm(ks[19], (DEPTH, C_CONV_CH), 0.01),
        'dt_bias': dt0 + jnp.log(-jnp.expm1(-dt0)),
        'a_log': jnp.log(jax.random.uniform(ks[21], (DEPTH, 2, C_HEADS), f32, 1.0, 16.0)),
        'd_skip': 1.0 + nrm(ks[22], (DEPTH, C_HEADS), 0.01),
        'ssm_norm': 1.0 + nrm(ks[23], (DEPTH, C_INNER), 0.01),
        'w_out': nrm(ks[24], (DEPTH, MIX_W, D_MODEL), MIX_W ** -0.5),
        'w_gate_up': nrm(ks[25], (DEPTH, D_MODEL, 2 * FF), D_MODEL ** -0.5),
        'w_down': nrm(ks[26], (DEPTH, FF, D_MODEL), FF ** -0.5),
        'norm_final': 1.0 + nrm(ks[27], (D_MODEL,), 0.01),
    }


def reference(x_prompt, x_sample, cache_attn_k, cache_attn_v, cache_diff_k, cache_diff_v,
              state_ssm_fwd, state_ssm_bwd, c, c_ctx, w_ada, b_ada, norm_mix, norm_ffn, w_in,
              attn_sink, diff_lambda, diff_norm, conv_w, conv_b, dt_bias, a_log, d_skip,
              ssm_norm, w_out, w_gate_up, w_down, norm_final):
    def layer_weights(l):
        return {'w_ada': w_ada[l], 'b_ada': b_ada[l], 'norm_mix': norm_mix[l], 'norm_ffn': norm_ffn[l],
                'w_in': w_in[l], 'attn_sink': attn_sink[l], 'diff_lambda': diff_lambda[l],
                'diff_norm': diff_norm[l], 'conv_w': conv_w[l], 'conv_b': conv_b[l],
                'dt_bias': dt_bias[l], 'a_log': a_log[l], 'd_skip': d_skip[l], 'ssm_norm': ssm_norm[l],
                'w_out': w_out[l], 'w_gate_up': w_gate_up[l], 'w_down': w_down[l]}

    h = x_prompt
    ctx_layers = []
    for l in range(DEPTH):
        h, ctx = trunk_layer(h, c_ctx, layer_weights(l), lambda_init(l), None)
        ctx_layers.append(ctx)
    y_prompt = rmsnorm(h, norm_final)
    new_attn_k = jnp.stack([t[0] for t in ctx_layers], axis=1)
    new_attn_v = jnp.stack([t[1] for t in ctx_layers], axis=1)
    new_diff_k = jnp.stack([t[2] for t in ctx_layers], axis=1)
    new_diff_v = jnp.stack([t[3] for t in ctx_layers], axis=1)
    new_ssm_fwd = jnp.stack([t[4] for t in ctx_layers], axis=1)
    new_ssm_bwd = jnp.stack([t[5] for t in ctx_layers], axis=1)

    h = x_sample
    for l in range(DEPTH):
        cache = (cache_attn_k[:, l], cache_attn_v[:, l], cache_diff_k[:, l], cache_diff_v[:, l],
                 state_ssm_fwd[:, l], state_ssm_bwd[:, l])
        h, _ = trunk_layer(h, c, layer_weights(l), lambda_init(l), cache)
    y_sample = rmsnorm(h, norm_final)
    return (y_prompt, y_sample, new_attn_k, new_attn_v, new_diff_k, new_diff_v, new_ssm_fwd, new_ssm_bwd)
```

```cpp
#include <hip/hip_runtime.h>
#include <cstdio>
#include <cstdint>
namespace pg8 {
#define PG8_LAS __attribute__((address_space(3)))
typedef unsigned short bf16_t;
typedef short bf16x8 __attribute__((ext_vector_type(8)));
typedef float f32x4 __attribute__((ext_vector_type(4)));
typedef unsigned u32x4 __attribute__((ext_vector_type(4)));
constexpr int BM = 256, BK = 64, HALF = 128, HTB = HALF * BK * 2  , STAGE_BYTES = 8 * HTB, NXCD = 8, WGM = 8;

__host__ __device__ __forceinline__ int lds_byte(int r, int c) { const int st = (r >> 4) * 2 + (c >> 5), rr = r & 15, cc = c & 31, ob = rr * 64 + cc * 2; return st * 1024 + (ob ^ (((ob >> 9) & 1) << 5)); }
__host__ __device__ __forceinline__ void stage_rc(int b, int& R, int& C) { const int st = b / 1024, sb = b % 1024, swz = sb ^ (((sb >> 9) & 1) << 5); R = (st >> 1) * 16 + swz / 64; C = (st & 1) * 32 + (swz % 64) / 2; }
__host__ __device__ __forceinline__ int perm32(int rho) { const int n = rho >> 4, i = rho & 15; return 8 * (i >> 2) + 4 * n + (i & 3); }

struct Unit { int pm, pn; };
struct Gemm { const bf16_t* A; const bf16_t* Bt; int M, N, K; };

struct StaticOrder {
    int nM, nN, nwg, G, c;
    __host__ __device__ void init(int M, int N, int G_, int c_) { nM = M / BM; nN = N / BM; nwg = nM * nN; G = G_; c = c_; }
    __host__ __device__ bool next(int i, Unit& u) const {
        const long L = (long)i * G + c; if (L >= nwg) return false;
        int wgid = (int)L; { const int q = nwg / NXCD, r = nwg % NXCD, xcd = wgid % NXCD, off = wgid / NXCD; wgid = (xcd < r ? xcd * (q + 1) : r * (q + 1) + (xcd - r) * q) + off; }
        const int nig = WGM * nN, gid = wgid / nig, fm = gid * WGM, gsz = (nM - fm) < WGM ? (nM - fm) : WGM;
        u.pm = fm + ((wgid % nig) % gsz); u.pn = (wgid % nig) / gsz; return true;
    }
    __device__ __forceinline__ void a_ready(const Unit&) const {}
    __device__ __forceinline__ void done(const Unit&) const {}
};

__device__ __forceinline__ unsigned cvt_pk_bf16(float lo, float hi) { unsigned r; asm volatile("v_cvt_pk_bf16_f32 %0, %1, %2" : "=v"(r) : "v"(lo), "v"(hi)); return r; }

struct EpiBf16 {
    static constexpr bool PERM = true, AFTER_DRAIN = false;
    bf16_t* O; int ldc;
    __device__ __forceinline__ void operator()(const f32x4 (&acc)[2][2][4][2], const Unit& u, int wr, int wc, int fr, int fq) const {
        const int row0 = u.pm * BM + wr * 64 + fr; const int col0 = u.pn * BM + wc * 32 + 8 * fq;
#pragma unroll
        for (int ai = 0; ai < 2; ++ai)
#pragma unroll
            for (int m = 0; m < 4; ++m) { bf16_t* rowp = O + (size_t)(row0 + ai * HALF + m * 16) * ldc + col0;
#pragma unroll
                for (int bj = 0; bj < 2; ++bj) { const f32x4 v0 = acc[ai][bj][m][0], v1 = acc[ai][bj][m][1];
                    u32x4 w; w.x = cvt_pk_bf16(v0[0], v0[1]); w.y = cvt_pk_bf16(v0[2], v0[3]); w.z = cvt_pk_bf16(v1[0], v1[1]); w.w = cvt_pk_bf16(v1[2], v1[3]);
                    *(u32x4*)(rowp + bj * HALF) = w; } }
    }
};
__device__ __forceinline__ int cond_of_pm(int pm) { return pm < 16 ? 0 : (pm < 32 ? 1 : 2); }
struct EpiResid {
    static constexpr bool PERM = false, AFTER_DRAIN = false;
    float* H; int ldc; const float* gate; int gstride;
    __device__ __forceinline__ void operator()(const f32x4 (&acc)[2][2][4][2], const Unit& u, int wr, int wc, int fr, int fq) const {
        const float* g = gate + (size_t)cond_of_pm(u.pm) * gstride;
        const int row0 = u.pm * BM + wr * 64 + fr; const int col0 = u.pn * BM + wc * 32 + 4 * fq;
        f32x4 gv[2][2];
#pragma unroll
        for (int bj = 0; bj < 2; ++bj)
#pragma unroll
            for (int n = 0; n < 2; ++n) gv[bj][n] = *(const f32x4*)(g + col0 + bj * HALF + n * 16);
#pragma unroll
        for (int ai = 0; ai < 2; ++ai)
#pragma unroll
            for (int m = 0; m < 4; ++m) { float* rowp = H + (size_t)(row0 + ai * HALF + m * 16) * ldc + col0;
#pragma unroll
                for (int bj = 0; bj < 2; ++bj)
#pragma unroll
                    for (int n = 0; n < 2; ++n) { f32x4* p = (f32x4*)(rowp + bj * HALF + n * 16); f32x4 h = *p; h = h + gv[bj][n] * acc[ai][bj][m][n]; *p = h; }
                asm volatile("" ::: "memory"); }
    }
};
__device__ __forceinline__ float silu_f(float x) { return x * __builtin_amdgcn_rcpf(1.0f + __expf(-x)); }
struct EpiSwiGLU {
    static constexpr bool PERM = true, AFTER_DRAIN = false;
    bf16_t* O; int ldc;
    __device__ __forceinline__ void operator()(const f32x4 (&acc)[2][2][4][2], const Unit& u, int wr, int wc, int fr, int fq) const {
        const int row0 = u.pm * BM + wr * 64 + fr; const int col0 = u.pn * HALF + wc * 32 + 8 * fq;
#pragma unroll
        for (int ai = 0; ai < 2; ++ai)
#pragma unroll
            for (int m = 0; m < 4; ++m) { bf16_t* rowp = O + (size_t)(row0 + ai * HALF + m * 16) * ldc + col0;
                const f32x4 g0 = acc[ai][0][m][0], g1 = acc[ai][0][m][1], u0 = acc[ai][1][m][0], u1 = acc[ai][1][m][1];
                u32x4 w;
                w.x = cvt_pk_bf16(silu_f(g0[0]) * u0[0], silu_f(g0[1]) * u0[1]); w.y = cvt_pk_bf16(silu_f(g0[2]) * u0[2], silu_f(g0[3]) * u0[3]);
                w.z = cvt_pk_bf16(silu_f(g1[0]) * u1[0], silu_f(g1[1]) * u1[1]); w.w = cvt_pk_bf16(silu_f(g1[2]) * u1[2], silu_f(g1[3]) * u1[3]);
                *(u32x4*)rowp = w; }
    }
};
template <class Epi, class Sched, bool ALIGN_EPI = false, bool SP2 = false>
__device__ __forceinline__ void gemm_phase(PG8_LAS unsigned char* lds, const Gemm g, const Sched& S, const Epi& E) {
    int tid_ = threadIdx.x; asm volatile("" : "+v"(tid_));
    const int tid = tid_, wid = __builtin_amdgcn_readfirstlane(tid >> 6), lane = tid & 63, wr = wid >> 2, wc = wid & 3, fr = lane & 15, fq = lane >> 4;
    const int K = g.K, nt = K / BK;
    unsigned voffA[2], voffB[2];
#pragma unroll
    for (int i = 0; i < 2; ++i) { int R, C; stage_rc(tid * 16 + i * 8192, R, C); const int Rb = Epi::PERM ? ((R & ~31) + perm32(R & 31)) : R;
        voffA[i] = (unsigned)(R * K + C) * 2u; voffB[i] = (unsigned)(Rb * K + C) * 2u; }
    const size_t kstep = (size_t)(BK * 2);
    const size_t hstep = (size_t)HALF * K * 2;
    const size_t tstep = 2 * hstep;
    const unsigned ldsw = (unsigned)wid * 1024u;
    const int aoff = lds_byte(wr * 64 + fr, fq * 8), boff = lds_byte(wc * 32 + fr, fq * 8);
#define PG8_SA(b, h) (((b) * 2 + (h)) * HTB)
#define PG8_SB(b, h) ((4 + (b) * 2 + (h)) * HTB)
#define PG8_STAGE(bufoff, gbase, voff) do { _Pragma("unroll") for (int _i = 0; _i < 2; ++_i) \
        __builtin_amdgcn_global_load_lds((const unsigned*)((const char*)(gbase) + (voff)[_i]), (PG8_LAS unsigned*)(lds + (bufoff) + ldsw + _i * 8192), 16, 0, 0); } while (0)
#define PG8_LDA(dst, b, h) do { _Pragma("unroll") for (int m = 0; m < 4; ++m) _Pragma("unroll") for (int k = 0; k < 2; ++k) dst[m][k] = *(const PG8_LAS bf16x8*)(lds + PG8_SA(b, h) + aoff + m * 2048 + k * 1024); } while (0)
#define PG8_LDB(dst, b, h) do { _Pragma("unroll") for (int n = 0; n < 2; ++n) _Pragma("unroll") for (int k = 0; k < 2; ++k) dst[n][k] = *(const PG8_LAS bf16x8*)(lds + PG8_SB(b, h) + boff + n * 2048 + k * 1024); } while (0)
#define PG8_MMA(ai, bj, At, Bt) do { __builtin_amdgcn_s_setprio(1); _Pragma("unroll") for (int m = 0; m < 4; ++m) _Pragma("unroll") for (int n = 0; n < 2; ++n) _Pragma("unroll") for (int k = 0; k < 2; ++k) \
        acc[ai][bj][m][n] = __builtin_amdgcn_mfma_f32_16x16x32_bf16(Bt[n][k], At[m][k], acc[ai][bj][m][n], 0, 0, 0); __builtin_amdgcn_s_setprio(0); } while (0)
#define PG8_WAIT_V(n) asm volatile("s_waitcnt vmcnt(" #n ")" ::: "memory")
#define PG8_WAIT_L(n) asm volatile("s_waitcnt lgkmcnt(" #n ")" ::: "memory")
#define PG8_BAR __builtin_amdgcn_s_barrier()
#define PG8_SCHED __builtin_amdgcn_sched_barrier(0)
    Unit cur, nxt; int ui = 0;
    if (!S.next(0, cur)) return;
    f32x4 acc[2][2][4][2];
#pragma unroll
    for (int a = 0; a < 2; ++a)
#pragma unroll
        for (int b = 0; b < 2; ++b)
#pragma unroll
            for (int m = 0; m < 4; ++m)
#pragma unroll
                for (int n = 0; n < 2; ++n) acc[a][b][m][n] = (f32x4){0.f, 0.f, 0.f, 0.f};
    bf16x8 At[4][2], B0[2][2], B1[2][2];
    const char* cA = (const char*)g.A + (size_t)cur.pm * tstep; const char* cB = (const char*)g.Bt + (size_t)cur.pn * tstep;
    S.a_ready(cur);
    if constexpr (SP2) {
        PG8_STAGE(PG8_SB(0, 0), cB, voffB); PG8_STAGE(PG8_SB(0, 1), cB + hstep, voffB); PG8_STAGE(PG8_SA(0, 0), cA, voffA); PG8_STAGE(PG8_SA(0, 1), cA + hstep, voffA);
        if (wr == 1) PG8_BAR;
        PG8_WAIT_V(2); PG8_BAR;
        PG8_STAGE(PG8_SB(1, 0), cB + kstep, voffB); PG8_STAGE(PG8_SA(1, 0), cA + kstep, voffA); PG8_STAGE(PG8_SB(1, 1), cB + hstep + kstep, voffB);
        PG8_WAIT_V(6); PG8_BAR;
    } else {
        PG8_STAGE(PG8_SB(0, 0), cB, voffB); PG8_STAGE(PG8_SA(0, 0), cA, voffA); PG8_STAGE(PG8_SB(0, 1), cB + hstep, voffB); PG8_STAGE(PG8_SA(0, 1), cA + hstep, voffA);
        if (wr == 1) PG8_BAR;
        PG8_WAIT_V(4); PG8_BAR;
        PG8_STAGE(PG8_SB(1, 0), cB + kstep, voffB); PG8_STAGE(PG8_SA(1, 0), cA + kstep, voffA); PG8_STAGE(PG8_SB(1, 1), cB + hstep + kstep, voffB);
        PG8_WAIT_V(6); PG8_BAR;
    }
    for (;;) {
        const bool has_next = S.next(ui + 1, nxt);
        const char* nA = has_next ? (const char*)g.A + (size_t)nxt.pm * tstep : cA; const char* nB = has_next ? (const char*)g.Bt + (size_t)nxt.pn * tstep : cB;
        for (int t = 0; t < nt; t += 2) {
            const bool last = (t == nt - 2);
            const char* a1 = cA + (size_t)(t + 1) * kstep;
            const char* a2 = last ? nA : cA + (size_t)(t + 2) * kstep; const char* b2 = last ? nB : cB + (size_t)(t + 2) * kstep;
            const char* a3 = a2 + kstep; const char* b3 = b2 + kstep;
            if (last && has_next) S.a_ready(nxt);
            if constexpr (SP2) {
            PG8_LDB(B0, 0, 0); PG8_LDB(B1, 0, 1); PG8_SCHED; PG8_LDA(At, 0, 0); PG8_STAGE(PG8_SA(1, 1), a1 + hstep, voffA);
            PG8_WAIT_V(8); PG8_WAIT_L(0); PG8_BAR; PG8_MMA(0, 0, At, B0); PG8_MMA(0, 1, At, B1); PG8_BAR; PG8_SCHED;
            PG8_LDA(At, 0, 1); PG8_STAGE(PG8_SB(0, 0), b2, voffB); PG8_STAGE(PG8_SB(0, 1), b2 + hstep, voffB); PG8_STAGE(PG8_SA(0, 0), a2, voffA);
            PG8_WAIT_V(8); PG8_WAIT_L(0); PG8_BAR; PG8_MMA(1, 0, At, B0); PG8_MMA(1, 1, At, B1); PG8_BAR; PG8_SCHED;
            PG8_LDB(B0, 1, 0); PG8_LDB(B1, 1, 1); PG8_SCHED; PG8_LDA(At, 1, 0); PG8_STAGE(PG8_SA(0, 1), a2 + hstep, voffA);
            PG8_WAIT_V(8); PG8_WAIT_L(0); PG8_BAR; PG8_MMA(0, 0, At, B0); PG8_MMA(0, 1, At, B1); PG8_BAR; PG8_SCHED;
            PG8_LDA(At, 1, 1); PG8_STAGE(PG8_SB(1, 0), b3, voffB); PG8_STAGE(PG8_SB(1, 1), b3 + hstep, voffB); PG8_STAGE(PG8_SA(1, 0), a3, voffA);
            PG8_WAIT_V(8); PG8_WAIT_L(0); PG8_BAR; PG8_MMA(1, 0, At, B0); PG8_MMA(1, 1, At, B1); PG8_BAR; PG8_SCHED;
            } else {
            PG8_LDB(B0, 0, 0); PG8_SCHED; PG8_LDA(At, 0, 0); PG8_STAGE(PG8_SA(1, 1), a1 + hstep, voffA);
            PG8_WAIT_L(8); PG8_BAR; PG8_WAIT_L(0); PG8_MMA(0, 0, At, B0); PG8_BAR; PG8_SCHED;
            PG8_LDB(B1, 0, 1); PG8_STAGE(PG8_SB(0, 0), b2, voffB);
            PG8_BAR; PG8_WAIT_L(0); PG8_MMA(0, 1, At, B1); PG8_BAR;
            PG8_LDA(At, 0, 1); PG8_STAGE(PG8_SA(0, 0), a2, voffA);
            PG8_BAR; PG8_WAIT_L(0); PG8_MMA(1, 0, At, B0); PG8_BAR; PG8_SCHED;
            PG8_STAGE(PG8_SB(0, 1), b2 + hstep, voffB);
            PG8_WAIT_V(6); PG8_BAR; PG8_MMA(1, 1, At, B1); PG8_BAR;
            PG8_LDB(B0, 1, 0); PG8_SCHED; PG8_LDA(At, 1, 0); PG8_STAGE(PG8_SA(0, 1), a2 + hstep, voffA);
            PG8_WAIT_L(8); PG8_BAR; PG8_WAIT_L(0); PG8_MMA(0, 0, At, B0); PG8_BAR; PG8_SCHED;
            PG8_LDB(B1, 1, 1); PG8_STAGE(PG8_SB(1, 0), b3, voffB);
            PG8_BAR; PG8_WAIT_L(0); PG8_MMA(0, 1, At, B1); PG8_BAR;
            PG8_LDA(At, 1, 1); PG8_STAGE(PG8_SA(1, 0), a3, voffA);
            PG8_BAR; PG8_WAIT_L(0); PG8_MMA(1, 0, At, B0); PG8_BAR; PG8_SCHED;
            PG8_STAGE(PG8_SB(1, 1), b3 + hstep, voffB);
            PG8_WAIT_V(6); PG8_BAR; PG8_MMA(1, 1, At, B1); PG8_BAR;
            }
        }
        if constexpr (ALIGN_EPI) { if (wr == 0) PG8_BAR; }
        if constexpr (!Epi::AFTER_DRAIN) { E(acc, cur, wr, wc, fr, fq); S.done(cur); }
        if (!has_next) break;
#pragma unroll
        for (int a = 0; a < 2; ++a)
#pragma unroll
            for (int b = 0; b < 2; ++b)
#pragma unroll
                for (int m = 0; m < 4; ++m)
#pragma unroll
                    for (int n = 0; n < 2; ++n) acc[a][b][m][n] = (f32x4){0.f, 0.f, 0.f, 0.f};
        cur = nxt; cA = nA; cB = nB; ++ui;
        if constexpr (ALIGN_EPI) { if (wr == 1) PG8_BAR; }
    }
    PG8_WAIT_V(0);
    if constexpr (!ALIGN_EPI) { if (wr == 0) PG8_BAR; }
    PG8_BAR;
    if constexpr (Epi::AFTER_DRAIN) { E.fused(acc, cur, wr, wc, fr, fq, lds, wid, lane); S.done(cur); }
#undef PG8_SA
#undef PG8_SB
#undef PG8_STAGE
#undef PG8_LDA
#undef PG8_LDB
#undef PG8_MMA
#undef PG8_WAIT_V
#undef PG8_WAIT_L
#undef PG8_BAR
#undef PG8_SCHED
}
}
#define GAS __attribute__((address_space(1)))
#define LAS __attribute__((address_space(3)))
typedef unsigned short bf16;
typedef unsigned v4u __attribute__((ext_vector_type(4)));
typedef float f32x4 __attribute__((ext_vector_type(4)));
typedef short bf16x8 __attribute__((ext_vector_type(8)));
typedef GAS unsigned gu32;
typedef GAS unsigned long long gu64;
#define RLX_AGENT __ATOMIC_RELAXED, __HIP_MEMORY_SCOPE_AGENT
#define LDS_WAIT() asm volatile("s_waitcnt lgkmcnt(0)" ::: "memory")
#define VM_WAIT() asm volatile("s_waitcnt vmcnt(0)" ::: "memory")
__device__ __forceinline__ unsigned long long rt() { return __builtin_amdgcn_s_memrealtime(); }
__device__ __forceinline__ unsigned f2bf(float f) { unsigned u = __builtin_bit_cast(unsigned, f); return (u + 0x7fffu + ((u >> 16) & 1u)) >> 16; }
__device__ __forceinline__ unsigned pk2(float lo, float hi) { return f2bf(lo) | (f2bf(hi) << 16); }

#define XB_TMO      128
#define XB_XCNT(j)  (256  + 64 * (j))
#define XB_XSUB(j)  (1280 + 64 * (j))
#define XB_XGEN(j)  (2304 + 64 * (j))
#define XB_TOP      3328
#define XB_TOPGEN   3392
#define XCD_BAR_WORDS 3456
#define XB_SPIN_CAP (1u << 18)

__device__ __forceinline__ unsigned xb_ld(unsigned* p)              { return __hip_atomic_load(p, __ATOMIC_RELAXED, __HIP_MEMORY_SCOPE_AGENT); }
__device__ __forceinline__ unsigned xb_add(unsigned* p, unsigned v) { return __hip_atomic_fetch_add(p, v, __ATOMIC_RELAXED, __HIP_MEMORY_SCOPE_AGENT); }
__device__ __forceinline__ unsigned xb_xcc_id() { return (unsigned)__builtin_amdgcn_s_getreg((3 << 11) | 20) & 0xFu; }
#define XB_SPIN(cond, bar) do { unsigned _sp = 0; while (cond) { __builtin_amdgcn_s_sleep(1); \
    if ((++_sp & 255u) == 0u) { if (xb_ld(&(bar)[XB_TMO])) break; if (_sp > XB_SPIN_CAP) { atomicAdd(&(bar)[XB_TMO], 1u); break; } } } } while (0)

struct XcdBarrier {
    unsigned* bar; unsigned x;
    volatile LAS unsigned* st;
};

__device__ __forceinline__ XcdBarrier xcd_barrier_post(unsigned* bar, volatile LAS unsigned* st) {
    XcdBarrier b; b.bar = bar; b.x = xb_xcc_id(); b.st = st;
    if (threadIdx.x == 0) (void)xb_add(&bar[XB_XCNT(b.x)], 1u);
    return b;
}
__device__ __forceinline__ void xcd_barrier_complete(unsigned* bar, unsigned x, unsigned& nloc, unsigned& nx) {
    const unsigned G = gridDim.x * gridDim.y * gridDim.z;
    unsigned sum, cnt, mine, sp = 0u;
    for (;;) {
        sum = 0u; cnt = 0u; mine = 0u;
#pragma unroll
        for (unsigned j = 0; j < 16; ++j) { const unsigned c = xb_ld(&bar[XB_XCNT(j)]); sum += c; cnt += (c > 0u) ? 1u : 0u; mine = (j == x) ? c : mine; }
        if (sum == G) break;
        __builtin_amdgcn_s_sleep(1);
        if ((++sp & 255u) == 0u) { if (xb_ld(&bar[XB_TMO])) break; if (sp > XB_SPIN_CAP) { atomicAdd(&bar[XB_TMO], 1u); break; } }
    }
    nloc = mine > 0u ? mine : 1u; nx = cnt > 0u ? cnt : 1u;
}

__device__ __forceinline__ void xcd_barrier(const XcdBarrier& b) {
    asm volatile("s_waitcnt vmcnt(0)" ::: "memory");
    __syncthreads();
    if (threadIdx.x == 0) {
        unsigned* bar = b.bar;
        __builtin_amdgcn_s_waitcnt(0);
        unsigned nloc = b.st[0], nx = b.st[1];
        if (nloc == 0u) { xcd_barrier_complete(bar, b.x, nloc, nx); b.st[0] = nloc; b.st[1] = nx; }
        const unsigned old = xb_add(&bar[XB_XSUB(b.x)], 1u);
        const unsigned gen = old / nloc;
        if (old + 1u == (gen + 1u) * nloc) {
            __builtin_amdgcn_fence(__ATOMIC_RELEASE, "agent");
            asm volatile("s_waitcnt vmcnt(0)" ::: "memory");
            const unsigned og = xb_add(&bar[XB_TOP], 1u);
            const unsigned tg = og / nx;
            if (og + 1u == (tg + 1u) * nx) xb_add(&bar[XB_TOPGEN], 1u);
            else XB_SPIN(xb_ld(&bar[XB_TOPGEN]) == tg, bar);
            __builtin_amdgcn_fence(__ATOMIC_ACQUIRE, "agent");
            xb_add(&bar[XB_XGEN(b.x)], 1u);
            asm volatile("s_waitcnt vmcnt(0)" ::: "memory");
        } else {
            XB_SPIN(xb_ld(&bar[XB_XGEN(b.x)]) == gen, bar);
            __builtin_amdgcn_fence(__ATOMIC_ACQUIRE, "agent");
            asm volatile("s_waitcnt vmcnt(0)" ::: "memory");
        }
    }
    __syncthreads();
}

constexpr int NWAVES = 8, NTHR = 512;
constexpr int DM = 2048, MROWS = 12288, DEPTH = 4;
constexpr int INC = 5152, INP = 5376, FF = 5632, GU = 11264;
constexpr int NMOD = 6 * DM;
constexpr float EPS = 1e-6f;
constexpr int PC_QA = 0, PC_KA = 512, PC_VA = 768, PC_QD = 1024, PC_KD = 1536, PC_VD = 2048, PC_Z = 2560, PC_XBC = 3584, PC_DT = 5120;
constexpr int RC_QA = 0, RC_KA = 512, RC_QD = 768, RC_KD = 1280, RCW = 1792;
constexpr size_t OUT_AK = 25165824, OUT_AV = OUT_AK + 4194304, OUT_DK = OUT_AV + 4194304, OUT_DV = OUT_DK + 8388608, OUT_SF = OUT_DV + 8388608, OUT_SB = OUT_SF + 8388608;
constexpr size_t MiB = 1u << 20;
constexpr size_t WS_CTL = 0, CTL_ZERO_BYTES = 1 * MiB;
constexpr size_t WS_TAB = 1 * MiB, WS_MOD = 2 * MiB, WS_MODP = 3 * MiB;
constexpr size_t WS_WIN = 8 * MiB, WS_WOUT = 92 * MiB, WS_WGU = 124 * MiB, WS_WDN = 300 * MiB;
constexpr size_t WS_H = 388 * MiB, WS_U = 484 * MiB, WS_P = 532 * MiB, WS_MIX = 658 * MiB, WS_ACT = 706 * MiB, WS_QKR = 838 * MiB;
constexpr size_t WS_XBC = 866 * MiB, WS_DT = 938 * MiB, WS_YF = 940 * MiB, WS_YB = 988 * MiB, WS_END = 1036 * MiB;
constexpr int CW_BAR = 4096;
constexpr int RING_BYTES = 131072, LDSCTL_OFF = RING_BYTES, MISC_OFF = LDSCTL_OFF + 320, LDS_BYTES = 147456;

struct Params { const float* in[28]; float* out; unsigned char* ws; int ph_lo, ph_hi; };
typedef __attribute__((address_space(4))) const Params* PP;
struct Frame { LAS unsigned char* lds; int tid, lane, wave, vcu, G; };

__device__ __forceinline__ float wave_sum(float v) {
#pragma unroll
    for (int o = 1; o < 64; o <<= 1) v += __shfl_xor(v, o);
    return v;
}
__device__ __forceinline__ float wave_max(float v) {
#pragma unroll
    for (int o = 1; o < 64; o <<= 1) v = fmaxf(v, __shfl_xor(v, o));
    return v;
}
__device__ __forceinline__ float bflo(unsigned w) { return __uint_as_float(w << 16); }
__device__ __forceinline__ float bfhi(unsigned w) { return __uint_as_float(w & 0xffff0000u); }
__device__ __forceinline__ float bf1(bf16 b) { return __uint_as_float((unsigned)b << 16); }
__device__ __forceinline__ float silu(float x) { return x / (1.0f + __expf(-x)); }

__device__ __forceinline__ void p0_transpose_item(const float* W, int K, int N, bf16* WT, int rowmap, LAS float* scr, int item, int lane) {
    const int nblk = N / 32, kb = item / nblk, nb = item % nblk, k0 = 64 * kb, n0 = 32 * nb;
#pragma unroll 8
    for (int i = 0; i < 32; ++i) { const int kk = 2 * i + (lane >> 5); scr[kk * 33 + (lane & 31)] = W[(size_t)(k0 + kk) * N + n0 + (lane & 31)]; }
    LDS_WAIT(); asm volatile("" ::: "memory");
    int r0 = n0;
    if (rowmap) r0 = (n0 < FF) ? ((n0 >> 7) * 256 + (n0 & 127)) : (((n0 - FF) >> 7) * 256 + 128 + ((n0 - FF) & 127));
    const int c = lane & 7;
#pragma unroll
    for (int j = 0; j < 4; ++j) { const int n = (lane >> 3) + 8 * j; const LAS float* s = scr + (8 * c) * 33 + n;
        v4u o; o.x = pk2(s[0 * 33], s[1 * 33]); o.y = pk2(s[2 * 33], s[3 * 33]); o.z = pk2(s[4 * 33], s[5 * 33]); o.w = pk2(s[6 * 33], s[7 * 33]);
        *(v4u*)(WT + (size_t)(r0 + n) * K + k0 + 8 * c) = o; }
    LDS_WAIT(); asm volatile("" ::: "memory");
}
__device__ __forceinline__ void p0_prologue(Frame& F, PP p) {
    unsigned char* ws = p->ws;
    LAS float* scr = (LAS float*)(F.lds + F.wave * 16384);
    const int gw = F.vcu * NWAVES + F.wave, NGW = F.G * NWAVES;
    const int gt = F.vcu * NTHR + F.tid, NGT = F.G * NTHR;
    constexpr int I_IN = 32 * (INC / 32), I_OUT = 32 * 64, I_GU = 32 * (GU / 32), I_DN = (FF / 64) * 64, I_L = I_IN + I_OUT + I_GU + I_DN;
    for (int it = gw; it < DEPTH * I_L; it += NGW) {
        const int l = it / I_L; int r = it % I_L;
        if (r < I_IN) { p0_transpose_item(p->in[14] + (size_t)l * DM * INC, DM, INC, (bf16*)(ws + WS_WIN) + (size_t)l * INP * DM, 0, scr, r, F.lane); continue; } r -= I_IN;
        if (r < I_OUT) { p0_transpose_item(p->in[24] + (size_t)l * DM * DM, DM, DM, (bf16*)(ws + WS_WOUT) + (size_t)l * DM * DM, 0, scr, r, F.lane); continue; } r -= I_OUT;
        if (r < I_GU) { p0_transpose_item(p->in[25] + (size_t)l * DM * GU, DM, GU, (bf16*)(ws + WS_WGU) + (size_t)l * GU * DM, 1, scr, r, F.lane); continue; } r -= I_GU;
        p0_transpose_item(p->in[26] + (size_t)l * FF * DM, FF, DM, (bf16*)(ws + WS_WDN) + (size_t)l * DM * FF, 0, scr, r, F.lane);
    }
    { constexpr int PADV = (INP - INC) * DM * 2 / 16;
      for (int i = gt; i < DEPTH * PADV; i += NGT) { const int l = i / PADV, r = i % PADV;
          *((v4u*)((bf16*)(ws + WS_WIN) + (size_t)l * INP * DM + (size_t)INC * DM) + r) = (v4u){0u, 0u, 0u, 0u}; } }
    { const f32x4* xp = (const f32x4*)p->in[0]; const f32x4* xs = (const f32x4*)p->in[1]; f32x4* H = (f32x4*)(ws + WS_H);
      constexpr int NP4 = 4096 * DM / 4, NT4 = MROWS * DM / 4;
      for (int i = gt; i < NT4; i += NGT) H[i] = (i < NP4) ? xp[i] : xs[i - NP4]; }
    __syncthreads();
    { LAS float* sc = (LAS float*)F.lds;
      float* MODP = (float*)(ws + WS_MODP);
      for (int it = blockIdx.x; it < DEPTH * 8 * 24; it += F.G) {
          const int l = it / 192, r = it % 192, kc = r / 24, nc = r % 24;
          if (F.tid < 256) {
              const int k = kc * 256 + F.tid;
              sc[F.tid] = silu(p->in[9][k]); sc[256 + F.tid] = silu(p->in[8][k]); sc[512 + F.tid] = silu(p->in[8][DM + k]);
          }
          __syncthreads();
          const int n = nc * 512 + F.tid;
          const float* w = p->in[10] + ((size_t)l * DM + (size_t)kc * 256) * NMOD + n;
          float a0 = 0.f, a1 = 0.f, a2 = 0.f;
          for (int k = 0; k < 256; k += 8) {
              float wv[8];
#pragma unroll
              for (int e = 0; e < 8; ++e) wv[e] = w[(size_t)(k + e) * NMOD];
#pragma unroll
              for (int e = 0; e < 8; ++e) { a0 += sc[k + e] * wv[e]; a1 += sc[256 + k + e] * wv[e]; a2 += sc[512 + k + e] * wv[e]; }
          }
          float* o = MODP + ((size_t)(kc * DEPTH + l) * 3) * NMOD + n;
          o[0] = a0; o[NMOD] = a1; o[2 * NMOD] = a2;
          __syncthreads();
      } }
    if (blockIdx.x == F.G - 1) {
        float2* tabA = (float2*)(ws + WS_TAB); float2* tabB = (float2*)(ws + WS_TAB + 16384); float* lam = (float*)(ws + WS_TAB + 32768);
        for (int i = F.tid; i < 2048 + 1024; i += NTHR) {
            const bool isA = i < 2048; const int j = isA ? i : i - 2048; const int pos = isA ? (j >> 5) : (j >> 4), k = isA ? (j & 31) : (j & 15);
            double r = 10000.0; r = sqrt(r); r = sqrt(r); r = sqrt(r); r = sqrt(r); if (isA) r = sqrt(r);
            const double ri = 1.0 / r; double inv = 1.0; for (int q = 0; q < k; ++q) inv *= ri;
            const double ang = (double)pos * inv; const double TWO_PI = 6.283185307179586476925;
            const double x = ang - TWO_PI * rint(ang / TWO_PI), x2 = x * x;
            double st = x, ss = x, ct = 1.0, cs = 1.0;
            for (int q = 1; q <= 16; ++q) { st *= -x2 / (double)((2 * q) * (2 * q + 1)); ss += st; ct *= -x2 / (double)((2 * q - 1) * (2 * q)); cs += ct; }
            const float2 v = make_float2((float)cs, (float)ss);
            if (isA) tabA[j] = v; else tabB[j] = v;
        }
        if (F.tid < DEPTH) {
            const float* lv = p->in[16] + F.tid * 256; float s01 = 0.f, s23 = 0.f;
            for (int i = 0; i < 64; ++i) { s01 += lv[i] * lv[64 + i]; s23 += lv[128 + i] * lv[192 + i]; }
            const float li = 0.8f - 0.6f * expf(-0.3f * (float)F.tid);
            lam[F.tid] = expf(s01) - expf(s23) + li; lam[4 + F.tid] = li;
        }
    }
}
__device__ __forceinline__ void p0b_mod(Frame& F, PP p) {
    const int gt = F.vcu * NTHR + F.tid, NGT = F.G * NTHR;
    const float* MODP = (const float*)(p->ws + WS_MODP); float* MOD = (float*)(p->ws + WS_MOD);
    for (int i = gt; i < DEPTH * 3 * NMOD; i += NGT) {
        const int l = i / (3 * NMOD), n = i % NMOD;
        float s = p->in[11][l * NMOD + n];
#pragma unroll
        for (int kc = 0; kc < 8; ++kc) s += MODP[(size_t)kc * DEPTH * 3 * NMOD + i];
        MOD[i] = s;
    }
}
__device__ __forceinline__ void norm_phase(Frame& F, const float* H, const float* g, const float* modl, int shoff, int scoff, bf16* U) {
    const int gw = F.vcu * NWAVES + F.wave, NGW = F.G * NWAVES;
    for (int m = gw; m < MROWS; m += NGW) {
        const int c = m < 4096 ? 0 : (m < 8192 ? 1 : 2);
        const float* sh = modl + c * NMOD + shoff; const float* sc = modl + c * NMOD + scoff;
        const f32x4* xr = (const f32x4*)(H + (size_t)m * DM) + F.lane;
        f32x4 v[8]; float ss = 0.f;
#pragma unroll
        for (int j = 0; j < 8; ++j) { v[j] = xr[64 * j]; ss += (v[j].x * v[j].x + v[j].y * v[j].y) + (v[j].z * v[j].z + v[j].w * v[j].w); }
        const float rstd = 1.0f / sqrtf(wave_sum(ss) * (1.0f / DM) + EPS);
        unsigned long long* o8 = (unsigned long long*)(U + (size_t)m * DM) + F.lane;
#pragma unroll
        for (int j = 0; j < 8; ++j) { const int col = 4 * F.lane + 256 * j;
            const f32x4 gv = *(const f32x4*)(g + col), sv = *(const f32x4*)(sc + col), hv = *(const f32x4*)(sh + col);
            const f32x4 o = (v[j] * rstd) * gv * (sv + 1.0f) + hv;
            o8[64 * j] = (unsigned long long)pk2(o.x, o.y) | ((unsigned long long)pk2(o.z, o.w) << 32); }
    }
}
__device__ __forceinline__ void final_phase(Frame& F, const float* H, const float* g, float* out) {
    const int gw = F.vcu * NWAVES + F.wave, NGW = F.G * NWAVES;
    for (int m = gw; m < MROWS; m += NGW) {
        const f32x4* xr = (const f32x4*)(H + (size_t)m * DM) + F.lane;
        f32x4 v[8]; float ss = 0.f;
#pragma unroll
        for (int j = 0; j < 8; ++j) { v[j] = xr[64 * j]; ss += (v[j].x * v[j].x + v[j].y * v[j].y) + (v[j].z * v[j].z + v[j].w * v[j].w); }
        const float rstd = 1.0f / sqrtf(wave_sum(ss) * (1.0f / DM) + EPS);
        f32x4* o = (f32x4*)(out + (size_t)m * DM) + F.lane;
#pragma unroll
        for (int j = 0; j < 8; ++j) { const f32x4 gv = *(const f32x4*)(g + 4 * F.lane + 256 * j); o[64 * j] = (v[j] * rstd) * gv; }
    }
}
__device__ __forceinline__ void prep_phase(Frame& F, PP p, int l) {
    unsigned char* ws = p->ws;
    const bf16* P = (const bf16*)(ws + WS_P); bf16* QKR = (bf16*)(ws + WS_QKR); float* XBC = (float*)(ws + WS_XBC); float* DT = (float*)(ws + WS_DT);
    const float2* tabA = (const float2*)(ws + WS_TAB); const float2* tabB = (const float2*)(ws + WS_TAB + 16384);
    const float* cw = p->in[18] + (size_t)l * 5 * 1536; const float* cb = p->in[19] + (size_t)l * 1536; const float* dtb = p->in[20] + l * 32;
    const int gw = F.vcu * NWAVES + F.wave, NGW = F.G * NWAVES, lane = F.lane;
    for (int m = gw; m < MROWS; m += NGW) {
        const bf16* prow = P + (size_t)m * INP;
        const int s0 = m < 4096 ? (m & ~255) : (4096 + ((m - 4096) & ~4095)); const int len = m < 4096 ? 256 : 4096; const int t = m - s0;
#pragma unroll
        for (int j = 0; j < 3; ++j) { const int c0 = 8 * lane + 512 * j;
            f32x4 a0 = *(const f32x4*)(cb + c0), a1 = *(const f32x4*)(cb + c0 + 4);
#pragma unroll
            for (int k = 0; k < 5; ++k) { const int tt = t + k - 2;
                if (tt >= 0 && tt < len) { const v4u raw = *(const v4u*)(P + (size_t)(s0 + tt) * INP + PC_XBC + c0);
                    const f32x4 w0 = *(const f32x4*)(cw + k * 1536 + c0), w1 = *(const f32x4*)(cw + k * 1536 + c0 + 4);
                    a0.x += w0.x * bflo(raw.x); a0.y += w0.y * bfhi(raw.x); a0.z += w0.z * bflo(raw.y); a0.w += w0.w * bfhi(raw.y);
                    a1.x += w1.x * bflo(raw.z); a1.y += w1.y * bfhi(raw.z); a1.z += w1.z * bflo(raw.w); a1.w += w1.w * bfhi(raw.w); } }
            a0.x = silu(a0.x); a0.y = silu(a0.y); a0.z = silu(a0.z); a0.w = silu(a0.w); a1.x = silu(a1.x); a1.y = silu(a1.y); a1.z = silu(a1.z); a1.w = silu(a1.w);
            *(f32x4*)(XBC + (size_t)m * 1536 + c0) = a0; *(f32x4*)(XBC + (size_t)m * 1536 + c0 + 4) = a1; }
        if (lane < 32) { const float v = bf1(prow[PC_DT + lane]) + dtb[lane]; DT[(size_t)m * 32 + lane] = v > 20.f ? v : log1pf(__expf(v)); }
        if (m >= 4096) {
            const int gr = t >> 6, gc = t & 63; bf16* qrow = QKR + (size_t)(m - 4096) * RCW;
#pragma unroll
            for (int i = 0; i < 6; ++i) { const int d = lane; const int src = (i < 4 ? PC_QA + i * 128 : PC_KA + (i - 4) * 128) + d, dst = (i < 4 ? RC_QA + i * 128 : RC_KA + (i - 4) * 128) + d;
                const float x1 = bf1(prow[src]), x2 = bf1(prow[src + 64]); const float2 cs = d < 32 ? tabA[gr * 32 + d] : tabA[gc * 32 + d - 32];
                qrow[dst] = (bf16)f2bf(x1 * cs.x - x2 * cs.y); qrow[dst + 64] = (bf16)f2bf(x1 * cs.y + x2 * cs.x); }
#pragma unroll
            for (int i = 0; i < 8; ++i) { const int pp = lane + 64 * i, ch = pp >> 5, d = pp & 31; const int src = (ch < 8 ? PC_QD + ch * 64 : PC_KD + (ch - 8) * 64) + d, dst = (ch < 8 ? RC_QD + ch * 64 : RC_KD + (ch - 8) * 64) + d;
                const float x1 = bf1(prow[src]), x2 = bf1(prow[src + 32]); const float2 cs = d < 16 ? tabB[gr * 16 + d] : tabB[gc * 16 + d - 16];
                qrow[dst] = (bf16)f2bf(x1 * cs.x - x2 * cs.y); qrow[dst + 32] = (bf16)f2bf(x1 * cs.y + x2 * cs.x); }
        } else {
            const int b = m >> 8, s = m & 255; const size_t r = (size_t)((b * DEPTH + l) * 256 + s);
            { const unsigned long long w = *((const unsigned long long*)(prow + PC_KA) + lane); *((f32x4*)(p->out + OUT_AK + r * 256) + lane) = (f32x4){bflo((unsigned)w), bfhi((unsigned)w), bflo((unsigned)(w >> 32)), bfhi((unsigned)(w >> 32))}; }
            { const unsigned long long w = *((const unsigned long long*)(prow + PC_VA) + lane); *((f32x4*)(p->out + OUT_AV + r * 256) + lane) = (f32x4){bflo((unsigned)w), bfhi((unsigned)w), bflo((unsigned)(w >> 32)), bfhi((unsigned)(w >> 32))}; }
            { const v4u w = *((const v4u*)(prow + PC_KD) + lane); f32x4* o = (f32x4*)(p->out + OUT_DK + r * 512) + 2 * lane; o[0] = (f32x4){bflo(w.x), bfhi(w.x), bflo(w.y), bfhi(w.y)}; o[1] = (f32x4){bflo(w.z), bfhi(w.z), bflo(w.w), bfhi(w.w)}; }
            { const v4u w = *((const v4u*)(prow + PC_VD) + lane); f32x4* o = (f32x4*)(p->out + OUT_DV + r * 512) + 2 * lane; o[0] = (f32x4){bflo(w.x), bfhi(w.x), bflo(w.y), bfhi(w.y)}; o[1] = (f32x4){bflo(w.z), bfhi(w.z), bflo(w.w), bfhi(w.w)}; }
        }
    }
}
constexpr int AT_KT = 0, AT_VT = 16640, AT_QS = 33024;
struct Seg { const void* k; const void* v; int ks, vs, n, f32, pos0; };

__device__ __forceinline__ void attn_stage_kv(Frame& F, const Seg& sg, int key0) {
    const int key = F.tid >> 3, ch = F.tid & 7;
    LAS unsigned* kd = (LAS unsigned*)(F.lds + AT_KT + key * 260 + ch * 32);
    LAS v4u* vd = (LAS v4u*)(F.lds + AT_VT + key * 256 + ch * 32);
    if (sg.f32) {
        const f32x4* ks = (const f32x4*)((const float*)sg.k + (size_t)(key0 + key) * sg.ks + ch * 16);
        const f32x4* vs = (const f32x4*)((const float*)sg.v + (size_t)(key0 + key) * sg.vs + ch * 16);
        const f32x4 k0 = ks[0], k1 = ks[1], k2 = ks[2], k3 = ks[3], v0 = vs[0], v1 = vs[1], v2 = vs[2], v3 = vs[3];
        kd[0] = pk2(k0.x, k0.y); kd[1] = pk2(k0.z, k0.w); kd[2] = pk2(k1.x, k1.y); kd[3] = pk2(k1.z, k1.w); kd[4] = pk2(k2.x, k2.y); kd[5] = pk2(k2.z, k2.w); kd[6] = pk2(k3.x, k3.y); kd[7] = pk2(k3.z, k3.w);
        vd[0] = (v4u){pk2(v0.x, v0.y), pk2(v0.z, v0.w), pk2(v1.x, v1.y), pk2(v1.z, v1.w)}; vd[1] = (v4u){pk2(v2.x, v2.y), pk2(v2.z, v2.w), pk2(v3.x, v3.y), pk2(v3.z, v3.w)};
    } else {
        const v4u* ks = (const v4u*)((const bf16*)sg.k + (size_t)(key0 + key) * sg.ks + ch * 16);
        const v4u* vs = (const v4u*)((const bf16*)sg.v + (size_t)(key0 + key) * sg.vs + ch * 16);
        const v4u k0 = ks[0], k1 = ks[1];
        kd[0] = k0.x; kd[1] = k0.y; kd[2] = k0.z; kd[3] = k0.w; kd[4] = k1.x; kd[5] = k1.y; kd[6] = k1.z; kd[7] = k1.w;
        vd[0] = vs[0]; vd[1] = vs[1];
    }
}
template <int NJ>
__device__ __forceinline__ void attn_seg(Frame& F, const Seg& sg, int qpos0, float (&mx)[4][2], float (&ls)[4][2], float (&o)[4][2][2]) {
    const LAS float* Qs = (const LAS float*)(F.lds + AT_QS);
    for (int key0 = 0; key0 < sg.n; key0 += 64) {
        __syncthreads();
        attn_stage_kv(F, sg, key0);
        __syncthreads();
        float sl[4], sh[4];
#pragma unroll
        for (int qi = 0; qi < 4; ++qi) { sl[qi] = 0.f; sh[qi] = 0.f; }
        const LAS unsigned* kr = (const LAS unsigned*)(F.lds + AT_KT + F.lane * 260);
#pragma unroll 8
        for (int dp = 0; dp < 32; ++dp) { const unsigned w = kr[dp]; const float k0 = bflo(w), k1 = bfhi(w);
#pragma unroll
            for (int qi = 0; qi < 4; ++qi) { const LAS float* q = Qs + (qi * 8 + F.wave) * 128 + 2 * dp; sl[qi] += q[0] * k0 + q[1] * k1; } }
#pragma unroll 8
        for (int dp = 32; dp < 64; ++dp) { const unsigned w = kr[dp]; const float k0 = bflo(w), k1 = bfhi(w);
#pragma unroll
            for (int qi = 0; qi < 4; ++qi) { const LAS float* q = Qs + (qi * 8 + F.wave) * 128 + 2 * dp; sh[qi] += q[0] * k0 + q[1] * k1; } }
        float pr[4][2];
#pragma unroll
        for (int qi = 0; qi < 4; ++qi) {
            bool valid = true;
            if (sg.pos0 >= 0) { const int dlt = (qpos0 + qi * 8 + F.wave) - (sg.pos0 + key0 + F.lane); valid = (dlt <= 128) && (dlt >= -128); }
#pragma unroll
            for (int j = 0; j < NJ; ++j) {
                const float s = (NJ == 1) ? (sl[qi] + sh[qi]) : (j == 0 ? sl[qi] : sh[qi]);
                const float mt = wave_max(valid ? s : -1e30f);
                const float mn = fmaxf(mx[qi][j], mt);
                const float pe = valid ? __expf(s - mn) : 0.f;
                const float scl = __expf(mx[qi][j] - mn);
                ls[qi][j] = ls[qi][j] * scl + wave_sum(pe);
                o[qi][j][0] *= scl; o[qi][j][1] *= scl; mx[qi][j] = mn; pr[qi][j] = pe;
            }
        }
        const LAS unsigned* vr = (const LAS unsigned*)(F.lds + AT_VT) + F.lane;
#pragma unroll 16
        for (int key = 0; key < 64; ++key) { const unsigned w = vr[key * 64]; const float v0 = bflo(w), v1 = bfhi(w);
#pragma unroll
            for (int qi = 0; qi < 4; ++qi)
#pragma unroll
                for (int j = 0; j < NJ; ++j) { const float pk = __shfl(pr[qi][j], key); o[qi][j][0] += pk * v0; o[qi][j][1] += pk * v1; } }
    }
}
template <int MODE>
__device__ __forceinline__ void attn_unit(Frame& F, const bf16* qsrc, int qstride, const Seg& s0, const Seg& s1, bool two, int qpos0, float scale,
                                          float sink, float lam, float onems, const float* dnorm, bf16* dst, int dstride) {
    constexpr int NJ = MODE == 0 ? 1 : 2;
    __syncthreads();
    { const int qq = F.tid >> 4, ch = F.tid & 15; const v4u w = *(const v4u*)(qsrc + (size_t)qq * qstride + ch * 8);
      LAS f32x4* qd = (LAS f32x4*)(F.lds + AT_QS + (qq * 128 + ch * 8) * 4);
      qd[0] = (f32x4){bflo(w.x) * scale, bfhi(w.x) * scale, bflo(w.y) * scale, bfhi(w.y) * scale}; qd[1] = (f32x4){bflo(w.z) * scale, bfhi(w.z) * scale, bflo(w.w) * scale, bfhi(w.w) * scale}; }
    float mx[4][2], ls[4][2], o[4][2][2];
#pragma unroll
    for (int qi = 0; qi < 4; ++qi)
#pragma unroll
        for (int j = 0; j < 2; ++j) { mx[qi][j] = -1e30f; ls[qi][j] = 0.f; o[qi][j][0] = 0.f; o[qi][j][1] = 0.f; }
    attn_seg<NJ>(F, s0, qpos0, mx, ls, o);
    if (two) attn_seg<NJ>(F, s1, qpos0, mx, ls, o);
#pragma unroll
    for (int qi = 0; qi < 4; ++qi) { float r0, r1;
        if (MODE == 0) { const float li = 1.0f / (ls[qi][0] + __expf(sink - mx[qi][0])); r0 = o[qi][0][0] * li; r1 = o[qi][0][1] * li; }
        else { const float l0 = 1.0f / ls[qi][0], l1 = lam / ls[qi][1]; r0 = o[qi][0][0] * l0 - o[qi][1][0] * l1; r1 = o[qi][0][1] * l0 - o[qi][1][1] * l1;
               const float rs = 1.0f / sqrtf(wave_sum(r0 * r0 + r1 * r1) * (1.0f / 128.0f) + EPS); r0 = r0 * rs * dnorm[2 * F.lane] * onems; r1 = r1 * rs * dnorm[2 * F.lane + 1] * onems; }
        *((unsigned*)(dst + (size_t)(qi * 8 + F.wave) * dstride) + F.lane) = pk2(r0, r1); }
}
constexpr int SS_X = 0, SS_B = 16384, SS_C = 49152, SS_DT = 81920;
__device__ __forceinline__ void ssd_unit(Frame& F, PP p, int l, int seq, int hd, int dir) {
    unsigned char* ws = p->ws; const float* XBC = (const float*)(ws + WS_XBC); const float* DT = (const float*)(ws + WS_DT);
    float* Y = (float*)(ws + (dir ? WS_YB : WS_YF));
    const int s0 = seq < 16 ? seq * 256 : 4096 + (seq - 16) * 4096, len = seq < 16 ? 256 : 4096, g = hd >> 3;
    const int pp = F.tid >> 3, nq = F.tid & 7;
    const float a = -__expf(p->in[21][(l * 2 + dir) * 16 + hd]);
    f32x4 h[4];
    if (seq < 16) { h[0] = h[1] = h[2] = h[3] = (f32x4){0.f, 0.f, 0.f, 0.f}; }
    else { const f32x4* hs = (const f32x4*)(p->in[dir ? 7 : 6] + ((((size_t)(seq - 16) * DEPTH + l) * 16 + hd) * 64 + pp) * 128 + nq * 16);
           h[0] = hs[0]; h[1] = hs[1]; h[2] = hs[2]; h[3] = hs[3]; }
    LAS float* xs = (LAS float*)(F.lds + SS_X); LAS float* Bs = (LAS float*)(F.lds + SS_B); LAS float* Cs = (LAS float*)(F.lds + SS_C); LAS float* dts = (LAS float*)(F.lds + SS_DT);
    for (int c = 0; c < len; c += 64) {
        __syncthreads();
#pragma unroll
        for (int r = 0; r < 10; ++r) { const int idx = F.tid + NTHR * r, i = idx / 80, q = idx % 80; const int t = dir ? (len - 1 - (c + i)) : (c + i);
            const float* row = XBC + (size_t)(s0 + t) * 1536;
            if (q < 16) *(LAS f32x4*)(xs + i * 64 + 4 * q) = *(const f32x4*)(row + hd * 64 + 4 * q);
            else if (q < 48) *(LAS f32x4*)(Bs + i * 128 + 4 * (q - 16)) = *(const f32x4*)(row + 1024 + g * 128 + 4 * (q - 16));
            else *(LAS f32x4*)(Cs + i * 128 + 4 * (q - 48)) = *(const f32x4*)(row + 1280 + g * 128 + 4 * (q - 48)); }
        if (F.tid < 64) { const int t = dir ? (len - 1 - (c + F.tid)) : (c + F.tid); dts[F.tid] = DT[(size_t)(s0 + t) * 32 + dir * 16 + hd]; }
        __syncthreads();
        for (int i = 0; i < 64; ++i) {
            const float dt = dts[i], dec = __expf(dt * a), xv = xs[i * 64 + pp] * dt;
            const LAS f32x4* bp = (const LAS f32x4*)(Bs + i * 128 + nq * 16); const LAS f32x4* cp = (const LAS f32x4*)(Cs + i * 128 + nq * 16);
            float y = 0.f;
#pragma unroll
            for (int k = 0; k < 4; ++k) { const f32x4 bv = bp[k], cv = cp[k]; h[k] = h[k] * dec + bv * xv; y += (cv.x * h[k].x + cv.y * h[k].y) + (cv.z * h[k].z + cv.w * h[k].w); }
            y += __shfl_xor(y, 1); y += __shfl_xor(y, 2); y += __shfl_xor(y, 4);
            if (nq == 0) { const int t = dir ? (len - 1 - (c + i)) : (c + i); Y[(size_t)(s0 + t) * 1024 + hd * 64 + pp] = y; }
        }
    }
    if (seq < 16) { f32x4* ho = (f32x4*)(p->out + (dir ? OUT_SB : OUT_SF) + ((((size_t)seq * DEPTH + l) * 16 + hd) * 64 + pp) * 128 + nq * 16);
        ho[0] = h[0]; ho[1] = h[1]; ho[2] = h[2]; ho[3] = h[3]; }
}
__device__ __forceinline__ void mix1_phase(Frame& F, PP p, int l) {
    unsigned char* ws = p->ws;
    const bf16* P = (const bf16*)(ws + WS_P); const bf16* QKR = (const bf16*)(ws + WS_QKR); bf16* MIX = (bf16*)(ws + WS_MIX);
    const float* lamv = (const float*)(ws + WS_TAB + 32768);
    const float lam = lamv[l], onems = 1.0f - lamv[4 + l];
    const float* dnorm = p->in[17] + l * 128;
    constexpr int U_SL = 64, U_SC = 512, U_BL = 1024, U_BC = 512, U_AL = 1024, U_AC = 512, U_ALL = U_SL + U_SC + U_BL + U_BC + U_AL + U_AC;
    for (int u = blockIdx.x; u < U_ALL; u += F.G) {
        int r = u;
        if (r < U_SL) { ssd_unit(F, p, l, 16 + (r >> 5), (r >> 1) & 15, r & 1); continue; } r -= U_SL;
        if (r < U_SC) { ssd_unit(F, p, l, r >> 5, (r >> 1) & 15, r & 1); continue; } r -= U_SC;
        if (r < U_BL) {
            const int b = r >> 9, h = (r >> 7) & 3, qb = r & 127; const int ml = b * 4096 + qb * 32;
            Seg s0{QKR + (size_t)(b * 4096) * RCW + RC_KD + h * 128, P + (size_t)(4096 + b * 4096) * INP + PC_VD + h * 128, RCW, INP, 4096, 0, -1};
            Seg s1{p->in[4] + ((size_t)(b * DEPTH + l) * 256) * 512 + h * 128, p->in[5] + ((size_t)(b * DEPTH + l) * 256) * 512 + h * 128, 512, 512, 256, 1, -1};
            attn_unit<1>(F, QKR + (size_t)ml * RCW + RC_QD + h * 128, RCW, s0, s1, true, 0, 0.125f, 0.f, lam, onems, dnorm, MIX + (size_t)(4096 + ml) * DM + 512 + h * 128, DM);
            continue; } r -= U_BL;
        if (r < U_BC) {
            const int b = r >> 5, h = (r >> 3) & 3, qb = r & 7; const int m0 = b * 256 + qb * 32;
            Seg s0{P + (size_t)(b * 256) * INP + PC_KD + h * 128, P + (size_t)(b * 256) * INP + PC_VD + h * 128, INP, INP, 256, 0, -1};
            attn_unit<1>(F, P + (size_t)m0 * INP + PC_QD + h * 128, INP, s0, s0, false, 0, 0.125f, 0.f, lam, onems, dnorm, MIX + (size_t)m0 * DM + 512 + h * 128, DM);
            continue; } r -= U_BC;
        const float scA = 0.08838834764831845f;
        if (r < U_AL) {
            const int b = r >> 9, h = (r >> 7) & 3, qb = r & 127, kv = h >> 1; const int ml = b * 4096 + qb * 32;
            const int qblk = qb >> 2; const int w0 = qblk * 128 - 128 < 0 ? 0 : qblk * 128 - 128, w1 = qblk * 128 + 256 > 4096 ? 4096 : qblk * 128 + 256;
            Seg s0{p->in[2] + ((size_t)(b * DEPTH + l) * 256) * 256 + kv * 128, p->in[3] + ((size_t)(b * DEPTH + l) * 256) * 256 + kv * 128, 256, 256, 256, 1, -1};
            Seg s1{QKR + (size_t)(b * 4096 + w0) * RCW + RC_KA + kv * 128, P + (size_t)(4096 + b * 4096 + w0) * INP + PC_VA + kv * 128, RCW, INP, w1 - w0, 0, w0};
            attn_unit<0>(F, QKR + (size_t)ml * RCW + RC_QA + h * 128, RCW, s0, s1, true, qb * 32, scA, p->in[15][l * 4 + h], 0.f, 0.f, dnorm, MIX + (size_t)(4096 + ml) * DM + h * 128, DM);
            continue; } r -= U_AL;
        {
            const int b = r >> 5, h = (r >> 3) & 3, qb = r & 7, kv = h >> 1; const int m0 = b * 256 + qb * 32;
            Seg s0{P + (size_t)(b * 256) * INP + PC_KA + kv * 128, P + (size_t)(b * 256) * INP + PC_VA + kv * 128, INP, INP, 256, 0, -1};
            attn_unit<0>(F, P + (size_t)m0 * INP + PC_QA + h * 128, INP, s0, s0, false, 0, scA, p->in[15][l * 4 + h], 0.f, 0.f, dnorm, MIX + (size_t)m0 * DM + h * 128, DM);
        }
    }
}
__device__ __forceinline__ void mix2_phase(Frame& F, PP p, int l) {
    unsigned char* ws = p->ws;
    const bf16* P = (const bf16*)(ws + WS_P); const float* XBC = (const float*)(ws + WS_XBC); const float* YF = (const float*)(ws + WS_YF); const float* YB = (const float*)(ws + WS_YB); bf16* MIX = (bf16*)(ws + WS_MIX);
    const float* dsk = p->in[22] + l * 16; const float* sn = p->in[23] + l * 1024;
    const int gw = F.vcu * NWAVES + F.wave, NGW = F.G * NWAVES, lane = F.lane;
    for (int m = gw; m < MROWS; m += NGW) {
        const int c0 = lane * 16; const float dk = dsk[c0 >> 6];
        const v4u z0 = *(const v4u*)(P + (size_t)m * INP + PC_Z + c0), z1 = *(const v4u*)(P + (size_t)m * INP + PC_Z + c0 + 8);
        float zz[16] = {bflo(z0.x), bfhi(z0.x), bflo(z0.y), bfhi(z0.y), bflo(z0.z), bfhi(z0.z), bflo(z0.w), bfhi(z0.w), bflo(z1.x), bfhi(z1.x), bflo(z1.y), bfhi(z1.y), bflo(z1.z), bfhi(z1.z), bflo(z1.w), bfhi(z1.w)};
        float y[16]; float ss = 0.f;
#pragma unroll
        for (int q = 0; q < 4; ++q) { const f32x4 a = *(const f32x4*)(YF + (size_t)m * 1024 + c0 + 4 * q), b = *(const f32x4*)(YB + (size_t)m * 1024 + c0 + 4 * q), x = *(const f32x4*)(XBC + (size_t)m * 1536 + c0 + 4 * q);
            const f32x4 v = a + b + x * dk;
            y[4 * q + 0] = v.x * silu(zz[4 * q + 0]); y[4 * q + 1] = v.y * silu(zz[4 * q + 1]); y[4 * q + 2] = v.z * silu(zz[4 * q + 2]); y[4 * q + 3] = v.w * silu(zz[4 * q + 3]); }
#pragma unroll
        for (int e = 0; e < 16; ++e) ss += y[e] * y[e];
#pragma unroll
        for (int o = 1; o < 32; o <<= 1) ss += __shfl_xor(ss, o);
        const float rs = 1.0f / sqrtf(ss * (1.0f / 512.0f) + EPS);
        v4u o0, o1;
        { const f32x4 g0 = *(const f32x4*)(sn + c0), g1 = *(const f32x4*)(sn + c0 + 4), g2 = *(const f32x4*)(sn + c0 + 8), g3 = *(const f32x4*)(sn + c0 + 12);
          o0.x = pk2(y[0] * rs * g0.x, y[1] * rs * g0.y); o0.y = pk2(y[2] * rs * g0.z, y[3] * rs * g0.w); o0.z = pk2(y[4] * rs * g1.x, y[5] * rs * g1.y); o0.w = pk2(y[6] * rs * g1.z, y[7] * rs * g1.w);
          o1.x = pk2(y[8] * rs * g2.x, y[9] * rs * g2.y); o1.y = pk2(y[10] * rs * g2.z, y[11] * rs * g2.w); o1.z = pk2(y[12] * rs * g3.x, y[13] * rs * g3.y); o1.w = pk2(y[14] * rs * g3.z, y[15] * rs * g3.w); }
        *(v4u*)(MIX + (size_t)m * DM + 1024 + c0) = o0; *(v4u*)(MIX + (size_t)m * DM + 1024 + c0 + 8) = o1;
    }
}

#ifndef MK_ONE_LAUNCH
#define MK_ONE_LAUNCH 1
#endif
constexpr int PH_PER_LAYER = 9, PH_TOTAL = 2 + DEPTH * PH_PER_LAYER + 1;
__global__ void __launch_bounds__(NTHR, 2) mk_fwd(Params p_) {
    extern __shared__ __attribute__((aligned(16))) unsigned char lds[];
    Frame F;
    F.lds = (LAS unsigned char*)lds;
    F.tid = threadIdx.x; F.lane = F.tid & 63; F.wave = __builtin_amdgcn_readfirstlane(F.tid >> 6);
    F.G = gridDim.x; { const int bx = blockIdx.x; F.vcu = (F.G % 8 == 0) ? (bx % 8) * (F.G / 8) + bx / 8 : bx; }
    PP p = (PP)__builtin_amdgcn_kernarg_segment_ptr();
    for (int u = F.tid; u < (LDS_BYTES - LDSCTL_OFF) / 4; u += NTHR) ((LAS unsigned*)(F.lds + LDSCTL_OFF))[u] = 0u;
    __syncthreads();
    XcdBarrier bar; bar.bar = (unsigned*)(p->ws + WS_CTL) + CW_BAR; bar.x = 0; bar.st = nullptr;
#if MK_ONE_LAUNCH
    bar = xcd_barrier_post((unsigned*)(p->ws + WS_CTL) + CW_BAR, (volatile LAS unsigned*)(F.lds + MISC_OFF) + 8);
#define GRID_BAR() xcd_barrier(bar)
#else
#define GRID_BAR() do {} while (0)
#endif
    const int lo = p->ph_lo, hi = p->ph_hi;
#define IN(k) (lo <= (k) && (k) < hi)
#define SEAM(k) do { if (IN(k) && IN((k) + 1)) GRID_BAR(); } while (0)
#define ENTER() do { int t_ = threadIdx.x; asm volatile("" : "+v"(t_)); F.tid = t_; F.lane = t_ & 63; F.wave = __builtin_amdgcn_readfirstlane(t_ >> 6); asm volatile("" : "+s"(p)); ws = p->ws; } while (0)
    unsigned char* ws;

    if (IN(0)) { ENTER(); p0_prologue(F, p); } SEAM(0);
    if (IN(1)) { ENTER(); p0b_mod(F, p); } SEAM(1);
#pragma unroll 1
    for (int l = 0; l < DEPTH; ++l) {
        const int pb = 2 + l * PH_PER_LAYER;
        if (IN(pb + 0)) { ENTER(); norm_phase(F, (const float*)(ws + WS_H), p->in[12] + l * DM, (const float*)(ws + WS_MOD) + (size_t)l * 3 * NMOD, 0, DM, (bf16*)(ws + WS_U)); } SEAM(pb + 0);
        if (IN(pb + 1)) { ENTER();
            pg8::Gemm g{(const bf16*)(ws + WS_U), (const bf16*)(ws + WS_WIN) + (size_t)l * INP * DM, MROWS, INP, DM}; pg8::StaticOrder S; S.init(MROWS, INP, F.G, (int)blockIdx.x);
            pg8::EpiBf16 E{(bf16*)(ws + WS_P), INP};
            pg8::gemm_phase<pg8::EpiBf16, pg8::StaticOrder, true, true>(F.lds, g, S, E);
        } SEAM(pb + 1);
        if (IN(pb + 2)) { ENTER(); prep_phase(F, p, l); } SEAM(pb + 2);
        if (IN(pb + 3)) { ENTER(); mix1_phase(F, p, l); } SEAM(pb + 3);
        if (IN(pb + 4)) { ENTER(); mix2_phase(F, p, l); } SEAM(pb + 4);
        if (IN(pb + 5)) { ENTER();
            pg8::Gemm g{(const bf16*)(ws + WS_MIX), (const bf16*)(ws + WS_WOUT) + (size_t)l * DM * DM, MROWS, DM, DM}; pg8::StaticOrder S; S.init(MROWS, DM, F.G, (int)blockIdx.x);
            pg8::EpiResid E{(float*)(ws + WS_H), DM, (const float*)(ws + WS_MOD) + (size_t)l * 3 * NMOD + 2 * DM, NMOD};
            pg8::gemm_phase<pg8::EpiResid, pg8::StaticOrder, true, true>(F.lds, g, S, E);
        } SEAM(pb + 5);
        if (IN(pb + 6)) { ENTER(); norm_phase(F, (const float*)(ws + WS_H), p->in[13] + l * DM, (const float*)(ws + WS_MOD) + (size_t)l * 3 * NMOD, 3 * DM, 4 * DM, (bf16*)(ws + WS_U)); } SEAM(pb + 6);
        if (IN(pb + 7)) { ENTER();
            pg8::Gemm g{(const bf16*)(ws + WS_U), (const bf16*)(ws + WS_WGU) + (size_t)l * GU * DM, MROWS, GU, DM}; pg8::StaticOrder S; S.init(MROWS, GU, F.G, (int)blockIdx.x);
            pg8::EpiSwiGLU E{(bf16*)(ws + WS_ACT), FF};
            pg8::gemm_phase<pg8::EpiSwiGLU, pg8::StaticOrder, true, true>(F.lds, g, S, E);
        } SEAM(pb + 7);
        if (IN(pb + 8)) { ENTER();
            pg8::Gemm g{(const bf16*)(ws + WS_ACT), (const bf16*)(ws + WS_WDN) + (size_t)l * DM * FF, MROWS, DM, FF}; pg8::StaticOrder S; S.init(MROWS, DM, F.G, (int)blockIdx.x);
            pg8::EpiResid E{(float*)(ws + WS_H), DM, (const float*)(ws + WS_MOD) + (size_t)l * 3 * NMOD + 5 * DM, NMOD};
            pg8::gemm_phase<pg8::EpiResid, pg8::StaticOrder, true, true>(F.lds, g, S, E);
        } SEAM(pb + 8);
    }
    if (IN(PH_TOTAL - 1)) { ENTER(); final_phase(F, (const float*)(ws + WS_H), p->in[27], p->out); }
#undef IN
#undef SEAM
#undef ENTER
}

extern "C" void kernel_launch(void* const* d_in, const int* in_sizes, int n_in, void* d_out, int out_size, void* d_ws, size_t ws_size, hipStream_t stream) {
    static int grid = 0;
    if (grid == 0) {
        if (n_in != 28 || out_size != 67108864 || ws_size < WS_END) { fprintf(stderr, "kernel_launch: unexpected sizes n_in %d out %d ws %zu\n", n_in, out_size, ws_size); grid = -1; return; }
        int dev = 0, cus = 0, per_cu = 0;
        if (hipGetDevice(&dev) != hipSuccess || hipDeviceGetAttribute(&cus, hipDeviceAttributeMultiprocessorCount, dev) != hipSuccess) { grid = -1; return; }
        if (hipFuncSetAttribute((const void*)mk_fwd, hipFuncAttributeMaxDynamicSharedMemorySize, LDS_BYTES) != hipSuccess) { fprintf(stderr, "kernel_launch: hipFuncSetAttribute failed\n"); grid = -1; return; }
        if (hipOccupancyMaxActiveBlocksPerMultiprocessor(&per_cu, (const void*)mk_fwd, NTHR, LDS_BYTES) != hipSuccess || per_cu < 1)
            fprintf(stderr, "kernel_launch: occupancy query reports %d workgroups per CU\n", per_cu);
        (void)hipGetLastError();
        grid = cus;
    }
    if (grid < 0) return;
    if (hipMemsetAsync((char*)d_ws + WS_CTL, 0, CTL_ZERO_BYTES, stream) != hipSuccess) return;
    Params a{};
    for (int i = 0; i < 28; ++i) a.in[i] = (const float*)d_in[i];
    a.out = (float*)d_out; a.ws = (unsigned char*)d_ws;
#if MK_ONE_LAUNCH
    a.ph_lo = 0; a.ph_hi = PH_TOTAL;
    hipLaunchKernelGGL(mk_fwd, dim3(grid), dim3(NTHR), LDS_BYTES, stream, a);
#else
    for (int ph = 0; ph < PH_TOTAL; ++ph) { a.ph_lo = ph; a.ph_hi = ph + 1; hipLaunchKernelGGL(mk_fwd, dim3(grid), dim3(NTHR), LDS_BYTES, stream, a); }
#endif
}
```

```cpp
#include <hip/hip_runtime.h>
#include <cstdio>
#include <cstdint>
namespace pg8 {
#define PG8_LAS __attribute__((address_space(3)))
typedef unsigned short bf16_t;
typedef short bf16x8 __attribute__((ext_vector_type(8)));
typedef float f32x4 __attribute__((ext_vector_type(4)));
typedef unsigned u32x4 __attribute__((ext_vector_type(4)));
constexpr int BM = 256, BK = 64, HALF = 128, HTB = HALF * BK * 2  , STAGE_BYTES = 8 * HTB, NXCD = 8, WGM = 8;

__host__ __device__ __forceinline__ int lds_byte(int r, int c) { const int st = (r >> 4) * 2 + (c >> 5), rr = r & 15, cc = c & 31, ob = rr * 64 + cc * 2; return st * 1024 + (ob ^ (((ob >> 9) & 1) << 5)); }
__host__ __device__ __forceinline__ void stage_rc(int b, int& R, int& C) { const int st = b / 1024, sb = b % 1024, swz = sb ^ (((sb >> 9) & 1) << 5); R = (st >> 1) * 16 + swz / 64; C = (st & 1) * 32 + (swz % 64) / 2; }
__host__ __device__ __forceinline__ int perm32(int rho) { const int n = rho >> 4, i = rho & 15; return 8 * (i >> 2) + 4 * n + (i & 3); }

struct Unit { int pm, pn; };
struct Gemm { const bf16_t* A; const bf16_t* Bt; int M, N, K; };

struct StaticOrder {
    int nM, nN, nwg, G, c;
    __host__ __device__ void init(int M, int N, int G_, int c_) { nM = M / BM; nN = N / BM; nwg = nM * nN; G = G_; c = c_; }
    __host__ __device__ bool next(int i, Unit& u) const {
        const long L = (long)i * G + c; if (L >= nwg) return false;
        int wgid = (int)L; { const int q = nwg / NXCD, r = nwg % NXCD, xcd = wgid % NXCD, off = wgid / NXCD; wgid = (xcd < r ? xcd * (q + 1) : r * (q + 1) + (xcd - r) * q) + off; }
        const int nig = WGM * nN, gid = wgid / nig, fm = gid * WGM, gsz = (nM - fm) < WGM ? (nM - fm) : WGM;
        u.pm = fm + ((wgid % nig) % gsz); u.pn = (wgid % nig) / gsz; return true;
    }
    __device__ __forceinline__ void a_ready(const Unit&) const {}
    __device__ __forceinline__ void done(const Unit&) const {}
};

__device__ __forceinline__ unsigned cvt_pk_bf16(float lo, float hi) { unsigned r; asm volatile("v_cvt_pk_bf16_f32 %0, %1, %2" : "=v"(r) : "v"(lo), "v"(hi)); return r; }

struct EpiBf16 {
    static constexpr bool PERM = true, AFTER_DRAIN = false;
    bf16_t* O; int ldc;
    __device__ __forceinline__ void operator()(const f32x4 (&acc)[2][2][4][2], const Unit& u, int wr, int wc, int fr, int fq) const {
        const int row0 = u.pm * BM + wr * 64 + fr; const int col0 = u.pn * BM + wc * 32 + 8 * fq;
#pragma unroll
        for (int ai = 0; ai < 2; ++ai)
#pragma unroll
            for (int m = 0; m < 4; ++m) { bf16_t* rowp = O + (size_t)(row0 + ai * HALF + m * 16) * ldc + col0;
#pragma unroll
                for (int bj = 0; bj < 2; ++bj) { const f32x4 v0 = acc[ai][bj][m][0], v1 = acc[ai][bj][m][1];
                    u32x4 w; w.x = cvt_pk_bf16(v0[0], v0[1]); w.y = cvt_pk_bf16(v0[2], v0[3]); w.z = cvt_pk_bf16(v1[0], v1[1]); w.w = cvt_pk_bf16(v1[2], v1[3]);
                    *(u32x4*)(rowp + bj * HALF) = w; } }
    }
};
__device__ __forceinline__ int cond_of_pm(int pm) { return pm < 16 ? 0 : (pm < 32 ? 1 : 2); }
struct EpiResid {
    static constexpr bool PERM = false, AFTER_DRAIN = false;
    float* H; int ldc; const float* gate; int gstride;
    __device__ __forceinline__ void operator()(const f32x4 (&acc)[2][2][4][2], const Unit& u, int wr, int wc, int fr, int fq) const {
        const float* g = gate + (size_t)cond_of_pm(u.pm) * gstride;
        const int row0 = u.pm * BM + wr * 64 + fr; const int col0 = u.pn * BM + wc * 32 + 4 * fq;
        f32x4 gv[2][2];
#pragma unroll
        for (int bj = 0; bj < 2; ++bj)
#pragma unroll
            for (int n = 0; n < 2; ++n) gv[bj][n] = *(const f32x4*)(g + col0 + bj * HALF + n * 16);
#pragma unroll
        for (int ai = 0; ai < 2; ++ai)
#pragma unroll
            for (int m = 0; m < 4; ++m) { float* rowp = H + (size_t)(row0 + ai * HALF + m * 16) * ldc + col0;
#pragma unroll
                for (int bj = 0; bj < 2; ++bj)
#pragma unroll
                    for (int n = 0; n < 2; ++n) { f32x4* p = (f32x4*)(rowp + bj * HALF + n * 16); f32x4 h = *p; h = h + gv[bj][n] * acc[ai][bj][m][n]; *p = h; }
                asm volatile("" ::: "memory"); }
    }
};
__device__ __forceinline__ float silu_f(float x) { return x * __builtin_amdgcn_rcpf(1.0f + __expf(-x)); }
struct EpiSwiGLU {
    static constexpr bool PERM = true, AFTER_DRAIN = false;
    bf16_t* O; int ldc;
    __device__ __forceinline__ void operator()(const f32x4 (&acc)[2][2][4][2], const Unit& u, int wr, int wc, int fr, int fq) const {
        const int row0 = u.pm * BM + wr * 64 + fr; const int col0 = u.pn * HALF + wc * 32 + 8 * fq;
#pragma unroll
        for (int ai = 0; ai < 2; ++ai)
#pragma unroll
            for (int m = 0; m < 4; ++m) { bf16_t* rowp = O + (size_t)(row0 + ai * HALF + m * 16) * ldc + col0;
                const f32x4 g0 = acc[ai][0][m][0], g1 = acc[ai][0][m][1], u0 = acc[ai][1][m][0], u1 = acc[ai][1][m][1];
                u32x4 w;
                w.x = cvt_pk_bf16(silu_f(g0[0]) * u0[0], silu_f(g0[1]) * u0[1]); w.y = cvt_pk_bf16(silu_f(g0[2]) * u0[2], silu_f(g0[3]) * u0[3]);
                w.z = cvt_pk_bf16(silu_f(g1[0]) * u1[0], silu_f(g1[1]) * u1[1]); w.w = cvt_pk_bf16(silu_f(g1[2]) * u1[2], silu_f(g1[3]) * u1[3]);
                *(u32x4*)rowp = w; }
    }
};
template <class Epi, class Sched, bool ALIGN_EPI = false, bool SP2 = false>
__device__ __forceinline__ void gemm_phase(PG8_LAS unsigned char* lds, const Gemm g, const Sched& S, const Epi& E) {
    int tid_ = threadIdx.x; asm volatile("" : "+v"(tid_));
    const int tid = tid_, wid = __builtin_amdgcn_readfirstlane(tid >> 6), lane = tid & 63, wr = wid >> 2, wc = wid & 3, fr = lane & 15, fq = lane >> 4;
    const int K = g.K, nt = K / BK;
    unsigned voffA[2], voffB[2];
#pragma unroll
    for (int i = 0; i < 2; ++i) { int R, C; stage_rc(tid * 16 + i * 8192, R, C); const int Rb = Epi::PERM ? ((R & ~31) + perm32(R & 31)) : R;
        voffA[i] = (unsigned)(R * K + C) * 2u; voffB[i] = (unsigned)(Rb * K + C) * 2u; }
    const size_t kstep = (size_t)(BK * 2);
    const size_t hstep = (size_t)HALF * K * 2;
    const size_t tstep = 2 * hstep;
    const unsigned ldsw = (unsigned)wid * 1024u;
    const int aoff = lds_byte(wr * 64 + fr, fq * 8), boff = lds_byte(wc * 32 + fr, fq * 8);
#define PG8_SA(b, h) (((b) * 2 + (h)) * HTB)
#define PG8_SB(b, h) ((4 + (b) * 2 + (h)) * HTB)
#define PG8_STAGE(bufoff, gbase, voff) do { _Pragma("unroll") for (int _i = 0; _i < 2; ++_i) \
        __builtin_amdgcn_global_load_lds((const unsigned*)((const char*)(gbase) + (voff)[_i]), (PG8_LAS unsigned*)(lds + (bufoff) + ldsw + _i * 8192), 16, 0, 0); } while (0)
#define PG8_LDA(dst, b, h) do { _Pragma("unroll") for (int m = 0; m < 4; ++m) _Pragma("unroll") for (int k = 0; k < 2; ++k) dst[m][k] = *(const PG8_LAS bf16x8*)(lds + PG8_SA(b, h) + aoff + m * 2048 + k * 1024); } while (0)
#define PG8_LDB(dst, b, h) do { _Pragma("unroll") for (int n = 0; n < 2; ++n) _Pragma("unroll") for (int k = 0; k < 2; ++k) dst[n][k] = *(const PG8_LAS bf16x8*)(lds + PG8_SB(b, h) + boff + n * 2048 + k * 1024); } while (0)
#define PG8_MMA(ai, bj, At, Bt) do { __builtin_amdgcn_s_setprio(1); _Pragma("unroll") for (int m = 0; m < 4; ++m) _Pragma("unroll") for (int n = 0; n < 2; ++n) _Pragma("unroll") for (int k = 0; k < 2; ++k) \
        acc[ai][bj][m][n] = __builtin_amdgcn_mfma_f32_16x16x32_bf16(Bt[n][k], At[m][k], acc[ai][bj][m][n], 0, 0, 0); __builtin_amdgcn_s_setprio(0); } while (0)
#define PG8_WAIT_V(n) asm volatile("s_waitcnt vmcnt(" #n ")" ::: "memory")
#define PG8_WAIT_L(n) asm volatile("s_waitcnt lgkmcnt(" #n ")" ::: "memory")
#define PG8_BAR __builtin_amdgcn_s_barrier()
#define PG8_SCHED __builtin_amdgcn_sched_barrier(0)
    Unit cur, nxt; int ui = 0;
    if (!S.next(0, cur)) return;
    f32x4 acc[2][2][4][2];
#pragma unroll
    for (int a = 0; a < 2; ++a)
#pragma unroll
        for (int b = 0; b < 2; ++b)
#pragma unroll
            for (int m = 0; m < 4; ++m)
#pragma unroll
                for (int n = 0; n < 2; ++n) acc[a][b][m][n] = (f32x4){0.f, 0.f, 0.f, 0.f};
    bf16x8 At[4][2], B0[2][2], B1[2][2];
    const char* cA = (const char*)g.A + (size_t)cur.pm * tstep; const char* cB = (const char*)g.Bt + (size_t)cur.pn * tstep;
    S.a_ready(cur);
    if constexpr (SP2) {
        PG8_STAGE(PG8_SB(0, 0), cB, voffB); PG8_STAGE(PG8_SB(0, 1), cB + hstep, voffB); PG8_STAGE(PG8_SA(0, 0), cA, voffA); PG8_STAGE(PG8_SA(0, 1), cA + hstep, voffA);
        if (wr == 1) PG8_BAR;
        PG8_WAIT_V(2); PG8_BAR;
        PG8_STAGE(PG8_SB(1, 0), cB + kstep, voffB); PG8_STAGE(PG8_SA(1, 0), cA + kstep, voffA); PG8_STAGE(PG8_SB(1, 1), cB + hstep + kstep, voffB);
        PG8_WAIT_V(6); PG8_BAR;
    } else {
        PG8_STAGE(PG8_SB(0, 0), cB, voffB); PG8_STAGE(PG8_SA(0, 0), cA, voffA); PG8_STAGE(PG8_SB(0, 1), cB + hstep, voffB); PG8_STAGE(PG8_SA(0, 1), cA + hstep, voffA);
        if (wr == 1) PG8_BAR;
        PG8_WAIT_V(4); PG8_BAR;
        PG8_STAGE(PG8_SB(1, 0), cB + kstep, voffB); PG8_STAGE(PG8_SA(1, 0), cA + kstep, voffA); PG8_STAGE(PG8_SB(1, 1), cB + hstep + kstep, voffB);
        PG8_WAIT_V(6); PG8_BAR;
    }
    for (;;) {
        const bool has_next = S.next(ui + 1, nxt);
        const char* nA = has_next ? (const char*)g.A + (size_t)nxt.pm * tstep : cA; const char* nB = has_next ? (const char*)g.Bt + (size_t)nxt.pn * tstep : cB;
        for (int t = 0; t < nt; t += 2) {
            const bool last = (t == nt - 2);
            const char* a1 = cA + (size_t)(t + 1) * kstep;
            const char* a2 = last ? nA : cA + (size_t)(t + 2) * kstep; const char* b2 = last ? nB : cB + (size_t)(t + 2) * kstep;
            const char* a3 = a2 + kstep; const char* b3 = b2 + kstep;
            if (last && has_next) S.a_ready(nxt);
            if constexpr (SP2) {
            PG8_LDB(B0, 0, 0); PG8_LDB(B1, 0, 1); PG8_SCHED; PG8_LDA(At, 0, 0); PG8_STAGE(PG8_SA(1, 1), a1 + hstep, voffA);
            PG8_WAIT_V(8); PG8_WAIT_L(0); PG8_BAR; PG8_MMA(0, 0, At, B0); PG8_MMA(0, 1, At, B1); PG8_BAR; PG8_SCHED;
            PG8_LDA(At, 0, 1); PG8_STAGE(PG8_SB(0, 0), b2, voffB); PG8_STAGE(PG8_SB(0, 1), b2 + hstep, voffB); PG8_STAGE(PG8_SA(0, 0), a2, voffA);
            PG8_WAIT_V(8); PG8_WAIT_L(0); PG8_BAR; PG8_MMA(1, 0, At, B0); PG8_MMA(1, 1, At, B1); PG8_BAR; PG8_SCHED;
            PG8_LDB(B0, 1, 0); PG8_LDB(B1, 1, 1); PG8_SCHED; PG8_LDA(At, 1, 0); PG8_STAGE(PG8_SA(0, 1), a2 + hstep, voffA);
            PG8_WAIT_V(8); PG8_WAIT_L(0); PG8_BAR; PG8_MMA(0, 0, At, B0); PG8_MMA(0, 1, At, B1); PG8_BAR; PG8_SCHED;
            PG8_LDA(At, 1, 1); PG8_STAGE(PG8_SB(1, 0), b3, voffB); PG8_STAGE(PG8_SB(1, 1), b3 + hstep, voffB); PG8_STAGE(PG8_SA(1, 0), a3, voffA);
            PG8_WAIT_V(8); PG8_WAIT_L(0); PG8_BAR; PG8_MMA(1, 0, At, B0); PG8_MMA(1, 1, At, B1); PG8_BAR; PG8_SCHED;
            } else {
            PG8_LDB(B0, 0, 0); PG8_SCHED; PG8_LDA(At, 0, 0); PG8_STAGE(PG8_SA(1, 1), a1 + hstep, voffA);
            PG8_WAIT_L(8); PG8_BAR; PG8_WAIT_L(0); PG8_MMA(0, 0, At, B0); PG8_BAR; PG8_SCHED;
            PG8_LDB(B1, 0, 1); PG8_STAGE(PG8_SB(0, 0), b2, voffB);
            PG8_BAR; PG8_WAIT_L(0); PG8_MMA(0, 1, At, B1); PG8_BAR;
            PG8_LDA(At, 0, 1); PG8_STAGE(PG8_SA(0, 0), a2, voffA);
            PG8_BAR; PG8_WAIT_L(0); PG8_MMA(1, 0, At, B0); PG8_BAR; PG8_SCHED;
            PG8_STAGE(PG8_SB(0, 1), b2 + hstep, voffB);
            PG8_WAIT_V(6); PG8_BAR; PG8_MMA(1, 1, At, B1); PG8_BAR;
            PG8_LDB(B0, 1, 0); PG8_SCHED; PG8_LDA(At, 1, 0); PG8_STAGE(PG8_SA(0, 1), a2 + hstep, voffA);
            PG8_WAIT_L(8); PG8_BAR; PG8_WAIT_L(0); PG8_MMA(0, 0, At, B0); PG8_BAR; PG8_SCHED;
            PG8_LDB(B1, 1, 1); PG8_STAGE(PG8_SB(1, 0), b3, voffB);
            PG8_BAR; PG8_WAIT_L(0); PG8_MMA(0, 1, At, B1); PG8_BAR;
            PG8_LDA(At, 1, 1); PG8_STAGE(PG8_SA(1, 0), a3, voffA);
            PG8_BAR; PG8_WAIT_L(0); PG8_MMA(1, 0, At, B0); PG8_BAR; PG8_SCHED;
            PG8_STAGE(PG8_SB(1, 1), b3 + hstep, voffB);
            PG8_WAIT_V(6); PG8_BAR; PG8_MMA(1, 1, At, B1); PG8_BAR;
            }
        }
        if constexpr (ALIGN_EPI) { if (wr == 0) PG8_BAR; }
        if constexpr (!Epi::AFTER_DRAIN) { E(acc, cur, wr, wc, fr, fq); S.done(cur); }
        if (!has_next) break;
#pragma unroll
        for (int a = 0; a < 2; ++a)
#pragma unroll
            for (int b = 0; b < 2; ++b)
#pragma unroll
                for (int m = 0; m < 4; ++m)
#pragma unroll
                    for (int n = 0; n < 2; ++n) acc[a][b][m][n] = (f32x4){0.f, 0.f, 0.f, 0.f};
        cur = nxt; cA = nA; cB = nB; ++ui;
        if constexpr (ALIGN_EPI) { if (wr == 1) PG8_BAR; }
    }
    PG8_WAIT_V(0);
    if constexpr (!ALIGN_EPI) { if (wr == 0) PG8_BAR; }
    PG8_BAR;
    if constexpr (Epi::AFTER_DRAIN) { E.fused(acc, cur, wr, wc, fr, fq, lds, wid, lane); S.done(cur); }
#undef PG8_SA
#undef PG8_SB
#undef PG8_STAGE
#undef PG8_LDA
#undef PG8_LDB
#undef PG8_MMA
#undef PG8_WAIT_V
#undef PG8_WAIT_L
#undef PG8_BAR
#undef PG8_SCHED
}
}
#define GAS __attribute__((address_space(1)))
#define LAS __attribute__((address_space(3)))
typedef unsigned short bf16;
typedef unsigned v4u __attribute__((ext_vector_type(4)));
typedef float f32x4 __attribute__((ext_vector_type(4)));
typedef short bf16x8 __attribute__((ext_vector_type(8)));
typedef GAS unsigned gu32;
typedef GAS unsigned long long gu64;
#define RLX_AGENT __ATOMIC_RELAXED, __HIP_MEMORY_SCOPE_AGENT
#define LDS_WAIT() asm volatile("s_waitcnt lgkmcnt(0)" ::: "memory")
#define VM_WAIT() asm volatile("s_waitcnt vmcnt(0)" ::: "memory")
__device__ __forceinline__ unsigned long long rt() { return __builtin_amdgcn_s_memrealtime(); }
__device__ __forceinline__ unsigned f2bf(float f) { unsigned u = __builtin_bit_cast(unsigned, f); return (u + 0x7fffu + ((u >> 16) & 1u)) >> 16; }
__device__ __forceinline__ unsigned pk2(float lo, float hi) { return f2bf(lo) | (f2bf(hi) << 16); }

#define XB_TMO      128
#define XB_XCNT(j)  (256  + 64 * (j))
#define XB_XSUB(j)  (1280 + 64 * (j))
#define XB_XGEN(j)  (2304 + 64 * (j))
#define XB_TOP      3328
#define XB_TOPGEN   3392
#define XCD_BAR_WORDS 3456
#define XB_SPIN_CAP (1u << 18)

__device__ __forceinline__ unsigned xb_ld(unsigned* p)              { return __hip_atomic_load(p, __ATOMIC_RELAXED, __HIP_MEMORY_SCOPE_AGENT); }
__device__ __forceinline__ unsigned xb_add(unsigned* p, unsigned v) { return __hip_atomic_fetch_add(p, v, __ATOMIC_RELAXED, __HIP_MEMORY_SCOPE_AGENT); }
__device__ __forceinline__ unsigned xb_xcc_id() { return (unsigned)__builtin_amdgcn_s_getreg((3 << 11) | 20) & 0xFu; }
#define XB_SPIN(cond, bar) do { unsigned _sp = 0; while (cond) { __builtin_amdgcn_s_sleep(1); \
    if ((++_sp & 255u) == 0u) { if (xb_ld(&(bar)[XB_TMO])) break; if (_sp > XB_SPIN_CAP) { atomicAdd(&(bar)[XB_TMO], 1u); break; } } } } while (0)

struct XcdBarrier {
    unsigned* bar; unsigned x;
    volatile LAS unsigned* st;
};

__device__ __forceinline__ XcdBarrier xcd_barrier_post(unsigned* bar, volatile LAS unsigned* st) {
    XcdBarrier b; b.bar = bar; b.x = xb_xcc_id(); b.st = st;
    if (threadIdx.x == 0) (void)xb_add(&bar[XB_XCNT(b.x)], 1u);
    return b;
}
__device__ __forceinline__ void xcd_barrier_complete(unsigned* bar, unsigned x, unsigned& nloc, unsigned& nx) {
    const unsigned G = gridDim.x * gridDim.y * gridDim.z;
    unsigned sum, cnt, mine, sp = 0u;
    for (;;) {
        sum = 0u; cnt = 0u; mine = 0u;
#pragma unroll
        for (unsigned j = 0; j < 16; ++j) { const unsigned c = xb_ld(&bar[XB_XCNT(j)]); sum += c; cnt += (c > 0u) ? 1u : 0u; mine = (j == x) ? c : mine; }
        if (sum == G) break;
        __builtin_amdgcn_s_sleep(1);
        if ((++sp & 255u) == 0u) { if (xb_ld(&bar[XB_TMO])) break; if (sp > XB_SPIN_CAP) { atomicAdd(&bar[XB_TMO], 1u); break; } }
    }
    nloc = mine > 0u ? mine : 1u; nx = cnt > 0u ? cnt : 1u;
}

__device__ __forceinline__ void xcd_barrier(const XcdBarrier& b) {
    asm volatile("s_waitcnt vmcnt(0)" ::: "memory");
    __syncthreads();
    if (threadIdx.x == 0) {
        unsigned* bar = b.bar;
        __builtin_amdgcn_s_waitcnt(0);
        unsigned nloc = b.st[0], nx = b.st[1];
        if (nloc == 0u) { xcd_barrier_complete(bar, b.x, nloc, nx); b.st[0] = nloc; b.st[1] = nx; }
        const unsigned old = xb_add(&bar[XB_XSUB(b.x)], 1u);
        const unsigned gen = old / nloc;
        if (old + 1u == (gen + 1u) * nloc) {
            __builtin_amdgcn_fence(__ATOMIC_RELEASE, "agent");
            asm volatile("s_waitcnt vmcnt(0)" ::: "memory");
            const unsigned og = xb_add(&bar[XB_TOP], 1u);
            const unsigned tg = og / nx;
            if (og + 1u == (tg + 1u) * nx) xb_add(&bar[XB_TOPGEN], 1u);
            else XB_SPIN(xb_ld(&bar[XB_TOPGEN]) == tg, bar);
            __builtin_amdgcn_fence(__ATOMIC_ACQUIRE, "agent");
            xb_add(&bar[XB_XGEN(b.x)], 1u);
            asm volatile("s_waitcnt vmcnt(0)" ::: "memory");
        } else {
            XB_SPIN(xb_ld(&bar[XB_XGEN(b.x)]) == gen, bar);
            __builtin_amdgcn_fence(__ATOMIC_ACQUIRE, "agent");
            asm volatile("s_waitcnt vmcnt(0)" ::: "memory");
        }
    }
    __syncthreads();
}

constexpr int NWAVES = 8, NTHR = 512;
constexpr int DM = 2048, MROWS = 12288, DEPTH = 4;
constexpr int INC = 5152, INP = 5376, FF = 5632, GU = 11264;
constexpr int NMOD = 6 * DM;
constexpr float EPS = 1e-6f;
constexpr int PC_QA = 0, PC_KA = 512, PC_VA = 768, PC_QD = 1024, PC_KD = 1536, PC_VD = 2048, PC_Z = 2560, PC_XBC = 3584, PC_DT = 5120;
constexpr int RC_QA = 0, RC_KA = 512, RC_QD = 768, RC_KD = 1280, RCW = 1792;
constexpr size_t OUT_AK = 25165824, OUT_AV = OUT_AK + 4194304, OUT_DK = OUT_AV + 4194304, OUT_DV = OUT_DK + 8388608, OUT_SF = OUT_DV + 8388608, OUT_SB = OUT_SF + 8388608;
constexpr size_t MiB = 1u << 20;
constexpr size_t WS_CTL = 0, CTL_ZERO_BYTES = 1 * MiB;
constexpr size_t WS_TAB = 1 * MiB, WS_MOD = 2 * MiB, WS_MODP = 3 * MiB;
constexpr size_t WS_WIN = 8 * MiB, WS_WOUT = 92 * MiB, WS_WGU = 124 * MiB, WS_WDN = 300 * MiB;
constexpr size_t WS_H = 388 * MiB, WS_U = 484 * MiB, WS_P = 532 * MiB, WS_MIX = 658 * MiB, WS_ACT = 706 * MiB, WS_QKR = 838 * MiB;
constexpr size_t WS_XBC = 866 * MiB, WS_DT = 938 * MiB, WS_YF = 940 * MiB, WS_YB = 988 * MiB, WS_END = 1036 * MiB;
constexpr int CW_BAR = 4096;
constexpr int RING_BYTES = 131072, LDSCTL_OFF = RING_BYTES, MISC_OFF = LDSCTL_OFF + 320, LDS_BYTES = 147456;

struct Params { const float* in[28]; float* out; unsigned char* ws; int ph_lo, ph_hi; };
typedef __attribute__((address_space(4))) const Params* PP;
struct Frame { LAS unsigned char* lds; int tid, lane, wave, vcu, G; };

__device__ __forceinline__ float wave_sum(float v) {
#pragma unroll
    for (int o = 1; o < 64; o <<= 1) v += __shfl_xor(v, o);
    return v;
}
__device__ __forceinline__ float wave_max(float v) {
#pragma unroll
    for (int o = 1; o < 64; o <<= 1) v = fmaxf(v, __shfl_xor(v, o));
    return v;
}
__device__ __forceinline__ float bflo(unsigned w) { return __uint_as_float(w << 16); }
__device__ __forceinline__ float bfhi(unsigned w) { return __uint_as_float(w & 0xffff0000u); }
__device__ __forceinline__ float bf1(bf16 b) { return __uint_as_float((unsigned)b << 16); }
__device__ __forceinline__ float silu(float x) { return x / (1.0f + __expf(-x)); }

__device__ __forceinline__ void p0_transpose_item(const float* W, int K, int N, bf16* WT, int rowmap, LAS float* scr, int item, int lane) {
    const int nblk = N / 32, kb = item / nblk, nb = item % nblk, k0 = 64 * kb, n0 = 32 * nb;
#pragma unroll 8
    for (int i = 0; i < 32; ++i) { const int kk = 2 * i + (lane >> 5); scr[kk * 33 + (lane & 31)] = W[(size_t)(k0 + kk) * N + n0 + (lane & 31)]; }
    LDS_WAIT(); asm volatile("" ::: "memory");
    int r0 = n0;
    if (rowmap) r0 = (n0 < FF) ? ((n0 >> 7) * 256 + (n0 & 127)) : (((n0 - FF) >> 7) * 256 + 128 + ((n0 - FF) & 127));
    const int c = lane & 7;
#pragma unroll
    for (int j = 0; j < 4; ++j) { const int n = (lane >> 3) + 8 * j; const LAS float* s = scr + (8 * c) * 33 + n;
        v4u o; o.x = pk2(s[0 * 33], s[1 * 33]); o.y = pk2(s[2 * 33], s[3 * 33]); o.z = pk2(s[4 * 33], s[5 * 33]); o.w = pk2(s[6 * 33], s[7 * 33]);
        *(v4u*)(WT + (size_t)(r0 + n) * K + k0 + 8 * c) = o; }
    LDS_WAIT(); asm volatile("" ::: "memory");
}
__device__ __forceinline__ void p0_prologue(Frame& F, PP p) {
    unsigned char* ws = p->ws;
    LAS float* scr = (LAS float*)(F.lds + F.wave * 16384);
    const int gw = F.vcu * NWAVES + F.wave, NGW = F.G * NWAVES;
    const int gt = F.vcu * NTHR + F.tid, NGT = F.G * NTHR;
    constexpr int I_IN = 32 * (INC / 32), I_OUT = 32 * 64, I_GU = 32 * (GU / 32), I_DN = (FF / 64) * 64, I_L = I_IN + I_OUT + I_GU + I_DN;
    for (int it = gw; it < DEPTH * I_L; it += NGW) {
        const int l = it / I_L; int r = it % I_L;
        if (r < I_IN) { p0_transpose_item(p->in[14] + (size_t)l * DM * INC, DM, INC, (bf16*)(ws + WS_WIN) + (size_t)l * INP * DM, 0, scr, r, F.lane); continue; } r -= I_IN;
        if (r < I_OUT) { p0_transpose_item(p->in[24] + (size_t)l * DM * DM, DM, DM, (bf16*)(ws + WS_WOUT) + (size_t)l * DM * DM, 0, scr, r, F.lane); continue; } r -= I_OUT;
        if (r < I_GU) { p0_transpose_item(p->in[25] + (size_t)l * DM * GU, DM, GU, (bf16*)(ws + WS_WGU) + (size_t)l * GU * DM, 1, scr, r, F.lane); continue; } r -= I_GU;
        p0_transpose_item(p->in[26] + (size_t)l * FF * DM, FF, DM, (bf16*)(ws + WS_WDN) + (size_t)l * DM * FF, 0, scr, r, F.lane);
    }
    { constexpr int PADV = (INP - INC) * DM * 2 / 16;
      for (int i = gt; i < DEPTH * PADV; i += NGT) { const int l = i / PADV, r = i % PADV;
          *((v4u*)((bf16*)(ws + WS_WIN) + (size_t)l * INP * DM + (size_t)INC * DM) + r) = (v4u){0u, 0u, 0u, 0u}; } }
    { const f32x4* xp = (const f32x4*)p->in[0]; const f32x4* xs = (const f32x4*)p->in[1]; f32x4* H = (f32x4*)(ws + WS_H);
      constexpr int NP4 = 4096 * DM / 4, NT4 = MROWS * DM / 4;
      for (int i = gt; i < NT4; i += NGT) H[i] = (i < NP4) ? xp[i] : xs[i - NP4]; }
    __syncthreads();
    { LAS float* sc = (LAS float*)F.lds;
      float* MODP = (float*)(ws + WS_MODP);
      for (int it = blockIdx.x; it < DEPTH * 8 * 24; it += F.G) {
          const int l = it / 192, r = it % 192, kc = r / 24, nc = r % 24;
          if (F.tid < 256) {
              const int k = kc * 256 + F.tid;
              sc[F.tid] = silu(p->in[9][k]); sc[256 + F.tid] = silu(p->in[8][k]); sc[512 + F.tid] = silu(p->in[8][DM + k]);
          }
          __syncthreads();
          const int n = nc * 512 + F.tid;
          const float* w = p->in[10] + ((size_t)l * DM + (size_t)kc * 256) * NMOD + n;
          float a0 = 0.f, a1 = 0.f, a2 = 0.f;
          for (int k = 0; k < 256; k += 8) {
              float wv[8];
#pragma unroll
              for (int e = 0; e < 8; ++e) wv[e] = w[(size_t)(k + e) * NMOD];
#pragma unroll
              for (int e = 0; e < 8; ++e) { a0 += sc[k + e] * wv[e]; a1 += sc[256 + k + e] * wv[e]; a2 += sc[512 + k + e] * wv[e]; }
          }
          float* o = MODP + ((size_t)(kc * DEPTH + l) * 3) * NMOD + n;
          o[0] = a0; o[NMOD] = a1; o[2 * NMOD] = a2;
          __syncthreads();
      } }
    if (blockIdx.x == F.G - 1) {
        float2* tabA = (float2*)(ws + WS_TAB); float2* tabB = (float2*)(ws + WS_TAB + 16384); float* lam = (float*)(ws + WS_TAB + 32768);
        for (int i = F.tid; i < 2048 + 1024; i += NTHR) {
            const bool isA = i < 2048; const int j = isA ? i : i - 2048; const int pos = isA ? (j >> 5) : (j >> 4), k = isA ? (j & 31) : (j & 15);
            double r = 10000.0; r = sqrt(r); r = sqrt(r); r = sqrt(r); r = sqrt(r); if (isA) r = sqrt(r);
            const double ri = 1.0 / r; double inv = 1.0; for (int q = 0; q < k; ++q) inv *= ri;
            const double ang = (double)pos * inv; const double TWO_PI = 6.283185307179586476925;
            const double x = ang - TWO_PI * rint(ang / TWO_PI), x2 = x * x;
            double st = x, ss = x, ct = 1.0, cs = 1.0;
            for (int q = 1; q <= 16; ++q) { st *= -x2 / (double)((2 * q) * (2 * q + 1)); ss += st; ct *= -x2 / (double)((2 * q - 1) * (2 * q)); cs += ct; }
            const float2 v = make_float2((float)cs, (float)ss);
            if (isA) tabA[j] = v; else tabB[j] = v;
        }
        if (F.tid < DEPTH) {
            const float* lv = p->in[16] + F.tid * 256; float s01 = 0.f, s23 = 0.f;
            for (int i = 0; i < 64; ++i) { s01 += lv[i] * lv[64 + i]; s23 += lv[128 + i] * lv[192 + i]; }
            const float li = 0.8f - 0.6f * expf(-0.3f * (float)F.tid);
            lam[F.tid] = expf(s01) - expf(s23) + li; lam[4 + F.tid] = li;
        }
    }
}
__device__ __forceinline__ void p0b_mod(Frame& F, PP p) {
    const int gt = F.vcu * NTHR + F.tid, NGT = F.G * NTHR;
    const float* MODP = (const float*)(p->ws + WS_MODP); float* MOD = (float*)(p->ws + WS_MOD);
    for (int i = gt; i < DEPTH * 3 * NMOD; i += NGT) {
        const int l = i / (3 * NMOD), n = i % NMOD;
        float s = p->in[11][l * NMOD + n];
#pragma unroll
        for (int kc = 0; kc < 8; ++kc) s += MODP[(size_t)kc * DEPTH * 3 * NMOD + i];
        MOD[i] = s;
    }
}
__device__ __forceinline__ void norm_phase(Frame& F, const float* H, const float* g, const float* modl, int shoff, int scoff, bf16* U) {
    const int gw = F.vcu * NWAVES + F.wave, NGW = F.G * NWAVES;
    for (int m = gw; m < MROWS; m += NGW) {
        const int c = m < 4096 ? 0 : (m < 8192 ? 1 : 2);
        const float* sh = modl + c * NMOD + shoff; const float* sc = modl + c * NMOD + scoff;
        const f32x4* xr = (const f32x4*)(H + (size_t)m * DM) + F.lane;
        f32x4 v[8]; float ss = 0.f;
#pragma unroll
        for (int j = 0; j < 8; ++j) { v[j] = xr[64 * j]; ss += (v[j].x * v[j].x + v[j].y * v[j].y) + (v[j].z * v[j].z + v[j].w * v[j].w); }
        const float rstd = 1.0f / sqrtf(wave_sum(ss) * (1.0f / DM) + EPS);
        unsigned long long* o8 = (unsigned long long*)(U + (size_t)m * DM) + F.lane;
#pragma unroll
        for (int j = 0; j < 8; ++j) { const int col = 4 * F.lane + 256 * j;
            const f32x4 gv = *(const f32x4*)(g + col), sv = *(const f32x4*)(sc + col), hv = *(const f32x4*)(sh + col);
            const f32x4 o = (v[j] * rstd) * gv * (sv + 1.0f) + hv;
            o8[64 * j] = (unsigned long long)pk2(o.x, o.y) | ((unsigned long long)pk2(o.z, o.w) << 32); }
    }
}
__device__ __forceinline__ void final_phase(Frame& F, const float* H, const float* g, float* out) {
    const int gw = F.vcu * NWAVES + F.wave, NGW = F.G * NWAVES;
    for (int m = gw; m < MROWS; m += NGW) {
        const f32x4* xr = (const f32x4*)(H + (size_t)m * DM) + F.lane;
        f32x4 v[8]; float ss = 0.f;
#pragma unroll
        for (int j = 0; j < 8; ++j) { v[j] = xr[64 * j]; ss += (v[j].x * v[j].x + v[j].y * v[j].y) + (v[j].z * v[j].z + v[j].w * v[j].w); }
        const float rstd = 1.0f / sqrtf(wave_sum(ss) * (1.0f / DM) + EPS);
        f32x4* o = (f32x4*)(out + (size_t)m * DM) + F.lane;
#pragma unroll
        for (int j = 0; j < 8; ++j) { const f32x4 gv = *(const f32x4*)(g + 4 * F.lane + 256 * j); o[64 * j] = (v[j] * rstd) * gv; }
    }
}
__device__ __forceinline__ void prep_phase(Frame& F, PP p, int l) {
    unsigned char* ws = p->ws;
    const bf16* P = (const bf16*)(ws + WS_P); bf16* QKR = (bf16*)(ws + WS_QKR); float* XBC = (float*)(ws + WS_XBC); float* DT = (float*)(ws + WS_DT);
    const float2* tabA = (const float2*)(ws + WS_TAB); const float2* tabB = (const float2*)(ws + WS_TAB + 16384);
    const float* cw = p->in[18] + (size_t)l * 5 * 1536; const float* cb = p->in[19] + (size_t)l * 1536; const float* dtb = p->in[20] + l * 32;
    const int gw = F.vcu * NWAVES + F.wave, NGW = F.G * NWAVES, lane = F.lane;
    for (int m = gw; m < MROWS; m += NGW) {
        const bf16* prow = P + (size_t)m * INP;
        const int s0 = m < 4096 ? (m & ~255) : (4096 + ((m - 4096) & ~4095)); const int len = m < 4096 ? 256 : 4096; const int t = m - s0;
#pragma unroll
        for (int j = 0; j < 3; ++j) { const int c0 = 8 * lane + 512 * j;
            f32x4 a0 = *(const f32x4*)(cb + c0), a1 = *(const f32x4*)(cb + c0 + 4);
#pragma unroll
            for (int k = 0; k < 5; ++k) { const int tt = t + k - 2;
                if (tt >= 0 && tt < len) { const v4u raw = *(const v4u*)(P + (size_t)(s0 + tt) * INP + PC_XBC + c0);
                    const f32x4 w0 = *(const f32x4*)(cw + k * 1536 + c0), w1 = *(const f32x4*)(cw + k * 1536 + c0 + 4);
                    a0.x += w0.x * bflo(raw.x); a0.y += w0.y * bfhi(raw.x); a0.z += w0.z * bflo(raw.y); a0.w += w0.w * bfhi(raw.y);
                    a1.x += w1.x * bflo(raw.z); a1.y += w1.y * bfhi(raw.z); a1.z += w1.z * bflo(raw.w); a1.w += w1.w * bfhi(raw.w); } }
            a0.x = silu(a0.x); a0.y = silu(a0.y); a0.z = silu(a0.z); a0.w = silu(a0.w); a1.x = silu(a1.x); a1.y = silu(a1.y); a1.z = silu(a1.z); a1.w = silu(a1.w);
            *(f32x4*)(XBC + (size_t)m * 1536 + c0) = a0; *(f32x4*)(XBC + (size_t)m * 1536 + c0 + 4) = a1; }
        if (lane < 32) { const float v = bf1(prow[PC_DT + lane]) + dtb[lane]; DT[(size_t)m * 32 + lane] = v > 20.f ? v : log1pf(__expf(v)); }
        if (m >= 4096) {
            const int gr = t >> 6, gc = t & 63; bf16* qrow = QKR + (size_t)(m - 4096) * RCW;
#pragma unroll
            for (int i = 0; i < 6; ++i) { const int d = lane; const int src = (i < 4 ? PC_QA + i * 128 : PC_KA + (i - 4) * 128) + d, dst = (i < 4 ? RC_QA + i * 128 : RC_KA + (i - 4) * 128) + d;
                const float x1 = bf1(prow[src]), x2 = bf1(prow[src + 64]); const float2 cs = d < 32 ? tabA[gr * 32 + d] : tabA[gc * 32 + d - 32];
                qrow[dst] = (bf16)f2bf(x1 * cs.x - x2 * cs.y); qrow[dst + 64] = (bf16)f2bf(x1 * cs.y + x2 * cs.x); }
#pragma unroll
            for (int i = 0; i < 8; ++i) { const int pp = lane + 64 * i, ch = pp >> 5, d = pp & 31; const int src = (ch < 8 ? PC_QD + ch * 64 : PC_KD + (ch - 8) * 64) + d, dst = (ch < 8 ? RC_QD + ch * 64 : RC_KD + (ch - 8) * 64) + d;
                const float x1 = bf1(prow[src]), x2 = bf1(prow[src + 32]); const float2 cs = d < 16 ? tabB[gr * 16 + d] : tabB[gc * 16 + d - 16];
                qrow[dst] = (bf16)f2bf(x1 * cs.x - x2 * cs.y); qrow[dst + 32] = (bf16)f2bf(x1 * cs.y + x2 * cs.x); }
        } else {
            const int b = m >> 8, s = m & 255; const size_t r = (size_t)((b * DEPTH + l) * 256 + s);
            { const unsigned long long w = *((const unsigned long long*)(prow + PC_KA) + lane); *((f32x4*)(p->out + OUT_AK + r * 256) + lane) = (f32x4){bflo((unsigned)w), bfhi((unsigned)w), bflo((unsigned)(w >> 32)), bfhi((unsigned)(w >> 32))}; }
            { const unsigned long long w = *((const unsigned long long*)(prow + PC_VA) + lane); *((f32x4*)(p->out + OUT_AV + r * 256) + lane) = (f32x4){bflo((unsigned)w), bfhi((unsigned)w), bflo((unsigned)(w >> 32)), bfhi((unsigned)(w >> 32))}; }
            { const v4u w = *((const v4u*)(prow + PC_KD) + lane); f32x4* o = (f32x4*)(p->out + OUT_DK + r * 512) + 2 * lane; o[0] = (f32x4){bflo(w.x), bfhi(w.x), bflo(w.y), bfhi(w.y)}; o[1] = (f32x4){bflo(w.z), bfhi(w.z), bflo(w.w), bfhi(w.w)}; }
            { const v4u w = *((const v4u*)(prow + PC_VD) + lane); f32x4* o = (f32x4*)(p->out + OUT_DV + r * 512) + 2 * lane; o[0] = (f32x4){bflo(w.x), bfhi(w.x), bflo(w.y), bfhi(w.y)}; o[1] = (f32x4){bflo(w.z), bfhi(w.z), bflo(w.w), bfhi(w.w)}; }
        }
    }
}
typedef float f32x16 __attribute__((ext_vector_type(16)));
typedef short s16x4 __attribute__((ext_vector_type(4)));
constexpr int FA_KSTR = 272, FA_VSTR = 320, FA_KB = 64 * FA_KSTR, FA_VB = 64 * FA_VSTR, FA_BUF = FA_KB + FA_VB;
constexpr int FA_OSTR = 272;
struct Seg { const void* k; const void* v; int ks, vs, n, f32, pos0; };
struct FaTile { v4u k[2], v[2]; };

__device__ __forceinline__ unsigned cvtpk(float lo, float hi) { typedef float f2 __attribute__((ext_vector_type(2))); typedef __bf16 b2 __attribute__((ext_vector_type(2))); f2 v = {lo, hi}; b2 b = __builtin_convertvector(v, b2); return __builtin_bit_cast(unsigned, b); }
__device__ __forceinline__ void fa_load(FaTile& t, const Seg& sg, int key0, int tid) {
#pragma unroll
    for (int i = 0; i < 2; ++i) { const int c = tid + 512 * i, key = c >> 4, ch = c & 15;
        if (sg.f32) {
            const f32x4* ks = (const f32x4*)((const float*)sg.k + (size_t)(key0 + key) * sg.ks + ch * 8);
            const f32x4* vs = (const f32x4*)((const float*)sg.v + (size_t)(key0 + key) * sg.vs + ch * 8);
            const f32x4 a = ks[0], b = ks[1], c2 = vs[0], d = vs[1];
            t.k[i] = (v4u){cvtpk(a.x, a.y), cvtpk(a.z, a.w), cvtpk(b.x, b.y), cvtpk(b.z, b.w)};
            t.v[i] = (v4u){cvtpk(c2.x, c2.y), cvtpk(c2.z, c2.w), cvtpk(d.x, d.y), cvtpk(d.z, d.w)};
        } else {
            t.k[i] = *(const v4u*)((const bf16*)sg.k + (size_t)(key0 + key) * sg.ks + ch * 8);
            t.v[i] = *(const v4u*)((const bf16*)sg.v + (size_t)(key0 + key) * sg.vs + ch * 8);
        } }
}
__device__ __forceinline__ void fa_store(const FaTile& t, LAS unsigned char* buf, int tid) {
#pragma unroll
    for (int i = 0; i < 2; ++i) { const int c = tid + 512 * i, key = c >> 4, ch = c & 15;
        *(LAS v4u*)(buf + key * FA_KSTR + ch * 16) = t.k[i];
        *(LAS v4u*)(buf + FA_KB + key * FA_VSTR + ch * 16) = t.v[i]; }
}
template <int NKS>
__device__ __forceinline__ void fa_tile(const LAS unsigned char* buf, const bf16x8 (&q)[NKS], f32x16 (&o)[4], float& m, float& lsum, float c, int kcolb, int lane, bool masked, int dpos  ) {
    const int r32 = lane & 31, h = lane >> 5;
    f32x16 p0, p1;
#pragma unroll
    for (int r = 0; r < 16; ++r) { p0[r] = 0.f; p1[r] = 0.f; }
    const LAS unsigned char* kp = buf + r32 * FA_KSTR + kcolb + h * 16;
#pragma unroll
    for (int ks = 0; ks < NKS; ++ks) {
        const bf16x8 a0 = *(const LAS bf16x8*)(kp + ks * 32), a1 = *(const LAS bf16x8*)(kp + 32 * FA_KSTR + ks * 32);
        p0 = __builtin_amdgcn_mfma_f32_32x32x16_bf16(a0, q[ks], p0, 0, 0, 0);
        p1 = __builtin_amdgcn_mfma_f32_32x32x16_bf16(a1, q[ks], p1, 0, 0, 0);
    }
    if (masked) {
#pragma unroll
        for (int r = 0; r < 16; ++r) { const int d0 = dpos - ((r & 3) + 8 * (r >> 2) + 4 * h), d1 = d0 - 32;
            if (d0 > 128 || d0 < -128) p0[r] = -INFINITY; if (d1 > 128 || d1 < -128) p1[r] = -INFINITY; }
    }
    float mt = fmaxf(p0[0], p1[0]);
#pragma unroll
    for (int r = 1; r < 16; ++r) mt = fmaxf(mt, fmaxf(p0[r], p1[r]));
    mt = fmaxf(mt, __shfl_xor(mt, 32));
    const float mn = fmaxf(m, mt * c);
    const float alpha = __builtin_amdgcn_exp2f(m - mn);
    m = mn;
    float rs = 0.f;
#pragma unroll
    for (int r = 0; r < 16; ++r) { p0[r] = __builtin_amdgcn_exp2f(p0[r] * c - mn); p1[r] = __builtin_amdgcn_exp2f(p1[r] * c - mn); rs += p0[r] + p1[r]; }
    lsum = lsum * alpha + rs;
#pragma unroll
    for (int b = 0; b < 4; ++b) o[b] = o[b] * alpha;
    bf16x8 pb[4];
    { v4u w;
      w = (v4u){cvtpk(p0[0], p0[1]), cvtpk(p0[2], p0[3]), cvtpk(p0[4], p0[5]), cvtpk(p0[6], p0[7])}; pb[0] = __builtin_bit_cast(bf16x8, w);
      w = (v4u){cvtpk(p0[8], p0[9]), cvtpk(p0[10], p0[11]), cvtpk(p0[12], p0[13]), cvtpk(p0[14], p0[15])}; pb[1] = __builtin_bit_cast(bf16x8, w);
      w = (v4u){cvtpk(p1[0], p1[1]), cvtpk(p1[2], p1[3]), cvtpk(p1[4], p1[5]), cvtpk(p1[6], p1[7])}; pb[2] = __builtin_bit_cast(bf16x8, w);
      w = (v4u){cvtpk(p1[8], p1[9]), cvtpk(p1[10], p1[11]), cvtpk(p1[12], p1[13]), cvtpk(p1[14], p1[15])}; pb[3] = __builtin_bit_cast(bf16x8, w); }
    const int i16 = lane & 15, gc = (lane >> 4) & 1;
    const LAS unsigned char* vp = buf + FA_KB + (4 * h + (i16 >> 2)) * FA_VSTR + (16 * gc + 4 * (i16 & 3)) * 2;
#pragma unroll
    for (int b = 0; b < 4; ++b)
#pragma unroll
        for (int s = 0; s < 4; ++s) {
            const s16x4 lo = __builtin_amdgcn_ds_read_tr16_b64_v4i16((LAS s16x4*)(vp + (16 * s) * FA_VSTR + b * 64));
            const s16x4 hi = __builtin_amdgcn_ds_read_tr16_b64_v4i16((LAS s16x4*)(vp + (16 * s + 8) * FA_VSTR + b * 64));
            const bf16x8 a = (bf16x8){lo[0], lo[1], lo[2], lo[3], hi[0], hi[1], hi[2], hi[3]};
            o[b] = __builtin_amdgcn_mfma_f32_32x32x16_bf16(a, pb[s], o[b], 0, 0, 0);
            if (s == 3) __builtin_amdgcn_sched_barrier(0);
        }
}
template <int MODE>
__device__ __forceinline__ void fa_unit(Frame& F, const bf16* qg, int qstride, const Seg& s0, const Seg& s1, bool two, int qpos0, float c, const float* sinkp, float lam, float onems, const float* dnorm, bf16* dst, int dstride) {
    constexpr int NKS = MODE == 0 ? 8 : 4;
    int tid_ = F.tid; asm volatile("" : "+v"(tid_));
    const int tid = tid_, lane = tid & 63, w = F.wave, r32 = lane & 31, h = lane >> 5, grp = w >> 2, qrow0 = (w & 3) * 32;
    const int kcolb = MODE == 0 ? 0 : grp * 128;
    qg += (MODE == 0 ? grp * 128 : grp * 64); if (MODE == 0) dst += grp * 128;
    bf16x8 q[NKS];
#pragma unroll
    for (int ks = 0; ks < NKS; ++ks) q[ks] = *(const bf16x8*)(qg + (size_t)(qrow0 + r32) * qstride + ks * 16 + h * 8);
    f32x16 o[4];
#pragma unroll
    for (int b = 0; b < 4; ++b)
#pragma unroll
        for (int r = 0; r < 16; ++r) o[b][r] = 0.f;
    float m = -INFINITY, lsum = 0.f;
    const int nt0 = s0.n >> 6, nt = nt0 + (two ? (s1.n >> 6) : 0);
    FaTile t;
    __syncthreads();
    fa_load(t, s0, 0, tid); fa_store(t, F.lds, tid);
    __syncthreads();
    for (int it = 0; it < nt; ++it) {
        const bool more = it + 1 < nt;
        if (more) { const int n = it + 1; if (n < nt0) fa_load(t, s0, n * 64, tid); else fa_load(t, s1, (n - nt0) * 64, tid); }
        const bool inseg1 = it >= nt0; const int pos0 = inseg1 ? s1.pos0 : s0.pos0; const int key0 = (inseg1 ? it - nt0 : it) * 64;
        fa_tile<NKS>(F.lds + (it & 1) * FA_BUF, q, o, m, lsum, c, kcolb, lane, pos0 >= 0, (qpos0 + qrow0 + r32) - (pos0 + key0));
        if (more) fa_store(t, F.lds + ((it + 1) & 1) * FA_BUF, tid);
        __syncthreads();
    }
    const float ltot = lsum + __shfl_xor(lsum, 32);
    if (MODE == 0) {
        const float inv = 1.0f / (ltot + __builtin_amdgcn_exp2f(sinkp[grp] * 1.4426950408889634f - m));
#pragma unroll
        for (int b = 0; b < 4; ++b) o[b] = o[b] * inv;
    } else {
        LAS float* comb = (LAS float*)(F.lds + (w & 3) * 16384);
        if (grp == 1) { const float f = lam / ltot;
#pragma unroll
            for (int b = 0; b < 4; ++b)
#pragma unroll
                for (int r = 0; r < 16; ++r) comb[(32 * b + (r & 3) + 8 * (r >> 2) + 4 * h) * 32 + r32] = o[b][r] * f; }
        __syncthreads();
        if (grp == 0) { const float inv = 1.0f / ltot; float ss = 0.f;
#pragma unroll
            for (int b = 0; b < 4; ++b)
#pragma unroll
                for (int r = 0; r < 16; ++r) { const float v = o[b][r] * inv - comb[(32 * b + (r & 3) + 8 * (r >> 2) + 4 * h) * 32 + r32]; o[b][r] = v; ss += v * v; }
            ss += __shfl_xor(ss, 32);
            const float rs = onems / sqrtf(ss * (1.0f / 128.0f) + EPS);
#pragma unroll
            for (int b = 0; b < 4; ++b)
#pragma unroll
                for (int r = 0; r < 16; ++r) o[b][r] = o[b][r] * rs * dnorm[32 * b + (r & 3) + 8 * (r >> 2) + 4 * h]; }
    }
    if (MODE == 0 || grp == 0) {
        LAS unsigned char* st = F.lds + (MODE == 0 ? w * (32 * FA_OSTR) : 65536 + (w & 3) * (32 * FA_OSTR));
#pragma unroll
        for (int b = 0; b < 4; ++b)
#pragma unroll
            for (int k = 0; k < 4; ++k) { typedef unsigned u2 __attribute__((ext_vector_type(2)));
                *(LAS u2*)(st + r32 * FA_OSTR + (32 * b + 8 * k + 4 * h) * 2) = (u2){cvtpk(o[b][4 * k], o[b][4 * k + 1]), cvtpk(o[b][4 * k + 2], o[b][4 * k + 3])}; }
        asm volatile("s_waitcnt lgkmcnt(0)" ::: "memory");
#pragma unroll
        for (int i = 0; i < 8; ++i) { const int cc = lane + 64 * i, row = cc >> 4, c16 = cc & 15;
            *(v4u*)(dst + (size_t)(qrow0 + row) * dstride + c16 * 8) = *(const LAS v4u*)(st + row * FA_OSTR + c16 * 16); }
    }
}
constexpr int SS_X = 0, SS_B = 16384, SS_C = 49152, SS_DT = 81920;
__device__ __forceinline__ void ssd_unit(Frame& F, PP p, int l, int seq, int hd, int dir) {
    unsigned char* ws = p->ws; const float* XBC = (const float*)(ws + WS_XBC); const float* DT = (const float*)(ws + WS_DT);
    float* Y = (float*)(ws + (dir ? WS_YB : WS_YF));
    const int s0 = seq < 16 ? seq * 256 : 4096 + (seq - 16) * 4096, len = seq < 16 ? 256 : 4096, g = hd >> 3;
    int tid_ = F.tid; asm volatile("" : "+v"(tid_)); const int tid = tid_;
    const int pp = tid >> 3, nq = tid & 7;
    const float a = -__expf(p->in[21][(l * 2 + dir) * 16 + hd]);
    f32x4 h[4];
    if (seq < 16) { h[0] = h[1] = h[2] = h[3] = (f32x4){0.f, 0.f, 0.f, 0.f}; }
    else { const f32x4* hs = (const f32x4*)(p->in[dir ? 7 : 6] + ((((size_t)(seq - 16) * DEPTH + l) * 16 + hd) * 64 + pp) * 128 + nq * 16);
           h[0] = hs[0]; h[1] = hs[1]; h[2] = hs[2]; h[3] = hs[3]; }
    LAS float* xs = (LAS float*)(F.lds + SS_X); LAS float* Bs = (LAS float*)(F.lds + SS_B); LAS float* Cs = (LAS float*)(F.lds + SS_C); LAS float* dts = (LAS float*)(F.lds + SS_DT);
    for (int c = 0; c < len; c += 64) {
        __syncthreads();
#pragma unroll
        for (int r = 0; r < 10; ++r) { const int idx = tid + NTHR * r, i = idx / 80, q = idx % 80; const int t = dir ? (len - 1 - (c + i)) : (c + i);
            const float* row = XBC + (size_t)(s0 + t) * 1536;
            if (q < 16) *(LAS f32x4*)(xs + i * 64 + 4 * q) = *(const f32x4*)(row + hd * 64 + 4 * q);
            else if (q < 48) *(LAS f32x4*)(Bs + i * 128 + 4 * (q - 16)) = *(const f32x4*)(row + 1024 + g * 128 + 4 * (q - 16));
            else *(LAS f32x4*)(Cs + i * 128 + 4 * (q - 48)) = *(const f32x4*)(row + 1280 + g * 128 + 4 * (q - 48)); }
        if (tid < 64) { const int t = dir ? (len - 1 - (c + tid)) : (c + tid); dts[tid] = DT[(size_t)(s0 + t) * 32 + dir * 16 + hd]; }
        __syncthreads();
        for (int i = 0; i < 64; ++i) {
            const float dt = dts[i], dec = __expf(dt * a), xv = xs[i * 64 + pp] * dt;
            const LAS f32x4* bp = (const LAS f32x4*)(Bs + i * 128 + nq * 16); const LAS f32x4* cp = (const LAS f32x4*)(Cs + i * 128 + nq * 16);
            float y = 0.f;
#pragma unroll
            for (int k = 0; k < 4; ++k) { const f32x4 bv = bp[k], cv = cp[k]; h[k] = h[k] * dec + bv * xv; y += (cv.x * h[k].x + cv.y * h[k].y) + (cv.z * h[k].z + cv.w * h[k].w); }
            y += __shfl_xor(y, 1); y += __shfl_xor(y, 2); y += __shfl_xor(y, 4);
            if (nq == 0) { const int t = dir ? (len - 1 - (c + i)) : (c + i); Y[(size_t)(s0 + t) * 1024 + hd * 64 + pp] = y; }
        }
    }
    if (seq < 16) { f32x4* ho = (f32x4*)(p->out + (dir ? OUT_SB : OUT_SF) + ((((size_t)seq * DEPTH + l) * 16 + hd) * 64 + pp) * 128 + nq * 16);
        ho[0] = h[0]; ho[1] = h[1]; ho[2] = h[2]; ho[3] = h[3]; }
}
__device__ __forceinline__ void mix1_phase(Frame& F, PP p, int l) {
    unsigned char* ws = p->ws;
    const bf16* P = (const bf16*)(ws + WS_P); const bf16* QKR = (const bf16*)(ws + WS_QKR); bf16* MIX = (bf16*)(ws + WS_MIX);
    const float* lamv = (const float*)(ws + WS_TAB + 32768);
    const float lam = lamv[l], onems = 1.0f - lamv[4 + l];
    const float* dnorm = p->in[17] + l * 128;
    constexpr int U_SL = 64, U_BL = 256, U_SC = 512, U_AL = 128, U_BC = 128, U_AC = 64, U_ALL = U_SL + U_BL + U_SC + U_AL + U_BC + U_AC;
    const float LOG2E = 1.4426950408889634f, cA = 0.08838834764831845f * LOG2E, cB = 0.125f * LOG2E;
    for (int u = blockIdx.x; u < U_ALL; u += F.G) {
        int r = u;
        if (r < U_SL) { ssd_unit(F, p, l, 16 + (r >> 5), (r >> 1) & 15, r & 1); continue; } r -= U_SL;
        int mode = 1; const bf16* qp; int qstr = RCW, qpos0 = 0; bool two = true; Seg s0, s1; bf16* dst; const float* sinkp = dnorm;
        if (r < U_BL) {
            const int b = r >> 7, h = (r >> 5) & 3, qb = r & 31; const int ml = b * 4096 + qb * 128;
            s0 = Seg{QKR + (size_t)(b * 4096) * RCW + RC_KD + h * 128, P + (size_t)(4096 + b * 4096) * INP + PC_VD + h * 128, RCW, INP, 4096, 0, -1};
            s1 = Seg{p->in[4] + ((size_t)(b * DEPTH + l) * 256) * 512 + h * 128, p->in[5] + ((size_t)(b * DEPTH + l) * 256) * 512 + h * 128, 512, 512, 256, 1, -1};
            qp = QKR + (size_t)ml * RCW + RC_QD + h * 128; dst = MIX + (size_t)(4096 + ml) * DM + 512 + h * 128;
        } else if (r < U_BL + U_SC) { r -= U_BL; ssd_unit(F, p, l, r >> 5, (r >> 1) & 15, r & 1); continue;
        } else if (r < U_BL + U_SC + U_AL) { r -= U_BL + U_SC;
            const int b = r >> 6, kv = (r >> 5) & 1, qb = r & 31; const int ml = b * 4096 + qb * 128;
            const int w0 = qb * 128 - 128 < 0 ? 0 : qb * 128 - 128, w1 = qb * 128 + 256 > 4096 ? 4096 : qb * 128 + 256;
            s0 = Seg{p->in[2] + ((size_t)(b * DEPTH + l) * 256) * 256 + kv * 128, p->in[3] + ((size_t)(b * DEPTH + l) * 256) * 256 + kv * 128, 256, 256, 256, 1, -1};
            s1 = Seg{QKR + (size_t)(b * 4096 + w0) * RCW + RC_KA + kv * 128, P + (size_t)(4096 + b * 4096 + w0) * INP + PC_VA + kv * 128, RCW, INP, w1 - w0, 0, w0};
            mode = 0; qp = QKR + (size_t)ml * RCW + RC_QA + kv * 256; qpos0 = qb * 128; sinkp = p->in[15] + l * 4 + kv * 2; dst = MIX + (size_t)(4096 + ml) * DM + kv * 256;
        } else if (r < U_BL + U_SC + U_AL + U_BC) { r -= U_BL + U_SC + U_AL;
            const int b = r >> 3, h = (r >> 1) & 3, qb = r & 1; const int m0 = b * 256 + qb * 128;
            s0 = Seg{P + (size_t)(b * 256) * INP + PC_KD + h * 128, P + (size_t)(b * 256) * INP + PC_VD + h * 128, INP, INP, 256, 0, -1}; s1 = s0; two = false;
            qp = P + (size_t)m0 * INP + PC_QD + h * 128; qstr = INP; dst = MIX + (size_t)m0 * DM + 512 + h * 128;
        } else { r -= U_BL + U_SC + U_AL + U_BC;
            const int b = r >> 2, kv = (r >> 1) & 1, qb = r & 1; const int m0 = b * 256 + qb * 128;
            s0 = Seg{P + (size_t)(b * 256) * INP + PC_KA + kv * 128, P + (size_t)(b * 256) * INP + PC_VA + kv * 128, INP, INP, 256, 0, -1}; s1 = s0; two = false;
            mode = 0; qp = P + (size_t)m0 * INP + PC_QA + kv * 256; qstr = INP; sinkp = p->in[15] + l * 4 + kv * 2; dst = MIX + (size_t)m0 * DM + kv * 256;
        }
        if (mode) fa_unit<1>(F, qp, qstr, s0, s1, two, qpos0, cB, sinkp, lam, onems, dnorm, dst, DM);
        else fa_unit<0>(F, qp, qstr, s0, s1, two, qpos0, cA, sinkp, lam, onems, dnorm, dst, DM);
    }
}
__device__ __forceinline__ void mix2_phase(Frame& F, PP p, int l) {
    unsigned char* ws = p->ws;
    const bf16* P = (const bf16*)(ws + WS_P); const float* XBC = (const float*)(ws + WS_XBC); const float* YF = (const float*)(ws + WS_YF); const float* YB = (const float*)(ws + WS_YB); bf16* MIX = (bf16*)(ws + WS_MIX);
    const float* dsk = p->in[22] + l * 16; const float* sn = p->in[23] + l * 1024;
    const int gw = F.vcu * NWAVES + F.wave, NGW = F.G * NWAVES, lane = F.lane;
    for (int m = gw; m < MROWS; m += NGW) {
        const int c0 = lane * 16; const float dk = dsk[c0 >> 6];
        const v4u z0 = *(const v4u*)(P + (size_t)m * INP + PC_Z + c0), z1 = *(const v4u*)(P + (size_t)m * INP + PC_Z + c0 + 8);
        float zz[16] = {bflo(z0.x), bfhi(z0.x), bflo(z0.y), bfhi(z0.y), bflo(z0.z), bfhi(z0.z), bflo(z0.w), bfhi(z0.w), bflo(z1.x), bfhi(z1.x), bflo(z1.y), bfhi(z1.y), bflo(z1.z), bfhi(z1.z), bflo(z1.w), bfhi(z1.w)};
        float y[16]; float ss = 0.f;
#pragma unroll
        for (int q = 0; q < 4; ++q) { const f32x4 a = *(const f32x4*)(YF + (size_t)m * 1024 + c0 + 4 * q), b = *(const f32x4*)(YB + (size_t)m * 1024 + c0 + 4 * q), x = *(const f32x4*)(XBC + (size_t)m * 1536 + c0 + 4 * q);
            const f32x4 v = a + b + x * dk;
            y[4 * q + 0] = v.x * silu(zz[4 * q + 0]); y[4 * q + 1] = v.y * silu(zz[4 * q + 1]); y[4 * q + 2] = v.z * silu(zz[4 * q + 2]); y[4 * q + 3] = v.w * silu(zz[4 * q + 3]); }
#pragma unroll
        for (int e = 0; e < 16; ++e) ss += y[e] * y[e];
#pragma unroll
        for (int o = 1; o < 32; o <<= 1) ss += __shfl_xor(ss, o);
        const float rs = 1.0f / sqrtf(ss * (1.0f / 512.0f) + EPS);
        v4u o0, o1;
        { const f32x4 g0 = *(const f32x4*)(sn + c0), g1 = *(const f32x4*)(sn + c0 + 4), g2 = *(const f32x4*)(sn + c0 + 8), g3 = *(const f32x4*)(sn + c0 + 12);
          o0.x = pk2(y[0] * rs * g0.x, y[1] * rs * g0.y); o0.y = pk2(y[2] * rs * g0.z, y[3] * rs * g0.w); o0.z = pk2(y[4] * rs * g1.x, y[5] * rs * g1.y); o0.w = pk2(y[6] * rs * g1.z, y[7] * rs * g1.w);
          o1.x = pk2(y[8] * rs * g2.x, y[9] * rs * g2.y); o1.y = pk2(y[10] * rs * g2.z, y[11] * rs * g2.w); o1.z = pk2(y[12] * rs * g3.x, y[13] * rs * g3.y); o1.w = pk2(y[14] * rs * g3.z, y[15] * rs * g3.w); }
        *(v4u*)(MIX + (size_t)m * DM + 1024 + c0) = o0; *(v4u*)(MIX + (size_t)m * DM + 1024 + c0 + 8) = o1;
    }
}

#ifndef MK_ONE_LAUNCH
#define MK_ONE_LAUNCH 1
#endif
constexpr int PH_PER_LAYER = 9, PH_TOTAL = 2 + DEPTH * PH_PER_LAYER + 1;
__global__ void __launch_bounds__(NTHR, 2) mk_fwd(Params p_) {
    extern __shared__ __attribute__((aligned(16))) unsigned char lds[];
    Frame F;
    F.lds = (LAS unsigned char*)lds;
    F.tid = threadIdx.x; F.lane = F.tid & 63; F.wave = __builtin_amdgcn_readfirstlane(F.tid >> 6);
    F.G = gridDim.x; { const int bx = blockIdx.x; F.vcu = (F.G % 8 == 0) ? (bx % 8) * (F.G / 8) + bx / 8 : bx; }
    PP p = (PP)__builtin_amdgcn_kernarg_segment_ptr();
    for (int u = F.tid; u < (LDS_BYTES - LDSCTL_OFF) / 4; u += NTHR) ((LAS unsigned*)(F.lds + LDSCTL_OFF))[u] = 0u;
    __syncthreads();
    XcdBarrier bar; bar.bar = (unsigned*)(p->ws + WS_CTL) + CW_BAR; bar.x = 0; bar.st = nullptr;
#if MK_ONE_LAUNCH
    bar = xcd_barrier_post((unsigned*)(p->ws + WS_CTL) + CW_BAR, (volatile LAS unsigned*)(F.lds + MISC_OFF) + 8);
#define GRID_BAR() xcd_barrier(bar)
#else
#define GRID_BAR() do {} while (0)
#endif
    const int lo = p->ph_lo, hi = p->ph_hi;
#define IN(k) (lo <= (k) && (k) < hi)
#define SEAM(k) do { if (IN(k) && IN((k) + 1)) GRID_BAR(); } while (0)
#define ENTER() do { int t_ = threadIdx.x; asm volatile("" : "+v"(t_)); F.tid = t_; F.lane = t_ & 63; F.wave = __builtin_amdgcn_readfirstlane(t_ >> 6); asm volatile("" : "+s"(p)); ws = p->ws; } while (0)
    unsigned char* ws;

    if (IN(0)) { ENTER(); p0_prologue(F, p); } SEAM(0);
    if (IN(1)) { ENTER(); p0b_mod(F, p); } SEAM(1);
#pragma unroll 1
    for (int l = 0; l < DEPTH; ++l) {
        const int pb = 2 + l * PH_PER_LAYER;
        if (IN(pb + 0)) { ENTER(); norm_phase(F, (const float*)(ws + WS_H), p->in[12] + l * DM, (const float*)(ws + WS_MOD) + (size_t)l * 3 * NMOD, 0, DM, (bf16*)(ws + WS_U)); } SEAM(pb + 0);
        if (IN(pb + 1)) { ENTER();
            pg8::Gemm g{(const bf16*)(ws + WS_U), (const bf16*)(ws + WS_WIN) + (size_t)l * INP * DM, MROWS, INP, DM}; pg8::StaticOrder S; S.init(MROWS, INP, F.G, (int)blockIdx.x);
            pg8::EpiBf16 E{(bf16*)(ws + WS_P), INP};
            pg8::gemm_phase<pg8::EpiBf16, pg8::StaticOrder, true, true>(F.lds, g, S, E);
        } SEAM(pb + 1);
        if (IN(pb + 2)) { ENTER(); prep_phase(F, p, l); } SEAM(pb + 2);
        if (IN(pb + 3)) { ENTER(); mix1_phase(F, p, l); } SEAM(pb + 3);
        if (IN(pb + 4)) { ENTER(); mix2_phase(F, p, l); } SEAM(pb + 4);
        if (IN(pb + 5)) { ENTER();
            pg8::Gemm g{(const bf16*)(ws + WS_MIX), (const bf16*)(ws + WS_WOUT) + (size_t)l * DM * DM, MROWS, DM, DM}; pg8::StaticOrder S; S.init(MROWS, DM, F.G, (int)blockIdx.x);
            pg8::EpiResid E{(float*)(ws + WS_H), DM, (const float*)(ws + WS_MOD) + (size_t)l * 3 * NMOD + 2 * DM, NMOD};
            pg8::gemm_phase<pg8::EpiResid, pg8::StaticOrder, true, true>(F.lds, g, S, E);
        } SEAM(pb + 5);
        if (IN(pb + 6)) { ENTER(); norm_phase(F, (const float*)(ws + WS_H), p->in[13] + l * DM, (const float*)(ws + WS_MOD) + (size_t)l * 3 * NMOD, 3 * DM, 4 * DM, (bf16*)(ws + WS_U)); } SEAM(pb + 6);
        if (IN(pb + 7)) { ENTER();
            pg8::Gemm g{(const bf16*)(ws + WS_U), (const bf16*)(ws + WS_WGU) + (size_t)l * GU * DM, MROWS, GU, DM}; pg8::StaticOrder S; S.init(MROWS, GU, F.G, (int)blockIdx.x);
            pg8::EpiSwiGLU E{(bf16*)(ws + WS_ACT), FF};
            pg8::gemm_phase<pg8::EpiSwiGLU, pg8::StaticOrder, true, true>(F.lds, g, S, E);
        } SEAM(pb + 7);
        if (IN(pb + 8)) { ENTER();
            pg8::Gemm g{(const bf16*)(ws + WS_ACT), (const bf16*)(ws + WS_WDN) + (size_t)l * DM * FF, MROWS, DM, FF}; pg8::StaticOrder S; S.init(MROWS, DM, F.G, (int)blockIdx.x);
            pg8::EpiResid E{(float*)(ws + WS_H), DM, (const float*)(ws + WS_MOD) + (size_t)l * 3 * NMOD + 5 * DM, NMOD};
            pg8::gemm_phase<pg8::EpiResid, pg8::StaticOrder, true, true>(F.lds, g, S, E);
        } SEAM(pb + 8);
    }
    if (IN(PH_TOTAL - 1)) { ENTER(); final_phase(F, (const float*)(ws + WS_H), p->in[27], p->out); }
#undef IN
#undef SEAM
#undef ENTER
}

extern "C" void kernel_launch(void* const* d_in, const int* in_sizes, int n_in, void* d_out, int out_size, void* d_ws, size_t ws_size, hipStream_t stream) {
    static int grid = 0;
    if (grid == 0) {
        if (n_in != 28 || out_size != 67108864 || ws_size < WS_END) { fprintf(stderr, "kernel_launch: unexpected sizes n_in %d out %d ws %zu\n", n_in, out_size, ws_size); grid = -1; return; }
        int dev = 0, cus = 0, per_cu = 0;
        if (hipGetDevice(&dev) != hipSuccess || hipDeviceGetAttribute(&cus, hipDeviceAttributeMultiprocessorCount, dev) != hipSuccess) { grid = -1; return; }
        if (hipFuncSetAttribute((const void*)mk_fwd, hipFuncAttributeMaxDynamicSharedMemorySize, LDS_BYTES) != hipSuccess) { fprintf(stderr, "kernel_launch: hipFuncSetAttribute failed\n"); grid = -1; return; }
        if (hipOccupancyMaxActiveBlocksPerMultiprocessor(&per_cu, (const void*)mk_fwd, NTHR, LDS_BYTES) != hipSuccess || per_cu < 1)
            fprintf(stderr, "kernel_launch: occupancy query reports %d workgroups per CU\n", per_cu);
        (void)hipGetLastError();
        grid = cus;
    }
    if (grid < 0) return;
    if (hipMemsetAsync((char*)d_ws + WS_CTL, 0, CTL_ZERO_BYTES, stream) != hipSuccess) return;
    Params a{};
    for (int i = 0; i < 28; ++i) a.in[i] = (const float*)d_in[i];
    a.out = (float*)d_out; a.ws = (unsigned char*)d_ws;
#if MK_ONE_LAUNCH
    a.ph_lo = 0; a.ph_hi = PH_TOTAL;
    hipLaunchKernelGGL(mk_fwd, dim3(grid), dim3(NTHR), LDS_BYTES, stream, a);
#else
    for (int ph = 0; ph < PH_TOTAL; ++ph) { a.ph_lo = ph; a.ph_hi = ph + 1; hipLaunchKernelGGL(mk_fwd, dim3(grid), dim3(NTHR), LDS_BYTES, stream, a); }
#endif
}
```

```cpp
#include <hip/hip_runtime.h>
#include <cstdio>
#include <cstdint>
namespace pg8 {
#define PG8_LAS __attribute__((address_space(3)))
typedef unsigned short bf16_t;
typedef short bf16x8 __attribute__((ext_vector_type(8)));
typedef float f32x4 __attribute__((ext_vector_type(4)));
typedef unsigned u32x4 __attribute__((ext_vector_type(4)));
constexpr int BM = 256, BK = 64, HALF = 128, HTB = HALF * BK * 2  , STAGE_BYTES = 8 * HTB, NXCD = 8, WGM = 8;

__host__ __device__ __forceinline__ int lds_byte(int r, int c) { const int st = (r >> 4) * 2 + (c >> 5), rr = r & 15, cc = c & 31, ob = rr * 64 + cc * 2; return st * 1024 + (ob ^ (((ob >> 9) & 1) << 5)); }
__host__ __device__ __forceinline__ void stage_rc(int b, int& R, int& C) { const int st = b / 1024, sb = b % 1024, swz = sb ^ (((sb >> 9) & 1) << 5); R = (st >> 1) * 16 + swz / 64; C = (st & 1) * 32 + (swz % 64) / 2; }
__host__ __device__ __forceinline__ int perm32(int rho) { const int n = rho >> 4, i = rho & 15; return 8 * (i >> 2) + 4 * n + (i & 3); }

struct Unit { int pm, pn; };
struct Gemm { const bf16_t* A; const bf16_t* Bt; int M, N, K; };

struct StaticOrder {
    int nM, nN, nwg, G, c;
    __host__ __device__ void init(int M, int N, int G_, int c_) { nM = M / BM; nN = N / BM; nwg = nM * nN; G = G_; c = c_; }
    __host__ __device__ bool next(int i, Unit& u) const {
        const long L = (long)i * G + c; if (L >= nwg) return false;
        int wgid = (int)L; { const int q = nwg / NXCD, r = nwg % NXCD, xcd = wgid % NXCD, off = wgid / NXCD; wgid = (xcd < r ? xcd * (q + 1) : r * (q + 1) + (xcd - r) * q) + off; }
        const int nig = WGM * nN, gid = wgid / nig, fm = gid * WGM, gsz = (nM - fm) < WGM ? (nM - fm) : WGM;
        u.pm = fm + ((wgid % nig) % gsz); u.pn = (wgid % nig) / gsz; return true;
    }
    __device__ __forceinline__ void a_ready(const Unit&) const {}
    __device__ __forceinline__ void done(const Unit&) const {}
};

__device__ __forceinline__ unsigned cvt_pk_bf16(float lo, float hi) { unsigned r; asm volatile("v_cvt_pk_bf16_f32 %0, %1, %2" : "=v"(r) : "v"(lo), "v"(hi)); return r; }

struct EpiBf16 {
    static constexpr bool PERM = true, AFTER_DRAIN = false;
    bf16_t* O; int ldc;
    __device__ __forceinline__ void operator()(const f32x4 (&acc)[2][2][4][2], const Unit& u, int wr, int wc, int fr, int fq) const {
        const int row0 = u.pm * BM + wr * 64 + fr; const int col0 = u.pn * BM + wc * 32 + 8 * fq;
#pragma unroll
        for (int ai = 0; ai < 2; ++ai)
#pragma unroll
            for (int m = 0; m < 4; ++m) { bf16_t* rowp = O + (size_t)(row0 + ai * HALF + m * 16) * ldc + col0;
#pragma unroll
                for (int bj = 0; bj < 2; ++bj) { const f32x4 v0 = acc[ai][bj][m][0], v1 = acc[ai][bj][m][1];
                    u32x4 w; w.x = cvt_pk_bf16(v0[0], v0[1]); w.y = cvt_pk_bf16(v0[2], v0[3]); w.z = cvt_pk_bf16(v1[0], v1[1]); w.w = cvt_pk_bf16(v1[2], v1[3]);
                    *(u32x4*)(rowp + bj * HALF) = w; } }
    }
};
__device__ __forceinline__ int cond_of_pm(int pm) { return pm < 16 ? 0 : (pm < 32 ? 1 : 2); }
struct EpiResid {
    static constexpr bool PERM = false, AFTER_DRAIN = false;
    float* H; int ldc; const float* gate; int gstride;
    __device__ __forceinline__ void operator()(const f32x4 (&acc)[2][2][4][2], const Unit& u, int wr, int wc, int fr, int fq) const {
        const float* g = gate + (size_t)cond_of_pm(u.pm) * gstride;
        const int row0 = u.pm * BM + wr * 64 + fr; const int col0 = u.pn * BM + wc * 32 + 4 * fq;
        f32x4 gv[2][2];
#pragma unroll
        for (int bj = 0; bj < 2; ++bj)
#pragma unroll
            for (int n = 0; n < 2; ++n) gv[bj][n] = *(const f32x4*)(g + col0 + bj * HALF + n * 16);
#pragma unroll
        for (int ai = 0; ai < 2; ++ai)
#pragma unroll
            for (int m = 0; m < 4; ++m) { float* rowp = H + (size_t)(row0 + ai * HALF + m * 16) * ldc + col0;
#pragma unroll
                for (int bj = 0; bj < 2; ++bj)
#pragma unroll
                    for (int n = 0; n < 2; ++n) { f32x4* p = (f32x4*)(rowp + bj * HALF + n * 16); f32x4 h = *p; h = h + gv[bj][n] * acc[ai][bj][m][n]; *p = h; }
                asm volatile("" ::: "memory"); }
    }
};
__device__ __forceinline__ float silu_f(float x) { return x * __builtin_amdgcn_rcpf(1.0f + __expf(-x)); }
struct EpiSwiGLU {
    static constexpr bool PERM = true, AFTER_DRAIN = false;
    bf16_t* O; int ldc;
    __device__ __forceinline__ void operator()(const f32x4 (&acc)[2][2][4][2], const Unit& u, int wr, int wc, int fr, int fq) const {
        const int row0 = u.pm * BM + wr * 64 + fr; const int col0 = u.pn * HALF + wc * 32 + 8 * fq;
#pragma unroll
        for (int ai = 0; ai < 2; ++ai)
#pragma unroll
            for (int m = 0; m < 4; ++m) { bf16_t* rowp = O + (size_t)(row0 + ai * HALF + m * 16) * ldc + col0;
                const f32x4 g0 = acc[ai][0][m][0], g1 = acc[ai][0][m][1], u0 = acc[ai][1][m][0], u1 = acc[ai][1][m][1];
                u32x4 w;
                w.x = cvt_pk_bf16(silu_f(g0[0]) * u0[0], silu_f(g0[1]) * u0[1]); w.y = cvt_pk_bf16(silu_f(g0[2]) * u0[2], silu_f(g0[3]) * u0[3]);
                w.z = cvt_pk_bf16(silu_f(g1[0]) * u1[0], silu_f(g1[1]) * u1[1]); w.w = cvt_pk_bf16(silu_f(g1[2]) * u1[2], silu_f(g1[3]) * u1[3]);
                *(u32x4*)rowp = w; }
    }
};
template <class Epi, class Sched, bool ALIGN_EPI = false, bool SP2 = false>
__device__ __forceinline__ void gemm_phase(PG8_LAS unsigned char* lds, const Gemm g, const Sched& S, const Epi& E) {
    int tid_ = threadIdx.x; asm volatile("" : "+v"(tid_));
    const int tid = tid_, wid = __builtin_amdgcn_readfirstlane(tid >> 6), lane = tid & 63, wr = wid >> 2, wc = wid & 3, fr = lane & 15, fq = lane >> 4;
    const int K = g.K, nt = K / BK;
    unsigned voffA[2], voffB[2];
#pragma unroll
    for (int i = 0; i < 2; ++i) { int R, C; stage_rc(tid * 16 + i * 8192, R, C); const int Rb = Epi::PERM ? ((R & ~31) + perm32(R & 31)) : R;
        voffA[i] = (unsigned)(R * K + C) * 2u; voffB[i] = (unsigned)(Rb * K + C) * 2u; }
    const size_t kstep = (size_t)(BK * 2);
    const size_t hstep = (size_t)HALF * K * 2;
    const size_t tstep = 2 * hstep;
    const unsigned ldsw = (unsigned)wid * 1024u;
    const int aoff = lds_byte(wr * 64 + fr, fq * 8), boff = lds_byte(wc * 32 + fr, fq * 8);
#define PG8_SA(b, h) (((b) * 2 + (h)) * HTB)
#define PG8_SB(b, h) ((4 + (b) * 2 + (h)) * HTB)
#define PG8_STAGE(bufoff, gbase, voff) do { _Pragma("unroll") for (int _i = 0; _i < 2; ++_i) \
        __builtin_amdgcn_global_load_lds((const unsigned*)((const char*)(gbase) + (voff)[_i]), (PG8_LAS unsigned*)(lds + (bufoff) + ldsw + _i * 8192), 16, 0, 0); } while (0)
#define PG8_LDA(dst, b, h) do { _Pragma("unroll") for (int m = 0; m < 4; ++m) _Pragma("unroll") for (int k = 0; k < 2; ++k) dst[m][k] = *(const PG8_LAS bf16x8*)(lds + PG8_SA(b, h) + aoff + m * 2048 + k * 1024); } while (0)
#define PG8_LDB(dst, b, h) do { _Pragma("unroll") for (int n = 0; n < 2; ++n) _Pragma("unroll") for (int k = 0; k < 2; ++k) dst[n][k] = *(const PG8_LAS bf16x8*)(lds + PG8_SB(b, h) + boff + n * 2048 + k * 1024); } while (0)
#define PG8_MMA(ai, bj, At, Bt) do { __builtin_amdgcn_s_setprio(1); _Pragma("unroll") for (int m = 0; m < 4; ++m) _Pragma("unroll") for (int n = 0; n < 2; ++n) _Pragma("unroll") for (int k = 0; k < 2; ++k) \
        acc[ai][bj][m][n] = __builtin_amdgcn_mfma_f32_16x16x32_bf16(Bt[n][k], At[m][k], acc[ai][bj][m][n], 0, 0, 0); __builtin_amdgcn_s_setprio(0); } while (0)
#define PG8_WAIT_V(n) asm volatile("s_waitcnt vmcnt(" #n ")" ::: "memory")
#define PG8_WAIT_L(n) asm volatile("s_waitcnt lgkmcnt(" #n ")" ::: "memory")
#define PG8_BAR __builtin_amdgcn_s_barrier()
#define PG8_SCHED __builtin_amdgcn_sched_barrier(0)
    Unit cur, nxt; int ui = 0;
    if (!S.next(0, cur)) return;
    f32x4 acc[2][2][4][2];
#pragma unroll
    for (int a = 0; a < 2; ++a)
#pragma unroll
        for (int b = 0; b < 2; ++b)
#pragma unroll
            for (int m = 0; m < 4; ++m)
#pragma unroll
                for (int n = 0; n < 2; ++n) acc[a][b][m][n] = (f32x4){0.f, 0.f, 0.f, 0.f};
    bf16x8 At[4][2], B0[2][2], B1[2][2];
    const char* cA = (const char*)g.A + (size_t)cur.pm * tstep; const char* cB = (const char*)g.Bt + (size_t)cur.pn * tstep;
    S.a_ready(cur);
    if constexpr (SP2) {
        PG8_STAGE(PG8_SB(0, 0), cB, voffB); PG8_STAGE(PG8_SB(0, 1), cB + hstep, voffB); PG8_STAGE(PG8_SA(0, 0), cA, voffA); PG8_STAGE(PG8_SA(0, 1), cA + hstep, voffA);
        if (wr == 1) PG8_BAR;
        PG8_WAIT_V(2); PG8_BAR;
        PG8_STAGE(PG8_SB(1, 0), cB + kstep, voffB); PG8_STAGE(PG8_SA(1, 0), cA + kstep, voffA); PG8_STAGE(PG8_SB(1, 1), cB + hstep + kstep, voffB);
        PG8_WAIT_V(6); PG8_BAR;
    } else {
        PG8_STAGE(PG8_SB(0, 0), cB, voffB); PG8_STAGE(PG8_SA(0, 0), cA, voffA); PG8_STAGE(PG8_SB(0, 1), cB + hstep, voffB); PG8_STAGE(PG8_SA(0, 1), cA + hstep, voffA);
        if (wr == 1) PG8_BAR;
        PG8_WAIT_V(4); PG8_BAR;
        PG8_STAGE(PG8_SB(1, 0), cB + kstep, voffB); PG8_STAGE(PG8_SA(1, 0), cA + kstep, voffA); PG8_STAGE(PG8_SB(1, 1), cB + hstep + kstep, voffB);
        PG8_WAIT_V(6); PG8_BAR;
    }
    for (;;) {
        const bool has_next = S.next(ui + 1, nxt);
        const char* nA = has_next ? (const char*)g.A + (size_t)nxt.pm * tstep : cA; const char* nB = has_next ? (const char*)g.Bt + (size_t)nxt.pn * tstep : cB;
        for (int t = 0; t < nt; t += 2) {
            const bool last = (t == nt - 2);
            const char* a1 = cA + (size_t)(t + 1) * kstep;
            const char* a2 = last ? nA : cA + (size_t)(t + 2) * kstep; const char* b2 = last ? nB : cB + (size_t)(t + 2) * kstep;
            const char* a3 = a2 + kstep; const char* b3 = b2 + kstep;
            if (last && has_next) S.a_ready(nxt);
            if constexpr (SP2) {
            PG8_LDB(B0, 0, 0); PG8_LDB(B1, 0, 1); PG8_SCHED; PG8_LDA(At, 0, 0); PG8_STAGE(PG8_SA(1, 1), a1 + hstep, voffA);
            PG8_WAIT_V(8); PG8_WAIT_L(0); PG8_BAR; PG8_MMA(0, 0, At, B0); PG8_MMA(0, 1, At, B1); PG8_BAR; PG8_SCHED;
            PG8_LDA(At, 0, 1); PG8_STAGE(PG8_SB(0, 0), b2, voffB); PG8_STAGE(PG8_SB(0, 1), b2 + hstep, voffB); PG8_STAGE(PG8_SA(0, 0), a2, voffA);
            PG8_WAIT_V(8); PG8_WAIT_L(0); PG8_BAR; PG8_MMA(1, 0, At, B0); PG8_MMA(1, 1, At, B1); PG8_BAR; PG8_SCHED;
            PG8_LDB(B0, 1, 0); PG8_LDB(B1, 1, 1); PG8_SCHED; PG8_LDA(At, 1, 0); PG8_STAGE(PG8_SA(0, 1), a2 + hstep, voffA);
            PG8_WAIT_V(8); PG8_WAIT_L(0); PG8_BAR; PG8_MMA(0, 0, At, B0); PG8_MMA(0, 1, At, B1); PG8_BAR; PG8_SCHED;
            PG8_LDA(At, 1, 1); PG8_STAGE(PG8_SB(1, 0), b3, voffB); PG8_STAGE(PG8_SB(1, 1), b3 + hstep, voffB); PG8_STAGE(PG8_SA(1, 0), a3, voffA);
            PG8_WAIT_V(8); PG8_WAIT_L(0); PG8_BAR; PG8_MMA(1, 0, At, B0); PG8_MMA(1, 1, At, B1); PG8_BAR; PG8_SCHED;
            } else {
            PG8_LDB(B0, 0, 0); PG8_SCHED; PG8_LDA(At, 0, 0); PG8_STAGE(PG8_SA(1, 1), a1 + hstep, voffA);
            PG8_WAIT_L(8); PG8_BAR; PG8_WAIT_L(0); PG8_MMA(0, 0, At, B0); PG8_BAR; PG8_SCHED;
            PG8_LDB(B1, 0, 1); PG8_STAGE(PG8_SB(0, 0), b2, voffB);
            PG8_BAR; PG8_WAIT_L(0); PG8_MMA(0, 1, At, B1); PG8_BAR;
            PG8_LDA(At, 0, 1); PG8_STAGE(PG8_SA(0, 0), a2, voffA);
            PG8_BAR; PG8_WAIT_L(0); PG8_MMA(1, 0, At, B0); PG8_BAR; PG8_SCHED;
            PG8_STAGE(PG8_SB(0, 1), b2 + hstep, voffB);
            PG8_WAIT_V(6); PG8_BAR; PG8_MMA(1, 1, At, B1); PG8_BAR;
            PG8_LDB(B0, 1, 0); PG8_SCHED; PG8_LDA(At, 1, 0); PG8_STAGE(PG8_SA(0, 1), a2 + hstep, voffA);
            PG8_WAIT_L(8); PG8_BAR; PG8_WAIT_L(0); PG8_MMA(0, 0, At, B0); PG8_BAR; PG8_SCHED;
            PG8_LDB(B1, 1, 1); PG8_STAGE(PG8_SB(1, 0), b3, voffB);
            PG8_BAR; PG8_WAIT_L(0); PG8_MMA(0, 1, At, B1); PG8_BAR;
            PG8_LDA(At, 1, 1); PG8_STAGE(PG8_SA(1, 0), a3, voffA);
            PG8_BAR; PG8_WAIT_L(0); PG8_MMA(1, 0, At, B0); PG8_BAR; PG8_SCHED;
            PG8_STAGE(PG8_SB(1, 1), b3 + hstep, voffB);
            PG8_WAIT_V(6); PG8_BAR; PG8_MMA(1, 1, At, B1); PG8_BAR;
            }
        }
        if constexpr (ALIGN_EPI) { if (wr == 0) PG8_BAR; }
        if constexpr (!Epi::AFTER_DRAIN) { E(acc, cur, wr, wc, fr, fq); S.done(cur); }
        if (!has_next) break;
#pragma unroll
        for (int a = 0; a < 2; ++a)
#pragma unroll
            for (int b = 0; b < 2; ++b)
#pragma unroll
                for (int m = 0; m < 4; ++m)
#pragma unroll
                    for (int n = 0; n < 2; ++n) acc[a][b][m][n] = (f32x4){0.f, 0.f, 0.f, 0.f};
        cur = nxt; cA = nA; cB = nB; ++ui;
        if constexpr (ALIGN_EPI) { if (wr == 1) PG8_BAR; }
    }
    PG8_WAIT_V(0);
    if constexpr (!ALIGN_EPI) { if (wr == 0) PG8_BAR; }
    PG8_BAR;
    if constexpr (Epi::AFTER_DRAIN) { E.fused(acc, cur, wr, wc, fr, fq, lds, wid, lane); S.done(cur); }
#undef PG8_SA
#undef PG8_SB
#undef PG8_STAGE
#undef PG8_LDA
#undef PG8_LDB
#undef PG8_MMA
#undef PG8_WAIT_V
#undef PG8_WAIT_L
#undef PG8_BAR
#undef PG8_SCHED
}
}
#define GAS __attribute__((address_space(1)))
#define LAS __attribute__((address_space(3)))
typedef unsigned short bf16;
typedef unsigned v4u __attribute__((ext_vector_type(4)));
typedef float f32x4 __attribute__((ext_vector_type(4)));
typedef short bf16x8 __attribute__((ext_vector_type(8)));
typedef GAS unsigned gu32;
typedef GAS unsigned long long gu64;
#define RLX_AGENT __ATOMIC_RELAXED, __HIP_MEMORY_SCOPE_AGENT
#define LDS_WAIT() asm volatile("s_waitcnt lgkmcnt(0)" ::: "memory")
#define VM_WAIT() asm volatile("s_waitcnt vmcnt(0)" ::: "memory")
__device__ __forceinline__ unsigned long long rt() { return __builtin_amdgcn_s_memrealtime(); }
__device__ __forceinline__ unsigned f2bf(float f) { unsigned u = __builtin_bit_cast(unsigned, f); return (u + 0x7fffu + ((u >> 16) & 1u)) >> 16; }
__device__ __forceinline__ unsigned pk2(float lo, float hi) { return f2bf(lo) | (f2bf(hi) << 16); }

#define XB_TMO      128
#define XB_XCNT(j)  (256  + 64 * (j))
#define XB_XSUB(j)  (1280 + 64 * (j))
#define XB_XGEN(j)  (2304 + 64 * (j))
#define XB_TOP      3328
#define XB_TOPGEN   3392
#define XCD_BAR_WORDS 3456
#define XB_SPIN_CAP (1u << 18)

__device__ __forceinline__ unsigned xb_ld(unsigned* p)              { return __hip_atomic_load(p, __ATOMIC_RELAXED, __HIP_MEMORY_SCOPE_AGENT); }
__device__ __forceinline__ unsigned xb_add(unsigned* p, unsigned v) { return __hip_atomic_fetch_add(p, v, __ATOMIC_RELAXED, __HIP_MEMORY_SCOPE_AGENT); }
__device__ __forceinline__ unsigned xb_xcc_id() { return (unsigned)__builtin_amdgcn_s_getreg((3 << 11) | 20) & 0xFu; }
#define XB_SPIN(cond, bar) do { unsigned _sp = 0; while (cond) { __builtin_amdgcn_s_sleep(1); \
    if ((++_sp & 255u) == 0u) { if (xb_ld(&(bar)[XB_TMO])) break; if (_sp > XB_SPIN_CAP) { atomicAdd(&(bar)[XB_TMO], 1u); break; } } } } while (0)

struct XcdBarrier {
    unsigned* bar; unsigned x;
    volatile LAS unsigned* st;
};

__device__ __forceinline__ XcdBarrier xcd_barrier_post(unsigned* bar, volatile LAS unsigned* st) {
    XcdBarrier b; b.bar = bar; b.x = xb_xcc_id(); b.st = st;
    if (threadIdx.x == 0) (void)xb_add(&bar[XB_XCNT(b.x)], 1u);
    return b;
}
__device__ __forceinline__ void xcd_barrier_complete(unsigned* bar, unsigned x, unsigned& nloc, unsigned& nx) {
    const unsigned G = gridDim.x * gridDim.y * gridDim.z;
    unsigned sum, cnt, mine, sp = 0u;
    for (;;) {
        sum = 0u; cnt = 0u; mine = 0u;
#pragma unroll
        for (unsigned j = 0; j < 16; ++j) { const unsigned c = xb_ld(&bar[XB_XCNT(j)]); sum += c; cnt += (c > 0u) ? 1u : 0u; mine = (j == x) ? c : mine; }
        if (sum == G) break;
        __builtin_amdgcn_s_sleep(1);
        if ((++sp & 255u) == 0u) { if (xb_ld(&bar[XB_TMO])) break; if (sp > XB_SPIN_CAP) { atomicAdd(&bar[XB_TMO], 1u); break; } }
    }
    nloc = mine > 0u ? mine : 1u; nx = cnt > 0u ? cnt : 1u;
}

__device__ __forceinline__ void xcd_barrier(const XcdBarrier& b) {
    asm volatile("s_waitcnt vmcnt(0)" ::: "memory");
    __syncthreads();
    if (threadIdx.x == 0) {
        unsigned* bar = b.bar;
        __builtin_amdgcn_s_waitcnt(0);
        unsigned nloc = b.st[0], nx = b.st[1];
        if (nloc == 0u) { xcd_barrier_complete(bar, b.x, nloc, nx); b.st[0] = nloc; b.st[1] = nx; }
        const unsigned old = xb_add(&bar[XB_XSUB(b.x)], 1u);
        const unsigned gen = old / nloc;
        if (old + 1u == (gen + 1u) * nloc) {
            __builtin_amdgcn_fence(__ATOMIC_RELEASE, "agent");
            asm volatile("s_waitcnt vmcnt(0)" ::: "memory");
            const unsigned og = xb_add(&bar[XB_TOP], 1u);
            const unsigned tg = og / nx;
            if (og + 1u == (tg + 1u) * nx) xb_add(&bar[XB_TOPGEN], 1u);
            else XB_SPIN(xb_ld(&bar[XB_TOPGEN]) == tg, bar);
            __builtin_amdgcn_fence(__ATOMIC_ACQUIRE, "agent");
            xb_add(&bar[XB_XGEN(b.x)], 1u);
            asm volatile("s_waitcnt vmcnt(0)" ::: "memory");
        } else {
            XB_SPIN(xb_ld(&bar[XB_XGEN(b.x)]) == gen, bar);
            __builtin_amdgcn_fence(__ATOMIC_ACQUIRE, "agent");
            asm volatile("s_waitcnt vmcnt(0)" ::: "memory");
        }
    }
    __syncthreads();
}

constexpr int NWAVES = 8, NTHR = 512;
constexpr int DM = 2048, MROWS = 12288, DEPTH = 4;
constexpr int INC = 5152, INP = 5376, FF = 5632, GU = 11264;
constexpr int NMOD = 6 * DM;
constexpr float EPS = 1e-6f;
constexpr int PC_QA = 0, PC_KA = 512, PC_VA = 768, PC_QD = 1024, PC_KD = 1536, PC_VD = 2048, PC_Z = 2560, PC_XBC = 3584, PC_DT = 5120;
constexpr int RC_QA = 0, RC_KA = 512, RC_QD = 768, RC_KD = 1280, RCW = 1792;
constexpr size_t OUT_AK = 25165824, OUT_AV = OUT_AK + 4194304, OUT_DK = OUT_AV + 4194304, OUT_DV = OUT_DK + 8388608, OUT_SF = OUT_DV + 8388608, OUT_SB = OUT_SF + 8388608;
constexpr size_t MiB = 1u << 20;
constexpr size_t WS_CTL = 0, CTL_ZERO_BYTES = 1 * MiB;
constexpr size_t WS_TAB = 1 * MiB, WS_MOD = 2 * MiB, WS_MODP = 3 * MiB;
constexpr size_t WS_WIN = 8 * MiB, WS_WOUT = 92 * MiB, WS_WGU = 124 * MiB, WS_WDN = 300 * MiB;
constexpr size_t WS_H = 388 * MiB, WS_U = 484 * MiB, WS_P = 532 * MiB, WS_MIX = 658 * MiB, WS_ACT = 706 * MiB, WS_QKR = 838 * MiB;
constexpr size_t WS_XBC = 866 * MiB, WS_DT = 938 * MiB, WS_YF = 940 * MiB, WS_YB = 988 * MiB, WS_ST = 1036 * MiB, WS_EDEC = 1132 * MiB, WS_CDEC = 1134 * MiB, WS_END = 1135 * MiB;
constexpr int CW_BAR = 4096;
constexpr int RING_BYTES = 131072, LDSCTL_OFF = RING_BYTES, MISC_OFF = LDSCTL_OFF + 320, LDS_BYTES = 147456;

struct Params { const float* in[28]; float* out; unsigned char* ws; int ph_lo, ph_hi; };
typedef __attribute__((address_space(4))) const Params* PP;
struct Frame { LAS unsigned char* lds; int tid, lane, wave, vcu, G; };

__device__ __forceinline__ float wave_sum(float v) {
#pragma unroll
    for (int o = 1; o < 64; o <<= 1) v += __shfl_xor(v, o);
    return v;
}
__device__ __forceinline__ float wave_max(float v) {
#pragma unroll
    for (int o = 1; o < 64; o <<= 1) v = fmaxf(v, __shfl_xor(v, o));
    return v;
}
__device__ __forceinline__ float bflo(unsigned w) { return __uint_as_float(w << 16); }
__device__ __forceinline__ float bfhi(unsigned w) { return __uint_as_float(w & 0xffff0000u); }
__device__ __forceinline__ float bf1(bf16 b) { return __uint_as_float((unsigned)b << 16); }
__device__ __forceinline__ float silu(float x) { return x / (1.0f + __expf(-x)); }

__device__ __forceinline__ void p0_transpose_item(const float* W, int K, int N, bf16* WT, int rowmap, LAS float* scr, int item, int lane) {
    const int nblk = N / 32, kb = item / nblk, nb = item % nblk, k0 = 64 * kb, n0 = 32 * nb;
#pragma unroll 8
    for (int i = 0; i < 32; ++i) { const int kk = 2 * i + (lane >> 5); scr[kk * 33 + (lane & 31)] = W[(size_t)(k0 + kk) * N + n0 + (lane & 31)]; }
    LDS_WAIT(); asm volatile("" ::: "memory");
    int r0 = n0;
    if (rowmap) r0 = (n0 < FF) ? ((n0 >> 7) * 256 + (n0 & 127)) : (((n0 - FF) >> 7) * 256 + 128 + ((n0 - FF) & 127));
    const int c = lane & 7;
#pragma unroll
    for (int j = 0; j < 4; ++j) { const int n = (lane >> 3) + 8 * j; const LAS float* s = scr + (8 * c) * 33 + n;
        v4u o; o.x = pk2(s[0 * 33], s[1 * 33]); o.y = pk2(s[2 * 33], s[3 * 33]); o.z = pk2(s[4 * 33], s[5 * 33]); o.w = pk2(s[6 * 33], s[7 * 33]);
        *(v4u*)(WT + (size_t)(r0 + n) * K + k0 + 8 * c) = o; }
    LDS_WAIT(); asm volatile("" ::: "memory");
}
__device__ __forceinline__ void p0_prologue(Frame& F, PP p) {
    unsigned char* ws = p->ws;
    LAS float* scr = (LAS float*)(F.lds + F.wave * 16384);
    const int gw = F.vcu * NWAVES + F.wave, NGW = F.G * NWAVES;
    const int gt = F.vcu * NTHR + F.tid, NGT = F.G * NTHR;
    constexpr int I_IN = 32 * (INC / 32), I_OUT = 32 * 64, I_GU = 32 * (GU / 32), I_DN = (FF / 64) * 64, I_L = I_IN + I_OUT + I_GU + I_DN;
    for (int it = gw; it < DEPTH * I_L; it += NGW) {
        const int l = it / I_L; int r = it % I_L;
        if (r < I_IN) { p0_transpose_item(p->in[14] + (size_t)l * DM * INC, DM, INC, (bf16*)(ws + WS_WIN) + (size_t)l * INP * DM, 0, scr, r, F.lane); continue; } r -= I_IN;
        if (r < I_OUT) { p0_transpose_item(p->in[24] + (size_t)l * DM * DM, DM, DM, (bf16*)(ws + WS_WOUT) + (size_t)l * DM * DM, 0, scr, r, F.lane); continue; } r -= I_OUT;
        if (r < I_GU) { p0_transpose_item(p->in[25] + (size_t)l * DM * GU, DM, GU, (bf16*)(ws + WS_WGU) + (size_t)l * GU * DM, 1, scr, r, F.lane); continue; } r -= I_GU;
        p0_transpose_item(p->in[26] + (size_t)l * FF * DM, FF, DM, (bf16*)(ws + WS_WDN) + (size_t)l * DM * FF, 0, scr, r, F.lane);
    }
    { constexpr int PADV = (INP - INC) * DM * 2 / 16;
      for (int i = gt; i < DEPTH * PADV; i += NGT) { const int l = i / PADV, r = i % PADV;
          *((v4u*)((bf16*)(ws + WS_WIN) + (size_t)l * INP * DM + (size_t)INC * DM) + r) = (v4u){0u, 0u, 0u, 0u}; } }
    { const f32x4* xp = (const f32x4*)p->in[0]; const f32x4* xs = (const f32x4*)p->in[1]; f32x4* H = (f32x4*)(ws + WS_H);
      constexpr int NP4 = 4096 * DM / 4, NT4 = MROWS * DM / 4;
      for (int i = gt; i < NT4; i += NGT) H[i] = (i < NP4) ? xp[i] : xs[i - NP4]; }
    __syncthreads();
    { LAS float* sc = (LAS float*)F.lds;
      float* MODP = (float*)(ws + WS_MODP);
      for (int it = blockIdx.x; it < DEPTH * 8 * 24; it += F.G) {
          const int l = it / 192, r = it % 192, kc = r / 24, nc = r % 24;
          if (F.tid < 256) {
              const int k = kc * 256 + F.tid;
              sc[F.tid] = silu(p->in[9][k]); sc[256 + F.tid] = silu(p->in[8][k]); sc[512 + F.tid] = silu(p->in[8][DM + k]);
          }
          __syncthreads();
          const int n = nc * 512 + F.tid;
          const float* w = p->in[10] + ((size_t)l * DM + (size_t)kc * 256) * NMOD + n;
          float a0 = 0.f, a1 = 0.f, a2 = 0.f;
          for (int k = 0; k < 256; k += 8) {
              float wv[8];
#pragma unroll
              for (int e = 0; e < 8; ++e) wv[e] = w[(size_t)(k + e) * NMOD];
#pragma unroll
              for (int e = 0; e < 8; ++e) { a0 += sc[k + e] * wv[e]; a1 += sc[256 + k + e] * wv[e]; a2 += sc[512 + k + e] * wv[e]; }
          }
          float* o = MODP + ((size_t)(kc * DEPTH + l) * 3) * NMOD + n;
          o[0] = a0; o[NMOD] = a1; o[2 * NMOD] = a2;
          __syncthreads();
      } }
    if (blockIdx.x == F.G - 1) {
        float2* tabA = (float2*)(ws + WS_TAB); float2* tabB = (float2*)(ws + WS_TAB + 16384); float* lam = (float*)(ws + WS_TAB + 32768);
        for (int i = F.tid; i < 2048 + 1024; i += NTHR) {
            const bool isA = i < 2048; const int j = isA ? i : i - 2048; const int pos = isA ? (j >> 5) : (j >> 4), k = isA ? (j & 31) : (j & 15);
            double r = 10000.0; r = sqrt(r); r = sqrt(r); r = sqrt(r); r = sqrt(r); if (isA) r = sqrt(r);
            const double ri = 1.0 / r; double inv = 1.0; for (int q = 0; q < k; ++q) inv *= ri;
            const double ang = (double)pos * inv; const double TWO_PI = 6.283185307179586476925;
            const double x = ang - TWO_PI * rint(ang / TWO_PI), x2 = x * x;
            double st = x, ss = x, ct = 1.0, cs = 1.0;
            for (int q = 1; q <= 16; ++q) { st *= -x2 / (double)((2 * q) * (2 * q + 1)); ss += st; ct *= -x2 / (double)((2 * q - 1) * (2 * q)); cs += ct; }
            const float2 v = make_float2((float)cs, (float)ss);
            if (isA) tabA[j] = v; else tabB[j] = v;
        }
        if (F.tid < DEPTH) {
            const float* lv = p->in[16] + F.tid * 256; float s01 = 0.f, s23 = 0.f;
            for (int i = 0; i < 64; ++i) { s01 += lv[i] * lv[64 + i]; s23 += lv[128 + i] * lv[192 + i]; }
            const float li = 0.8f - 0.6f * expf(-0.3f * (float)F.tid);
            lam[F.tid] = expf(s01) - expf(s23) + li; lam[4 + F.tid] = li;
        }
    }
}
__device__ __forceinline__ void p0b_mod(Frame& F, PP p) {
    const int gt = F.vcu * NTHR + F.tid, NGT = F.G * NTHR;
    const float* MODP = (const float*)(p->ws + WS_MODP); float* MOD = (float*)(p->ws + WS_MOD);
    for (int i = gt; i < DEPTH * 3 * NMOD; i += NGT) {
        const int l = i / (3 * NMOD), n = i % NMOD;
        float s = p->in[11][l * NMOD + n];
#pragma unroll
        for (int kc = 0; kc < 8; ++kc) s += MODP[(size_t)kc * DEPTH * 3 * NMOD + i];
        MOD[i] = s;
    }
}
__device__ __forceinline__ void norm_phase(Frame& F, const float* H, const float* g, const float* modl, int shoff, int scoff, bf16* U) {
    const int gw = F.vcu * NWAVES + F.wave, NGW = F.G * NWAVES;
    for (int m = gw; m < MROWS; m += NGW) {
        const int c = m < 4096 ? 0 : (m < 8192 ? 1 : 2);
        const float* sh = modl + c * NMOD + shoff; const float* sc = modl + c * NMOD + scoff;
        const f32x4* xr = (const f32x4*)(H + (size_t)m * DM) + F.lane;
        f32x4 v[8]; float ss = 0.f;
#pragma unroll
        for (int j = 0; j < 8; ++j) { v[j] = xr[64 * j]; ss += (v[j].x * v[j].x + v[j].y * v[j].y) + (v[j].z * v[j].z + v[j].w * v[j].w); }
        const float rstd = 1.0f / sqrtf(wave_sum(ss) * (1.0f / DM) + EPS);
        unsigned long long* o8 = (unsigned long long*)(U + (size_t)m * DM) + F.lane;
#pragma unroll
        for (int j = 0; j < 8; ++j) { const int col = 4 * F.lane + 256 * j;
            const f32x4 gv = *(const f32x4*)(g + col), sv = *(const f32x4*)(sc + col), hv = *(const f32x4*)(sh + col);
            const f32x4 o = (v[j] * rstd) * gv * (sv + 1.0f) + hv;
            o8[64 * j] = (unsigned long long)pk2(o.x, o.y) | ((unsigned long long)pk2(o.z, o.w) << 32); }
    }
}
__device__ __forceinline__ void final_phase(Frame& F, const float* H, const float* g, float* out) {
    const int gw = F.vcu * NWAVES + F.wave, NGW = F.G * NWAVES;
    for (int m = gw; m < MROWS; m += NGW) {
        const f32x4* xr = (const f32x4*)(H + (size_t)m * DM) + F.lane;
        f32x4 v[8]; float ss = 0.f;
#pragma unroll
        for (int j = 0; j < 8; ++j) { v[j] = xr[64 * j]; ss += (v[j].x * v[j].x + v[j].y * v[j].y) + (v[j].z * v[j].z + v[j].w * v[j].w); }
        const float rstd = 1.0f / sqrtf(wave_sum(ss) * (1.0f / DM) + EPS);
        f32x4* o = (f32x4*)(out + (size_t)m * DM) + F.lane;
#pragma unroll
        for (int j = 0; j < 8; ++j) { const f32x4 gv = *(const f32x4*)(g + 4 * F.lane + 256 * j); o[64 * j] = (v[j] * rstd) * gv; }
    }
}
__device__ __forceinline__ void prep_phase(Frame& F, PP p, int l) {
    unsigned char* ws = p->ws;
    const bf16* P = (const bf16*)(ws + WS_P); bf16* QKR = (bf16*)(ws + WS_QKR); bf16* XBC = (bf16*)(ws + WS_XBC); float* DT = (float*)(ws + WS_DT);
    const float2* tabA = (const float2*)(ws + WS_TAB); const float2* tabB = (const float2*)(ws + WS_TAB + 16384);
    const float* cw = p->in[18] + (size_t)l * 5 * 1536; const float* cb = p->in[19] + (size_t)l * 1536; const float* dtb = p->in[20] + l * 32;
    const int gw = F.vcu * NWAVES + F.wave, NGW = F.G * NWAVES, lane = F.lane;
    for (int m = gw; m < MROWS; m += NGW) {
        const bf16* prow = P + (size_t)m * INP;
        const int s0 = m < 4096 ? (m & ~255) : (4096 + ((m - 4096) & ~4095)); const int len = m < 4096 ? 256 : 4096; const int t = m - s0;
#pragma unroll
        for (int j = 0; j < 3; ++j) { const int c0 = 8 * lane + 512 * j;
            f32x4 a0 = *(const f32x4*)(cb + c0), a1 = *(const f32x4*)(cb + c0 + 4);
#pragma unroll
            for (int k = 0; k < 5; ++k) { const int tt = t + k - 2;
                if (tt >= 0 && tt < len) { const v4u raw = *(const v4u*)(P + (size_t)(s0 + tt) * INP + PC_XBC + c0);
                    const f32x4 w0 = *(const f32x4*)(cw + k * 1536 + c0), w1 = *(const f32x4*)(cw + k * 1536 + c0 + 4);
                    a0.x += w0.x * bflo(raw.x); a0.y += w0.y * bfhi(raw.x); a0.z += w0.z * bflo(raw.y); a0.w += w0.w * bfhi(raw.y);
                    a1.x += w1.x * bflo(raw.z); a1.y += w1.y * bfhi(raw.z); a1.z += w1.z * bflo(raw.w); a1.w += w1.w * bfhi(raw.w); } }
            a0.x = silu(a0.x); a0.y = silu(a0.y); a0.z = silu(a0.z); a0.w = silu(a0.w); a1.x = silu(a1.x); a1.y = silu(a1.y); a1.z = silu(a1.z); a1.w = silu(a1.w);
            *(v4u*)(XBC + (size_t)m * 1536 + c0) = (v4u){pk2(a0.x, a0.y), pk2(a0.z, a0.w), pk2(a1.x, a1.y), pk2(a1.z, a1.w)}; }
        if (lane < 32) { const float v = bf1(prow[PC_DT + lane]) + dtb[lane]; DT[(size_t)m * 32 + lane] = v > 20.f ? v : log1pf(__expf(v)); }
        if (m >= 4096) {
            const int gr = t >> 6, gc = t & 63; bf16* qrow = QKR + (size_t)(m - 4096) * RCW;
#pragma unroll
            for (int i = 0; i < 6; ++i) { const int d = lane; const int src = (i < 4 ? PC_QA + i * 128 : PC_KA + (i - 4) * 128) + d, dst = (i < 4 ? RC_QA + i * 128 : RC_KA + (i - 4) * 128) + d;
                const float x1 = bf1(prow[src]), x2 = bf1(prow[src + 64]); const float2 cs = d < 32 ? tabA[gr * 32 + d] : tabA[gc * 32 + d - 32];
                qrow[dst] = (bf16)f2bf(x1 * cs.x - x2 * cs.y); qrow[dst + 64] = (bf16)f2bf(x1 * cs.y + x2 * cs.x); }
#pragma unroll
            for (int i = 0; i < 8; ++i) { const int pp = lane + 64 * i, ch = pp >> 5, d = pp & 31; const int src = (ch < 8 ? PC_QD + ch * 64 : PC_KD + (ch - 8) * 64) + d, dst = (ch < 8 ? RC_QD + ch * 64 : RC_KD + (ch - 8) * 64) + d;
                const float x1 = bf1(prow[src]), x2 = bf1(prow[src + 32]); const float2 cs = d < 16 ? tabB[gr * 16 + d] : tabB[gc * 16 + d - 16];
                qrow[dst] = (bf16)f2bf(x1 * cs.x - x2 * cs.y); qrow[dst + 32] = (bf16)f2bf(x1 * cs.y + x2 * cs.x); }
        } else {
            const int b = m >> 8, s = m & 255; const size_t r = (size_t)((b * DEPTH + l) * 256 + s);
            { const unsigned long long w = *((const unsigned long long*)(prow + PC_KA) + lane); *((f32x4*)(p->out + OUT_AK + r * 256) + lane) = (f32x4){bflo((unsigned)w), bfhi((unsigned)w), bflo((unsigned)(w >> 32)), bfhi((unsigned)(w >> 32))}; }
            { const unsigned long long w = *((const unsigned long long*)(prow + PC_VA) + lane); *((f32x4*)(p->out + OUT_AV + r * 256) + lane) = (f32x4){bflo((unsigned)w), bfhi((unsigned)w), bflo((unsigned)(w >> 32)), bfhi((unsigned)(w >> 32))}; }
            { const v4u w = *((const v4u*)(prow + PC_KD) + lane); f32x4* o = (f32x4*)(p->out + OUT_DK + r * 512) + 2 * lane; o[0] = (f32x4){bflo(w.x), bfhi(w.x), bflo(w.y), bfhi(w.y)}; o[1] = (f32x4){bflo(w.z), bfhi(w.z), bflo(w.w), bfhi(w.w)}; }
            { const v4u w = *((const v4u*)(prow + PC_VD) + lane); f32x4* o = (f32x4*)(p->out + OUT_DV + r * 512) + 2 * lane; o[0] = (f32x4){bflo(w.x), bfhi(w.x), bflo(w.y), bfhi(w.y)}; o[1] = (f32x4){bflo(w.z), bfhi(w.z), bflo(w.w), bfhi(w.w)}; }
        }
    }
}
typedef float f32x16 __attribute__((ext_vector_type(16)));
typedef short s16x4 __attribute__((ext_vector_type(4)));
constexpr int FA_KSTR = 272, FA_VSTR = 320, FA_KB = 64 * FA_KSTR, FA_VB = 64 * FA_VSTR, FA_BUF = FA_KB + FA_VB;
constexpr int FA_OSTR = 272;
struct Seg { const void* k; const void* v; int ks, vs, n, f32, pos0; };
struct FaTile { v4u k[2], v[2]; };

__device__ __forceinline__ unsigned cvtpk(float lo, float hi) { typedef float f2 __attribute__((ext_vector_type(2))); typedef __bf16 b2 __attribute__((ext_vector_type(2))); f2 v = {lo, hi}; b2 b = __builtin_convertvector(v, b2); return __builtin_bit_cast(unsigned, b); }
__device__ __forceinline__ void fa_load(FaTile& t, const Seg& sg, int key0, int tid) {
#pragma unroll
    for (int i = 0; i < 2; ++i) { const int c = tid + 512 * i, key = c >> 4, ch = c & 15;
        if (sg.f32) {
            const f32x4* ks = (const f32x4*)((const float*)sg.k + (size_t)(key0 + key) * sg.ks + ch * 8);
            const f32x4* vs = (const f32x4*)((const float*)sg.v + (size_t)(key0 + key) * sg.vs + ch * 8);
            const f32x4 a = ks[0], b = ks[1], c2 = vs[0], d = vs[1];
            t.k[i] = (v4u){cvtpk(a.x, a.y), cvtpk(a.z, a.w), cvtpk(b.x, b.y), cvtpk(b.z, b.w)};
            t.v[i] = (v4u){cvtpk(c2.x, c2.y), cvtpk(c2.z, c2.w), cvtpk(d.x, d.y), cvtpk(d.z, d.w)};
        } else {
            t.k[i] = *(const v4u*)((const bf16*)sg.k + (size_t)(key0 + key) * sg.ks + ch * 8);
            t.v[i] = *(const v4u*)((const bf16*)sg.v + (size_t)(key0 + key) * sg.vs + ch * 8);
        } }
}
__device__ __forceinline__ void fa_store(const FaTile& t, LAS unsigned char* buf, int tid) {
#pragma unroll
    for (int i = 0; i < 2; ++i) { const int c = tid + 512 * i, key = c >> 4, ch = c & 15;
        *(LAS v4u*)(buf + key * FA_KSTR + ch * 16) = t.k[i];
        *(LAS v4u*)(buf + FA_KB + key * FA_VSTR + ch * 16) = t.v[i]; }
}
template <int NKS>
__device__ __forceinline__ void fa_tile(const LAS unsigned char* buf, const bf16x8 (&q)[NKS], f32x16 (&o)[4], float& m, float& lsum, float c, int kcolb, int lane, bool masked, int dpos  ) {
    const int r32 = lane & 31, h = lane >> 5;
    f32x16 p0, p1;
#pragma unroll
    for (int r = 0; r < 16; ++r) { p0[r] = 0.f; p1[r] = 0.f; }
    const LAS unsigned char* kp = buf + r32 * FA_KSTR + kcolb + h * 16;
#pragma unroll
    for (int ks = 0; ks < NKS; ++ks) {
        const bf16x8 a0 = *(const LAS bf16x8*)(kp + ks * 32), a1 = *(const LAS bf16x8*)(kp + 32 * FA_KSTR + ks * 32);
        p0 = __builtin_amdgcn_mfma_f32_32x32x16_bf16(a0, q[ks], p0, 0, 0, 0);
        p1 = __builtin_amdgcn_mfma_f32_32x32x16_bf16(a1, q[ks], p1, 0, 0, 0);
    }
    if (masked) {
#pragma unroll
        for (int r = 0; r < 16; ++r) { const int d0 = dpos - ((r & 3) + 8 * (r >> 2) + 4 * h), d1 = d0 - 32;
            if (d0 > 128 || d0 < -128) p0[r] = -INFINITY; if (d1 > 128 || d1 < -128) p1[r] = -INFINITY; }
    }
    float mt = fmaxf(p0[0], p1[0]);
#pragma unroll
    for (int r = 1; r < 16; ++r) mt = fmaxf(mt, fmaxf(p0[r], p1[r]));
    mt = fmaxf(mt, __shfl_xor(mt, 32));
    const float mn = fmaxf(m, mt * c);
    const float alpha = __builtin_amdgcn_exp2f(m - mn);
    m = mn;
    float rs = 0.f;
#pragma unroll
    for (int r = 0; r < 16; ++r) { p0[r] = __builtin_amdgcn_exp2f(p0[r] * c - mn); p1[r] = __builtin_amdgcn_exp2f(p1[r] * c - mn); rs += p0[r] + p1[r]; }
    lsum = lsum * alpha + rs;
#pragma unroll
    for (int b = 0; b < 4; ++b) o[b] = o[b] * alpha;
    bf16x8 pb[4];
    { v4u w;
      w = (v4u){cvtpk(p0[0], p0[1]), cvtpk(p0[2], p0[3]), cvtpk(p0[4], p0[5]), cvtpk(p0[6], p0[7])}; pb[0] = __builtin_bit_cast(bf16x8, w);
      w = (v4u){cvtpk(p0[8], p0[9]), cvtpk(p0[10], p0[11]), cvtpk(p0[12], p0[13]), cvtpk(p0[14], p0[15])}; pb[1] = __builtin_bit_cast(bf16x8, w);
      w = (v4u){cvtpk(p1[0], p1[1]), cvtpk(p1[2], p1[3]), cvtpk(p1[4], p1[5]), cvtpk(p1[6], p1[7])}; pb[2] = __builtin_bit_cast(bf16x8, w);
      w = (v4u){cvtpk(p1[8], p1[9]), cvtpk(p1[10], p1[11]), cvtpk(p1[12], p1[13]), cvtpk(p1[14], p1[15])}; pb[3] = __builtin_bit_cast(bf16x8, w); }
    const int i16 = lane & 15, gc = (lane >> 4) & 1;
    const LAS unsigned char* vp = buf + FA_KB + (4 * h + (i16 >> 2)) * FA_VSTR + (16 * gc + 4 * (i16 & 3)) * 2;
#pragma unroll
    for (int b = 0; b < 4; ++b)
#pragma unroll
        for (int s = 0; s < 4; ++s) {
            const s16x4 lo = __builtin_amdgcn_ds_read_tr16_b64_v4i16((LAS s16x4*)(vp + (16 * s) * FA_VSTR + b * 64));
            const s16x4 hi = __builtin_amdgcn_ds_read_tr16_b64_v4i16((LAS s16x4*)(vp + (16 * s + 8) * FA_VSTR + b * 64));
            const bf16x8 a = (bf16x8){lo[0], lo[1], lo[2], lo[3], hi[0], hi[1], hi[2], hi[3]};
            o[b] = __builtin_amdgcn_mfma_f32_32x32x16_bf16(a, pb[s], o[b], 0, 0, 0);
            if (s == 3) __builtin_amdgcn_sched_barrier(0);
        }
}
template <int MODE>
__device__ __forceinline__ void fa_unit(Frame& F, const bf16* qg, int qstride, const Seg& s0, const Seg& s1, bool two, int qpos0, float c, const float* sinkp, float lam, float onems, const float* dnorm, bf16* dst, int dstride) {
    constexpr int NKS = MODE == 0 ? 8 : 4;
    int tid_ = F.tid; asm volatile("" : "+v"(tid_));
    const int tid = tid_, lane = tid & 63, w = F.wave, r32 = lane & 31, h = lane >> 5, grp = w >> 2, qrow0 = (w & 3) * 32;
    const int kcolb = MODE == 0 ? 0 : grp * 128;
    qg += (MODE == 0 ? grp * 128 : grp * 64); if (MODE == 0) dst += grp * 128;
    bf16x8 q[NKS];
#pragma unroll
    for (int ks = 0; ks < NKS; ++ks) q[ks] = *(const bf16x8*)(qg + (size_t)(qrow0 + r32) * qstride + ks * 16 + h * 8);
    f32x16 o[4];
#pragma unroll
    for (int b = 0; b < 4; ++b)
#pragma unroll
        for (int r = 0; r < 16; ++r) o[b][r] = 0.f;
    float m = -INFINITY, lsum = 0.f;
    const int nt0 = s0.n >> 6, nt = nt0 + (two ? (s1.n >> 6) : 0);
    FaTile t;
    __syncthreads();
    fa_load(t, s0, 0, tid); fa_store(t, F.lds, tid);
    __syncthreads();
    for (int it = 0; it < nt; ++it) {
        const bool more = it + 1 < nt;
        if (more) { const int n = it + 1; if (n < nt0) fa_load(t, s0, n * 64, tid); else fa_load(t, s1, (n - nt0) * 64, tid); }
        const bool inseg1 = it >= nt0; const int pos0 = inseg1 ? s1.pos0 : s0.pos0; const int key0 = (inseg1 ? it - nt0 : it) * 64;
        fa_tile<NKS>(F.lds + (it & 1) * FA_BUF, q, o, m, lsum, c, kcolb, lane, pos0 >= 0, (qpos0 + qrow0 + r32) - (pos0 + key0));
        if (more) fa_store(t, F.lds + ((it + 1) & 1) * FA_BUF, tid);
        __syncthreads();
    }
    const float ltot = lsum + __shfl_xor(lsum, 32);
    if (MODE == 0) {
        const float inv = 1.0f / (ltot + __builtin_amdgcn_exp2f(sinkp[grp] * 1.4426950408889634f - m));
#pragma unroll
        for (int b = 0; b < 4; ++b) o[b] = o[b] * inv;
    } else {
        LAS float* comb = (LAS float*)(F.lds + (w & 3) * 16384);
        if (grp == 1) { const float f = lam / ltot;
#pragma unroll
            for (int b = 0; b < 4; ++b)
#pragma unroll
                for (int r = 0; r < 16; ++r) comb[(32 * b + (r & 3) + 8 * (r >> 2) + 4 * h) * 32 + r32] = o[b][r] * f; }
        __syncthreads();
        if (grp == 0) { const float inv = 1.0f / ltot; float ss = 0.f;
#pragma unroll
            for (int b = 0; b < 4; ++b)
#pragma unroll
                for (int r = 0; r < 16; ++r) { const float v = o[b][r] * inv - comb[(32 * b + (r & 3) + 8 * (r >> 2) + 4 * h) * 32 + r32]; o[b][r] = v; ss += v * v; }
            ss += __shfl_xor(ss, 32);
            const float rs = onems / sqrtf(ss * (1.0f / 128.0f) + EPS);
#pragma unroll
            for (int b = 0; b < 4; ++b)
#pragma unroll
                for (int r = 0; r < 16; ++r) o[b][r] = o[b][r] * rs * dnorm[32 * b + (r & 3) + 8 * (r >> 2) + 4 * h]; }
    }
    if (MODE == 0 || grp == 0) {
        LAS unsigned char* st = F.lds + (MODE == 0 ? w * (32 * FA_OSTR) : 65536 + (w & 3) * (32 * FA_OSTR));
#pragma unroll
        for (int b = 0; b < 4; ++b)
#pragma unroll
            for (int k = 0; k < 4; ++k) { typedef unsigned u2 __attribute__((ext_vector_type(2)));
                *(LAS u2*)(st + r32 * FA_OSTR + (32 * b + 8 * k + 4 * h) * 2) = (u2){cvtpk(o[b][4 * k], o[b][4 * k + 1]), cvtpk(o[b][4 * k + 2], o[b][4 * k + 3])}; }
        asm volatile("s_waitcnt lgkmcnt(0)" ::: "memory");
#pragma unroll
        for (int i = 0; i < 8; ++i) { const int cc = lane + 64 * i, row = cc >> 4, c16 = cc & 15;
            *(v4u*)(dst + (size_t)(qrow0 + row) * dstride + c16 * 8) = *(const LAS v4u*)(st + row * FA_OSTR + c16 * 16); }
    }
}
constexpr int NCHUNK = 96;
constexpr int S1_CM = 0, S1_BM = 34816, S1_XM = 69632, S1_TAB = 94208;
constexpr int S1_CSTR = 272, S1_XSTR = 192;
__device__ __forceinline__ int crow16(int r, int h) { return (r & 3) + 8 * (r >> 2) + 4 * h; }

__device__ __forceinline__ void s1_unit(Frame& F, PP p, int l, int cc, int hd) {
    unsigned char* ws = p->ws;
    int tid_ = F.tid; asm volatile("" : "+v"(tid_));
    const int tid = tid_, lane = tid & 63, w = F.wave, r32 = lane & 31, hh = lane >> 5, i16 = lane & 15, gc = (lane >> 4) & 1;
    const bf16* XB = (const bf16*)(ws + WS_XBC); const float* DT = (const float*)(ws + WS_DT);
    float* EDEC = (float*)(ws + WS_EDEC); float* CDEC = (float*)(ws + WS_CDEC); float* ST = (float*)(ws + WS_ST);
    const int m0 = cc * 128, g = hd >> 3;
    LAS unsigned char* L = F.lds;
    LAS float* tab = (LAS float*)(L + S1_TAB);
    __syncthreads();
#pragma unroll
    for (int i = 0; i < 4; ++i) { const int c = tid + 512 * i, row = c >> 4, ch = c & 15; const bf16* src = XB + (size_t)(m0 + row) * 1536;
        *(LAS v4u*)(L + S1_CM + row * S1_CSTR + ch * 16) = *(const v4u*)(src + 1280 + g * 128 + ch * 8);
        *(LAS v4u*)(L + S1_BM + row * S1_CSTR + ch * 16) = *(const v4u*)(src + 1024 + g * 128 + ch * 8); }
#pragma unroll
    for (int i = 0; i < 2; ++i) { const int c = tid + 512 * i, row = c >> 3, ch = c & 7;
        *(LAS v4u*)(L + S1_XM + row * S1_XSTR + ch * 16) = *(const v4u*)(XB + (size_t)(m0 + row) * 1536 + hd * 64 + ch * 8); }
    if (tid < 256) { const int li = tid & 127, d = tid >> 7; tab[(2 + d) * 128 + li] = DT[(size_t)(m0 + li) * 32 + d * 16 + hd]; }
    __syncthreads();
    if (w < 2) {
        const float a = -__expf(p->in[21][(l * 2 + w) * 16 + hd]);
        const float d0 = tab[(2 + w) * 128 + 2 * lane], d1 = tab[(2 + w) * 128 + 2 * lane + 1];
        const float v0 = d0 * a, v1 = d1 * a, s = v0 + v1;
        float inc = s;
        if (w == 0) {
#pragma unroll
            for (int o = 1; o < 64; o <<= 1) { const float t = __shfl_up(inc, o); if (lane >= o) inc += t; }
        } else {
#pragma unroll
            for (int o = 1; o < 64; o <<= 1) { const float t = __shfl_down(inc, o); if (lane + o < 64) inc += t; }
        }
        const float exc = inc - s;
        const float c0 = (w == 0) ? exc + v0 : exc + v1 + v0, c1 = (w == 0) ? exc + v0 + v1 : exc + v1;
        const float tot = __shfl(inc, w == 0 ? 63 : 0);
        tab[w * 128 + 2 * lane] = c0; tab[w * 128 + 2 * lane + 1] = c1;
        tab[(4 + w) * 128 + 2 * lane] = __expf(tot - c0) * d0; tab[(4 + w) * 128 + 2 * lane + 1] = __expf(tot - c1) * d1;
        EDEC[(size_t)(m0 + 2 * lane) * 32 + w * 16 + hd] = __expf(c0); EDEC[(size_t)(m0 + 2 * lane + 1) * 32 + w * 16 + hd] = __expf(c1);
        if (lane == 0) CDEC[(w * NCHUNK + cc) * 16 + hd] = __expf(tot);
    }
    __syncthreads();
    const int dir = w >> 2, wq = w & 3;
    {
        const LAS float* cum = tab + dir * 128; const LAS float* dtv = tab + (2 + dir) * 128;
        const int lpos = 32 * wq + r32; const float cl = cum[lpos];
        bf16x8 cf[8];
#pragma unroll
        for (int ks = 0; ks < 8; ++ks) cf[ks] = *(const LAS bf16x8*)(L + S1_CM + lpos * S1_CSTR + ks * 32 + hh * 16);
        f32x16 o[2];
#pragma unroll
        for (int b = 0; b < 2; ++b)
#pragma unroll
            for (int r = 0; r < 16; ++r) o[b][r] = 0.f;
        const int sb0 = dir == 0 ? 0 : wq, sb1 = dir == 0 ? wq : 3;
        for (int sb = sb0; sb <= sb1; ++sb) {
            f32x16 cb;
#pragma unroll
            for (int r = 0; r < 16; ++r) cb[r] = 0.f;
#pragma unroll
            for (int ks = 0; ks < 8; ++ks) { const bf16x8 a = *(const LAS bf16x8*)(L + S1_BM + (32 * sb + r32) * S1_CSTR + ks * 32 + hh * 16);
                cb = __builtin_amdgcn_mfma_f32_32x32x16_bf16(a, cf[ks], cb, 0, 0, 0); }
#pragma unroll
            for (int r = 0; r < 16; ++r) { const int s = 32 * sb + crow16(r, hh);
                const float v = cb[r] * __expf(cl - cum[s]) * dtv[s];
                const bool ok = dir == 0 ? (s <= lpos) : (s >= lpos);
                cb[r] = ok ? v : 0.f; }
            bf16x8 pb[2];
            { v4u t;
              t = (v4u){cvtpk(cb[0], cb[1]), cvtpk(cb[2], cb[3]), cvtpk(cb[4], cb[5]), cvtpk(cb[6], cb[7])}; pb[0] = __builtin_bit_cast(bf16x8, t);
              t = (v4u){cvtpk(cb[8], cb[9]), cvtpk(cb[10], cb[11]), cvtpk(cb[12], cb[13]), cvtpk(cb[14], cb[15])}; pb[1] = __builtin_bit_cast(bf16x8, t); }
            const LAS unsigned char* xp = L + S1_XM + (32 * sb + 4 * hh + (i16 >> 2)) * S1_XSTR + (16 * gc + 4 * (i16 & 3)) * 2;
#pragma unroll
            for (int b = 0; b < 2; ++b)
#pragma unroll
                for (int k2 = 0; k2 < 2; ++k2) {
                    const s16x4 lo = __builtin_amdgcn_ds_read_tr16_b64_v4i16((LAS s16x4*)(xp + (16 * k2) * S1_XSTR + b * 64));
                    const s16x4 hi = __builtin_amdgcn_ds_read_tr16_b64_v4i16((LAS s16x4*)(xp + (16 * k2 + 8) * S1_XSTR + b * 64));
                    const bf16x8 a = (bf16x8){lo[0], lo[1], lo[2], lo[3], hi[0], hi[1], hi[2], hi[3]};
                    o[b] = __builtin_amdgcn_mfma_f32_32x32x16_bf16(a, pb[k2], o[b], 0, 0, 0);
                }
        }
        float* yr = (float*)(ws + (dir ? WS_YB : WS_YF)) + (size_t)(m0 + lpos) * 1024 + hd * 64;
#pragma unroll
        for (int b = 0; b < 2; ++b)
#pragma unroll
            for (int k = 0; k < 4; ++k) *(f32x4*)(yr + 32 * b + 8 * k + 4 * hh) = (f32x4){o[b][4 * k], o[b][4 * k + 1], o[b][4 * k + 2], o[b][4 * k + 3]};
    }
    {
        const LAS float* wv = tab + (4 + dir) * 128;
        f32x16 st[2];
#pragma unroll
        for (int b = 0; b < 2; ++b)
#pragma unroll
            for (int r = 0; r < 16; ++r) st[b][r] = 0.f;
        const LAS unsigned char* xp = L + S1_XM + (8 * hh + (i16 >> 2)) * S1_XSTR + (16 * gc + 4 * (i16 & 3)) * 2;
        const LAS unsigned char* bp = L + S1_BM + (8 * hh + (i16 >> 2)) * S1_CSTR + (32 * wq + 16 * gc + 4 * (i16 & 3)) * 2;
#pragma unroll
        for (int ks = 0; ks < 8; ++ks) {
            const f32x4 w0 = *(const LAS f32x4*)(wv + 16 * ks + 8 * hh), w1 = *(const LAS f32x4*)(wv + 16 * ks + 8 * hh + 4);
            const s16x4 blo = __builtin_amdgcn_ds_read_tr16_b64_v4i16((LAS s16x4*)(bp + (16 * ks) * S1_CSTR));
            const s16x4 bhi = __builtin_amdgcn_ds_read_tr16_b64_v4i16((LAS s16x4*)(bp + (16 * ks + 4) * S1_CSTR));
            const bf16x8 bfr = (bf16x8){blo[0], blo[1], blo[2], blo[3], bhi[0], bhi[1], bhi[2], bhi[3]};
#pragma unroll
            for (int b = 0; b < 2; ++b) {
                const s16x4 lo = __builtin_amdgcn_ds_read_tr16_b64_v4i16((LAS s16x4*)(xp + (16 * ks) * S1_XSTR + b * 64));
                const s16x4 hi = __builtin_amdgcn_ds_read_tr16_b64_v4i16((LAS s16x4*)(xp + (16 * ks + 4) * S1_XSTR + b * 64));
                v4u t;
                t.x = cvtpk(bf1((bf16)lo[0]) * w0.x, bf1((bf16)lo[1]) * w0.y); t.y = cvtpk(bf1((bf16)lo[2]) * w0.z, bf1((bf16)lo[3]) * w0.w);
                t.z = cvtpk(bf1((bf16)hi[0]) * w1.x, bf1((bf16)hi[1]) * w1.y); t.w = cvtpk(bf1((bf16)hi[2]) * w1.z, bf1((bf16)hi[3]) * w1.w);
                st[b] = __builtin_amdgcn_mfma_f32_32x32x16_bf16(__builtin_bit_cast(bf16x8, t), bfr, st[b], 0, 0, 0);
            }
        }
        float* so = ST + ((size_t)(dir * NCHUNK + cc) * 16 + hd) * 8192 + 32 * wq + r32;
#pragma unroll
        for (int b = 0; b < 2; ++b)
#pragma unroll
            for (int r = 0; r < 16; ++r) so[(size_t)(32 * b + crow16(r, hh)) * 128] = st[b][r];
    }
}
__device__ __forceinline__ void s2_scan(Frame& F, PP p, int l) {
    unsigned char* ws = p->ws; float* ST = (float*)(ws + WS_ST); const float* CDEC = (const float*)(ws + WS_CDEC);
    const int gt = F.vcu * NTHR + F.tid, NGT = F.G * NTHR;
    for (int idx = gt; idx < 576 * 2048; idx += NGT) {
        const int combo = idx >> 11, e4 = idx & 2047, seq = combo >> 5, hd = (combo >> 1) & 15, dir = combo & 1;
        const int c0 = seq < 16 ? seq * 2 : 32 + (seq - 16) * 32, nc = seq < 16 ? 2 : 32;
        f32x4 H = (f32x4){0.f, 0.f, 0.f, 0.f};
        if (seq >= 16) H = *((const f32x4*)(p->in[dir ? 7 : 6] + (((size_t)(seq - 16) * DEPTH + l) * 16 + hd) * 8192) + e4);
        for (int k = 0; k < nc; k += 2) {
            const int ca = dir ? c0 + nc - 1 - k : c0 + k, cb = dir ? ca - 1 : ca + 1;
            f32x4* pa = (f32x4*)(ST + ((size_t)(dir * NCHUNK + ca) * 16 + hd) * 8192) + e4; f32x4* pb = (f32x4*)(ST + ((size_t)(dir * NCHUNK + cb) * 16 + hd) * 8192) + e4;
            const f32x4 ta = *pa, tb = *pb; const float da = CDEC[(dir * NCHUNK + ca) * 16 + hd], db = CDEC[(dir * NCHUNK + cb) * 16 + hd];
            *pa = H; H = H * da + ta; *pb = H; H = H * db + tb;
        }
        if (seq < 16) *((f32x4*)(p->out + (dir ? OUT_SB : OUT_SF) + (((size_t)seq * DEPTH + l) * 16 + hd) * 8192) + e4) = H;
    }
}
constexpr int S3_CM = 0, S3_SS = 34816;
__device__ __forceinline__ void s3_unit(Frame& F, PP p, int l, int cc, int g) {
    unsigned char* ws = p->ws;
    int tid_ = F.tid; asm volatile("" : "+v"(tid_));
    const int tid = tid_, lane = tid & 63, w = F.wave, r32 = lane & 31, hh = lane >> 5;
    const bf16* XB = (const bf16*)(ws + WS_XBC); const bf16* P = (const bf16*)(ws + WS_P); bf16* MIX = (bf16*)(ws + WS_MIX);
    const float* EDEC = (const float*)(ws + WS_EDEC); const float* ST = (const float*)(ws + WS_ST);
    const float* YF = (const float*)(ws + WS_YF); const float* YB = (const float*)(ws + WS_YB);
    const int m0 = cc * 128, hd = g * 8 + w;
    const float dk = p->in[22][l * 16 + hd]; const float* sn = p->in[23] + l * 1024 + hd * 64;
    LAS unsigned char* L = F.lds; LAS float* SS = (LAS float*)(L + S3_SS);
    __syncthreads();
#pragma unroll
    for (int i = 0; i < 4; ++i) { const int c = tid + 512 * i, row = c >> 4, ch = c & 15;
        *(LAS v4u*)(L + S3_CM + row * S1_CSTR + ch * 16) = *(const v4u*)(XB + (size_t)(m0 + row) * 1536 + 1280 + g * 128 + ch * 8); }
    bf16x8 hf[2][2][8];
#pragma unroll
    for (int d = 0; d < 2; ++d)
#pragma unroll
        for (int b = 0; b < 2; ++b) { const float* hp = ST + ((size_t)(d * NCHUNK + cc) * 16 + hd) * 8192 + (size_t)(32 * b + r32) * 128 + 8 * hh;
#pragma unroll
            for (int ks = 0; ks < 8; ++ks) { const f32x4 a = *(const f32x4*)(hp + 16 * ks), c = *(const f32x4*)(hp + 16 * ks + 4);
                const v4u t = (v4u){cvtpk(a.x, a.y), cvtpk(a.z, a.w), cvtpk(c.x, c.y), cvtpk(c.z, c.w)}; hf[d][b][ks] = __builtin_bit_cast(bf16x8, t); } }
    __syncthreads();
    bf16* mixr = MIX + (size_t)m0 * DM + 1024 + hd * 64;
#pragma unroll 1
    for (int lb = 0; lb < 4; ++lb) {
        const int lpos = 32 * lb + r32; const size_t m = (size_t)(m0 + lpos);
        f32x16 tot[2];
#pragma unroll
        for (int d = 0; d < 2; ++d) {
            f32x16 tmp[2];
#pragma unroll
            for (int b = 0; b < 2; ++b)
#pragma unroll
                for (int r = 0; r < 16; ++r) tmp[b][r] = 0.f;
#pragma unroll
            for (int ks = 0; ks < 8; ++ks) { const bf16x8 cfr = *(const LAS bf16x8*)(L + S3_CM + lpos * S1_CSTR + ks * 32 + hh * 16);
                tmp[0] = __builtin_amdgcn_mfma_f32_32x32x16_bf16(hf[d][0][ks], cfr, tmp[0], 0, 0, 0);
                tmp[1] = __builtin_amdgcn_mfma_f32_32x32x16_bf16(hf[d][1][ks], cfr, tmp[1], 0, 0, 0); }
            const float e = EDEC[m * 32 + d * 16 + hd];
            if (d == 0) { tot[0] = tmp[0] * e; tot[1] = tmp[1] * e; } else { tot[0] = tot[0] + tmp[0] * e; tot[1] = tot[1] + tmp[1] * e; }
        }
        float ss = 0.f;
#pragma unroll
        for (int b = 0; b < 2; ++b)
#pragma unroll
            for (int k = 0; k < 4; ++k) { const int pc = 32 * b + 8 * k + 4 * hh;
                const f32x4 yf = *(const f32x4*)(YF + m * 1024 + hd * 64 + pc), yb = *(const f32x4*)(YB + m * 1024 + hd * 64 + pc);
                const unsigned long long xw = *(const unsigned long long*)(XB + m * 1536 + hd * 64 + pc), zw = *(const unsigned long long*)(P + m * INP + PC_Z + hd * 64 + pc);
                float y0 = tot[b][4 * k] + yf.x + yb.x + dk * bflo((unsigned)xw), y1 = tot[b][4 * k + 1] + yf.y + yb.y + dk * bfhi((unsigned)xw);
                float y2 = tot[b][4 * k + 2] + yf.z + yb.z + dk * bflo((unsigned)(xw >> 32)), y3 = tot[b][4 * k + 3] + yf.w + yb.w + dk * bfhi((unsigned)(xw >> 32));
                y0 *= silu(bflo((unsigned)zw)); y1 *= silu(bfhi((unsigned)zw)); y2 *= silu(bflo((unsigned)(zw >> 32))); y3 *= silu(bfhi((unsigned)(zw >> 32)));
                ss += (y0 * y0 + y1 * y1) + (y2 * y2 + y3 * y3);
                *(unsigned long long*)(mixr + (size_t)lpos * DM + pc) = (unsigned long long)cvtpk(y0, y1) | ((unsigned long long)cvtpk(y2, y3) << 32); }
        ss += __shfl_xor(ss, 32);
        if (hh == 0) SS[w * 128 + lpos] = ss;
    }
    asm volatile("s_waitcnt vmcnt(0)" ::: "memory");
    __syncthreads();
#pragma unroll 1
    for (int lb = 0; lb < 4; ++lb) {
        const int lpos = 32 * lb + r32;
        float tsum = 0.f;
#pragma unroll
        for (int q = 0; q < 8; ++q) tsum += SS[q * 128 + lpos];
        const float rs = 1.0f / sqrtf(tsum * (1.0f / 512.0f) + EPS);
#pragma unroll
        for (int b = 0; b < 2; ++b)
#pragma unroll
            for (int k = 0; k < 4; ++k) { const int pc = 32 * b + 8 * k + 4 * hh;
                unsigned long long* q = (unsigned long long*)(mixr + (size_t)lpos * DM + pc); const unsigned long long v = *q; const f32x4 nv = *(const f32x4*)(sn + pc);
                *q = (unsigned long long)cvtpk(bflo((unsigned)v) * rs * nv.x, bfhi((unsigned)v) * rs * nv.y) | ((unsigned long long)cvtpk(bflo((unsigned)(v >> 32)) * rs * nv.z, bfhi((unsigned)(v >> 32)) * rs * nv.w) << 32); }
    }
}
__device__ __forceinline__ void s3_phase(Frame& F, PP p, int l) {
    for (int u = blockIdx.x; u < NCHUNK * 2; u += F.G) s3_unit(F, p, l, u >> 1, u & 1);
}
__device__ __forceinline__ void mix1_phase(Frame& F, PP p, int l) {
    unsigned char* ws = p->ws;
    const bf16* P = (const bf16*)(ws + WS_P); const bf16* QKR = (const bf16*)(ws + WS_QKR); bf16* MIX = (bf16*)(ws + WS_MIX);
    const float* lamv = (const float*)(ws + WS_TAB + 32768);
    const float lam = lamv[l], onems = 1.0f - lamv[4 + l];
    const float* dnorm = p->in[17] + l * 128;
    constexpr int U_BL = 256, U_AL = 128, U_BC = 128, U_AC = 64, U_FA = U_BL + U_AL + U_BC + U_AC, U_S1 = NCHUNK * 16, U_ALL = U_FA + U_S1;
    const float LOG2E = 1.4426950408889634f, cA = 0.08838834764831845f * LOG2E, cB = 0.125f * LOG2E;
    for (int u = blockIdx.x; u < U_ALL; u += F.G) {
        int r = u;
        if (r >= U_FA) { r -= U_FA; s1_unit(F, p, l, r >> 4, r & 15); continue; }
        int mode = 1; const bf16* qp; int qstr = RCW, qpos0 = 0; bool two = true; Seg s0, s1; bf16* dst; const float* sinkp = dnorm;
        if (r < U_BL) {
            const int b = r >> 7, h = (r >> 5) & 3, qb = r & 31; const int ml = b * 4096 + qb * 128;
            s0 = Seg{QKR + (size_t)(b * 4096) * RCW + RC_KD + h * 128, P + (size_t)(4096 + b * 4096) * INP + PC_VD + h * 128, RCW, INP, 4096, 0, -1};
            s1 = Seg{p->in[4] + ((size_t)(b * DEPTH + l) * 256) * 512 + h * 128, p->in[5] + ((size_t)(b * DEPTH + l) * 256) * 512 + h * 128, 512, 512, 256, 1, -1};
            qp = QKR + (size_t)ml * RCW + RC_QD + h * 128; dst = MIX + (size_t)(4096 + ml) * DM + 512 + h * 128;
        } else if (r < U_BL + U_AL) { r -= U_BL;
            const int b = r >> 6, kv = (r >> 5) & 1, qb = r & 31; const int ml = b * 4096 + qb * 128;
            const int w0 = qb * 128 - 128 < 0 ? 0 : qb * 128 - 128, w1 = qb * 128 + 256 > 4096 ? 4096 : qb * 128 + 256;
            s0 = Seg{p->in[2] + ((size_t)(b * DEPTH + l) * 256) * 256 + kv * 128, p->in[3] + ((size_t)(b * DEPTH + l) * 256) * 256 + kv * 128, 256, 256, 256, 1, -1};
            s1 = Seg{QKR + (size_t)(b * 4096 + w0) * RCW + RC_KA + kv * 128, P + (size_t)(4096 + b * 4096 + w0) * INP + PC_VA + kv * 128, RCW, INP, w1 - w0, 0, w0};
            mode = 0; qp = QKR + (size_t)ml * RCW + RC_QA + kv * 256; qpos0 = qb * 128; sinkp = p->in[15] + l * 4 + kv * 2; dst = MIX + (size_t)(4096 + ml) * DM + kv * 256;
        } else if (r < U_BL + U_AL + U_BC) { r -= U_BL + U_AL;
            const int b = r >> 3, h = (r >> 1) & 3, qb = r & 1; const int m0 = b * 256 + qb * 128;
            s0 = Seg{P + (size_t)(b * 256) * INP + PC_KD + h * 128, P + (size_t)(b * 256) * INP + PC_VD + h * 128, INP, INP, 256, 0, -1}; s1 = s0; two = false;
            qp = P + (size_t)m0 * INP + PC_QD + h * 128; qstr = INP; dst = MIX + (size_t)m0 * DM + 512 + h * 128;
        } else { r -= U_BL + U_AL + U_BC;
            const int b = r >> 2, kv = (r >> 1) & 1, qb = r & 1; const int m0 = b * 256 + qb * 128;
            s0 = Seg{P + (size_t)(b * 256) * INP + PC_KA + kv * 128, P + (size_t)(b * 256) * INP + PC_VA + kv * 128, INP, INP, 256, 0, -1}; s1 = s0; two = false;
            mode = 0; qp = P + (size_t)m0 * INP + PC_QA + kv * 256; qstr = INP; sinkp = p->in[15] + l * 4 + kv * 2; dst = MIX + (size_t)m0 * DM + kv * 256;
        }
        if (mode) fa_unit<1>(F, qp, qstr, s0, s1, two, qpos0, cB, sinkp, lam, onems, dnorm, dst, DM);
        else fa_unit<0>(F, qp, qstr, s0, s1, two, qpos0, cA, sinkp, lam, onems, dnorm, dst, DM);
    }
}
#ifndef MK_ONE_LAUNCH
#define MK_ONE_LAUNCH 1
#endif
constexpr int PH_PER_LAYER = 10, PH_TOTAL = 2 + DEPTH * PH_PER_LAYER + 1;
__global__ void __launch_bounds__(NTHR, 2) mk_fwd(Params p_) {
    extern __shared__ __attribute__((aligned(16))) unsigned char lds[];
    Frame F;
    F.lds = (LAS unsigned char*)lds;
    F.tid = threadIdx.x; F.lane = F.tid & 63; F.wave = __builtin_amdgcn_readfirstlane(F.tid >> 6);
    F.G = gridDim.x; { const int bx = blockIdx.x; F.vcu = (F.G % 8 == 0) ? (bx % 8) * (F.G / 8) + bx / 8 : bx; }
    PP p = (PP)__builtin_amdgcn_kernarg_segment_ptr();
    for (int u = F.tid; u < (LDS_BYTES - LDSCTL_OFF) / 4; u += NTHR) ((LAS unsigned*)(F.lds + LDSCTL_OFF))[u] = 0u;
    __syncthreads();
    XcdBarrier bar; bar.bar = (unsigned*)(p->ws + WS_CTL) + CW_BAR; bar.x = 0; bar.st = nullptr;
#if MK_ONE_LAUNCH
    bar = xcd_barrier_post((unsigned*)(p->ws + WS_CTL) + CW_BAR, (volatile LAS unsigned*)(F.lds + MISC_OFF) + 8);
#define GRID_BAR() xcd_barrier(bar)
#else
#define GRID_BAR() do {} while (0)
#endif
    const int lo = p->ph_lo, hi = p->ph_hi;
#define IN(k) (lo <= (k) && (k) < hi)
#define SEAM(k) do { if (IN(k) && IN((k) + 1)) GRID_BAR(); } while (0)
#define ENTER() do { int t_ = threadIdx.x; asm volatile("" : "+v"(t_)); F.tid = t_; F.lane = t_ & 63; F.wave = __builtin_amdgcn_readfirstlane(t_ >> 6); asm volatile("" : "+s"(p)); ws = p->ws; } while (0)
    unsigned char* ws;

    if (IN(0)) { ENTER(); p0_prologue(F, p); } SEAM(0);
    if (IN(1)) { ENTER(); p0b_mod(F, p); } SEAM(1);
#pragma unroll 1
    for (int l = 0; l < DEPTH; ++l) {
        const int pb = 2 + l * PH_PER_LAYER;
        if (IN(pb + 0)) { ENTER(); norm_phase(F, (const float*)(ws + WS_H), p->in[12] + l * DM, (const float*)(ws + WS_MOD) + (size_t)l * 3 * NMOD, 0, DM, (bf16*)(ws + WS_U)); } SEAM(pb + 0);
        if (IN(pb + 1)) { ENTER();
            pg8::Gemm g{(const bf16*)(ws + WS_U), (const bf16*)(ws + WS_WIN) + (size_t)l * INP * DM, MROWS, INP, DM}; pg8::StaticOrder S; S.init(MROWS, INP, F.G, (int)blockIdx.x);
            pg8::EpiBf16 E{(bf16*)(ws + WS_P), INP};
            pg8::gemm_phase<pg8::EpiBf16, pg8::StaticOrder, true, true>(F.lds, g, S, E);
        } SEAM(pb + 1);
        if (IN(pb + 2)) { ENTER(); prep_phase(F, p, l); } SEAM(pb + 2);
        if (IN(pb + 3)) { ENTER(); mix1_phase(F, p, l); } SEAM(pb + 3);
        if (IN(pb + 4)) { ENTER(); s2_scan(F, p, l); } SEAM(pb + 4);
        if (IN(pb + 5)) { ENTER(); s3_phase(F, p, l); } SEAM(pb + 5);
        if (IN(pb + 6)) { ENTER();
            pg8::Gemm g{(const bf16*)(ws + WS_MIX), (const bf16*)(ws + WS_WOUT) + (size_t)l * DM * DM, MROWS, DM, DM}; pg8::StaticOrder S; S.init(MROWS, DM, F.G, (int)blockIdx.x);
            pg8::EpiResid E{(float*)(ws + WS_H), DM, (const float*)(ws + WS_MOD) + (size_t)l * 3 * NMOD + 2 * DM, NMOD};
            pg8::gemm_phase<pg8::EpiResid, pg8::StaticOrder, true, true>(F.lds, g, S, E);
        } SEAM(pb + 6);
        if (IN(pb + 7)) { ENTER(); norm_phase(F, (const float*)(ws + WS_H), p->in[13] + l * DM, (const float*)(ws + WS_MOD) + (size_t)l * 3 * NMOD, 3 * DM, 4 * DM, (bf16*)(ws + WS_U)); } SEAM(pb + 7);
        if (IN(pb + 8)) { ENTER();
            pg8::Gemm g{(const bf16*)(ws + WS_U), (const bf16*)(ws + WS_WGU) + (size_t)l * GU * DM, MROWS, GU, DM}; pg8::StaticOrder S; S.init(MROWS, GU, F.G, (int)blockIdx.x);
            pg8::EpiSwiGLU E{(bf16*)(ws + WS_ACT), FF};
            pg8::gemm_phase<pg8::EpiSwiGLU, pg8::StaticOrder, true, true>(F.lds, g, S, E);
        } SEAM(pb + 8);
        if (IN(pb + 9)) { ENTER();
            pg8::Gemm g{(const bf16*)(ws + WS_ACT), (const bf16*)(ws + WS_WDN) + (size_t)l * DM * FF, MROWS, DM, FF}; pg8::StaticOrder S; S.init(MROWS, DM, F.G, (int)blockIdx.x);
            pg8::EpiResid E{(float*)(ws + WS_H), DM, (const float*)(ws + WS_MOD) + (size_t)l * 3 * NMOD + 5 * DM, NMOD};
            pg8::gemm_phase<pg8::EpiResid, pg8::StaticOrder, true, true>(F.lds, g, S, E);
        } SEAM(pb + 9);
    }
    if (IN(PH_TOTAL - 1)) { ENTER(); final_phase(F, (const float*)(ws + WS_H), p->in[27], p->out); }
#undef IN
#undef SEAM
#undef ENTER
}

extern "C" void kernel_launch(void* const* d_in, const int* in_sizes, int n_in, void* d_out, int out_size, void* d_ws, size_t ws_size, hipStream_t stream) {
    static int grid = 0;
    if (grid == 0) {
        if (n_in != 28 || out_size != 67108864 || ws_size < WS_END) { fprintf(stderr, "kernel_launch: unexpected sizes n_in %d out %d ws %zu\n", n_in, out_size, ws_size); grid = -1; return; }
        int dev = 0, cus = 0, per_cu = 0;
        if (hipGetDevice(&dev) != hipSuccess || hipDeviceGetAttribute(&cus, hipDeviceAttributeMultiprocessorCount, dev) != hipSuccess) { grid = -1; return; }
        if (hipFuncSetAttribute((const void*)mk_fwd, hipFuncAttributeMaxDynamicSharedMemorySize, LDS_BYTES) != hipSuccess) { fprintf(stderr, "kernel_launch: hipFuncSetAttribute failed\n"); grid = -1; return; }
        if (hipOccupancyMaxActiveBlocksPerMultiprocessor(&per_cu, (const void*)mk_fwd, NTHR, LDS_BYTES) != hipSuccess || per_cu < 1)
            fprintf(stderr, "kernel_launch: occupancy query reports %d workgroups per CU\n", per_cu);
        (void)hipGetLastError();
        grid = cus;
    }
    if (grid < 0) return;
    if (hipMemsetAsync((char*)d_ws + WS_CTL, 0, CTL_ZERO_BYTES, stream) != hipSuccess) return;
    Params a{};
    for (int i = 0; i < 28; ++i) a.in[i] = (const float*)d_in[i];
    a.out = (float*)d_out; a.ws = (unsigned char*)d_ws;
#if MK_ONE_LAUNCH
    a.ph_lo = 0; a.ph_hi = PH_TOTAL;
    hipLaunchKernelGGL(mk_fwd, dim3(grid), dim3(NTHR), LDS_BYTES, stream, a);
#else
    for (int ph = 0; ph < PH_TOTAL; ++ph) { a.ph_lo = ph; a.ph_hi = ph + 1; hipLaunchKernelGGL(mk_fwd, dim3(grid), dim3(NTHR), LDS_BYTES, stream, a); }
#endif
}
```

```cpp
#include <hip/hip_runtime.h>
#include <cstdio>
#include <cstdint>
namespace pg8 {
#define PG8_LAS __attribute__((address_space(3)))
typedef unsigned short bf16_t;
typedef short bf16x8 __attribute__((ext_vector_type(8)));
typedef float f32x4 __attribute__((ext_vector_type(4)));
typedef unsigned u32x4 __attribute__((ext_vector_type(4)));
constexpr int BM = 256, BK = 64, HALF = 128, HTB = HALF * BK * 2  , STAGE_BYTES = 8 * HTB, NXCD = 8, WGM = 8;

__host__ __device__ __forceinline__ int lds_byte(int r, int c) { const int st = (r >> 4) * 2 + (c >> 5), rr = r & 15, cc = c & 31, ob = rr * 64 + cc * 2; return st * 1024 + (ob ^ (((ob >> 9) & 1) << 5)); }
__host__ __device__ __forceinline__ void stage_rc(int b, int& R, int& C) { const int st = b / 1024, sb = b % 1024, swz = sb ^ (((sb >> 9) & 1) << 5); R = (st >> 1) * 16 + swz / 64; C = (st & 1) * 32 + (swz % 64) / 2; }
__host__ __device__ __forceinline__ int perm32(int rho) { const int n = rho >> 4, i = rho & 15; return 8 * (i >> 2) + 4 * n + (i & 3); }

struct Unit { int pm, pn, pk; };
struct Gemm { const bf16_t* A; const bf16_t* Bt; int M, N, K, Ksub; };

struct StaticOrder {
    int nM, nN, nwg, G, c;
    __host__ __device__ void init(int M, int N, int G_, int c_) { nM = M / BM; nN = N / BM; nwg = nM * nN; G = G_; c = c_; }
    __host__ __device__ bool next(int i, Unit& u) const {
        const long L = (long)i * G + c; if (L >= nwg) return false;
        int wgid = (int)L; { const int q = nwg / NXCD, r = nwg % NXCD, xcd = wgid % NXCD, off = wgid / NXCD; wgid = (xcd < r ? xcd * (q + 1) : r * (q + 1) + (xcd - r) * q) + off; }
        const int nig = WGM * nN, gid = wgid / nig, fm = gid * WGM, gsz = (nM - fm) < WGM ? (nM - fm) : WGM;
        u.pm = fm + ((wgid % nig) % gsz); u.pn = (wgid % nig) / gsz; u.pk = 0; return true;
    }
    __device__ __forceinline__ void a_ready(const Unit&) const {}
    __device__ __forceinline__ void done(const Unit&) const {}
};
struct SplitOrder {
    StaticOrder s; int KS;
    __host__ __device__ void init(int M, int N, int KS_, int G_, int c_) { KS = KS_; s.init(M, N * KS_, G_, c_); }
    __host__ __device__ bool next(int i, Unit& u) const { if (!s.next(i, u)) return false; u.pk = u.pn % KS; u.pn = u.pn / KS; return true; }
    __device__ __forceinline__ void a_ready(const Unit&) const {}
    __device__ __forceinline__ void done(const Unit&) const {}
};


__device__ __forceinline__ unsigned cvt_pk_bf16(float lo, float hi) { unsigned r; asm volatile("v_cvt_pk_bf16_f32 %0, %1, %2" : "=v"(r) : "v"(lo), "v"(hi)); return r; }

struct EpiBf16 {
    static constexpr bool PERM = true, AFTER_DRAIN = false;
    bf16_t* O; int ldc;
    __device__ __forceinline__ void operator()(const f32x4 (&acc)[2][2][4][2], const Unit& u, int wr, int wc, int fr, int fq) const {
        const int row0 = u.pm * BM + wr * 64 + fr; const int col0 = u.pn * BM + wc * 32 + 8 * fq;
#pragma unroll
        for (int ai = 0; ai < 2; ++ai)
#pragma unroll
            for (int m = 0; m < 4; ++m) { bf16_t* rowp = O + (size_t)(row0 + ai * HALF + m * 16) * ldc + col0;
#pragma unroll
                for (int bj = 0; bj < 2; ++bj) { const f32x4 v0 = acc[ai][bj][m][0], v1 = acc[ai][bj][m][1];
                    u32x4 w; w.x = cvt_pk_bf16(v0[0], v0[1]); w.y = cvt_pk_bf16(v0[2], v0[3]); w.z = cvt_pk_bf16(v1[0], v1[1]); w.w = cvt_pk_bf16(v1[2], v1[3]);
                    *(u32x4*)(rowp + bj * HALF) = w; } }
    }
};
__device__ __forceinline__ int cond_of_pm(int pm) { return pm < 16 ? 0 : (pm < 32 ? 1 : 2); }
struct EpiResid {
    static constexpr bool PERM = false, AFTER_DRAIN = false;
    float* H; int ldc; const float* gate; int gstride;
    __device__ __forceinline__ void operator()(const f32x4 (&acc)[2][2][4][2], const Unit& u, int wr, int wc, int fr, int fq) const {
        const float* g = gate + (size_t)cond_of_pm(u.pm) * gstride;
        const int row0 = u.pm * BM + wr * 64 + fr; const int col0 = u.pn * BM + wc * 32 + 4 * fq;
        f32x4 gv[2][2];
#pragma unroll
        for (int bj = 0; bj < 2; ++bj)
#pragma unroll
            for (int n = 0; n < 2; ++n) gv[bj][n] = *(const f32x4*)(g + col0 + bj * HALF + n * 16);
#pragma unroll
        for (int ai = 0; ai < 2; ++ai)
#pragma unroll
            for (int m = 0; m < 4; ++m) { float* rowp = H + (size_t)(row0 + ai * HALF + m * 16) * ldc + col0;
#pragma unroll
                for (int bj = 0; bj < 2; ++bj)
#pragma unroll
                    for (int n = 0; n < 2; ++n) { f32x4* p = (f32x4*)(rowp + bj * HALF + n * 16); f32x4 h = *p; h = h + gv[bj][n] * acc[ai][bj][m][n]; *p = h; }
                asm volatile("" ::: "memory"); }
    }
};
__device__ __forceinline__ float silu_f(float x) { return x * __builtin_amdgcn_rcpf(1.0f + __expf(-x)); }
struct EpiSwiGLU {
    static constexpr bool PERM = true, AFTER_DRAIN = false;
    bf16_t* O; int ldc;
    __device__ __forceinline__ void operator()(const f32x4 (&acc)[2][2][4][2], const Unit& u, int wr, int wc, int fr, int fq) const {
        const int row0 = u.pm * BM + wr * 64 + fr; const int col0 = u.pn * HALF + wc * 32 + 8 * fq;
#pragma unroll
        for (int ai = 0; ai < 2; ++ai)
#pragma unroll
            for (int m = 0; m < 4; ++m) { bf16_t* rowp = O + (size_t)(row0 + ai * HALF + m * 16) * ldc + col0;
                const f32x4 g0 = acc[ai][0][m][0], g1 = acc[ai][0][m][1], u0 = acc[ai][1][m][0], u1 = acc[ai][1][m][1];
                u32x4 w;
                w.x = cvt_pk_bf16(silu_f(g0[0]) * u0[0], silu_f(g0[1]) * u0[1]); w.y = cvt_pk_bf16(silu_f(g0[2]) * u0[2], silu_f(g0[3]) * u0[3]);
                w.z = cvt_pk_bf16(silu_f(g1[0]) * u1[0], silu_f(g1[1]) * u1[1]); w.w = cvt_pk_bf16(silu_f(g1[2]) * u1[2], silu_f(g1[3]) * u1[3]);
                *(u32x4*)rowp = w; }
    }
};
template <class Epi, class Sched, bool ALIGN_EPI = false, bool SP2 = false>
__device__ __forceinline__ void gemm_phase(PG8_LAS unsigned char* lds, const Gemm g, const Sched& S, const Epi& E, int tid_in) {
    int tid_ = tid_in; asm volatile("" : "+v"(tid_));
    const int tid = tid_, wid = __builtin_amdgcn_readfirstlane(tid >> 6), lane = tid & 63, wr = wid >> 2, wc = wid & 3, fr = lane & 15, fq = lane >> 4;
    const int K = g.K, nt = g.Ksub / BK; const size_t koff = (size_t)g.Ksub * 2;
    unsigned voffA[2], voffB[2];
#pragma unroll
    for (int i = 0; i < 2; ++i) { int R, C; stage_rc(tid * 16 + i * 8192, R, C); const int Rb = Epi::PERM ? ((R & ~31) + perm32(R & 31)) : R;
        voffA[i] = (unsigned)(R * K + C) * 2u; voffB[i] = (unsigned)(Rb * K + C) * 2u; }
    const size_t kstep = (size_t)(BK * 2);
    const size_t hstep = (size_t)HALF * K * 2;
    const size_t tstep = 2 * hstep;
    const unsigned ldsw = (unsigned)wid * 1024u;
    const int aoff = lds_byte(wr * 64 + fr, fq * 8), boff = lds_byte(wc * 32 + fr, fq * 8);
#define PG8_SA(b, h) (((b) * 2 + (h)) * HTB)
#define PG8_SB(b, h) ((4 + (b) * 2 + (h)) * HTB)
#define PG8_STAGE(bufoff, gbase, voff) do { _Pragma("unroll") for (int _i = 0; _i < 2; ++_i) \
        __builtin_amdgcn_global_load_lds((const unsigned*)((const char*)(gbase) + (voff)[_i]), (PG8_LAS unsigned*)(lds + (bufoff) + ldsw + _i * 8192), 16, 0, 0); } while (0)
#define PG8_LDA(dst, b, h) do { _Pragma("unroll") for (int m = 0; m < 4; ++m) _Pragma("unroll") for (int k = 0; k < 2; ++k) dst[m][k] = *(const PG8_LAS bf16x8*)(lds + PG8_SA(b, h) + aoff + m * 2048 + k * 1024); } while (0)
#define PG8_LDB(dst, b, h) do { _Pragma("unroll") for (int n = 0; n < 2; ++n) _Pragma("unroll") for (int k = 0; k < 2; ++k) dst[n][k] = *(const PG8_LAS bf16x8*)(lds + PG8_SB(b, h) + boff + n * 2048 + k * 1024); } while (0)
#define PG8_MMA(ai, bj, At, Bt) do { __builtin_amdgcn_s_setprio(1); _Pragma("unroll") for (int m = 0; m < 4; ++m) _Pragma("unroll") for (int n = 0; n < 2; ++n) _Pragma("unroll") for (int k = 0; k < 2; ++k) \
        acc[ai][bj][m][n] = __builtin_amdgcn_mfma_f32_16x16x32_bf16(Bt[n][k], At[m][k], acc[ai][bj][m][n], 0, 0, 0); __builtin_amdgcn_s_setprio(0); } while (0)
#define PG8_WAIT_V(n) asm volatile("s_waitcnt vmcnt(" #n ")" ::: "memory")
#define PG8_WAIT_L(n) asm volatile("s_waitcnt lgkmcnt(" #n ")" ::: "memory")
#define PG8_BAR __builtin_amdgcn_s_barrier()
#define PG8_SCHED __builtin_amdgcn_sched_barrier(0)
    Unit cur, nxt; int ui = 0;
    if (!S.next(0, cur)) return;
    f32x4 acc[2][2][4][2];
#pragma unroll
    for (int a = 0; a < 2; ++a)
#pragma unroll
        for (int b = 0; b < 2; ++b)
#pragma unroll
            for (int m = 0; m < 4; ++m)
#pragma unroll
                for (int n = 0; n < 2; ++n) acc[a][b][m][n] = (f32x4){0.f, 0.f, 0.f, 0.f};
    bf16x8 At[4][2], B0[2][2], B1[2][2];
    const char* cA = (const char*)g.A + (size_t)cur.pm * tstep + cur.pk * koff; const char* cB = (const char*)g.Bt + (size_t)cur.pn * tstep + cur.pk * koff;
    S.a_ready(cur);
    if constexpr (SP2) {
        PG8_STAGE(PG8_SB(0, 0), cB, voffB); PG8_STAGE(PG8_SB(0, 1), cB + hstep, voffB); PG8_STAGE(PG8_SA(0, 0), cA, voffA); PG8_STAGE(PG8_SA(0, 1), cA + hstep, voffA);
        if (wr == 1) PG8_BAR;
        PG8_WAIT_V(2); PG8_BAR;
        PG8_STAGE(PG8_SB(1, 0), cB + kstep, voffB); PG8_STAGE(PG8_SA(1, 0), cA + kstep, voffA); PG8_STAGE(PG8_SB(1, 1), cB + hstep + kstep, voffB);
        PG8_WAIT_V(6); PG8_BAR;
    } else {
        PG8_STAGE(PG8_SB(0, 0), cB, voffB); PG8_STAGE(PG8_SA(0, 0), cA, voffA); PG8_STAGE(PG8_SB(0, 1), cB + hstep, voffB); PG8_STAGE(PG8_SA(0, 1), cA + hstep, voffA);
        if (wr == 1) PG8_BAR;
        PG8_WAIT_V(4); PG8_BAR;
        PG8_STAGE(PG8_SB(1, 0), cB + kstep, voffB); PG8_STAGE(PG8_SA(1, 0), cA + kstep, voffA); PG8_STAGE(PG8_SB(1, 1), cB + hstep + kstep, voffB);
        PG8_WAIT_V(6); PG8_BAR;
    }
    for (;;) {
        const bool has_next = S.next(ui + 1, nxt);
        const char* nA = has_next ? (const char*)g.A + (size_t)nxt.pm * tstep + nxt.pk * koff : cA; const char* nB = has_next ? (const char*)g.Bt + (size_t)nxt.pn * tstep + nxt.pk * koff : cB;
        for (int t = 0; t < nt; t += 2) {
            const bool last = (t == nt - 2);
            const char* a1 = cA + (size_t)(t + 1) * kstep;
            const char* a2 = last ? nA : cA + (size_t)(t + 2) * kstep; const char* b2 = last ? nB : cB + (size_t)(t + 2) * kstep;
            const char* a3 = a2 + kstep; const char* b3 = b2 + kstep;
            if (last && has_next) S.a_ready(nxt);
            if constexpr (SP2) {
            PG8_LDB(B0, 0, 0); PG8_LDB(B1, 0, 1); PG8_SCHED; PG8_LDA(At, 0, 0); PG8_STAGE(PG8_SA(1, 1), a1 + hstep, voffA);
            PG8_WAIT_V(8); PG8_WAIT_L(0); PG8_BAR; PG8_MMA(0, 0, At, B0); PG8_MMA(0, 1, At, B1); PG8_BAR; PG8_SCHED;
            PG8_LDA(At, 0, 1); PG8_STAGE(PG8_SB(0, 0), b2, voffB); PG8_STAGE(PG8_SB(0, 1), b2 + hstep, voffB); PG8_STAGE(PG8_SA(0, 0), a2, voffA);
            PG8_WAIT_V(8); PG8_WAIT_L(0); PG8_BAR; PG8_MMA(1, 0, At, B0); PG8_MMA(1, 1, At, B1); PG8_BAR; PG8_SCHED;
            PG8_LDB(B0, 1, 0); PG8_LDB(B1, 1, 1); PG8_SCHED; PG8_LDA(At, 1, 0); PG8_STAGE(PG8_SA(0, 1), a2 + hstep, voffA);
            PG8_WAIT_V(8); PG8_WAIT_L(0); PG8_BAR; PG8_MMA(0, 0, At, B0); PG8_MMA(0, 1, At, B1); PG8_BAR; PG8_SCHED;
            PG8_LDA(At, 1, 1); PG8_STAGE(PG8_SB(1, 0), b3, voffB); PG8_STAGE(PG8_SB(1, 1), b3 + hstep, voffB); PG8_STAGE(PG8_SA(1, 0), a3, voffA);
            PG8_WAIT_V(8); PG8_WAIT_L(0); PG8_BAR; PG8_MMA(1, 0, At, B0); PG8_MMA(1, 1, At, B1); PG8_BAR; PG8_SCHED;
            } else {
            PG8_LDB(B0, 0, 0); PG8_SCHED; PG8_LDA(At, 0, 0); PG8_STAGE(PG8_SA(1, 1), a1 + hstep, voffA);
            PG8_WAIT_L(8); PG8_BAR; PG8_WAIT_L(0); PG8_MMA(0, 0, At, B0); PG8_BAR; PG8_SCHED;
            PG8_LDB(B1, 0, 1); PG8_STAGE(PG8_SB(0, 0), b2, voffB);
            PG8_BAR; PG8_WAIT_L(0); PG8_MMA(0, 1, At, B1); PG8_BAR;
            PG8_LDA(At, 0, 1); PG8_STAGE(PG8_SA(0, 0), a2, voffA);
            PG8_BAR; PG8_WAIT_L(0); PG8_MMA(1, 0, At, B0); PG8_BAR; PG8_SCHED;
            PG8_STAGE(PG8_SB(0, 1), b2 + hstep, voffB);
            PG8_WAIT_V(6); PG8_BAR; PG8_MMA(1, 1, At, B1); PG8_BAR;
            PG8_LDB(B0, 1, 0); PG8_SCHED; PG8_LDA(At, 1, 0); PG8_STAGE(PG8_SA(0, 1), a2 + hstep, voffA);
            PG8_WAIT_L(8); PG8_BAR; PG8_WAIT_L(0); PG8_MMA(0, 0, At, B0); PG8_BAR; PG8_SCHED;
            PG8_LDB(B1, 1, 1); PG8_STAGE(PG8_SB(1, 0), b3, voffB);
            PG8_BAR; PG8_WAIT_L(0); PG8_MMA(0, 1, At, B1); PG8_BAR;
            PG8_LDA(At, 1, 1); PG8_STAGE(PG8_SA(1, 0), a3, voffA);
            PG8_BAR; PG8_WAIT_L(0); PG8_MMA(1, 0, At, B0); PG8_BAR; PG8_SCHED;
            PG8_STAGE(PG8_SB(1, 1), b3 + hstep, voffB);
            PG8_WAIT_V(6); PG8_BAR; PG8_MMA(1, 1, At, B1); PG8_BAR;
            }
        }
        if constexpr (ALIGN_EPI) { if (wr == 0) PG8_BAR; }
        if constexpr (!Epi::AFTER_DRAIN) { E(acc, cur, wr, wc, fr, fq); S.done(cur); }
        if (!has_next) break;
#pragma unroll
        for (int a = 0; a < 2; ++a)
#pragma unroll
            for (int b = 0; b < 2; ++b)
#pragma unroll
                for (int m = 0; m < 4; ++m)
#pragma unroll
                    for (int n = 0; n < 2; ++n) acc[a][b][m][n] = (f32x4){0.f, 0.f, 0.f, 0.f};
        cur = nxt; cA = nA; cB = nB; ++ui;
        if constexpr (ALIGN_EPI) { if (wr == 1) PG8_BAR; }
    }
    PG8_WAIT_V(0);
    if constexpr (!ALIGN_EPI) { if (wr == 0) PG8_BAR; }
    PG8_BAR;
    if constexpr (Epi::AFTER_DRAIN) { E.fused(acc, cur, wr, wc, fr, fq, lds, wid, lane); S.done(cur); }
#undef PG8_SA
#undef PG8_SB
#undef PG8_STAGE
#undef PG8_LDA
#undef PG8_LDB
#undef PG8_MMA
#undef PG8_WAIT_V
#undef PG8_WAIT_L
#undef PG8_BAR
#undef PG8_SCHED
}
}
#define GAS __attribute__((address_space(1)))
#define LAS __attribute__((address_space(3)))
typedef unsigned short bf16;
typedef unsigned v4u __attribute__((ext_vector_type(4)));
typedef float f32x4 __attribute__((ext_vector_type(4)));
typedef short bf16x8 __attribute__((ext_vector_type(8)));
typedef GAS unsigned gu32;
typedef GAS unsigned long long gu64;
#define RLX_AGENT __ATOMIC_RELAXED, __HIP_MEMORY_SCOPE_AGENT
#define LDS_WAIT() asm volatile("s_waitcnt lgkmcnt(0)" ::: "memory")
#define VM_WAIT() asm volatile("s_waitcnt vmcnt(0)" ::: "memory")
__device__ __forceinline__ unsigned long long rt() { return __builtin_amdgcn_s_memrealtime(); }
__device__ __forceinline__ unsigned f2bf(float f) { unsigned u = __builtin_bit_cast(unsigned, f); return (u + 0x7fffu + ((u >> 16) & 1u)) >> 16; }
__device__ __forceinline__ unsigned pk2(float lo, float hi) { return f2bf(lo) | (f2bf(hi) << 16); }

#define XB_TMO      128
#define XB_XCNT(j)  (256  + 64 * (j))
#define XB_XSUB(j)  (1280 + 64 * (j))
#define XB_XGEN(j)  (2304 + 64 * (j))
#define XB_TOP      3328
#define XB_TOPGEN   3392
#define XCD_BAR_WORDS 3456
#define XB_SPIN_CAP (1u << 18)

__device__ __forceinline__ unsigned xb_ld(unsigned* p)              { return __hip_atomic_load(p, __ATOMIC_RELAXED, __HIP_MEMORY_SCOPE_AGENT); }
__device__ __forceinline__ unsigned xb_add(unsigned* p, unsigned v) { return __hip_atomic_fetch_add(p, v, __ATOMIC_RELAXED, __HIP_MEMORY_SCOPE_AGENT); }
__device__ __forceinline__ unsigned xb_xcc_id() { return (unsigned)__builtin_amdgcn_s_getreg((3 << 11) | 20) & 0xFu; }
#define XB_SPIN(cond, bar) do { unsigned _sp = 0; while (cond) { __builtin_amdgcn_s_sleep(1); \
    if ((++_sp & 255u) == 0u) { if (xb_ld(&(bar)[XB_TMO])) break; if (_sp > XB_SPIN_CAP) { atomicAdd(&(bar)[XB_TMO], 1u); break; } } } } while (0)

struct XcdBarrier {
    unsigned* bar; unsigned x;
    volatile LAS unsigned* st;
};

__device__ __forceinline__ XcdBarrier xcd_barrier_post(unsigned* bar, volatile LAS unsigned* st, bool leader) {
    XcdBarrier b; b.bar = bar; b.x = xb_xcc_id(); b.st = st;
    if (leader) (void)xb_add(&bar[XB_XCNT(b.x)], 1u);
    return b;
}
__device__ __forceinline__ void xcd_barrier_complete(unsigned* bar, unsigned x, unsigned& nloc, unsigned& nx) {
    const unsigned G = gridDim.x * gridDim.y * gridDim.z;
    unsigned sum, cnt, mine, sp = 0u;
    for (;;) {
        sum = 0u; cnt = 0u; mine = 0u;
#pragma unroll
        for (unsigned j = 0; j < 16; ++j) { const unsigned c = xb_ld(&bar[XB_XCNT(j)]); sum += c; cnt += (c > 0u) ? 1u : 0u; mine = (j == x) ? c : mine; }
        if (sum == G) break;
        __builtin_amdgcn_s_sleep(1);
        if ((++sp & 255u) == 0u) { if (xb_ld(&bar[XB_TMO])) break; if (sp > XB_SPIN_CAP) { atomicAdd(&bar[XB_TMO], 1u); break; } }
    }
    nloc = mine > 0u ? mine : 1u; nx = cnt > 0u ? cnt : 1u;
}

__device__ __forceinline__ void xcd_barrier(const XcdBarrier& b, bool leader) {
    asm volatile("s_waitcnt vmcnt(0)" ::: "memory");
    __syncthreads();
    if (leader) {
        unsigned* bar = b.bar;
        __builtin_amdgcn_s_waitcnt(0);
        unsigned nloc = b.st[0], nx = b.st[1];
        if (nloc == 0u) { xcd_barrier_complete(bar, b.x, nloc, nx); b.st[0] = nloc; b.st[1] = nx; }
        const unsigned old = xb_add(&bar[XB_XSUB(b.x)], 1u);
        const unsigned gen = old / nloc;
        if (old + 1u == (gen + 1u) * nloc) {
            __builtin_amdgcn_fence(__ATOMIC_RELEASE, "agent");
            asm volatile("s_waitcnt vmcnt(0)" ::: "memory");
            const unsigned og = xb_add(&bar[XB_TOP], 1u);
            const unsigned tg = og / nx;
            if (og + 1u == (tg + 1u) * nx) xb_add(&bar[XB_TOPGEN], 1u);
            else XB_SPIN(xb_ld(&bar[XB_TOPGEN]) == tg, bar);
            __builtin_amdgcn_fence(__ATOMIC_ACQUIRE, "agent");
            xb_add(&bar[XB_XGEN(b.x)], 1u);
            asm volatile("s_waitcnt vmcnt(0)" ::: "memory");
        } else {
            XB_SPIN(xb_ld(&bar[XB_XGEN(b.x)]) == gen, bar);
            __builtin_amdgcn_fence(__ATOMIC_ACQUIRE, "agent");
            asm volatile("s_waitcnt vmcnt(0)" ::: "memory");
        }
    }
    __syncthreads();
}

constexpr int NWAVES = 8, NTHR = 512;
constexpr int DM = 2048, MROWS = 12288, DEPTH = 4;
constexpr int INC = 5152, INP = 5376, FF = 5632, GU = 11264;
constexpr int NMOD = 6 * DM;
constexpr float EPS = 1e-6f;
constexpr int PC_QA = 0, PC_KA = 512, PC_VA = 768, PC_QD = 1024, PC_KD = 1536, PC_VD = 2048, PC_Z = 2560, PC_XBC = 3584, PC_DT = 5120;
constexpr int RC_QA = 0, RC_KA = 512, RC_QD = 768, RC_KD = 1280, RCW = 1792;
constexpr size_t OUT_AK = 25165824, OUT_AV = OUT_AK + 4194304, OUT_DK = OUT_AV + 4194304, OUT_DV = OUT_DK + 8388608, OUT_SF = OUT_DV + 8388608, OUT_SB = OUT_SF + 8388608;
constexpr size_t MiB = 1u << 20;
constexpr size_t WS_CTL = 0, CTL_ZERO_BYTES = 1 * MiB;
constexpr size_t WS_TAB = 1 * MiB, WS_MOD = 2 * MiB, WS_MODP = 3 * MiB;
constexpr size_t WS_WIN = 8 * MiB, WS_WOUT = 92 * MiB, WS_WGU = 124 * MiB, WS_WDN = 300 * MiB;
constexpr size_t WS_H = 388 * MiB, WS_U = 484 * MiB, WS_P = 532 * MiB, WS_MIX = 658 * MiB, WS_ACT = 706 * MiB, WS_QKR = 838 * MiB;
constexpr size_t WS_XBC = 866 * MiB, WS_DT = 938 * MiB, WS_YF = 940 * MiB, WS_YB = 988 * MiB, WS_ST = 1036 * MiB, WS_EDEC = 1132 * MiB, WS_CDEC = 1134 * MiB, WS_SSQ = 1135 * MiB, WS_END = 1136 * MiB;
constexpr int CW_BAR = 4096;
constexpr int RING_BYTES = 131072, LDSCTL_OFF = RING_BYTES, MISC_OFF = LDSCTL_OFF + 320, LDS_BYTES = 147456;

struct Params { const float* in[28]; float* out; unsigned char* ws; int ph_lo, ph_hi; };
typedef __attribute__((address_space(4))) const Params* PP;
struct Frame { LAS unsigned char* lds; int tid, lane, wave, vcu, G; };

template <int M> __device__ __forceinline__ float xor_lt32(float v) { return __builtin_bit_cast(float, __builtin_amdgcn_ds_swizzle(__builtin_bit_cast(int, v), 0x1F | (M << 10))); }
__device__ __forceinline__ float half_sum(float v) { const unsigned u = __builtin_bit_cast(unsigned, v); auto r = __builtin_amdgcn_permlane32_swap(u, u, false, false); return __builtin_bit_cast(float, (unsigned)r[0]) + __builtin_bit_cast(float, (unsigned)r[1]); }
__device__ __forceinline__ float half_max(float v) { const unsigned u = __builtin_bit_cast(unsigned, v); auto r = __builtin_amdgcn_permlane32_swap(u, u, false, false); return fmaxf(__builtin_bit_cast(float, (unsigned)r[0]), __builtin_bit_cast(float, (unsigned)r[1])); }
__device__ __forceinline__ float bperm(float v, int srclane) { return __builtin_bit_cast(float, __builtin_amdgcn_ds_bpermute(srclane << 2, __builtin_bit_cast(int, v))); }
__device__ __forceinline__ float wave_sum(float v) { v += xor_lt32<1>(v); v += xor_lt32<2>(v); v += xor_lt32<4>(v); v += xor_lt32<8>(v); v += xor_lt32<16>(v); return half_sum(v); }
__device__ __forceinline__ float wave_max(float v) { v = fmaxf(v, xor_lt32<1>(v)); v = fmaxf(v, xor_lt32<2>(v)); v = fmaxf(v, xor_lt32<4>(v)); v = fmaxf(v, xor_lt32<8>(v)); v = fmaxf(v, xor_lt32<16>(v)); return half_max(v); }
__device__ __forceinline__ float bflo(unsigned w) { return __uint_as_float(w << 16); }
__device__ __forceinline__ float bfhi(unsigned w) { return __uint_as_float(w & 0xffff0000u); }
__device__ __forceinline__ float bf1(bf16 b) { return __uint_as_float((unsigned)b << 16); }
__device__ __forceinline__ float silu(float x) { return x / (1.0f + __expf(-x)); }

__device__ __forceinline__ void p0_transpose_item(const float* W, int K, int N, bf16* WT, int rowmap, LAS float* scr, int item, int lane) {
    const int nblk = N / 32, kb = item / nblk, nb = item % nblk, k0 = 64 * kb, n0 = 32 * nb;
#pragma unroll 8
    for (int i = 0; i < 32; ++i) { const int kk = 2 * i + (lane >> 5); scr[kk * 33 + (lane & 31)] = W[(size_t)(k0 + kk) * N + n0 + (lane & 31)]; }
    LDS_WAIT(); asm volatile("" ::: "memory");
    int r0 = n0;
    if (rowmap) r0 = (n0 < FF) ? ((n0 >> 7) * 256 + (n0 & 127)) : (((n0 - FF) >> 7) * 256 + 128 + ((n0 - FF) & 127));
    const int c = lane & 7;
#pragma unroll
    for (int j = 0; j < 4; ++j) { const int n = (lane >> 3) + 8 * j; const LAS float* s = scr + (8 * c) * 33 + n;
        v4u o; o.x = pk2(s[0 * 33], s[1 * 33]); o.y = pk2(s[2 * 33], s[3 * 33]); o.z = pk2(s[4 * 33], s[5 * 33]); o.w = pk2(s[6 * 33], s[7 * 33]);
        *(v4u*)(WT + (size_t)(r0 + n) * K + k0 + 8 * c) = o; }
    LDS_WAIT(); asm volatile("" ::: "memory");
}
__device__ __forceinline__ void p0_prologue(Frame& F, PP p) {
    unsigned char* ws = p->ws;
    LAS float* scr = (LAS float*)(F.lds + F.wave * 16384);
    const int gw = F.vcu * NWAVES + F.wave, NGW = F.G * NWAVES;
    const int gt = F.vcu * NTHR + F.tid, NGT = F.G * NTHR;
    constexpr int I_IN = 32 * (INC / 32), I_OUT = 32 * 64, I_GU = 32 * (GU / 32), I_DN = (FF / 64) * 64, I_L = I_IN + I_OUT + I_GU + I_DN;
    for (int it = gw; it < DEPTH * I_L; it += NGW) {
        const int l = it / I_L; int r = it % I_L;
        if (r < I_IN) { p0_transpose_item(p->in[14] + (size_t)l * DM * INC, DM, INC, (bf16*)(ws + WS_WIN) + (size_t)l * INP * DM, 0, scr, r, F.lane); continue; } r -= I_IN;
        if (r < I_OUT) { p0_transpose_item(p->in[24] + (size_t)l * DM * DM, DM, DM, (bf16*)(ws + WS_WOUT) + (size_t)l * DM * DM, 0, scr, r, F.lane); continue; } r -= I_OUT;
        if (r < I_GU) { p0_transpose_item(p->in[25] + (size_t)l * DM * GU, DM, GU, (bf16*)(ws + WS_WGU) + (size_t)l * GU * DM, 1, scr, r, F.lane); continue; } r -= I_GU;
        p0_transpose_item(p->in[26] + (size_t)l * FF * DM, FF, DM, (bf16*)(ws + WS_WDN) + (size_t)l * DM * FF, 0, scr, r, F.lane);
    }
    { constexpr int PADV = (INP - INC) * DM * 2 / 16;
      for (int i = gt; i < DEPTH * PADV; i += NGT) { const int l = i / PADV, r = i % PADV;
          *((v4u*)((bf16*)(ws + WS_WIN) + (size_t)l * INP * DM + (size_t)INC * DM) + r) = (v4u){0u, 0u, 0u, 0u}; } }
    { const f32x4* xp = (const f32x4*)p->in[0]; const f32x4* xs = (const f32x4*)p->in[1]; f32x4* H = (f32x4*)(ws + WS_H);
      constexpr int NP4 = 4096 * DM / 4, NT4 = MROWS * DM / 4;
      for (int i = gt; i < NT4; i += NGT) H[i] = (i < NP4) ? xp[i] : xs[i - NP4]; }
    __syncthreads();
    { LAS float* sc = (LAS float*)F.lds;
      float* MODP = (float*)(ws + WS_MODP);
      for (int it = blockIdx.x; it < DEPTH * 8 * 24; it += F.G) {
          const int l = it / 192, r = it % 192, kc = r / 24, nc = r % 24;
          if (F.tid < 256) {
              const int k = kc * 256 + F.tid;
              sc[F.tid] = silu(p->in[9][k]); sc[256 + F.tid] = silu(p->in[8][k]); sc[512 + F.tid] = silu(p->in[8][DM + k]);
          }
          __syncthreads();
          const int n = nc * 512 + F.tid;
          const float* w = p->in[10] + ((size_t)l * DM + (size_t)kc * 256) * NMOD + n;
          float a0 = 0.f, a1 = 0.f, a2 = 0.f;
          for (int k = 0; k < 256; k += 8) {
              float wv[8];
#pragma unroll
              for (int e = 0; e < 8; ++e) wv[e] = w[(size_t)(k + e) * NMOD];
#pragma unroll
              for (int e = 0; e < 8; ++e) { a0 += sc[k + e] * wv[e]; a1 += sc[256 + k + e] * wv[e]; a2 += sc[512 + k + e] * wv[e]; }
          }
          float* o = MODP + ((size_t)(kc * DEPTH + l) * 3) * NMOD + n;
          o[0] = a0; o[NMOD] = a1; o[2 * NMOD] = a2;
          __syncthreads();
      } }
    if (blockIdx.x == F.G - 1) {
        float2* tabA = (float2*)(ws + WS_TAB); float2* tabB = (float2*)(ws + WS_TAB + 16384); float* lam = (float*)(ws + WS_TAB + 32768);
        for (int i = F.tid; i < 2048 + 1024; i += NTHR) {
            const bool isA = i < 2048; const int j = isA ? i : i - 2048; const int pos = isA ? (j >> 5) : (j >> 4), k = isA ? (j & 31) : (j & 15);
            double r = 10000.0; r = sqrt(r); r = sqrt(r); r = sqrt(r); r = sqrt(r); if (isA) r = sqrt(r);
            const double ri = 1.0 / r; double inv = 1.0; for (int q = 0; q < k; ++q) inv *= ri;
            const double ang = (double)pos * inv; const double TWO_PI = 6.283185307179586476925;
            const double x = ang - TWO_PI * rint(ang / TWO_PI), x2 = x * x;
            double st = x, ss = x, ct = 1.0, cs = 1.0;
            for (int q = 1; q <= 16; ++q) { st *= -x2 / (double)((2 * q) * (2 * q + 1)); ss += st; ct *= -x2 / (double)((2 * q - 1) * (2 * q)); cs += ct; }
            const float2 v = make_float2((float)cs, (float)ss);
            if (isA) tabA[j] = v; else tabB[j] = v;
        }
        if (F.tid < DEPTH) {
            const float* lv = p->in[16] + F.tid * 256; float s01 = 0.f, s23 = 0.f;
            for (int i = 0; i < 64; ++i) { s01 += lv[i] * lv[64 + i]; s23 += lv[128 + i] * lv[192 + i]; }
            const float li = 0.8f - 0.6f * expf(-0.3f * (float)F.tid);
            lam[F.tid] = expf(s01) - expf(s23) + li; lam[4 + F.tid] = li;
        }
    }
}
__device__ __forceinline__ void p0b_mod(Frame& F, PP p) {
    const int gt = F.vcu * NTHR + F.tid, NGT = F.G * NTHR;
    const float* MODP = (const float*)(p->ws + WS_MODP); float* MOD = (float*)(p->ws + WS_MOD);
    for (int i = gt; i < DEPTH * 3 * NMOD; i += NGT) {
        const int l = i / (3 * NMOD), n = i % NMOD;
        float s = p->in[11][l * NMOD + n];
#pragma unroll
        for (int kc = 0; kc < 8; ++kc) s += MODP[(size_t)kc * DEPTH * 3 * NMOD + i];
        MOD[i] = s;
    }
}
__device__ __forceinline__ void norm_phase(Frame& F, const float* H, const float* g, const float* modl, int shoff, int scoff, bf16* U) {
    const int gw = F.vcu * NWAVES + F.wave, NGW = F.G * NWAVES;
    for (int m = gw; m < MROWS; m += NGW) {
        const int c = m < 4096 ? 0 : (m < 8192 ? 1 : 2);
        const float* sh = modl + c * NMOD + shoff; const float* sc = modl + c * NMOD + scoff;
        const f32x4* xr = (const f32x4*)(H + (size_t)m * DM) + F.lane;
        f32x4 v[8]; float ss = 0.f;
#pragma unroll
        for (int j = 0; j < 8; ++j) { v[j] = xr[64 * j]; ss += (v[j].x * v[j].x + v[j].y * v[j].y) + (v[j].z * v[j].z + v[j].w * v[j].w); }
        const float rstd = 1.0f / sqrtf(wave_sum(ss) * (1.0f / DM) + EPS);
        unsigned long long* o8 = (unsigned long long*)(U + (size_t)m * DM) + F.lane;
#pragma unroll
        for (int j = 0; j < 8; ++j) { const int col = 4 * F.lane + 256 * j;
            const f32x4 gv = *(const f32x4*)(g + col), sv = *(const f32x4*)(sc + col), hv = *(const f32x4*)(sh + col);
            const f32x4 o = (v[j] * rstd) * gv * (sv + 1.0f) + hv;
            o8[64 * j] = (unsigned long long)pk2(o.x, o.y) | ((unsigned long long)pk2(o.z, o.w) << 32); }
    }
}
__device__ __forceinline__ void final_phase(Frame& F, const float* H, const float* g, float* out) {
    const int gw = F.vcu * NWAVES + F.wave, NGW = F.G * NWAVES;
    for (int m = gw; m < MROWS; m += NGW) {
        const f32x4* xr = (const f32x4*)(H + (size_t)m * DM) + F.lane;
        f32x4 v[8]; float ss = 0.f;
#pragma unroll
        for (int j = 0; j < 8; ++j) { v[j] = xr[64 * j]; ss += (v[j].x * v[j].x + v[j].y * v[j].y) + (v[j].z * v[j].z + v[j].w * v[j].w); }
        const float rstd = 1.0f / sqrtf(wave_sum(ss) * (1.0f / DM) + EPS);
        f32x4* o = (f32x4*)(out + (size_t)m * DM) + F.lane;
#pragma unroll
        for (int j = 0; j < 8; ++j) { const f32x4 gv = *(const f32x4*)(g + 4 * F.lane + 256 * j); o[64 * j] = (v[j] * rstd) * gv; }
    }
}
__device__ __forceinline__ void prep_phase(Frame& F, PP p, int l) {
    unsigned char* ws = p->ws;
    const bf16* P = (const bf16*)(ws + WS_P); bf16* QKR = (bf16*)(ws + WS_QKR); bf16* XBC = (bf16*)(ws + WS_XBC); float* DT = (float*)(ws + WS_DT);
    const float2* tabA = (const float2*)(ws + WS_TAB); const float2* tabB = (const float2*)(ws + WS_TAB + 16384);
    const float* cw = p->in[18] + (size_t)l * 5 * 1536; const float* cb = p->in[19] + (size_t)l * 1536; const float* dtb = p->in[20] + l * 32;
    const int gw = F.vcu * NWAVES + F.wave, NGW = F.G * NWAVES, lane = F.lane;
    for (int m = gw; m < MROWS; m += NGW) {
        const bf16* prow = P + (size_t)m * INP;
        const int s0 = m < 4096 ? (m & ~255) : (4096 + ((m - 4096) & ~4095)); const int len = m < 4096 ? 256 : 4096; const int t = m - s0;
#pragma unroll
        for (int j = 0; j < 3; ++j) { const int c0 = 8 * lane + 512 * j;
            f32x4 a0 = *(const f32x4*)(cb + c0), a1 = *(const f32x4*)(cb + c0 + 4);
#pragma unroll
            for (int k = 0; k < 5; ++k) { const int tt = t + k - 2;
                if (tt >= 0 && tt < len) { const v4u raw = *(const v4u*)(P + (size_t)(s0 + tt) * INP + PC_XBC + c0);
                    const f32x4 w0 = *(const f32x4*)(cw + k * 1536 + c0), w1 = *(const f32x4*)(cw + k * 1536 + c0 + 4);
                    a0.x += w0.x * bflo(raw.x); a0.y += w0.y * bfhi(raw.x); a0.z += w0.z * bflo(raw.y); a0.w += w0.w * bfhi(raw.y);
                    a1.x += w1.x * bflo(raw.z); a1.y += w1.y * bfhi(raw.z); a1.z += w1.z * bflo(raw.w); a1.w += w1.w * bfhi(raw.w); } }
            a0.x = silu(a0.x); a0.y = silu(a0.y); a0.z = silu(a0.z); a0.w = silu(a0.w); a1.x = silu(a1.x); a1.y = silu(a1.y); a1.z = silu(a1.z); a1.w = silu(a1.w);
            *(v4u*)(XBC + (size_t)m * 1536 + c0) = (v4u){pk2(a0.x, a0.y), pk2(a0.z, a0.w), pk2(a1.x, a1.y), pk2(a1.z, a1.w)}; }
        if (lane < 32) { const float v = bf1(prow[PC_DT + lane]) + dtb[lane]; DT[(size_t)m * 32 + lane] = v > 20.f ? v : log1pf(__expf(v)); }
        if (m >= 4096) {
            const int gr = t >> 6, gc = t & 63; bf16* qrow = QKR + (size_t)(m - 4096) * RCW;
#pragma unroll
            for (int i = 0; i < 6; ++i) { const int d = lane; const int src = (i < 4 ? PC_QA + i * 128 : PC_KA + (i - 4) * 128) + d, dst = (i < 4 ? RC_QA + i * 128 : RC_KA + (i - 4) * 128) + d;
                const float x1 = bf1(prow[src]), x2 = bf1(prow[src + 64]); const float2 cs = d < 32 ? tabA[gr * 32 + d] : tabA[gc * 32 + d - 32];
                qrow[dst] = (bf16)f2bf(x1 * cs.x - x2 * cs.y); qrow[dst + 64] = (bf16)f2bf(x1 * cs.y + x2 * cs.x); }
#pragma unroll
            for (int i = 0; i < 8; ++i) { const int pp = lane + 64 * i, ch = pp >> 5, d = pp & 31; const int src = (ch < 8 ? PC_QD + ch * 64 : PC_KD + (ch - 8) * 64) + d, dst = (ch < 8 ? RC_QD + ch * 64 : RC_KD + (ch - 8) * 64) + d;
                const float x1 = bf1(prow[src]), x2 = bf1(prow[src + 32]); const float2 cs = d < 16 ? tabB[gr * 16 + d] : tabB[gc * 16 + d - 16];
                qrow[dst] = (bf16)f2bf(x1 * cs.x - x2 * cs.y); qrow[dst + 32] = (bf16)f2bf(x1 * cs.y + x2 * cs.x); }
        } else {
            const int b = m >> 8, s = m & 255; const size_t r = (size_t)((b * DEPTH + l) * 256 + s);
            { const unsigned long long w = *((const unsigned long long*)(prow + PC_KA) + lane); *((f32x4*)(p->out + OUT_AK + r * 256) + lane) = (f32x4){bflo((unsigned)w), bfhi((unsigned)w), bflo((unsigned)(w >> 32)), bfhi((unsigned)(w >> 32))}; }
            { const unsigned long long w = *((const unsigned long long*)(prow + PC_VA) + lane); *((f32x4*)(p->out + OUT_AV + r * 256) + lane) = (f32x4){bflo((unsigned)w), bfhi((unsigned)w), bflo((unsigned)(w >> 32)), bfhi((unsigned)(w >> 32))}; }
            { const v4u w = *((const v4u*)(prow + PC_KD) + lane); f32x4* o = (f32x4*)(p->out + OUT_DK + r * 512) + 2 * lane; o[0] = (f32x4){bflo(w.x), bfhi(w.x), bflo(w.y), bfhi(w.y)}; o[1] = (f32x4){bflo(w.z), bfhi(w.z), bflo(w.w), bfhi(w.w)}; }
            { const v4u w = *((const v4u*)(prow + PC_VD) + lane); f32x4* o = (f32x4*)(p->out + OUT_DV + r * 512) + 2 * lane; o[0] = (f32x4){bflo(w.x), bfhi(w.x), bflo(w.y), bfhi(w.y)}; o[1] = (f32x4){bflo(w.z), bfhi(w.z), bflo(w.w), bfhi(w.w)}; }
        }
    }
}
typedef float f32x16 __attribute__((ext_vector_type(16)));
typedef short s16x4 __attribute__((ext_vector_type(4)));
constexpr int FA_KSTR = 272, FA_VSTR = 320, FA_KB = 64 * FA_KSTR, FA_VB = 64 * FA_VSTR, FA_BUF = FA_KB + FA_VB;
constexpr int FA_OSTR = 272;
struct Seg { const void* k; const void* v; int ks, vs, n, f32, pos0; };
struct FaTile { v4u k[2], v[2]; };

__device__ __forceinline__ unsigned cvtpk(float lo, float hi) { typedef float f2 __attribute__((ext_vector_type(2))); typedef __bf16 b2 __attribute__((ext_vector_type(2))); f2 v = {lo, hi}; b2 b = __builtin_convertvector(v, b2); return __builtin_bit_cast(unsigned, b); }
__device__ __forceinline__ void fa_load(FaTile& t, const Seg& sg, int key0, int tid) {
#pragma unroll
    for (int i = 0; i < 2; ++i) { const int c = tid + 512 * i, key = c >> 4, ch = c & 15;
        if (sg.f32) {
            const f32x4* ks = (const f32x4*)((const float*)sg.k + (size_t)(key0 + key) * sg.ks + ch * 8);
            const f32x4* vs = (const f32x4*)((const float*)sg.v + (size_t)(key0 + key) * sg.vs + ch * 8);
            const f32x4 a = ks[0], b = ks[1], c2 = vs[0], d = vs[1];
            t.k[i] = (v4u){cvtpk(a.x, a.y), cvtpk(a.z, a.w), cvtpk(b.x, b.y), cvtpk(b.z, b.w)};
            t.v[i] = (v4u){cvtpk(c2.x, c2.y), cvtpk(c2.z, c2.w), cvtpk(d.x, d.y), cvtpk(d.z, d.w)};
        } else {
            t.k[i] = *(const v4u*)((const bf16*)sg.k + (size_t)(key0 + key) * sg.ks + ch * 8);
            t.v[i] = *(const v4u*)((const bf16*)sg.v + (size_t)(key0 + key) * sg.vs + ch * 8);
        } }
}
__device__ __forceinline__ void fa_store(const FaTile& t, LAS unsigned char* buf, int tid) {
#pragma unroll
    for (int i = 0; i < 2; ++i) { const int c = tid + 512 * i, key = c >> 4, ch = c & 15;
        *(LAS v4u*)(buf + key * FA_KSTR + ch * 16) = t.k[i];
        *(LAS v4u*)(buf + FA_KB + key * FA_VSTR + ch * 16) = t.v[i]; }
}
template <int NKS>
__device__ __forceinline__ void fa_tile(const LAS unsigned char* buf, const bf16x8 (&q)[NKS], f32x16 (&o)[4], float& m, float& lsum, float c, int kcolb, int lane, bool masked, int dpos  ) {
    const int r32 = lane & 31, h = lane >> 5;
    f32x16 p0, p1;
#pragma unroll
    for (int r = 0; r < 16; ++r) { p0[r] = 0.f; p1[r] = 0.f; }
    const LAS unsigned char* kp = buf + r32 * FA_KSTR + kcolb + h * 16;
#pragma unroll
    for (int ks = 0; ks < NKS; ++ks) {
        const bf16x8 a0 = *(const LAS bf16x8*)(kp + ks * 32), a1 = *(const LAS bf16x8*)(kp + 32 * FA_KSTR + ks * 32);
        p0 = __builtin_amdgcn_mfma_f32_32x32x16_bf16(a0, q[ks], p0, 0, 0, 0);
        p1 = __builtin_amdgcn_mfma_f32_32x32x16_bf16(a1, q[ks], p1, 0, 0, 0);
    }
    if (masked) {
#pragma unroll
        for (int r = 0; r < 16; ++r) { const int d0 = dpos - ((r & 3) + 8 * (r >> 2) + 4 * h), d1 = d0 - 32;
            if (d0 > 128 || d0 < -128) p0[r] = -INFINITY; if (d1 > 128 || d1 < -128) p1[r] = -INFINITY; }
    }
    float mt = fmaxf(p0[0], p1[0]);
#pragma unroll
    for (int r = 1; r < 16; ++r) mt = fmaxf(mt, fmaxf(p0[r], p1[r]));
    mt = half_max(mt);
    const float mn = fmaxf(m, mt * c);
    const float alpha = __builtin_amdgcn_exp2f(m - mn);
    m = mn;
    float rs = 0.f;
#pragma unroll
    for (int r = 0; r < 16; ++r) { p0[r] = __builtin_amdgcn_exp2f(p0[r] * c - mn); p1[r] = __builtin_amdgcn_exp2f(p1[r] * c - mn); rs += p0[r] + p1[r]; }
    lsum = lsum * alpha + rs;
#pragma unroll
    for (int b = 0; b < 4; ++b) o[b] = o[b] * alpha;
    bf16x8 pb[4];
    { v4u w;
      w = (v4u){cvtpk(p0[0], p0[1]), cvtpk(p0[2], p0[3]), cvtpk(p0[4], p0[5]), cvtpk(p0[6], p0[7])}; pb[0] = __builtin_bit_cast(bf16x8, w);
      w = (v4u){cvtpk(p0[8], p0[9]), cvtpk(p0[10], p0[11]), cvtpk(p0[12], p0[13]), cvtpk(p0[14], p0[15])}; pb[1] = __builtin_bit_cast(bf16x8, w);
      w = (v4u){cvtpk(p1[0], p1[1]), cvtpk(p1[2], p1[3]), cvtpk(p1[4], p1[5]), cvtpk(p1[6], p1[7])}; pb[2] = __builtin_bit_cast(bf16x8, w);
      w = (v4u){cvtpk(p1[8], p1[9]), cvtpk(p1[10], p1[11]), cvtpk(p1[12], p1[13]), cvtpk(p1[14], p1[15])}; pb[3] = __builtin_bit_cast(bf16x8, w); }
    const int i16 = lane & 15, gc = (lane >> 4) & 1;
    const LAS unsigned char* vp = buf + FA_KB + (4 * h + (i16 >> 2)) * FA_VSTR + (16 * gc + 4 * (i16 & 3)) * 2;
#pragma unroll
    for (int b = 0; b < 4; ++b)
#pragma unroll
        for (int s = 0; s < 4; ++s) {
            const s16x4 lo = __builtin_amdgcn_ds_read_tr16_b64_v4i16((LAS s16x4*)(vp + (16 * s) * FA_VSTR + b * 64));
            const s16x4 hi = __builtin_amdgcn_ds_read_tr16_b64_v4i16((LAS s16x4*)(vp + (16 * s + 8) * FA_VSTR + b * 64));
            const bf16x8 a = (bf16x8){lo[0], lo[1], lo[2], lo[3], hi[0], hi[1], hi[2], hi[3]};
            o[b] = __builtin_amdgcn_mfma_f32_32x32x16_bf16(a, pb[s], o[b], 0, 0, 0);
            if (s == 3) __builtin_amdgcn_sched_barrier(0);
        }
}
template <int MODE>
__device__ __forceinline__ void fa_unit(Frame& F, const bf16* qg, int qstride, const Seg& s0, const Seg& s1, bool two, int qpos0, float c, const float* sinkp, float lam, float onems, const float* dnorm, bf16* dst, int dstride) {
    constexpr int NKS = MODE == 0 ? 8 : 4;
    int tid_ = F.tid; asm volatile("" : "+v"(tid_));
    const int tid = tid_, lane = tid & 63, w = F.wave, r32 = lane & 31, h = lane >> 5, grp = w >> 2, qrow0 = (w & 3) * 32;
    const int kcolb = MODE == 0 ? 0 : grp * 128;
    qg += (MODE == 0 ? grp * 128 : grp * 64); if (MODE == 0) dst += grp * 128;
    bf16x8 q[NKS];
#pragma unroll
    for (int ks = 0; ks < NKS; ++ks) q[ks] = *(const bf16x8*)(qg + (size_t)(qrow0 + r32) * qstride + ks * 16 + h * 8);
    f32x16 o[4];
#pragma unroll
    for (int b = 0; b < 4; ++b)
#pragma unroll
        for (int r = 0; r < 16; ++r) o[b][r] = 0.f;
    float m = -INFINITY, lsum = 0.f;
    const int nt0 = s0.n >> 6, nt = nt0 + (two ? (s1.n >> 6) : 0);
    FaTile t;
    __syncthreads();
    fa_load(t, s0, 0, tid); fa_store(t, F.lds, tid);
    __syncthreads();
    for (int it = 0; it < nt; ++it) {
        const bool more = it + 1 < nt;
        if (more) { const int n = it + 1; if (n < nt0) fa_load(t, s0, n * 64, tid); else fa_load(t, s1, (n - nt0) * 64, tid); }
        const bool inseg1 = it >= nt0; const int pos0 = inseg1 ? s1.pos0 : s0.pos0; const int key0 = (inseg1 ? it - nt0 : it) * 64;
        fa_tile<NKS>(F.lds + (it & 1) * FA_BUF, q, o, m, lsum, c, kcolb, lane, pos0 >= 0, (qpos0 + qrow0 + r32) - (pos0 + key0));
        if (more) fa_store(t, F.lds + ((it + 1) & 1) * FA_BUF, tid);
        __syncthreads();
    }
    const float ltot = half_sum(lsum);
    if (MODE == 0) {
        const float inv = 1.0f / (ltot + __builtin_amdgcn_exp2f(sinkp[grp] * 1.4426950408889634f - m));
#pragma unroll
        for (int b = 0; b < 4; ++b) o[b] = o[b] * inv;
    } else {
        LAS float* comb = (LAS float*)(F.lds + (w & 3) * 16384);
        if (grp == 1) { const float f = lam / ltot;
#pragma unroll
            for (int b = 0; b < 4; ++b)
#pragma unroll
                for (int r = 0; r < 16; ++r) comb[(32 * b + (r & 3) + 8 * (r >> 2) + 4 * h) * 32 + r32] = o[b][r] * f; }
        __syncthreads();
        if (grp == 0) { const float inv = 1.0f / ltot; float ss = 0.f;
#pragma unroll
            for (int b = 0; b < 4; ++b)
#pragma unroll
                for (int r = 0; r < 16; ++r) { const float v = o[b][r] * inv - comb[(32 * b + (r & 3) + 8 * (r >> 2) + 4 * h) * 32 + r32]; o[b][r] = v; ss += v * v; }
            ss = half_sum(ss);
            const float rs = onems / sqrtf(ss * (1.0f / 128.0f) + EPS);
#pragma unroll
            for (int b = 0; b < 4; ++b)
#pragma unroll
                for (int r = 0; r < 16; ++r) o[b][r] = o[b][r] * rs * dnorm[32 * b + (r & 3) + 8 * (r >> 2) + 4 * h]; }
    }
    if (MODE == 0 || grp == 0) {
        LAS unsigned char* st = F.lds + (MODE == 0 ? w * (32 * FA_OSTR) : 65536 + (w & 3) * (32 * FA_OSTR));
#pragma unroll
        for (int b = 0; b < 4; ++b)
#pragma unroll
            for (int k = 0; k < 4; ++k) { typedef unsigned u2 __attribute__((ext_vector_type(2)));
                *(LAS u2*)(st + r32 * FA_OSTR + (32 * b + 8 * k + 4 * h) * 2) = (u2){cvtpk(o[b][4 * k], o[b][4 * k + 1]), cvtpk(o[b][4 * k + 2], o[b][4 * k + 3])}; }
        asm volatile("s_waitcnt lgkmcnt(0)" ::: "memory");
#pragma unroll
        for (int i = 0; i < 8; ++i) { const int cc = lane + 64 * i, row = cc >> 4, c16 = cc & 15;
            *(v4u*)(dst + (size_t)(qrow0 + row) * dstride + c16 * 8) = *(const LAS v4u*)(st + row * FA_OSTR + c16 * 16); }
    }
}
constexpr int NCHUNK = 96;
constexpr int S1_CSTR = 272, S1_XSTR = 160;
constexpr int S3_CM = 0, S3_BM = 34816, S3_XM = 69632, S3_TAB = 90112, S3_SSP = 92160;
constexpr int S1_BM = 0, S1_XM = 34816, S1_TAB = 55296;
#define LBAR() asm volatile("s_waitcnt lgkmcnt(0)\n\ts_barrier" ::: "memory")
__device__ __forceinline__ int crow16(int r, int h) { return (r & 3) + 8 * (r >> 2) + 4 * h; }

struct S1Pre { v4u b[4], x[2]; float dt, al; };
__device__ __forceinline__ void s1_load(S1Pre& q, const bf16* XB, const float* DT, const float* alog, int u, int tid, int wave) {
    const int cc = u >> 4, hd = u & 15, m0 = cc * 128, g = hd >> 3;
    const unsigned offB = (unsigned)((tid >> 4) * 1536 + (tid & 15) * 8) * 2u, offX = (unsigned)((tid >> 3) * 1536 + (tid & 7) * 8) * 2u;
#pragma unroll
    for (int i = 0; i < 4; ++i) { const char* bs = (const char*)(XB + (size_t)(m0 + 32 * i) * 1536 + 1024 + g * 128); q.b[i] = *(const v4u*)(bs + offB); }
#pragma unroll
    for (int i = 0; i < 2; ++i) { const char* xs = (const char*)(XB + (size_t)(m0 + 64 * i) * 1536 + hd * 64); q.x[i] = *(const v4u*)(xs + offX); }
    q.dt = *(const float*)((const char*)(DT + (size_t)m0 * 32 + hd) + (unsigned)((tid & 127) * 32 + ((tid >> 7) & 1) * 16) * 4u);
    q.al = alog[(wave & 1) * 16 + hd];
}
__device__ __forceinline__ void s1_store(const S1Pre& q, LAS unsigned char* L, int tid) {
#pragma unroll
    for (int i = 0; i < 4; ++i) { const int c = tid + 512 * i, row = c >> 4, ch = c & 15; *(LAS v4u*)(L + S1_BM + row * S1_CSTR + ch * 16) = q.b[i]; }
#pragma unroll
    for (int i = 0; i < 2; ++i) { const int c = tid + 512 * i, row = c >> 3, ch = c & 7; *(LAS v4u*)(L + S1_XM + row * S1_XSTR + ch * 16) = q.x[i]; }
    if (tid < 256) ((LAS float*)(L + S1_TAB))[tid] = q.dt;
}
__device__ __forceinline__ void s1_phase_units(Frame& F, PP p, int l, int ufirst, int ustride, int uend) {
    unsigned char* ws = p->ws;
    int tid_ = F.tid; asm volatile("" : "+v"(tid_));
    const int tid = tid_, lane = tid & 63, w = F.wave, r32 = lane & 31, hh = lane >> 5, i16 = lane & 15, gc = (lane >> 4) & 1;
    const bf16* XB = (const bf16*)(ws + WS_XBC); const float* DT = (const float*)(ws + WS_DT); const float* alog = p->in[21] + l * 32;
    float* CUMG = (float*)(ws + WS_EDEC); float* CDEC = (float*)(ws + WS_CDEC); bf16* STR = (bf16*)(ws + WS_ST);
    LAS unsigned char* L = F.lds; LAS float* tab = (LAS float*)(L + S1_TAB);
    int u = ufirst; if (u >= uend) return;
    S1Pre q; s1_load(q, XB, DT, alog, u, tid, w);
    while (u < uend) {
        const int cc = u >> 4, hd = u & 15; const float al = q.al;
        LBAR();
        s1_store(q, L, tid);
        LBAR();
        const int un = u + ustride; if (un < uend) s1_load(q, XB, DT, alog, un, tid, w);
        if (w < 2) {
            const float a = -__expf(al);
            const float d0 = tab[w * 128 + 2 * lane], d1 = tab[w * 128 + 2 * lane + 1];
            const float v0 = d0 * a, v1 = d1 * a, s = v0 + v1;
            float inc = s;
            if (w == 0) {
#pragma unroll
                for (int o = 1; o < 64; o <<= 1) { const float t = bperm(inc, lane - o); if (lane >= o) inc += t; }
            } else {
#pragma unroll
                for (int o = 1; o < 64; o <<= 1) { const float t = bperm(inc, lane + o); if (lane + o < 64) inc += t; }
            }
            const float exc = inc - s;
            const float c0 = (w == 0) ? exc + v0 : exc + v1 + v0, c1 = (w == 0) ? exc + v0 + v1 : exc + v1;
            const float tot = bperm(inc, w == 0 ? 63 : 0);
            tab[(2 + w) * 128 + 2 * lane] = __expf(tot - c0) * d0; tab[(2 + w) * 128 + 2 * lane + 1] = __expf(tot - c1) * d1;
            typedef float f2 __attribute__((ext_vector_type(2)));
            *(f2*)(CUMG + ((size_t)(cc * 16 + hd) * 2 + w) * 128 + 2 * lane) = (f2){c0, c1};
            if (lane == 0) CDEC[(w * NCHUNK + cc) * 16 + hd] = __expf(tot);
        }
        LBAR();
        {
            const int nb = w & 3, pb = w >> 2;
            f32x16 st[2];
#pragma unroll
            for (int d = 0; d < 2; ++d)
#pragma unroll
                for (int r = 0; r < 16; ++r) st[d][r] = 0.f;
            const LAS unsigned char* bp = L + S1_BM + (8 * hh + (i16 >> 2)) * S1_CSTR + (32 * nb + 16 * gc + 4 * (i16 & 3)) * 2;
            const LAS unsigned char* xp = L + S1_XM + (8 * hh + (i16 >> 2)) * S1_XSTR + (32 * pb + 16 * gc + 4 * (i16 & 3)) * 2;
#pragma unroll
            for (int ks = 0; ks < 8; ++ks) {
                const s16x4 alo = __builtin_amdgcn_ds_read_tr16_b64_v4i16((LAS s16x4*)(bp + (16 * ks) * S1_CSTR));
                const s16x4 ahi = __builtin_amdgcn_ds_read_tr16_b64_v4i16((LAS s16x4*)(bp + (16 * ks + 4) * S1_CSTR));
                const bf16x8 afr = (bf16x8){alo[0], alo[1], alo[2], alo[3], ahi[0], ahi[1], ahi[2], ahi[3]};
                const s16x4 lo = __builtin_amdgcn_ds_read_tr16_b64_v4i16((LAS s16x4*)(xp + (16 * ks) * S1_XSTR));
                const s16x4 hi = __builtin_amdgcn_ds_read_tr16_b64_v4i16((LAS s16x4*)(xp + (16 * ks + 4) * S1_XSTR));
                const float x0 = bf1((bf16)lo[0]), x1 = bf1((bf16)lo[1]), x2 = bf1((bf16)lo[2]), x3 = bf1((bf16)lo[3]), x4 = bf1((bf16)hi[0]), x5 = bf1((bf16)hi[1]), x6 = bf1((bf16)hi[2]), x7 = bf1((bf16)hi[3]);
#pragma unroll
                for (int d = 0; d < 2; ++d) {
                    const f32x4 w0 = *(const LAS f32x4*)(tab + (2 + d) * 128 + 16 * ks + 8 * hh), w1 = *(const LAS f32x4*)(tab + (2 + d) * 128 + 16 * ks + 8 * hh + 4);
                    const v4u t = (v4u){cvtpk(x0 * w0.x, x1 * w0.y), cvtpk(x2 * w0.z, x3 * w0.w), cvtpk(x4 * w1.x, x5 * w1.y), cvtpk(x6 * w1.z, x7 * w1.w)};
                    st[d] = __builtin_amdgcn_mfma_f32_32x32x16_bf16(afr, __builtin_bit_cast(bf16x8, t), st[d], 0, 0, 0);
                }
            }
#pragma unroll
            for (int d = 0; d < 2; ++d) { bf16* so = STR + ((size_t)(d * NCHUNK + cc) * 16 + hd) * 8192 + (size_t)((nb * 2 + pb) * 2) * 512 + lane * 8;
#pragma unroll
                for (int j = 0; j < 2; ++j) *(v4u*)(so + j * 512) = (v4u){cvtpk(st[d][8 * j], st[d][8 * j + 1]), cvtpk(st[d][8 * j + 2], st[d][8 * j + 3]), cvtpk(st[d][8 * j + 4], st[d][8 * j + 5]), cvtpk(st[d][8 * j + 6], st[d][8 * j + 7])}; }
        }
        u = un;
    }
    LBAR();
}
__device__ __forceinline__ void s2_scan(Frame& F, PP p, int l) {
    unsigned char* ws = p->ws; bf16* STR = (bf16*)(ws + WS_ST); const float* CDEC = (const float*)(ws + WS_CDEC);
    const int gt = F.vcu * NTHR + F.tid, NGT = F.G * NTHR;
    for (int idx = gt; idx < 576 * 1024; idx += NGT) {
        const int combo = idx >> 10, v = idx & 1023, seq = combo >> 5, hd = (combo >> 1) & 15, dir = combo & 1;
        const int c0 = seq < 16 ? seq * 2 : 32 + (seq - 16) * 32, nc = seq < 16 ? 2 : 32;
        const int ln = v & 63, blk = v >> 6, j = blk & 1, pb = (blk >> 1) & 1, nb = blk >> 2; const int pp = 32 * pb + (ln & 31), n0 = 32 * nb + 16 * j + 4 * (ln >> 5);
        f32x4 H0 = (f32x4){0.f, 0.f, 0.f, 0.f}, H1 = H0;
        if (seq >= 16) { const float* h0 = p->in[dir ? 7 : 6] + (((size_t)(seq - 16) * DEPTH + l) * 16 + hd) * 8192 + pp * 128 + n0; H0 = *(const f32x4*)h0; H1 = *(const f32x4*)(h0 + 8); }
        for (int k = 0; k < nc; k += 2) {
            const int ca = dir ? c0 + nc - 1 - k : c0 + k, cb = dir ? ca - 1 : ca + 1;
            v4u* pa = (v4u*)(STR + ((size_t)(dir * NCHUNK + ca) * 16 + hd) * 8192) + v; v4u* pbb = (v4u*)(STR + ((size_t)(dir * NCHUNK + cb) * 16 + hd) * 8192) + v;
            const v4u ta = *pa, tb = *pbb; const float da = CDEC[(dir * NCHUNK + ca) * 16 + hd], db = CDEC[(dir * NCHUNK + cb) * 16 + hd];
            *pa = (v4u){cvtpk(H0.x, H0.y), cvtpk(H0.z, H0.w), cvtpk(H1.x, H1.y), cvtpk(H1.z, H1.w)};
            H0 = H0 * da + (f32x4){bflo(ta.x), bfhi(ta.x), bflo(ta.y), bfhi(ta.y)}; H1 = H1 * da + (f32x4){bflo(ta.z), bfhi(ta.z), bflo(ta.w), bfhi(ta.w)};
            *pbb = (v4u){cvtpk(H0.x, H0.y), cvtpk(H0.z, H0.w), cvtpk(H1.x, H1.y), cvtpk(H1.z, H1.w)};
            H0 = H0 * db + (f32x4){bflo(tb.x), bfhi(tb.x), bflo(tb.y), bfhi(tb.y)}; H1 = H1 * db + (f32x4){bflo(tb.z), bfhi(tb.z), bflo(tb.w), bfhi(tb.w)};
        }
        if (seq < 16) { float* o = p->out + (dir ? OUT_SB : OUT_SF) + (((size_t)seq * DEPTH + l) * 16 + hd) * 8192 + pp * 128 + n0; *(f32x4*)o = H0; *(f32x4*)(o + 8) = H1; }
    }
}
struct S3Pre { v4u c[4], b[4], x[2]; float dt, cum; };
__device__ __forceinline__ void s3_load(S3Pre& q, const bf16* XB, const float* DT, const float* CUMG, int u, int tid) {
    const int cc = u >> 4, hd = u & 15, m0 = cc * 128, g = hd >> 3;
    const unsigned offB = (unsigned)((tid >> 4) * 1536 + (tid & 15) * 8) * 2u, offX = (unsigned)((tid >> 3) * 1536 + (tid & 7) * 8) * 2u;
#pragma unroll
    for (int i = 0; i < 4; ++i) { const char* bs = (const char*)(XB + (size_t)(m0 + 32 * i) * 1536 + g * 128); q.c[i] = *(const v4u*)(bs + 2560 + offB); q.b[i] = *(const v4u*)(bs + 2048 + offB); }
#pragma unroll
    for (int i = 0; i < 2; ++i) { const char* xs = (const char*)(XB + (size_t)(m0 + 64 * i) * 1536 + hd * 64); q.x[i] = *(const v4u*)(xs + offX); }
    q.dt = *(const float*)((const char*)(DT + (size_t)m0 * 32 + hd) + (unsigned)((tid & 127) * 32 + ((tid >> 7) & 1) * 16) * 4u);
    q.cum = *(const float*)((const char*)(CUMG + (size_t)(cc * 16 + hd) * 256) + (unsigned)(tid & 255) * 4u);
}
__device__ __forceinline__ void s3_store(const S3Pre& q, LAS unsigned char* L, int tid) {
#pragma unroll
    for (int i = 0; i < 4; ++i) { const int c = tid + 512 * i, row = c >> 4, ch = c & 15; *(LAS v4u*)(L + S3_CM + row * S1_CSTR + ch * 16) = q.c[i]; *(LAS v4u*)(L + S3_BM + row * S1_CSTR + ch * 16) = q.b[i]; }
#pragma unroll
    for (int i = 0; i < 2; ++i) { const int c = tid + 512 * i, row = c >> 3, ch = c & 7; *(LAS v4u*)(L + S3_XM + row * S1_XSTR + ch * 16) = q.x[i]; }
    if (tid < 256) { ((LAS float*)(L + S3_TAB))[tid] = q.cum; ((LAS float*)(L + S3_TAB))[256 + tid] = q.dt; }
}
__device__ __forceinline__ void s3_phase(Frame& F, PP p, int l) {
    unsigned char* ws = p->ws;
    int tid_ = F.tid; asm volatile("" : "+v"(tid_));
    const int tid = tid_, lane = tid & 63, w = F.wave, r32 = lane & 31, hh = lane >> 5, i16 = lane & 15, gc = (lane >> 4) & 1;
    const bf16* XB = (const bf16*)(ws + WS_XBC); const bf16* P = (const bf16*)(ws + WS_P); bf16* MIX = (bf16*)(ws + WS_MIX);
    const float* DT = (const float*)(ws + WS_DT); const float* CUMG = (const float*)(ws + WS_EDEC); const bf16* STR = (const bf16*)(ws + WS_ST); float* SSQ = (float*)(ws + WS_SSQ);
    LAS unsigned char* L = F.lds; const LAS float* tab = (const LAS float*)(L + S3_TAB); LAS float* SSP = (LAS float*)(L + S3_SSP);
    const int lb = w & 3, pb = w >> 2, lpos = 32 * lb + r32;
    const int uend = NCHUNK * 16;
    int u = blockIdx.x; if (u >= uend) return;
    S3Pre q; s3_load(q, XB, DT, CUMG, u, tid);
    while (u < uend) {
        const int cc = u >> 4, hd = u & 15, m0 = cc * 128;
        LBAR();
        s3_store(q, L, tid);
        LBAR();
        const int un = u + F.G; if (un < uend) s3_load(q, XB, DT, CUMG, un, tid);
        v4u hf[2][8];
#pragma unroll
        for (int k = 0; k < 8; ++k) hf[0][k] = *(const v4u*)((const char*)(STR + ((size_t)(0 * NCHUNK + cc) * 16 + hd) * 8192 + (((k >> 1) * 2 + pb) * 2 + (k & 1)) * 512) + (unsigned)lane * 16u);
        unsigned long long zw[4];
        const float dk = p->in[22][l * 16 + hd];
        f32x16 acc;
#pragma unroll
        for (int r = 0; r < 16; ++r) acc[r] = 0.f;
#pragma unroll
        for (int d = 0; d < 2; ++d) {
            const LAS float* cum = tab + d * 128; const LAS float* dtv = tab + (2 + d) * 128; const float cl = cum[lpos];
            const int sb0 = d == 0 ? 0 : lb, sb1 = d == 0 ? lb : 3;
            for (int sb = sb0; sb <= sb1; ++sb) {
                f32x16 cb;
#pragma unroll
                for (int r = 0; r < 16; ++r) cb[r] = 0.f;
#pragma unroll
                for (int ks = 0; ks < 8; ++ks) { const bf16x8 a = *(const LAS bf16x8*)(L + S3_BM + (32 * sb + r32) * S1_CSTR + ks * 32 + hh * 16);
                    const bf16x8 cfr = *(const LAS bf16x8*)(L + S3_CM + lpos * S1_CSTR + ks * 32 + hh * 16);
                    cb = __builtin_amdgcn_mfma_f32_32x32x16_bf16(a, cfr, cb, 0, 0, 0); }
#pragma unroll
                for (int r = 0; r < 16; ++r) { const int s = 32 * sb + crow16(r, hh);
                    float v = cb[r] * __expf(cl - cum[s]) * dtv[s];
                    const bool ok = d == 0 ? (s <= lpos) : (s >= lpos);
                    v = ok ? v : 0.f; if (d == 0 && s == lpos) v += dk;
                    cb[r] = v; }
                bf16x8 pb2[2];
                { v4u t;
                  t = (v4u){cvtpk(cb[0], cb[1]), cvtpk(cb[2], cb[3]), cvtpk(cb[4], cb[5]), cvtpk(cb[6], cb[7])}; pb2[0] = __builtin_bit_cast(bf16x8, t);
                  t = (v4u){cvtpk(cb[8], cb[9]), cvtpk(cb[10], cb[11]), cvtpk(cb[12], cb[13]), cvtpk(cb[14], cb[15])}; pb2[1] = __builtin_bit_cast(bf16x8, t); }
                const LAS unsigned char* xp = L + S3_XM + (32 * sb + 4 * hh + (i16 >> 2)) * S1_XSTR + (32 * pb + 16 * gc + 4 * (i16 & 3)) * 2;
#pragma unroll
                for (int k2 = 0; k2 < 2; ++k2) {
                    const s16x4 lo = __builtin_amdgcn_ds_read_tr16_b64_v4i16((LAS s16x4*)(xp + (16 * k2) * S1_XSTR));
                    const s16x4 hi = __builtin_amdgcn_ds_read_tr16_b64_v4i16((LAS s16x4*)(xp + (16 * k2 + 8) * S1_XSTR));
                    const bf16x8 a = (bf16x8){lo[0], lo[1], lo[2], lo[3], hi[0], hi[1], hi[2], hi[3]};
                    acc = __builtin_amdgcn_mfma_f32_32x32x16_bf16(a, pb2[k2], acc, 0, 0, 0);
                }
            }
            if (d == 0) {
#pragma unroll
                for (int k = 0; k < 8; ++k) hf[1][k] = *(const v4u*)((const char*)(STR + ((size_t)(1 * NCHUNK + cc) * 16 + hd) * 8192 + (((k >> 1) * 2 + pb) * 2 + (k & 1)) * 512) + (unsigned)lane * 16u);
#pragma unroll
                for (int k = 0; k < 4; ++k) zw[k] = *(const unsigned long long*)((const char*)(P + (size_t)m0 * INP + PC_Z + hd * 64 + 32 * pb + 8 * k) + (unsigned)(lpos * INP + 4 * hh) * 2u);
            }
        }
#pragma unroll
        for (int d = 0; d < 2; ++d) { const float e = __expf(tab[d * 128 + lpos]);
#pragma unroll
            for (int k = 0; k < 8; ++k) { typedef unsigned u2 __attribute__((ext_vector_type(2)));
                const LAS unsigned char* cp = L + S3_CM + lpos * S1_CSTR + (32 * (k >> 1) + 16 * (k & 1) + 4 * hh) * 2;
                const u2 c0 = *(const LAS u2*)cp, c1 = *(const LAS u2*)(cp + 16);
                const v4u t = (v4u){cvtpk(bflo(c0.x) * e, bfhi(c0.x) * e), cvtpk(bflo(c0.y) * e, bfhi(c0.y) * e), cvtpk(bflo(c1.x) * e, bfhi(c1.x) * e), cvtpk(bflo(c1.y) * e, bfhi(c1.y) * e)};
                acc = __builtin_amdgcn_mfma_f32_32x32x16_bf16(__builtin_bit_cast(bf16x8, hf[d][k]), __builtin_bit_cast(bf16x8, t), acc, 0, 0, 0); } }
        float ss = 0.f;
        char* mixr = (char*)(MIX + (size_t)m0 * DM + 1024 + hd * 64 + 32 * pb); const unsigned mixo = (unsigned)(lpos * DM + 4 * hh) * 2u;
#pragma unroll
        for (int k = 0; k < 4; ++k) { const unsigned long long z = zw[k];
            const float y0 = acc[4 * k] * silu(bflo((unsigned)z)), y1 = acc[4 * k + 1] * silu(bfhi((unsigned)z)), y2 = acc[4 * k + 2] * silu(bflo((unsigned)(z >> 32))), y3 = acc[4 * k + 3] * silu(bfhi((unsigned)(z >> 32)));
            ss += (y0 * y0 + y1 * y1) + (y2 * y2 + y3 * y3);
            *(unsigned long long*)(mixr + 16 * k + mixo) = (unsigned long long)cvtpk(y0, y1) | ((unsigned long long)cvtpk(y2, y3) << 32); }
        ss = half_sum(ss);
        if (hh == 0) SSP[pb * 128 + lpos] = ss;
        LBAR();
        if (tid < 128) SSQ[(size_t)(m0 + tid) * 16 + hd] = SSP[tid] + SSP[128 + tid];
        u = un;
    }
    LBAR();
}
__device__ __forceinline__ void nrm_phase(Frame& F, PP p, int l) {
    unsigned char* ws = p->ws; bf16* MIX = (bf16*)(ws + WS_MIX); const float* SSQ = (const float*)(ws + WS_SSQ); const float* sn = p->in[23] + l * 1024;
    const int gw = F.vcu * NWAVES + F.wave, NGW = F.G * NWAVES, lane = F.lane;
    for (int m = gw; m < MROWS; m += NGW) {
        const int c0 = lane * 16, g = lane >> 5;
        const f32x4 s0 = *(const f32x4*)(SSQ + (size_t)m * 16 + g * 8), s1 = *(const f32x4*)(SSQ + (size_t)m * 16 + g * 8 + 4);
        const float rs = 1.0f / sqrtf(((s0.x + s0.y) + (s0.z + s0.w) + (s1.x + s1.y) + (s1.z + s1.w)) * (1.0f / 512.0f) + EPS);
        v4u* q = (v4u*)(MIX + (size_t)m * DM + 1024 + c0); v4u a = q[0], b = q[1];
        const f32x4 g0 = *(const f32x4*)(sn + c0), g1 = *(const f32x4*)(sn + c0 + 4), g2 = *(const f32x4*)(sn + c0 + 8), g3 = *(const f32x4*)(sn + c0 + 12);
        a.x = cvtpk(bflo(a.x) * rs * g0.x, bfhi(a.x) * rs * g0.y); a.y = cvtpk(bflo(a.y) * rs * g0.z, bfhi(a.y) * rs * g0.w); a.z = cvtpk(bflo(a.z) * rs * g1.x, bfhi(a.z) * rs * g1.y); a.w = cvtpk(bflo(a.w) * rs * g1.z, bfhi(a.w) * rs * g1.w);
        b.x = cvtpk(bflo(b.x) * rs * g2.x, bfhi(b.x) * rs * g2.y); b.y = cvtpk(bflo(b.y) * rs * g2.z, bfhi(b.y) * rs * g2.w); b.z = cvtpk(bflo(b.z) * rs * g3.x, bfhi(b.z) * rs * g3.y); b.w = cvtpk(bflo(b.w) * rs * g3.z, bfhi(b.w) * rs * g3.w);
        q[0] = a; q[1] = b;
    }
}
__device__ __forceinline__ void mix1_phase(Frame& F, PP p, int l) {
    unsigned char* ws = p->ws;
    const bf16* P = (const bf16*)(ws + WS_P); const bf16* QKR = (const bf16*)(ws + WS_QKR); bf16* MIX = (bf16*)(ws + WS_MIX);
    const float* lamv = (const float*)(ws + WS_TAB + 32768);
    const float lam = lamv[l], onems = 1.0f - lamv[4 + l];
    const float* dnorm = p->in[17] + l * 128;
    constexpr int U_BL = 256, U_AL = 128, U_BC = 128, U_AC = 64, U_FA = U_BL + U_AL + U_BC + U_AC;
    const float LOG2E = 1.4426950408889634f, cA = 0.08838834764831845f * LOG2E, cB = 0.125f * LOG2E;
    for (int u = blockIdx.x; u < U_FA; u += F.G) {
        int r = u;
        int mode = 1; const bf16* qp; int qstr = RCW, qpos0 = 0; bool two = true; Seg s0, s1; bf16* dst; const float* sinkp = dnorm;
        if (r < U_BL) {
            const int b = r >> 7, h = (r >> 5) & 3, qb = r & 31; const int ml = b * 4096 + qb * 128;
            s0 = Seg{QKR + (size_t)(b * 4096) * RCW + RC_KD + h * 128, P + (size_t)(4096 + b * 4096) * INP + PC_VD + h * 128, RCW, INP, 4096, 0, -1};
            s1 = Seg{p->in[4] + ((size_t)(b * DEPTH + l) * 256) * 512 + h * 128, p->in[5] + ((size_t)(b * DEPTH + l) * 256) * 512 + h * 128, 512, 512, 256, 1, -1};
            qp = QKR + (size_t)ml * RCW + RC_QD + h * 128; dst = MIX + (size_t)(4096 + ml) * DM + 512 + h * 128;
        } else if (r < U_BL + U_AL) { r -= U_BL;
            const int b = r >> 6, kv = (r >> 5) & 1, qb = r & 31; const int ml = b * 4096 + qb * 128;
            const int w0 = qb * 128 - 128 < 0 ? 0 : qb * 128 - 128, w1 = qb * 128 + 256 > 4096 ? 4096 : qb * 128 + 256;
            s0 = Seg{p->in[2] + ((size_t)(b * DEPTH + l) * 256) * 256 + kv * 128, p->in[3] + ((size_t)(b * DEPTH + l) * 256) * 256 + kv * 128, 256, 256, 256, 1, -1};
            s1 = Seg{QKR + (size_t)(b * 4096 + w0) * RCW + RC_KA + kv * 128, P + (size_t)(4096 + b * 4096 + w0) * INP + PC_VA + kv * 128, RCW, INP, w1 - w0, 0, w0};
            mode = 0; qp = QKR + (size_t)ml * RCW + RC_QA + kv * 256; qpos0 = qb * 128; sinkp = p->in[15] + l * 4 + kv * 2; dst = MIX + (size_t)(4096 + ml) * DM + kv * 256;
        } else if (r < U_BL + U_AL + U_BC) { r -= U_BL + U_AL;
            const int b = r >> 3, h = (r >> 1) & 3, qb = r & 1; const int m0 = b * 256 + qb * 128;
            s0 = Seg{P + (size_t)(b * 256) * INP + PC_KD + h * 128, P + (size_t)(b * 256) * INP + PC_VD + h * 128, INP, INP, 256, 0, -1}; s1 = s0; two = false;
            qp = P + (size_t)m0 * INP + PC_QD + h * 128; qstr = INP; dst = MIX + (size_t)m0 * DM + 512 + h * 128;
        } else { r -= U_BL + U_AL + U_BC;
            const int b = r >> 2, kv = (r >> 1) & 1, qb = r & 1; const int m0 = b * 256 + qb * 128;
            s0 = Seg{P + (size_t)(b * 256) * INP + PC_KA + kv * 128, P + (size_t)(b * 256) * INP + PC_VA + kv * 128, INP, INP, 256, 0, -1}; s1 = s0; two = false;
            mode = 0; qp = P + (size_t)m0 * INP + PC_QA + kv * 256; qstr = INP; sinkp = p->in[15] + l * 4 + kv * 2; dst = MIX + (size_t)m0 * DM + kv * 256;
        }
        if (mode) fa_unit<1>(F, qp, qstr, s0, s1, two, qpos0, cB, sinkp, lam, onems, dnorm, dst, DM);
        else fa_unit<0>(F, qp, qstr, s0, s1, two, qpos0, cA, sinkp, lam, onems, dnorm, dst, DM);
    }
    __syncthreads();
    s1_phase_units(F, p, l, blockIdx.x, F.G, NCHUNK * 16);
}
#ifndef MK_ONE_LAUNCH
#define MK_ONE_LAUNCH 1
#endif
constexpr int PH_PER_LAYER = 11, PH_TOTAL = 2 + DEPTH * PH_PER_LAYER + 1;
__global__ void __launch_bounds__(NTHR, 2) mk_fwd(Params p_) {
    extern __shared__ __attribute__((aligned(16))) unsigned char lds[];
    Frame F;
    F.lds = (LAS unsigned char*)lds;
    F.tid = threadIdx.x; F.lane = F.tid & 63; F.wave = __builtin_amdgcn_readfirstlane(F.tid >> 6); const int wave0 = F.wave;
    F.G = gridDim.x; { const int bx = blockIdx.x; F.vcu = (F.G % 8 == 0) ? (bx % 8) * (F.G / 8) + bx / 8 : bx; }
    PP p = (PP)__builtin_amdgcn_kernarg_segment_ptr();
    for (int u = F.tid; u < (LDS_BYTES - LDSCTL_OFF) / 4; u += NTHR) ((LAS unsigned*)(F.lds + LDSCTL_OFF))[u] = 0u;
    __syncthreads();
    XcdBarrier bar; bar.bar = (unsigned*)(p->ws + WS_CTL) + CW_BAR; bar.x = 0; bar.st = nullptr;
#if MK_ONE_LAUNCH
    bar = xcd_barrier_post((unsigned*)(p->ws + WS_CTL) + CW_BAR, (volatile LAS unsigned*)(F.lds + MISC_OFF) + 8, F.tid == 0);
#define GRID_BAR() xcd_barrier(bar, wave0 == 0 && __builtin_amdgcn_mbcnt_hi(~0u, __builtin_amdgcn_mbcnt_lo(~0u, 0u)) == 0u)
#else
#define GRID_BAR() do {} while (0)
#endif
    const int lo = p->ph_lo, hi = p->ph_hi;
#define IN(k) (lo <= (k) && (k) < hi)
#define SEAM(k) do { if (IN(k) && IN((k) + 1)) GRID_BAR(); } while (0)
#define ENTER() do { int wv_ = wave0; asm volatile("" : "+s"(wv_)); int t_ = wv_ * 64 + (int)__builtin_amdgcn_mbcnt_hi(~0u, __builtin_amdgcn_mbcnt_lo(~0u, 0u)); asm volatile("" : "+v"(t_)); F.tid = t_; F.lane = t_ & 63; F.wave = wv_; asm volatile("" : "+s"(p)); ws = p->ws; } while (0)
    unsigned char* ws;

    if (IN(0)) { ENTER(); p0_prologue(F, p); } SEAM(0);
    if (IN(1)) { ENTER(); p0b_mod(F, p); } SEAM(1);
#pragma unroll 1
    for (int l = 0; l < DEPTH; ++l) {
        const int pb = 2 + l * PH_PER_LAYER;
        if (IN(pb + 0)) { ENTER(); norm_phase(F, (const float*)(ws + WS_H), p->in[12] + l * DM, (const float*)(ws + WS_MOD) + (size_t)l * 3 * NMOD, 0, DM, (bf16*)(ws + WS_U)); } SEAM(pb + 0);
        if (IN(pb + 1)) { ENTER();
            pg8::Gemm g{(const bf16*)(ws + WS_U), (const bf16*)(ws + WS_WIN) + (size_t)l * INP * DM, MROWS, INP, DM, DM}; pg8::StaticOrder S; S.init(MROWS, INP, F.G, (int)blockIdx.x);
            pg8::EpiBf16 E{(bf16*)(ws + WS_P), INP};
            pg8::gemm_phase<pg8::EpiBf16, pg8::StaticOrder, true, true>(F.lds, g, S, E, F.tid);
        } SEAM(pb + 1);
        if (IN(pb + 2)) { ENTER(); prep_phase(F, p, l); } SEAM(pb + 2);
        if (IN(pb + 3)) { ENTER(); mix1_phase(F, p, l); } SEAM(pb + 3);
        if (IN(pb + 4)) { ENTER(); s2_scan(F, p, l); } SEAM(pb + 4);
        if (IN(pb + 5)) { ENTER(); s3_phase(F, p, l); } SEAM(pb + 5);
        if (IN(pb + 6)) { ENTER(); nrm_phase(F, p, l); } SEAM(pb + 6);
        if (IN(pb + 7)) { ENTER();
            pg8::Gemm g{(const bf16*)(ws + WS_MIX), (const bf16*)(ws + WS_WOUT) + (size_t)l * DM * DM, MROWS, DM, DM, DM}; pg8::StaticOrder S; S.init(MROWS, DM, F.G, (int)blockIdx.x);
            pg8::EpiResid E{(float*)(ws + WS_H), DM, (const float*)(ws + WS_MOD) + (size_t)l * 3 * NMOD + 2 * DM, NMOD};
            pg8::gemm_phase<pg8::EpiResid, pg8::StaticOrder, true, true>(F.lds, g, S, E, F.tid);
        } SEAM(pb + 7);
        if (IN(pb + 8)) { ENTER(); norm_phase(F, (const float*)(ws + WS_H), p->in[13] + l * DM, (const float*)(ws + WS_MOD) + (size_t)l * 3 * NMOD, 3 * DM, 4 * DM, (bf16*)(ws + WS_U)); } SEAM(pb + 8);
        if (IN(pb + 9)) { ENTER();
            pg8::Gemm g{(const bf16*)(ws + WS_U), (const bf16*)(ws + WS_WGU) + (size_t)l * GU * DM, MROWS, GU, DM, DM}; pg8::StaticOrder S; S.init(MROWS, GU, F.G, (int)blockIdx.x);
            pg8::EpiSwiGLU E{(bf16*)(ws + WS_ACT), FF};
            pg8::gemm_phase<pg8::EpiSwiGLU, pg8::StaticOrder, true, true>(F.lds, g, S, E, F.tid);
        } SEAM(pb + 9);
        if (IN(pb + 10)) { ENTER();
            pg8::Gemm g{(const bf16*)(ws + WS_ACT), (const bf16*)(ws + WS_WDN) + (size_t)l * DM * FF, MROWS, DM, FF, FF}; pg8::StaticOrder S; S.init(MROWS, DM, F.G, (int)blockIdx.x);
            pg8::EpiResid E{(float*)(ws + WS_H), DM, (const float*)(ws + WS_MOD) + (size_t)l * 3 * NMOD + 5 * DM, NMOD};
            pg8::gemm_phase<pg8::EpiResid, pg8::StaticOrder, true, true>(F.lds, g, S, E, F.tid);
        } SEAM(pb + 10);
    }
    if (IN(PH_TOTAL - 1)) { ENTER(); final_phase(F, (const float*)(ws + WS_H), p->in[27], p->out); }
#undef IN
#undef SEAM
#undef ENTER
}

extern "C" void kernel_launch(void* const* d_in, const int* in_sizes, int n_in, void* d_out, int out_size, void* d_ws, size_t ws_size, hipStream_t stream) {
    static int grid = 0;
    if (grid == 0) {
        if (n_in != 28 || out_size != 67108864 || ws_size < WS_END) { fprintf(stderr, "kernel_launch: unexpected sizes n_in %d out %d ws %zu\n", n_in, out_size, ws_size); grid = -1; return; }
        int dev = 0, cus = 0, per_cu = 0;
        if (hipGetDevice(&dev) != hipSuccess || hipDeviceGetAttribute(&cus, hipDeviceAttributeMultiprocessorCount, dev) != hipSuccess) { grid = -1; return; }
        if (hipFuncSetAttribute((const void*)mk_fwd, hipFuncAttributeMaxDynamicSharedMemorySize, LDS_BYTES) != hipSuccess) { fprintf(stderr, "kernel_launch: hipFuncSetAttribute failed\n"); grid = -1; return; }
        if (hipOccupancyMaxActiveBlocksPerMultiprocessor(&per_cu, (const void*)mk_fwd, NTHR, LDS_BYTES) != hipSuccess || per_cu < 1)
            fprintf(stderr, "kernel_launch: occupancy query reports %d workgroups per CU\n", per_cu);
        (void)hipGetLastError();
        grid = cus;
    }
    if (grid < 0) return;
    if (hipMemsetAsync((char*)d_ws + WS_CTL, 0, CTL_ZERO_BYTES, stream) != hipSuccess) return;
    Params a{};
    for (int i = 0; i < 28; ++i) a.in[i] = (const float*)d_in[i];
    a.out = (float*)d_out; a.ws = (unsigned char*)d_ws;
#if MK_ONE_LAUNCH
    a.ph_lo = 0; a.ph_hi = PH_TOTAL;
    hipLaunchKernelGGL(mk_fwd, dim3(grid), dim3(NTHR), LDS_BYTES, stream, a);
#else
    for (int ph = 0; ph < PH_TOTAL; ++ph) { a.ph_lo = ph; a.ph_hi = ph + 1; hipLaunchKernelGGL(mk_fwd, dim3(grid), dim3(NTHR), LDS_BYTES, stream, a); }
#endif
}
```

```cpp
#include <hip/hip_runtime.h>
#include <cstdio>
#include <cstdint>
namespace pg8 {
#define PG8_LAS __attribute__((address_space(3)))
typedef unsigned short bf16_t;
typedef short bf16x8 __attribute__((ext_vector_type(8)));
typedef float f32x4 __attribute__((ext_vector_type(4)));
typedef unsigned u32x4 __attribute__((ext_vector_type(4)));
constexpr int BM = 256, BK = 64, HALF = 128, HTB = HALF * BK * 2  , STAGE_BYTES = 8 * HTB, NXCD = 8, WGM = 8;

__host__ __device__ __forceinline__ int lds_byte(int r, int c) { const int st = (r >> 4) * 2 + (c >> 5), rr = r & 15, cc = c & 31, ob = rr * 64 + cc * 2; return st * 1024 + (ob ^ (((ob >> 9) & 1) << 5)); }
__host__ __device__ __forceinline__ void stage_rc(int b, int& R, int& C) { const int st = b / 1024, sb = b % 1024, swz = sb ^ (((sb >> 9) & 1) << 5); R = (st >> 1) * 16 + swz / 64; C = (st & 1) * 32 + (swz % 64) / 2; }
__host__ __device__ __forceinline__ int perm32(int rho) { const int n = rho >> 4, i = rho & 15; return 8 * (i >> 2) + 4 * n + (i & 3); }

struct Unit { int pm, pn, pk; };
struct Gemm { const bf16_t* A; const bf16_t* Bt; int M, N, K, Ksub; };

struct StaticOrder {
    int nM, nN, nwg, G, c;
    __host__ __device__ void init(int M, int N, int G_, int c_) { nM = M / BM; nN = N / BM; nwg = nM * nN; G = G_; c = c_; }
    __host__ __device__ bool next(int i, Unit& u) const {
        const long L = (long)i * G + c; if (L >= nwg) return false;
        int wgid = (int)L; { const int q = nwg / NXCD, r = nwg % NXCD, xcd = wgid % NXCD, off = wgid / NXCD; wgid = (xcd < r ? xcd * (q + 1) : r * (q + 1) + (xcd - r) * q) + off; }
        const int nig = WGM * nN, gid = wgid / nig, fm = gid * WGM, gsz = (nM - fm) < WGM ? (nM - fm) : WGM;
        u.pm = fm + ((wgid % nig) % gsz); u.pn = (wgid % nig) / gsz; u.pk = 0; return true;
    }
    __device__ __forceinline__ void a_ready(const Unit&) const {}
    __device__ __forceinline__ void done(const Unit&) const {}
};
struct SplitOrder {
    StaticOrder s; int KS;
    __host__ __device__ void init(int M, int N, int KS_, int G_, int c_) { KS = KS_; s.init(M, N * KS_, G_, c_); }
    __host__ __device__ bool next(int i, Unit& u) const { if (!s.next(i, u)) return false; u.pk = u.pn % KS; u.pn = u.pn / KS; return true; }
    __device__ __forceinline__ void a_ready(const Unit&) const {}
    __device__ __forceinline__ void done(const Unit&) const {}
};


__device__ __forceinline__ unsigned cvt_pk_bf16(float lo, float hi) { unsigned r; asm volatile("v_cvt_pk_bf16_f32 %0, %1, %2" : "=v"(r) : "v"(lo), "v"(hi)); return r; }

struct EpiBf16 {
    static constexpr bool PERM = true, AFTER_DRAIN = false;
    bf16_t* O; int ldc;
    __device__ __forceinline__ void operator()(const f32x4 (&acc)[2][2][4][2], const Unit& u, int wr, int wc, int fr, int fq) const {
        const int row0 = u.pm * BM + wr * 64 + fr; const int col0 = u.pn * BM + wc * 32 + 8 * fq;
#pragma unroll
        for (int ai = 0; ai < 2; ++ai)
#pragma unroll
            for (int m = 0; m < 4; ++m) { bf16_t* rowp = O + (size_t)(row0 + ai * HALF + m * 16) * ldc + col0;
#pragma unroll
                for (int bj = 0; bj < 2; ++bj) { const f32x4 v0 = acc[ai][bj][m][0], v1 = acc[ai][bj][m][1];
                    u32x4 w; w.x = cvt_pk_bf16(v0[0], v0[1]); w.y = cvt_pk_bf16(v0[2], v0[3]); w.z = cvt_pk_bf16(v1[0], v1[1]); w.w = cvt_pk_bf16(v1[2], v1[3]);
                    *(u32x4*)(rowp + bj * HALF) = w; } }
    }
};
__device__ __forceinline__ int cond_of_pm(int pm) { return pm < 16 ? 0 : (pm < 32 ? 1 : 2); }
struct EpiResid {
    static constexpr bool PERM = false, AFTER_DRAIN = false;
    const float* base0; const float* base1; float* H; int ldc; const float* gate; int gstride;
    __device__ __forceinline__ void operator()(const f32x4 (&acc)[2][2][4][2], const Unit& u, int wr, int wc, int fr, int fq) const {
        const float* g = gate + (size_t)cond_of_pm(u.pm) * gstride;
        const int row0 = u.pm * BM + wr * 64 + fr; const int col0 = u.pn * BM + wc * 32 + 4 * fq;
        const float* bs = u.pm < 16 ? base0 + (size_t)row0 * ldc : base1 + (size_t)(row0 - 4096) * ldc;
        f32x4 gv[2][2];
#pragma unroll
        for (int bj = 0; bj < 2; ++bj)
#pragma unroll
            for (int n = 0; n < 2; ++n) gv[bj][n] = *(const f32x4*)(g + col0 + bj * HALF + n * 16);
#pragma unroll
        for (int ai = 0; ai < 2; ++ai)
#pragma unroll
            for (int m = 0; m < 4; ++m) { const size_t ro = (size_t)(ai * HALF + m * 16) * ldc + col0; float* rowp = H + (size_t)row0 * ldc + ro;
#pragma unroll
                for (int bj = 0; bj < 2; ++bj)
#pragma unroll
                    for (int n = 0; n < 2; ++n) { f32x4 h = *(const f32x4*)(bs + ro + bj * HALF + n * 16); h = h + gv[bj][n] * acc[ai][bj][m][n]; *(f32x4*)(rowp + bj * HALF + n * 16) = h; }
                asm volatile("" ::: "memory"); }
    }
};
__device__ __forceinline__ float silu_f(float x) { return x * __builtin_amdgcn_rcpf(1.0f + __expf(-x)); }
struct EpiSwiGLU {
    static constexpr bool PERM = true, AFTER_DRAIN = false;
    bf16_t* O; int ldc;
    __device__ __forceinline__ void operator()(const f32x4 (&acc)[2][2][4][2], const Unit& u, int wr, int wc, int fr, int fq) const {
        const int row0 = u.pm * BM + wr * 64 + fr; const int col0 = u.pn * HALF + wc * 32 + 8 * fq;
#pragma unroll
        for (int ai = 0; ai < 2; ++ai)
#pragma unroll
            for (int m = 0; m < 4; ++m) { bf16_t* rowp = O + (size_t)(row0 + ai * HALF + m * 16) * ldc + col0;
                const f32x4 g0 = acc[ai][0][m][0], g1 = acc[ai][0][m][1], u0 = acc[ai][1][m][0], u1 = acc[ai][1][m][1];
                u32x4 w;
                w.x = cvt_pk_bf16(silu_f(g0[0]) * u0[0], silu_f(g0[1]) * u0[1]); w.y = cvt_pk_bf16(silu_f(g0[2]) * u0[2], silu_f(g0[3]) * u0[3]);
                w.z = cvt_pk_bf16(silu_f(g1[0]) * u1[0], silu_f(g1[1]) * u1[1]); w.w = cvt_pk_bf16(silu_f(g1[2]) * u1[2], silu_f(g1[3]) * u1[3]);
                *(u32x4*)rowp = w; }
    }
};
template <class Epi, class Sched, bool ALIGN_EPI = false, bool SP2 = false>
__device__ __forceinline__ void gemm_phase(PG8_LAS unsigned char* lds, const Gemm g, const Sched& S, const Epi& E, int tid_in) {
    int tid_ = tid_in; asm volatile("" : "+v"(tid_));
    const int tid = tid_, wid = __builtin_amdgcn_readfirstlane(tid >> 6), lane = tid & 63, wr = wid >> 2, wc = wid & 3, fr = lane & 15, fq = lane >> 4;
    const int K = g.K, nt = g.Ksub / BK; const size_t koff = (size_t)g.Ksub * 2;
    unsigned voffA[2], voffB[2];
#pragma unroll
    for (int i = 0; i < 2; ++i) { int R, C; stage_rc(tid * 16 + i * 8192, R, C); const int Rb = Epi::PERM ? ((R & ~31) + perm32(R & 31)) : R;
        voffA[i] = (unsigned)(R * K + C) * 2u; voffB[i] = (unsigned)(Rb * K + C) * 2u; }
    const size_t kstep = (size_t)(BK * 2);
    const size_t hstep = (size_t)HALF * K * 2;
    const size_t tstep = 2 * hstep;
    const unsigned ldsw = (unsigned)wid * 1024u;
    const int aoff = lds_byte(wr * 64 + fr, fq * 8), boff = lds_byte(wc * 32 + fr, fq * 8);
#define PG8_SA(b, h) (((b) * 2 + (h)) * HTB)
#define PG8_SB(b, h) ((4 + (b) * 2 + (h)) * HTB)
#define PG8_STAGE(bufoff, gbase, voff) do { _Pragma("unroll") for (int _i = 0; _i < 2; ++_i) \
        __builtin_amdgcn_global_load_lds((const unsigned*)((const char*)(gbase) + (voff)[_i]), (PG8_LAS unsigned*)(lds + (bufoff) + ldsw + _i * 8192), 16, 0, 0); } while (0)
#define PG8_LDA(dst, b, h) do { _Pragma("unroll") for (int m = 0; m < 4; ++m) _Pragma("unroll") for (int k = 0; k < 2; ++k) dst[m][k] = *(const PG8_LAS bf16x8*)(lds + PG8_SA(b, h) + aoff + m * 2048 + k * 1024); } while (0)
#define PG8_LDB(dst, b, h) do { _Pragma("unroll") for (int n = 0; n < 2; ++n) _Pragma("unroll") for (int k = 0; k < 2; ++k) dst[n][k] = *(const PG8_LAS bf16x8*)(lds + PG8_SB(b, h) + boff + n * 2048 + k * 1024); } while (0)
#define PG8_MMA(ai, bj, At, Bt) do { __builtin_amdgcn_s_setprio(1); _Pragma("unroll") for (int m = 0; m < 4; ++m) _Pragma("unroll") for (int n = 0; n < 2; ++n) _Pragma("unroll") for (int k = 0; k < 2; ++k) \
        acc[ai][bj][m][n] = __builtin_amdgcn_mfma_f32_16x16x32_bf16(Bt[n][k], At[m][k], acc[ai][bj][m][n], 0, 0, 0); __builtin_amdgcn_s_setprio(0); } while (0)
#define PG8_WAIT_V(n) asm volatile("s_waitcnt vmcnt(" #n ")" ::: "memory")
#define PG8_WAIT_L(n) asm volatile("s_waitcnt lgkmcnt(" #n ")" ::: "memory")
#define PG8_BAR __builtin_amdgcn_s_barrier()
#define PG8_SCHED __builtin_amdgcn_sched_barrier(0)
    Unit cur, nxt; int ui = 0;
    if (!S.next(0, cur)) return;
    f32x4 acc[2][2][4][2];
#pragma unroll
    for (int a = 0; a < 2; ++a)
#pragma unroll
        for (int b = 0; b < 2; ++b)
#pragma unroll
            for (int m = 0; m < 4; ++m)
#pragma unroll
                for (int n = 0; n < 2; ++n) acc[a][b][m][n] = (f32x4){0.f, 0.f, 0.f, 0.f};
    bf16x8 At[4][2], B0[2][2], B1[2][2];
    const char* cA = (const char*)g.A + (size_t)cur.pm * tstep + cur.pk * koff; const char* cB = (const char*)g.Bt + (size_t)cur.pn * tstep + cur.pk * koff;
    S.a_ready(cur);
    if constexpr (SP2) {
        PG8_STAGE(PG8_SB(0, 0), cB, voffB); PG8_STAGE(PG8_SB(0, 1), cB + hstep, voffB); PG8_STAGE(PG8_SA(0, 0), cA, voffA); PG8_STAGE(PG8_SA(0, 1), cA + hstep, voffA);
        if (wr == 1) PG8_BAR;
        PG8_WAIT_V(2); PG8_BAR;
        PG8_STAGE(PG8_SB(1, 0), cB + kstep, voffB); PG8_STAGE(PG8_SA(1, 0), cA + kstep, voffA); PG8_STAGE(PG8_SB(1, 1), cB + hstep + kstep, voffB);
        PG8_WAIT_V(6); PG8_BAR;
    } else {
        PG8_STAGE(PG8_SB(0, 0), cB, voffB); PG8_STAGE(PG8_SA(0, 0), cA, voffA); PG8_STAGE(PG8_SB(0, 1), cB + hstep, voffB); PG8_STAGE(PG8_SA(0, 1), cA + hstep, voffA);
        if (wr == 1) PG8_BAR;
        PG8_WAIT_V(4); PG8_BAR;
        PG8_STAGE(PG8_SB(1, 0), cB + kstep, voffB); PG8_STAGE(PG8_SA(1, 0), cA + kstep, voffA); PG8_STAGE(PG8_SB(1, 1), cB + hstep + kstep, voffB);
        PG8_WAIT_V(6); PG8_BAR;
    }
    for (;;) {
        const bool has_next = S.next(ui + 1, nxt);
        const char* nA = has_next ? (const char*)g.A + (size_t)nxt.pm * tstep + nxt.pk * koff : cA; const char* nB = has_next ? (const char*)g.Bt + (size_t)nxt.pn * tstep + nxt.pk * koff : cB;
        for (int t = 0; t < nt; t += 2) {
            const bool last = (t == nt - 2);
            const char* a1 = cA + (size_t)(t + 1) * kstep;
            const char* a2 = last ? nA : cA + (size_t)(t + 2) * kstep; const char* b2 = last ? nB : cB + (size_t)(t + 2) * kstep;
            const char* a3 = a2 + kstep; const char* b3 = b2 + kstep;
            if (last && has_next) S.a_ready(nxt);
            if constexpr (SP2) {
            PG8_LDB(B0, 0, 0); PG8_LDB(B1, 0, 1); PG8_SCHED; PG8_LDA(At, 0, 0); PG8_STAGE(PG8_SA(1, 1), a1 + hstep, voffA);
            PG8_WAIT_V(8); PG8_WAIT_L(0); PG8_BAR; PG8_MMA(0, 0, At, B0); PG8_MMA(0, 1, At, B1); PG8_BAR; PG8_SCHED;
            PG8_LDA(At, 0, 1); PG8_STAGE(PG8_SB(0, 0), b2, voffB); PG8_STAGE(PG8_SB(0, 1), b2 + hstep, voffB); PG8_STAGE(PG8_SA(0, 0), a2, voffA);
            PG8_WAIT_V(8); PG8_WAIT_L(0); PG8_BAR; PG8_MMA(1, 0, At, B0); PG8_MMA(1, 1, At, B1); PG8_BAR; PG8_SCHED;
            PG8_LDB(B0, 1, 0); PG8_LDB(B1, 1, 1); PG8_SCHED; PG8_LDA(At, 1, 0); PG8_STAGE(PG8_SA(0, 1), a2 + hstep, voffA);
            PG8_WAIT_V(8); PG8_WAIT_L(0); PG8_BAR; PG8_MMA(0, 0, At, B0); PG8_MMA(0, 1, At, B1); PG8_BAR; PG8_SCHED;
            PG8_LDA(At, 1, 1); PG8_STAGE(PG8_SB(1, 0), b3, voffB); PG8_STAGE(PG8_SB(1, 1), b3 + hstep, voffB); PG8_STAGE(PG8_SA(1, 0), a3, voffA);
            PG8_WAIT_V(8); PG8_WAIT_L(0); PG8_BAR; PG8_MMA(1, 0, At, B0); PG8_MMA(1, 1, At, B1); PG8_BAR; PG8_SCHED;
            } else {
            PG8_LDB(B0, 0, 0); PG8_SCHED; PG8_LDA(At, 0, 0); PG8_STAGE(PG8_SA(1, 1), a1 + hstep, voffA);
            PG8_WAIT_L(8); PG8_BAR; PG8_WAIT_L(0); PG8_MMA(0, 0, At, B0); PG8_BAR; PG8_SCHED;
            PG8_LDB(B1, 0, 1); PG8_STAGE(PG8_SB(0, 0), b2, voffB);
            PG8_BAR; PG8_WAIT_L(0); PG8_MMA(0, 1, At, B1); PG8_BAR;
            PG8_LDA(At, 0, 1); PG8_STAGE(PG8_SA(0, 0), a2, voffA);
            PG8_BAR; PG8_WAIT_L(0); PG8_MMA(1, 0, At, B0); PG8_BAR; PG8_SCHED;
            PG8_STAGE(PG8_SB(0, 1), b2 + hstep, voffB);
            PG8_WAIT_V(6); PG8_BAR; PG8_MMA(1, 1, At, B1); PG8_BAR;
            PG8_LDB(B0, 1, 0); PG8_SCHED; PG8_LDA(At, 1, 0); PG8_STAGE(PG8_SA(0, 1), a2 + hstep, voffA);
            PG8_WAIT_L(8); PG8_BAR; PG8_WAIT_L(0); PG8_MMA(0, 0, At, B0); PG8_BAR; PG8_SCHED;
            PG8_LDB(B1, 1, 1); PG8_STAGE(PG8_SB(1, 0), b3, voffB);
            PG8_BAR; PG8_WAIT_L(0); PG8_MMA(0, 1, At, B1); PG8_BAR;
            PG8_LDA(At, 1, 1); PG8_STAGE(PG8_SA(1, 0), a3, voffA);
            PG8_BAR; PG8_WAIT_L(0); PG8_MMA(1, 0, At, B0); PG8_BAR; PG8_SCHED;
            PG8_STAGE(PG8_SB(1, 1), b3 + hstep, voffB);
            PG8_WAIT_V(6); PG8_BAR; PG8_MMA(1, 1, At, B1); PG8_BAR;
            }
        }
        if constexpr (ALIGN_EPI) { if (wr == 0) PG8_BAR; }
        if constexpr (!Epi::AFTER_DRAIN) { E(acc, cur, wr, wc, fr, fq); S.done(cur); }
        if (!has_next) break;
#pragma unroll
        for (int a = 0; a < 2; ++a)
#pragma unroll
            for (int b = 0; b < 2; ++b)
#pragma unroll
                for (int m = 0; m < 4; ++m)
#pragma unroll
                    for (int n = 0; n < 2; ++n) acc[a][b][m][n] = (f32x4){0.f, 0.f, 0.f, 0.f};
        cur = nxt; cA = nA; cB = nB; ++ui;
        if constexpr (ALIGN_EPI) { if (wr == 1) PG8_BAR; }
    }
    PG8_WAIT_V(0);
    if constexpr (!ALIGN_EPI) { if (wr == 0) PG8_BAR; }
    PG8_BAR;
    if constexpr (Epi::AFTER_DRAIN) { E.fused(acc, cur, wr, wc, fr, fq, lds, wid, lane); S.done(cur); }
#undef PG8_SA
#undef PG8_SB
#undef PG8_STAGE
#undef PG8_LDA
#undef PG8_LDB
#undef PG8_MMA
#undef PG8_WAIT_V
#undef PG8_WAIT_L
#undef PG8_BAR
#undef PG8_SCHED
}
}
#define GAS __attribute__((address_space(1)))
#define LAS __attribute__((address_space(3)))
typedef unsigned short bf16;
typedef unsigned v4u __attribute__((ext_vector_type(4)));
typedef float f32x4 __attribute__((ext_vector_type(4)));
typedef short bf16x8 __attribute__((ext_vector_type(8)));
typedef GAS unsigned gu32;
typedef GAS unsigned long long gu64;
#define RLX_AGENT __ATOMIC_RELAXED, __HIP_MEMORY_SCOPE_AGENT
#define LDS_WAIT() asm volatile("s_waitcnt lgkmcnt(0)" ::: "memory")
#define VM_WAIT() asm volatile("s_waitcnt vmcnt(0)" ::: "memory")
__device__ __forceinline__ unsigned long long rt() { return __builtin_amdgcn_s_memrealtime(); }
__device__ __forceinline__ unsigned f2bf(float f) { unsigned u = __builtin_bit_cast(unsigned, f); return (u + 0x7fffu + ((u >> 16) & 1u)) >> 16; }
__device__ __forceinline__ unsigned pk2(float lo, float hi) { return f2bf(lo) | (f2bf(hi) << 16); }

#define XB_TMO      128
#define XB_XCNT(j)  (256  + 64 * (j))
#define XB_XSUB(j)  (1280 + 64 * (j))
#define XB_XGEN(j)  (2304 + 64 * (j))
#define XB_TOP      3328
#define XB_TOPGEN   3392
#define XCD_BAR_WORDS 3456
#define XB_SPIN_CAP (1u << 18)

__device__ __forceinline__ unsigned xb_ld(unsigned* p)              { return __hip_atomic_load(p, __ATOMIC_RELAXED, __HIP_MEMORY_SCOPE_AGENT); }
__device__ __forceinline__ unsigned xb_add(unsigned* p, unsigned v) { return __hip_atomic_fetch_add(p, v, __ATOMIC_RELAXED, __HIP_MEMORY_SCOPE_AGENT); }
__device__ __forceinline__ unsigned xb_xcc_id() { return (unsigned)__builtin_amdgcn_s_getreg((3 << 11) | 20) & 0xFu; }
#define XB_SPIN(cond, bar) do { unsigned _sp = 0; while (cond) { __builtin_amdgcn_s_sleep(1); \
    if ((++_sp & 255u) == 0u) { if (xb_ld(&(bar)[XB_TMO])) break; if (_sp > XB_SPIN_CAP) { atomicAdd(&(bar)[XB_TMO], 1u); break; } } } } while (0)

struct XcdBarrier {
    unsigned* bar; unsigned x;
    volatile LAS unsigned* st;
};

__device__ __forceinline__ XcdBarrier xcd_barrier_post(unsigned* bar, volatile LAS unsigned* st, bool leader) {
    XcdBarrier b; b.bar = bar; b.x = xb_xcc_id(); b.st = st;
    if (leader) (void)xb_add(&bar[XB_XCNT(b.x)], 1u);
    return b;
}
__device__ __forceinline__ void xcd_barrier_complete(unsigned* bar, unsigned x, unsigned& nloc, unsigned& nx) {
    const unsigned G = gridDim.x * gridDim.y * gridDim.z;
    unsigned sum, cnt, mine, sp = 0u;
    for (;;) {
        sum = 0u; cnt = 0u; mine = 0u;
#pragma unroll
        for (unsigned j = 0; j < 16; ++j) { const unsigned c = xb_ld(&bar[XB_XCNT(j)]); sum += c; cnt += (c > 0u) ? 1u : 0u; mine = (j == x) ? c : mine; }
        if (sum == G) break;
        __builtin_amdgcn_s_sleep(1);
        if ((++sp & 255u) == 0u) { if (xb_ld(&bar[XB_TMO])) break; if (sp > XB_SPIN_CAP) { atomicAdd(&bar[XB_TMO], 1u); break; } }
    }
    nloc = mine > 0u ? mine : 1u; nx = cnt > 0u ? cnt : 1u;
}

__device__ __forceinline__ void xcd_barrier(const XcdBarrier& b, bool leader) {
    asm volatile("s_waitcnt vmcnt(0)" ::: "memory");
    __syncthreads();
    if (leader) {
        unsigned* bar = b.bar;
        __builtin_amdgcn_s_waitcnt(0);
        unsigned nloc = b.st[0], nx = b.st[1];
        if (nloc == 0u) { xcd_barrier_complete(bar, b.x, nloc, nx); b.st[0] = nloc; b.st[1] = nx; }
        const unsigned old = xb_add(&bar[XB_XSUB(b.x)], 1u);
        const unsigned gen = old / nloc;
        if (old + 1u == (gen + 1u) * nloc) {
            __builtin_amdgcn_fence(__ATOMIC_RELEASE, "agent");
            asm volatile("s_waitcnt vmcnt(0)" ::: "memory");
            const unsigned og = xb_add(&bar[XB_TOP], 1u);
            const unsigned tg = og / nx;
            if (og + 1u == (tg + 1u) * nx) xb_add(&bar[XB_TOPGEN], 1u);
            else XB_SPIN(xb_ld(&bar[XB_TOPGEN]) == tg, bar);
            __builtin_amdgcn_fence(__ATOMIC_ACQUIRE, "agent");
            xb_add(&bar[XB_XGEN(b.x)], 1u);
            asm volatile("s_waitcnt vmcnt(0)" ::: "memory");
        } else {
            XB_SPIN(xb_ld(&bar[XB_XGEN(b.x)]) == gen, bar);
            __builtin_amdgcn_fence(__ATOMIC_ACQUIRE, "agent");
            asm volatile("s_waitcnt vmcnt(0)" ::: "memory");
        }
    }
    __syncthreads();
}

constexpr int NWAVES = 8, NTHR = 512;
constexpr int DM = 2048, MROWS = 12288, DEPTH = 4;
constexpr int INC = 5152, INP = 5376, FF = 5632, GU = 11264;
constexpr int NMOD = 6 * DM;
constexpr float EPS = 1e-6f;
constexpr int PC_QA = 0, PC_KA = 512, PC_VA = 768, PC_QD = 1024, PC_KD = 1536, PC_VD = 2048, PC_Z = 2560, PC_XBC = 3584, PC_DT = 5120;
constexpr int RC_QA = 0, RC_KA = 512, RC_QD = 768, RC_KD = 1280, RCW = 1792;
constexpr size_t OUT_AK = 25165824, OUT_AV = OUT_AK + 4194304, OUT_DK = OUT_AV + 4194304, OUT_DV = OUT_DK + 8388608, OUT_SF = OUT_DV + 8388608, OUT_SB = OUT_SF + 8388608;
constexpr size_t MiB = 1u << 20;
constexpr size_t WS_CTL = 0, CTL_ZERO_BYTES = 1 * MiB;
constexpr size_t WS_TAB = 1 * MiB, WS_MOD = 2 * MiB, WS_MODP = 3 * MiB;
constexpr size_t WS_WIN = 8 * MiB, WS_WOUT = 92 * MiB, WS_WGU = 124 * MiB, WS_WDN = 300 * MiB;
constexpr size_t WS_H = 388 * MiB, WS_U = 484 * MiB, WS_P = 532 * MiB, WS_MIX = 658 * MiB, WS_ACT = 706 * MiB, WS_QKR = 838 * MiB;
constexpr size_t WS_XBC = 866 * MiB, WS_DT = 938 * MiB, WS_YF = 940 * MiB, WS_YB = 988 * MiB, WS_ST = 1036 * MiB, WS_EDEC = 1132 * MiB, WS_CDEC = 1134 * MiB, WS_SSQ = 1135 * MiB, WS_END = 1136 * MiB;
constexpr int CW_BAR = 4096;
constexpr int RING_BYTES = 131072, LDSCTL_OFF = RING_BYTES, MISC_OFF = LDSCTL_OFF + 320, LDS_BYTES = 147456;

struct Params { const float* in[28]; float* out; unsigned char* ws; int ph_lo, ph_hi; };
typedef __attribute__((address_space(4))) const Params* PP;
struct Frame { LAS unsigned char* lds; int tid, lane, wave, vcu, G; };

template <int M> __device__ __forceinline__ float xor_lt32(float v) { return __builtin_bit_cast(float, __builtin_amdgcn_ds_swizzle(__builtin_bit_cast(int, v), 0x1F | (M << 10))); }
__device__ __forceinline__ float half_sum(float v) { const unsigned u = __builtin_bit_cast(unsigned, v); auto r = __builtin_amdgcn_permlane32_swap(u, u, false, false); return __builtin_bit_cast(float, (unsigned)r[0]) + __builtin_bit_cast(float, (unsigned)r[1]); }
__device__ __forceinline__ float half_max(float v) { const unsigned u = __builtin_bit_cast(unsigned, v); auto r = __builtin_amdgcn_permlane32_swap(u, u, false, false); return fmaxf(__builtin_bit_cast(float, (unsigned)r[0]), __builtin_bit_cast(float, (unsigned)r[1])); }
__device__ __forceinline__ float bperm(float v, int srclane) { return __builtin_bit_cast(float, __builtin_amdgcn_ds_bpermute(srclane << 2, __builtin_bit_cast(int, v))); }
__device__ __forceinline__ float wave_sum(float v) { v += xor_lt32<1>(v); v += xor_lt32<2>(v); v += xor_lt32<4>(v); v += xor_lt32<8>(v); v += xor_lt32<16>(v); return half_sum(v); }
__device__ __forceinline__ float wave_max(float v) { v = fmaxf(v, xor_lt32<1>(v)); v = fmaxf(v, xor_lt32<2>(v)); v = fmaxf(v, xor_lt32<4>(v)); v = fmaxf(v, xor_lt32<8>(v)); v = fmaxf(v, xor_lt32<16>(v)); return half_max(v); }
__device__ __forceinline__ float bflo(unsigned w) { return __uint_as_float(w << 16); }
__device__ __forceinline__ float bfhi(unsigned w) { return __uint_as_float(w & 0xffff0000u); }
__device__ __forceinline__ float bf1(bf16 b) { return __uint_as_float((unsigned)b << 16); }
__device__ __forceinline__ float silu(float x) { return x / (1.0f + __expf(-x)); }

__device__ __forceinline__ void p0_transpose_item(const float* W, int K, int N, bf16* WT, int rowmap, LAS float* scr, int item, int lane) {
    const int nblk = N / 32, kb = item / nblk, nb = item % nblk, k0 = 64 * kb, n0 = 32 * nb;
#pragma unroll 8
    for (int i = 0; i < 32; ++i) { const int kk = 2 * i + (lane >> 5); scr[kk * 33 + (lane & 31)] = W[(size_t)(k0 + kk) * N + n0 + (lane & 31)]; }
    LDS_WAIT(); asm volatile("" ::: "memory");
    int r0 = n0;
    if (rowmap) r0 = (n0 < FF) ? ((n0 >> 7) * 256 + (n0 & 127)) : (((n0 - FF) >> 7) * 256 + 128 + ((n0 - FF) & 127));
    const int c = lane & 7;
#pragma unroll
    for (int j = 0; j < 4; ++j) { const int n = (lane >> 3) + 8 * j; const LAS float* s = scr + (8 * c) * 33 + n;
        v4u o; o.x = pk2(s[0 * 33], s[1 * 33]); o.y = pk2(s[2 * 33], s[3 * 33]); o.z = pk2(s[4 * 33], s[5 * 33]); o.w = pk2(s[6 * 33], s[7 * 33]);
        *(v4u*)(WT + (size_t)(r0 + n) * K + k0 + 8 * c) = o; }
    LDS_WAIT(); asm volatile("" ::: "memory");
}
__device__ __forceinline__ void conv_layer(Frame& F, PP p, int l, int wi, int nw) {
    unsigned char* ws = p->ws;
    LAS float* scr = (LAS float*)(F.lds + F.wave * 16384);
    constexpr int I_IN = 32 * (INC / 32), I_OUT = 32 * 64, I_GU = 32 * (GU / 32), I_DN = (FF / 64) * 64, I_L = I_IN + I_OUT + I_GU + I_DN;
    for (int it = wi; it < I_L; it += nw) {
        int r = it;
        if (r < I_IN) { p0_transpose_item(p->in[14] + (size_t)l * DM * INC, DM, INC, (bf16*)(ws + WS_WIN) + (size_t)l * INP * DM, 0, scr, r, F.lane); continue; } r -= I_IN;
        if (r < I_OUT) { p0_transpose_item(p->in[24] + (size_t)l * DM * DM, DM, DM, (bf16*)(ws + WS_WOUT) + (size_t)l * DM * DM, 0, scr, r, F.lane); continue; } r -= I_OUT;
        if (r < I_GU) { p0_transpose_item(p->in[25] + (size_t)l * DM * GU, DM, GU, (bf16*)(ws + WS_WGU) + (size_t)l * GU * DM, 1, scr, r, F.lane); continue; } r -= I_GU;
        p0_transpose_item(p->in[26] + (size_t)l * FF * DM, FF, DM, (bf16*)(ws + WS_WDN) + (size_t)l * DM * FF, 0, scr, r, F.lane);
    }
    constexpr int PADV = (INP - INC) * DM * 2 / 16;
    for (int i = wi * 64 + F.lane; i < PADV; i += nw * 64) *((v4u*)((bf16*)(ws + WS_WIN) + (size_t)l * INP * DM + (size_t)INC * DM) + i) = (v4u){0u, 0u, 0u, 0u};
}
__device__ __forceinline__ void adaln_layer(Frame& F, PP p, int l, int bi, int nb) {
    LAS float* sc = (LAS float*)F.lds;
    float* MODP = (float*)(p->ws + WS_MODP);
    for (int it = bi; it < 8 * 24; it += nb) {
        const int kc = it / 24, nc = it % 24;
        __syncthreads();
        if (F.tid < 256) { const int k = kc * 256 + F.tid; sc[F.tid] = silu(p->in[9][k]); sc[256 + F.tid] = silu(p->in[8][k]); sc[512 + F.tid] = silu(p->in[8][DM + k]); }
        __syncthreads();
        const int n = nc * 512 + F.tid;
        const float* w = p->in[10] + ((size_t)l * DM + (size_t)kc * 256) * NMOD + n;
        float a0 = 0.f, a1 = 0.f, a2 = 0.f;
        for (int k = 0; k < 256; k += 8) {
            float wv[8];
#pragma unroll
            for (int e = 0; e < 8; ++e) wv[e] = w[(size_t)(k + e) * NMOD];
#pragma unroll
            for (int e = 0; e < 8; ++e) { a0 += sc[k + e] * wv[e]; a1 += sc[256 + k + e] * wv[e]; a2 += sc[512 + k + e] * wv[e]; }
        }
        float* o = MODP + ((size_t)(kc * DEPTH + l) * 3) * NMOD + n;
        o[0] = a0; o[NMOD] = a1; o[2 * NMOD] = a2;
    }
    __syncthreads();
}
__device__ __forceinline__ void mod_layer(PP p, int l, int gt, int ngt) {
    const float* MODP = (const float*)(p->ws + WS_MODP); float* MOD = (float*)(p->ws + WS_MOD);
    for (int i = gt; i < 3 * NMOD; i += ngt) {
        const int n = i % NMOD; const int gi = l * 3 * NMOD + i;
        float s = p->in[11][l * NMOD + n];
#pragma unroll
        for (int kc = 0; kc < 8; ++kc) s += MODP[(size_t)kc * DEPTH * 3 * NMOD + gi];
        MOD[gi] = s;
    }
}
__device__ __forceinline__ void p0_prologue(Frame& F, PP p) {
    unsigned char* ws = p->ws;
    conv_layer(F, p, 0, F.vcu * NWAVES + F.wave, F.G * NWAVES);
    adaln_layer(F, p, 0, blockIdx.x, F.G);
    if (blockIdx.x == F.G - 1) {
        float2* tabA = (float2*)(ws + WS_TAB); float2* tabB = (float2*)(ws + WS_TAB + 16384); float* lam = (float*)(ws + WS_TAB + 32768);
        for (int i = F.tid; i < 2048 + 1024; i += NTHR) {
            const bool isA = i < 2048; const int j = isA ? i : i - 2048; const int pos = isA ? (j >> 5) : (j >> 4), k = isA ? (j & 31) : (j & 15);
            double r = 10000.0; r = sqrt(r); r = sqrt(r); r = sqrt(r); r = sqrt(r); if (isA) r = sqrt(r);
            const double ri = 1.0 / r; double inv = 1.0; for (int q = 0; q < k; ++q) inv *= ri;
            const double ang = (double)pos * inv; const double TWO_PI = 6.283185307179586476925;
            const double x = ang - TWO_PI * rint(ang / TWO_PI), x2 = x * x;
            double st = x, ss = x, ct = 1.0, cs = 1.0;
            for (int q = 1; q <= 16; ++q) { st *= -x2 / (double)((2 * q) * (2 * q + 1)); ss += st; ct *= -x2 / (double)((2 * q - 1) * (2 * q)); cs += ct; }
            const float2 v = make_float2((float)cs, (float)ss);
            if (isA) tabA[j] = v; else tabB[j] = v;
        }
        if (F.tid < DEPTH) {
            const float* lv = p->in[16] + F.tid * 256; float s01 = 0.f, s23 = 0.f;
            for (int i = 0; i < 64; ++i) { s01 += lv[i] * lv[64 + i]; s23 += lv[128 + i] * lv[192 + i]; }
            const float li = 0.8f - 0.6f * expf(-0.3f * (float)F.tid);
            lam[F.tid] = expf(s01) - expf(s23) + li; lam[4 + F.tid] = li;
        }
    }
}
__device__ __forceinline__ void norm_phase(Frame& F, const float* H0, const float* H1, const float* g, const float* modl, int shoff, int scoff, bf16* U) {
    const int gw = F.vcu * NWAVES + F.wave, NGW = F.G * NWAVES;
    for (int m = gw; m < MROWS; m += NGW) {
        const int c = m < 4096 ? 0 : (m < 8192 ? 1 : 2);
        const float* sh = modl + c * NMOD + shoff; const float* sc = modl + c * NMOD + scoff;
        const f32x4* xr = (const f32x4*)(m < 4096 ? H0 + (size_t)m * DM : H1 + (size_t)(m - 4096) * DM) + F.lane;
        f32x4 v[8]; float ss = 0.f;
#pragma unroll
        for (int j = 0; j < 8; ++j) { v[j] = xr[64 * j]; ss += (v[j].x * v[j].x + v[j].y * v[j].y) + (v[j].z * v[j].z + v[j].w * v[j].w); }
        const float rstd = 1.0f / sqrtf(wave_sum(ss) * (1.0f / DM) + EPS);
        unsigned long long* o8 = (unsigned long long*)(U + (size_t)m * DM) + F.lane;
#pragma unroll
        for (int j = 0; j < 8; ++j) { const int col = 4 * F.lane + 256 * j;
            const f32x4 gv = *(const f32x4*)(g + col), sv = *(const f32x4*)(sc + col), hv = *(const f32x4*)(sh + col);
            const f32x4 o = (v[j] * rstd) * gv * (sv + 1.0f) + hv;
            o8[64 * j] = (unsigned long long)pk2(o.x, o.y) | ((unsigned long long)pk2(o.z, o.w) << 32); }
    }
}
__device__ __forceinline__ void final_phase(Frame& F, const float* H, const float* g, float* out) {
    const int gw = F.vcu * NWAVES + F.wave, NGW = F.G * NWAVES;
    for (int m = gw; m < MROWS; m += NGW) {
        const f32x4* xr = (const f32x4*)(H + (size_t)m * DM) + F.lane;
        f32x4 v[8]; float ss = 0.f;
#pragma unroll
        for (int j = 0; j < 8; ++j) { v[j] = xr[64 * j]; ss += (v[j].x * v[j].x + v[j].y * v[j].y) + (v[j].z * v[j].z + v[j].w * v[j].w); }
        const float rstd = 1.0f / sqrtf(wave_sum(ss) * (1.0f / DM) + EPS);
        f32x4* o = (f32x4*)(out + (size_t)m * DM) + F.lane;
#pragma unroll
        for (int j = 0; j < 8; ++j) { const f32x4 gv = *(const f32x4*)(g + 4 * F.lane + 256 * j); o[64 * j] = (v[j] * rstd) * gv; }
    }
}
__device__ __forceinline__ void prep_phase(Frame& F, PP p, int l) {
    unsigned char* ws = p->ws;
    const bf16* P = (const bf16*)(ws + WS_P); bf16* QKR = (bf16*)(ws + WS_QKR); bf16* XBC = (bf16*)(ws + WS_XBC); float* DT = (float*)(ws + WS_DT);
    const float2* tabA = (const float2*)(ws + WS_TAB); const float2* tabB = (const float2*)(ws + WS_TAB + 16384);
    const float* cw = p->in[18] + (size_t)l * 5 * 1536; const float* cb = p->in[19] + (size_t)l * 1536; const float* dtb = p->in[20] + l * 32;
    const int gw = F.vcu * NWAVES + F.wave, NGW = F.G * NWAVES, lane = F.lane;
    for (int m = gw; m < MROWS; m += NGW) {
        const bf16* prow = P + (size_t)m * INP;
        const int s0 = m < 4096 ? (m & ~255) : (4096 + ((m - 4096) & ~4095)); const int len = m < 4096 ? 256 : 4096; const int t = m - s0;
#pragma unroll
        for (int j = 0; j < 3; ++j) { const int c0 = 8 * lane + 512 * j;
            f32x4 a0 = *(const f32x4*)(cb + c0), a1 = *(const f32x4*)(cb + c0 + 4);
#pragma unroll
            for (int k = 0; k < 5; ++k) { const int tt = t + k - 2;
                if (tt >= 0 && tt < len) { const v4u raw = *(const v4u*)(P + (size_t)(s0 + tt) * INP + PC_XBC + c0);
                    const f32x4 w0 = *(const f32x4*)(cw + k * 1536 + c0), w1 = *(const f32x4*)(cw + k * 1536 + c0 + 4);
                    a0.x += w0.x * bflo(raw.x); a0.y += w0.y * bfhi(raw.x); a0.z += w0.z * bflo(raw.y); a0.w += w0.w * bfhi(raw.y);
                    a1.x += w1.x * bflo(raw.z); a1.y += w1.y * bfhi(raw.z); a1.z += w1.z * bflo(raw.w); a1.w += w1.w * bfhi(raw.w); } }
            a0.x = silu(a0.x); a0.y = silu(a0.y); a0.z = silu(a0.z); a0.w = silu(a0.w); a1.x = silu(a1.x); a1.y = silu(a1.y); a1.z = silu(a1.z); a1.w = silu(a1.w);
            *(v4u*)(XBC + (size_t)m * 1536 + c0) = (v4u){pk2(a0.x, a0.y), pk2(a0.z, a0.w), pk2(a1.x, a1.y), pk2(a1.z, a1.w)}; }
        if (lane < 32) { const float v = bf1(prow[PC_DT + lane]) + dtb[lane]; DT[(size_t)m * 32 + lane] = v > 20.f ? v : log1pf(__expf(v)); }
        if (m >= 4096) {
            const int gr = t >> 6, gc = t & 63; bf16* qrow = QKR + (size_t)(m - 4096) * RCW;
#pragma unroll
            for (int i = 0; i < 6; ++i) { const int d = lane; const int src = (i < 4 ? PC_QA + i * 128 : PC_KA + (i - 4) * 128) + d, dst = (i < 4 ? RC_QA + i * 128 : RC_KA + (i - 4) * 128) + d;
                const float x1 = bf1(prow[src]), x2 = bf1(prow[src + 64]); const float2 cs = d < 32 ? tabA[gr * 32 + d] : tabA[gc * 32 + d - 32];
                qrow[dst] = (bf16)f2bf(x1 * cs.x - x2 * cs.y); qrow[dst + 64] = (bf16)f2bf(x1 * cs.y + x2 * cs.x); }
#pragma unroll
            for (int i = 0; i < 8; ++i) { const int pp = lane + 64 * i, ch = pp >> 5, d = pp & 31; const int src = (ch < 8 ? PC_QD + ch * 64 : PC_KD + (ch - 8) * 64) + d, dst = (ch < 8 ? RC_QD + ch * 64 : RC_KD + (ch - 8) * 64) + d;
                const float x1 = bf1(prow[src]), x2 = bf1(prow[src + 32]); const float2 cs = d < 16 ? tabB[gr * 16 + d] : tabB[gc * 16 + d - 16];
                qrow[dst] = (bf16)f2bf(x1 * cs.x - x2 * cs.y); qrow[dst + 32] = (bf16)f2bf(x1 * cs.y + x2 * cs.x); }
        } else {
            const int b = m >> 8, s = m & 255; const size_t r = (size_t)((b * DEPTH + l) * 256 + s);
            { const unsigned long long w = *((const unsigned long long*)(prow + PC_KA) + lane); *((f32x4*)(p->out + OUT_AK + r * 256) + lane) = (f32x4){bflo((unsigned)w), bfhi((unsigned)w), bflo((unsigned)(w >> 32)), bfhi((unsigned)(w >> 32))}; }
            { const unsigned long long w = *((const unsigned long long*)(prow + PC_VA) + lane); *((f32x4*)(p->out + OUT_AV + r * 256) + lane) = (f32x4){bflo((unsigned)w), bfhi((unsigned)w), bflo((unsigned)(w >> 32)), bfhi((unsigned)(w >> 32))}; }
            { const v4u w = *((const v4u*)(prow + PC_KD) + lane); f32x4* o = (f32x4*)(p->out + OUT_DK + r * 512) + 2 * lane; o[0] = (f32x4){bflo(w.x), bfhi(w.x), bflo(w.y), bfhi(w.y)}; o[1] = (f32x4){bflo(w.z), bfhi(w.z), bflo(w.w), bfhi(w.w)}; }
            { const v4u w = *((const v4u*)(prow + PC_VD) + lane); f32x4* o = (f32x4*)(p->out + OUT_DV + r * 512) + 2 * lane; o[0] = (f32x4){bflo(w.x), bfhi(w.x), bflo(w.y), bfhi(w.y)}; o[1] = (f32x4){bflo(w.z), bfhi(w.z), bflo(w.w), bfhi(w.w)}; }
        }
    }
}
typedef float f32x16 __attribute__((ext_vector_type(16)));
typedef short s16x4 __attribute__((ext_vector_type(4)));
constexpr int FA_KSTR = 272, FA_VSTR = 320, FA_KB = 64 * FA_KSTR, FA_VB = 64 * FA_VSTR, FA_BUF = FA_KB + FA_VB;
constexpr int FA_OSTR = 272;
struct Seg { const void* k; const void* v; int ks, vs, n, f32, pos0; };
struct FaTile { v4u k[2], v[2]; };

__device__ __forceinline__ unsigned cvtpk(float lo, float hi) { typedef float f2 __attribute__((ext_vector_type(2))); typedef __bf16 b2 __attribute__((ext_vector_type(2))); f2 v = {lo, hi}; b2 b = __builtin_convertvector(v, b2); return __builtin_bit_cast(unsigned, b); }
__device__ __forceinline__ void fa_load(FaTile& t, const Seg& sg, int key0, int tid) {
#pragma unroll
    for (int i = 0; i < 2; ++i) { const int c = tid + 512 * i, key = c >> 4, ch = c & 15;
        if (sg.f32) {
            const f32x4* ks = (const f32x4*)((const float*)sg.k + (size_t)(key0 + key) * sg.ks + ch * 8);
            const f32x4* vs = (const f32x4*)((const float*)sg.v + (size_t)(key0 + key) * sg.vs + ch * 8);
            const f32x4 a = ks[0], b = ks[1], c2 = vs[0], d = vs[1];
            t.k[i] = (v4u){cvtpk(a.x, a.y), cvtpk(a.z, a.w), cvtpk(b.x, b.y), cvtpk(b.z, b.w)};
            t.v[i] = (v4u){cvtpk(c2.x, c2.y), cvtpk(c2.z, c2.w), cvtpk(d.x, d.y), cvtpk(d.z, d.w)};
        } else {
            t.k[i] = *(const v4u*)((const bf16*)sg.k + (size_t)(key0 + key) * sg.ks + ch * 8);
            t.v[i] = *(const v4u*)((const bf16*)sg.v + (size_t)(key0 + key) * sg.vs + ch * 8);
        } }
}
__device__ __forceinline__ void fa_store(const FaTile& t, LAS unsigned char* buf, int tid) {
#pragma unroll
    for (int i = 0; i < 2; ++i) { const int c = tid + 512 * i, key = c >> 4, ch = c & 15;
        *(LAS v4u*)(buf + key * FA_KSTR + ch * 16) = t.k[i];
        *(LAS v4u*)(buf + FA_KB + key * FA_VSTR + ch * 16) = t.v[i]; }
}
template <int NKS>
__device__ __forceinline__ void fa_tile(const LAS unsigned char* buf, const bf16x8 (&q)[NKS], f32x16 (&o)[4], float& m, float& lsum, float c, int kcolb, int lane, bool masked, int dpos  ) {
    const int r32 = lane & 31, h = lane >> 5;
    f32x16 p0, p1;
#pragma unroll
    for (int r = 0; r < 16; ++r) { p0[r] = 0.f; p1[r] = 0.f; }
    const LAS unsigned char* kp = buf + r32 * FA_KSTR + kcolb + h * 16;
#pragma unroll
    for (int ks = 0; ks < NKS; ++ks) {
        const bf16x8 a0 = *(const LAS bf16x8*)(kp + ks * 32), a1 = *(const LAS bf16x8*)(kp + 32 * FA_KSTR + ks * 32);
        p0 = __builtin_amdgcn_mfma_f32_32x32x16_bf16(a0, q[ks], p0, 0, 0, 0);
        p1 = __builtin_amdgcn_mfma_f32_32x32x16_bf16(a1, q[ks], p1, 0, 0, 0);
    }
    if (masked) {
#pragma unroll
        for (int r = 0; r < 16; ++r) { const int d0 = dpos - ((r & 3) + 8 * (r >> 2) + 4 * h), d1 = d0 - 32;
            if (d0 > 128 || d0 < -128) p0[r] = -INFINITY; if (d1 > 128 || d1 < -128) p1[r] = -INFINITY; }
    }
    float mt = fmaxf(p0[0], p1[0]);
#pragma unroll
    for (int r = 1; r < 16; ++r) mt = fmaxf(mt, fmaxf(p0[r], p1[r]));
    mt = half_max(mt);
    const float mn = fmaxf(m, mt * c);
    const float alpha = __builtin_amdgcn_exp2f(m - mn);
    m = mn;
    float rs = 0.f;
#pragma unroll
    for (int r = 0; r < 16; ++r) { p0[r] = __builtin_amdgcn_exp2f(p0[r] * c - mn); p1[r] = __builtin_amdgcn_exp2f(p1[r] * c - mn); rs += p0[r] + p1[r]; }
    lsum = lsum * alpha + rs;
    if (__builtin_amdgcn_ballot_w64(alpha != 1.0f) != 0ull) {
#pragma unroll
        for (int b = 0; b < 4; ++b) o[b] = o[b] * alpha;
    }
    bf16x8 pb[4];
    { v4u w;
      w = (v4u){cvtpk(p0[0], p0[1]), cvtpk(p0[2], p0[3]), cvtpk(p0[4], p0[5]), cvtpk(p0[6], p0[7])}; pb[0] = __builtin_bit_cast(bf16x8, w);
      w = (v4u){cvtpk(p0[8], p0[9]), cvtpk(p0[10], p0[11]), cvtpk(p0[12], p0[13]), cvtpk(p0[14], p0[15])}; pb[1] = __builtin_bit_cast(bf16x8, w);
      w = (v4u){cvtpk(p1[0], p1[1]), cvtpk(p1[2], p1[3]), cvtpk(p1[4], p1[5]), cvtpk(p1[6], p1[7])}; pb[2] = __builtin_bit_cast(bf16x8, w);
      w = (v4u){cvtpk(p1[8], p1[9]), cvtpk(p1[10], p1[11]), cvtpk(p1[12], p1[13]), cvtpk(p1[14], p1[15])}; pb[3] = __builtin_bit_cast(bf16x8, w); }
    const int i16 = lane & 15, gc = (lane >> 4) & 1;
    const LAS unsigned char* vp = buf + FA_KB + (4 * h + (i16 >> 2)) * FA_VSTR + (16 * gc + 4 * (i16 & 3)) * 2;
#pragma unroll
    for (int s = 0; s < 4; ++s) {
#pragma unroll
        for (int b = 0; b < 4; ++b) {
            const s16x4 lo = __builtin_amdgcn_ds_read_tr16_b64_v4i16((LAS s16x4*)(vp + (16 * s) * FA_VSTR + b * 64));
            const s16x4 hi = __builtin_amdgcn_ds_read_tr16_b64_v4i16((LAS s16x4*)(vp + (16 * s + 8) * FA_VSTR + b * 64));
            const bf16x8 a = (bf16x8){lo[0], lo[1], lo[2], lo[3], hi[0], hi[1], hi[2], hi[3]};
            o[b] = __builtin_amdgcn_mfma_f32_32x32x16_bf16(a, pb[s], o[b], 0, 0, 0);
        }
        __builtin_amdgcn_sched_barrier(0);
    }
}
template <int MODE>
__device__ __forceinline__ void fa_unit(Frame& F, const bf16* qg, int qstride, const Seg& s0, const Seg& s1, bool two, int qpos0, float c, const float* sinkp, float lam, float onems, const float* dnorm, bf16* dst, int dstride) {
    constexpr int NKS = MODE == 0 ? 8 : 4;
    int tid_ = F.tid; asm volatile("" : "+v"(tid_));
    const int tid = tid_, lane = tid & 63, w = F.wave, r32 = lane & 31, h = lane >> 5, grp = w >> 2, qrow0 = (w & 3) * 32;
    const int kcolb = MODE == 0 ? 0 : grp * 128;
    qg += (MODE == 0 ? grp * 128 : grp * 64); if (MODE == 0) dst += grp * 128;
    bf16x8 q[NKS];
#pragma unroll
    for (int ks = 0; ks < NKS; ++ks) q[ks] = *(const bf16x8*)(qg + (size_t)(qrow0 + r32) * qstride + ks * 16 + h * 8);
    f32x16 o[4];
#pragma unroll
    for (int b = 0; b < 4; ++b)
#pragma unroll
        for (int r = 0; r < 16; ++r) o[b][r] = 0.f;
    float m = -INFINITY, lsum = 0.f;
    const int nt0 = s0.n >> 6, nt = nt0 + (two ? (s1.n >> 6) : 0);
    FaTile t;
    __syncthreads();
    fa_load(t, s0, 0, tid); fa_store(t, F.lds, tid);
    __syncthreads();
    for (int it = 0; it < nt; ++it) {
        const bool more = it + 1 < nt;
        if (more) { const int n = it + 1; if (n < nt0) fa_load(t, s0, n * 64, tid); else fa_load(t, s1, (n - nt0) * 64, tid); }
        const bool inseg1 = it >= nt0; const int pos0 = inseg1 ? s1.pos0 : s0.pos0; const int key0 = (inseg1 ? it - nt0 : it) * 64;
        fa_tile<NKS>(F.lds + (it & 1) * FA_BUF, q, o, m, lsum, c, kcolb, lane, pos0 >= 0, (qpos0 + qrow0 + r32) - (pos0 + key0));
        if (more) fa_store(t, F.lds + ((it + 1) & 1) * FA_BUF, tid);
        __syncthreads();
    }
    const float ltot = half_sum(lsum);
    if (MODE == 0) {
        const float inv = 1.0f / (ltot + __builtin_amdgcn_exp2f(sinkp[grp] * 1.4426950408889634f - m));
#pragma unroll
        for (int b = 0; b < 4; ++b) o[b] = o[b] * inv;
    } else {
        LAS float* comb = (LAS float*)(F.lds + (w & 3) * 16384);
        if (grp == 1) { const float f = lam / ltot;
#pragma unroll
            for (int b = 0; b < 4; ++b)
#pragma unroll
                for (int r = 0; r < 16; ++r) comb[(32 * b + (r & 3) + 8 * (r >> 2) + 4 * h) * 32 + r32] = o[b][r] * f; }
        __syncthreads();
        if (grp == 0) { const float inv = 1.0f / ltot; float ss = 0.f;
#pragma unroll
            for (int b = 0; b < 4; ++b)
#pragma unroll
                for (int r = 0; r < 16; ++r) { const float v = o[b][r] * inv - comb[(32 * b + (r & 3) + 8 * (r >> 2) + 4 * h) * 32 + r32]; o[b][r] = v; ss += v * v; }
            ss = half_sum(ss);
            const float rs = onems / sqrtf(ss * (1.0f / 128.0f) + EPS);
#pragma unroll
            for (int b = 0; b < 4; ++b)
#pragma unroll
                for (int r = 0; r < 16; ++r) o[b][r] = o[b][r] * rs * dnorm[32 * b + (r & 3) + 8 * (r >> 2) + 4 * h]; }
    }
    if (MODE == 0 || grp == 0) {
        LAS unsigned char* st = F.lds + (MODE == 0 ? w * (32 * FA_OSTR) : 65536 + (w & 3) * (32 * FA_OSTR));
#pragma unroll
        for (int b = 0; b < 4; ++b)
#pragma unroll
            for (int k = 0; k < 4; ++k) { typedef unsigned u2 __attribute__((ext_vector_type(2)));
                *(LAS u2*)(st + r32 * FA_OSTR + (32 * b + 8 * k + 4 * h) * 2) = (u2){cvtpk(o[b][4 * k], o[b][4 * k + 1]), cvtpk(o[b][4 * k + 2], o[b][4 * k + 3])}; }
        asm volatile("s_waitcnt lgkmcnt(0)" ::: "memory");
#pragma unroll
        for (int i = 0; i < 8; ++i) { const int cc = lane + 64 * i, row = cc >> 4, c16 = cc & 15;
            *(v4u*)(dst + (size_t)(qrow0 + row) * dstride + c16 * 8) = *(const LAS v4u*)(st + row * FA_OSTR + c16 * 16); }
    }
}
constexpr int NCHUNK = 96;
constexpr int S1_CSTR = 272, S1_XSTR = 160;
constexpr int S3_CM = 0, S3_BM = 34816, S3_XM = 69632, S3_TAB = 90112, S3_SSP = 92160;
constexpr int S1_BM = 0, S1_XM = 34816, S1_TAB = 55296;
#define LBAR() asm volatile("s_waitcnt lgkmcnt(0)\n\ts_barrier" ::: "memory")
__device__ __forceinline__ int crow16(int r, int h) { return (r & 3) + 8 * (r >> 2) + 4 * h; }

struct S1Pre { v4u b[4], x[2]; float dt, al; };
__device__ __forceinline__ void s1_load(S1Pre& q, const bf16* XB, const float* DT, const float* alog, int u, int tid, int wave) {
    const int cc = u >> 4, hd = u & 15, m0 = cc * 128, g = hd >> 3;
    const unsigned offB = (unsigned)((tid >> 4) * 1536 + (tid & 15) * 8) * 2u, offX = (unsigned)((tid >> 3) * 1536 + (tid & 7) * 8) * 2u;
#pragma unroll
    for (int i = 0; i < 4; ++i) { const char* bs = (const char*)(XB + (size_t)(m0 + 32 * i) * 1536 + 1024 + g * 128); q.b[i] = *(const v4u*)(bs + offB); }
#pragma unroll
    for (int i = 0; i < 2; ++i) { const char* xs = (const char*)(XB + (size_t)(m0 + 64 * i) * 1536 + hd * 64); q.x[i] = *(const v4u*)(xs + offX); }
    q.dt = *(const float*)((const char*)(DT + (size_t)m0 * 32 + hd) + (unsigned)((tid & 127) * 32 + ((tid >> 7) & 1) * 16) * 4u);
    q.al = alog[(wave & 1) * 16 + hd];
}
__device__ __forceinline__ void s1_store(const S1Pre& q, LAS unsigned char* L, int tid) {
#pragma unroll
    for (int i = 0; i < 4; ++i) { const int c = tid + 512 * i, row = c >> 4, ch = c & 15; *(LAS v4u*)(L + S1_BM + row * S1_CSTR + ch * 16) = q.b[i]; }
#pragma unroll
    for (int i = 0; i < 2; ++i) { const int c = tid + 512 * i, row = c >> 3, ch = c & 7; *(LAS v4u*)(L + S1_XM + row * S1_XSTR + ch * 16) = q.x[i]; }
    if (tid < 256) ((LAS float*)(L + S1_TAB))[tid] = q.dt;
}
__device__ __forceinline__ void s1_phase_units(Frame& F, PP p, int l, int ufirst, int ustride, int uend) {
    unsigned char* ws = p->ws;
    int tid_ = F.tid; asm volatile("" : "+v"(tid_));
    const int tid = tid_, lane = tid & 63, w = F.wave, r32 = lane & 31, hh = lane >> 5, i16 = lane & 15, gc = (lane >> 4) & 1;
    const bf16* XB = (const bf16*)(ws + WS_XBC); const float* DT = (const float*)(ws + WS_DT); const float* alog = p->in[21] + l * 32;
    float* CUMG = (float*)(ws + WS_EDEC); float* CDEC = (float*)(ws + WS_CDEC); bf16* STR = (bf16*)(ws + WS_ST);
    LAS unsigned char* L = F.lds; LAS float* tab = (LAS float*)(L + S1_TAB);
    int u = ufirst; if (u >= uend) return;
    S1Pre q; s1_load(q, XB, DT, alog, u, tid, w);
    while (u < uend) {
        const int cc = u >> 4, hd = u & 15; const float al = q.al;
        LBAR();
        s1_store(q, L, tid);
        LBAR();
        const int un = u + ustride; if (un < uend) s1_load(q, XB, DT, alog, un, tid, w);
        if (w < 2) {
            const float a = -__expf(al);
            const float d0 = tab[w * 128 + 2 * lane], d1 = tab[w * 128 + 2 * lane + 1];
            const float v0 = d0 * a, v1 = d1 * a, s = v0 + v1;
            float inc = s;
            if (w == 0) {
#pragma unroll
                for (int o = 1; o < 64; o <<= 1) { const float t = bperm(inc, lane - o); if (lane >= o) inc += t; }
            } else {
#pragma unroll
                for (int o = 1; o < 64; o <<= 1) { const float t = bperm(inc, lane + o); if (lane + o < 64) inc += t; }
            }
            const float exc = inc - s;
            const float c0 = (w == 0) ? exc + v0 : exc + v1 + v0, c1 = (w == 0) ? exc + v0 + v1 : exc + v1;
            const float tot = bperm(inc, w == 0 ? 63 : 0);
            tab[(2 + w) * 128 + 2 * lane] = __expf(tot - c0) * d0; tab[(2 + w) * 128 + 2 * lane + 1] = __expf(tot - c1) * d1;
            typedef float f2 __attribute__((ext_vector_type(2)));
            *(f2*)(CUMG + ((size_t)(cc * 16 + hd) * 2 + w) * 128 + 2 * lane) = (f2){c0, c1};
            if (lane == 0) CDEC[(w * NCHUNK + cc) * 16 + hd] = __expf(tot);
        }
        LBAR();
        {
            const int nb = w & 3, pb = w >> 2;
            f32x16 st[2];
#pragma unroll
            for (int d = 0; d < 2; ++d)
#pragma unroll
                for (int r = 0; r < 16; ++r) st[d][r] = 0.f;
            const LAS unsigned char* bp = L + S1_BM + (8 * hh + (i16 >> 2)) * S1_CSTR + (32 * nb + 16 * gc + 4 * (i16 & 3)) * 2;
            const LAS unsigned char* xp = L + S1_XM + (8 * hh + (i16 >> 2)) * S1_XSTR + (32 * pb + 16 * gc + 4 * (i16 & 3)) * 2;
#pragma unroll
            for (int ks = 0; ks < 8; ++ks) {
                const s16x4 alo = __builtin_amdgcn_ds_read_tr16_b64_v4i16((LAS s16x4*)(bp + (16 * ks) * S1_CSTR));
                const s16x4 ahi = __builtin_amdgcn_ds_read_tr16_b64_v4i16((LAS s16x4*)(bp + (16 * ks + 4) * S1_CSTR));
                const bf16x8 afr = (bf16x8){alo[0], alo[1], alo[2], alo[3], ahi[0], ahi[1], ahi[2], ahi[3]};
                const s16x4 lo = __builtin_amdgcn_ds_read_tr16_b64_v4i16((LAS s16x4*)(xp + (16 * ks) * S1_XSTR));
                const s16x4 hi = __builtin_amdgcn_ds_read_tr16_b64_v4i16((LAS s16x4*)(xp + (16 * ks + 4) * S1_XSTR));
                const float x0 = bf1((bf16)lo[0]), x1 = bf1((bf16)lo[1]), x2 = bf1((bf16)lo[2]), x3 = bf1((bf16)lo[3]), x4 = bf1((bf16)hi[0]), x5 = bf1((bf16)hi[1]), x6 = bf1((bf16)hi[2]), x7 = bf1((bf16)hi[3]);
#pragma unroll
                for (int d = 0; d < 2; ++d) {
                    const f32x4 w0 = *(const LAS f32x4*)(tab + (2 + d) * 128 + 16 * ks + 8 * hh), w1 = *(const LAS f32x4*)(tab + (2 + d) * 128 + 16 * ks + 8 * hh + 4);
                    const v4u t = (v4u){cvtpk(x0 * w0.x, x1 * w0.y), cvtpk(x2 * w0.z, x3 * w0.w), cvtpk(x4 * w1.x, x5 * w1.y), cvtpk(x6 * w1.z, x7 * w1.w)};
                    st[d] = __builtin_amdgcn_mfma_f32_32x32x16_bf16(afr, __builtin_bit_cast(bf16x8, t), st[d], 0, 0, 0);
                }
            }
#pragma unroll
            for (int d = 0; d < 2; ++d) { bf16* so = STR + ((size_t)(d * NCHUNK + cc) * 16 + hd) * 8192 + (size_t)((nb * 2 + pb) * 2) * 512 + lane * 8;
#pragma unroll
                for (int j = 0; j < 2; ++j) *(v4u*)(so + j * 512) = (v4u){cvtpk(st[d][8 * j], st[d][8 * j + 1]), cvtpk(st[d][8 * j + 2], st[d][8 * j + 3]), cvtpk(st[d][8 * j + 4], st[d][8 * j + 5]), cvtpk(st[d][8 * j + 6], st[d][8 * j + 7])}; }
        }
        u = un;
    }
    LBAR();
}
__device__ __forceinline__ void s2_scan(Frame& F, PP p, int l) {
    unsigned char* ws = p->ws; bf16* STR = (bf16*)(ws + WS_ST); const float* CDEC = (const float*)(ws + WS_CDEC);
    const int gt = F.vcu * NTHR + F.tid, NGT = F.G * NTHR;
    for (int idx = gt; idx < 576 * 1024; idx += NGT) {
        const int combo = idx >> 10, v = idx & 1023, seq = combo >> 5, hd = (combo >> 1) & 15, dir = combo & 1;
        const int c0 = seq < 16 ? seq * 2 : 32 + (seq - 16) * 32, nc = seq < 16 ? 2 : 32;
        const int ln = v & 63, blk = v >> 6, j = blk & 1, pb = (blk >> 1) & 1, nb = blk >> 2; const int pp = 32 * pb + (ln & 31), n0 = 32 * nb + 16 * j + 4 * (ln >> 5);
        f32x4 H0 = (f32x4){0.f, 0.f, 0.f, 0.f}, H1 = H0;
        if (seq >= 16) { const float* h0 = p->in[dir ? 7 : 6] + (((size_t)(seq - 16) * DEPTH + l) * 16 + hd) * 8192 + pp * 128 + n0; H0 = *(const f32x4*)h0; H1 = *(const f32x4*)(h0 + 8); }
        for (int k = 0; k < nc; k += 2) {
            const int ca = dir ? c0 + nc - 1 - k : c0 + k, cb = dir ? ca - 1 : ca + 1;
            v4u* pa = (v4u*)(STR + ((size_t)(dir * NCHUNK + ca) * 16 + hd) * 8192) + v; v4u* pbb = (v4u*)(STR + ((size_t)(dir * NCHUNK + cb) * 16 + hd) * 8192) + v;
            const v4u ta = *pa, tb = *pbb; const float da = CDEC[(dir * NCHUNK + ca) * 16 + hd], db = CDEC[(dir * NCHUNK + cb) * 16 + hd];
            *pa = (v4u){cvtpk(H0.x, H0.y), cvtpk(H0.z, H0.w), cvtpk(H1.x, H1.y), cvtpk(H1.z, H1.w)};
            H0 = H0 * da + (f32x4){bflo(ta.x), bfhi(ta.x), bflo(ta.y), bfhi(ta.y)}; H1 = H1 * da + (f32x4){bflo(ta.z), bfhi(ta.z), bflo(ta.w), bfhi(ta.w)};
            *pbb = (v4u){cvtpk(H0.x, H0.y), cvtpk(H0.z, H0.w), cvtpk(H1.x, H1.y), cvtpk(H1.z, H1.w)};
            H0 = H0 * db + (f32x4){bflo(tb.x), bfhi(tb.x), bflo(tb.y), bfhi(tb.y)}; H1 = H1 * db + (f32x4){bflo(tb.z), bfhi(tb.z), bflo(tb.w), bfhi(tb.w)};
        }
        if (seq < 16) { float* o = p->out + (dir ? OUT_SB : OUT_SF) + (((size_t)seq * DEPTH + l) * 16 + hd) * 8192 + pp * 128 + n0; *(f32x4*)o = H0; *(f32x4*)(o + 8) = H1; }
    }
}
struct S3Pre { v4u c[4], b[4], x[2]; float dt, cum, dk; };
__device__ __forceinline__ void s3_load(S3Pre& q, const bf16* XB, const float* DT, const float* CUMG, const float* dskip, int u, int tid) {
    const int cc = u >> 4, hd = u & 15, m0 = cc * 128, g = hd >> 3;
    const unsigned offB = (unsigned)((tid >> 4) * 1536 + (tid & 15) * 8) * 2u, offX = (unsigned)((tid >> 3) * 1536 + (tid & 7) * 8) * 2u;
#pragma unroll
    for (int i = 0; i < 4; ++i) { const char* bs = (const char*)(XB + (size_t)(m0 + 32 * i) * 1536 + g * 128); q.c[i] = *(const v4u*)(bs + 2560 + offB); q.b[i] = *(const v4u*)(bs + 2048 + offB); }
#pragma unroll
    for (int i = 0; i < 2; ++i) { const char* xs = (const char*)(XB + (size_t)(m0 + 64 * i) * 1536 + hd * 64); q.x[i] = *(const v4u*)(xs + offX); }
    q.dt = *(const float*)((const char*)(DT + (size_t)m0 * 32 + hd) + (unsigned)((tid & 127) * 32 + ((tid >> 7) & 1) * 16) * 4u);
    q.cum = *(const float*)((const char*)(CUMG + (size_t)(cc * 16 + hd) * 256) + (unsigned)(tid & 255) * 4u);
    q.dk = dskip[hd];
}
__device__ __forceinline__ void s3_store(const S3Pre& q, LAS unsigned char* L, int tid) {
#pragma unroll
    for (int i = 0; i < 4; ++i) { const int c = tid + 512 * i, row = c >> 4, ch = c & 15; *(LAS v4u*)(L + S3_CM + row * S1_CSTR + ch * 16) = q.c[i]; *(LAS v4u*)(L + S3_BM + row * S1_CSTR + ch * 16) = q.b[i]; }
#pragma unroll
    for (int i = 0; i < 2; ++i) { const int c = tid + 512 * i, row = c >> 3, ch = c & 7; *(LAS v4u*)(L + S3_XM + row * S1_XSTR + ch * 16) = q.x[i]; }
    if (tid < 256) { ((LAS float*)(L + S3_TAB))[tid] = q.cum; ((LAS float*)(L + S3_TAB))[256 + tid] = q.dt; }
}
__device__ __forceinline__ void s3_phase(Frame& F, PP p, int l) {
    unsigned char* ws = p->ws;
    int tid_ = F.tid; asm volatile("" : "+v"(tid_));
    const int tid = tid_, lane = tid & 63, w = F.wave, r32 = lane & 31, hh = lane >> 5, i16 = lane & 15, gc = (lane >> 4) & 1;
    const bf16* XB = (const bf16*)(ws + WS_XBC); const bf16* P = (const bf16*)(ws + WS_P); bf16* MIX = (bf16*)(ws + WS_MIX);
    const float* DT = (const float*)(ws + WS_DT); const float* CUMG = (const float*)(ws + WS_EDEC); const bf16* STR = (const bf16*)(ws + WS_ST); float* SSQ = (float*)(ws + WS_SSQ);
    LAS unsigned char* L = F.lds; const LAS float* tab = (const LAS float*)(L + S3_TAB); LAS float* SSP = (LAS float*)(L + S3_SSP);
    const int lb = w & 3, pb = w >> 2, lpos = 32 * lb + r32;
    const int uend = NCHUNK * 16;
    int u = blockIdx.x; if (u >= uend) return;
    const float* dskip = p->in[22] + l * 16;
    S3Pre q; s3_load(q, XB, DT, CUMG, dskip, u, tid);
    while (u < uend) {
        const int cc = u >> 4, hd = u & 15, m0 = cc * 128; const float dk = q.dk;
        LBAR();
        s3_store(q, L, tid);
        LBAR();
        const int un = u + F.G; if (un < uend) s3_load(q, XB, DT, CUMG, dskip, un, tid);
        v4u hf[2][8];
#pragma unroll
        for (int k = 0; k < 8; ++k) hf[0][k] = *(const v4u*)((const char*)(STR + ((size_t)(0 * NCHUNK + cc) * 16 + hd) * 8192 + (((k >> 1) * 2 + pb) * 2 + (k & 1)) * 512) + (unsigned)lane * 16u);
        unsigned long long zw[4];
        f32x16 acc;
#pragma unroll
        for (int r = 0; r < 16; ++r) acc[r] = 0.f;
#pragma unroll
        for (int d = 0; d < 2; ++d) {
            const LAS float* cum = tab + d * 128; const LAS float* dtv = tab + (2 + d) * 128; const float cl = cum[lpos];
            const int sb0 = d == 0 ? 0 : lb, sb1 = d == 0 ? lb : 3;
            for (int sb = sb0; sb <= sb1; ++sb) {
                f32x16 cb;
#pragma unroll
                for (int r = 0; r < 16; ++r) cb[r] = 0.f;
#pragma unroll
                for (int ks = 0; ks < 8; ++ks) { const bf16x8 a = *(const LAS bf16x8*)(L + S3_BM + (32 * sb + r32) * S1_CSTR + ks * 32 + hh * 16);
                    const bf16x8 cfr = *(const LAS bf16x8*)(L + S3_CM + lpos * S1_CSTR + ks * 32 + hh * 16);
                    cb = __builtin_amdgcn_mfma_f32_32x32x16_bf16(a, cfr, cb, 0, 0, 0);
                    if ((ks & 3) == 3) __builtin_amdgcn_sched_barrier(0); }
#pragma unroll
                for (int r = 0; r < 16; ++r) { const int s = 32 * sb + crow16(r, hh);
                    float v = cb[r] * __expf(cl - cum[s]) * dtv[s];
                    const bool ok = d == 0 ? (s <= lpos) : (s >= lpos);
                    v = ok ? v : 0.f; if (d == 0 && s == lpos) v += dk;
                    cb[r] = v; }
                bf16x8 pb2[2];
                { v4u t;
                  t = (v4u){cvtpk(cb[0], cb[1]), cvtpk(cb[2], cb[3]), cvtpk(cb[4], cb[5]), cvtpk(cb[6], cb[7])}; pb2[0] = __builtin_bit_cast(bf16x8, t);
                  t = (v4u){cvtpk(cb[8], cb[9]), cvtpk(cb[10], cb[11]), cvtpk(cb[12], cb[13]), cvtpk(cb[14], cb[15])}; pb2[1] = __builtin_bit_cast(bf16x8, t); }
                const LAS unsigned char* xp = L + S3_XM + (32 * sb + 4 * hh + (i16 >> 2)) * S1_XSTR + (32 * pb + 16 * gc + 4 * (i16 & 3)) * 2;
#pragma unroll
                for (int k2 = 0; k2 < 2; ++k2) {
                    const s16x4 lo = __builtin_amdgcn_ds_read_tr16_b64_v4i16((LAS s16x4*)(xp + (16 * k2) * S1_XSTR));
                    const s16x4 hi = __builtin_amdgcn_ds_read_tr16_b64_v4i16((LAS s16x4*)(xp + (16 * k2 + 8) * S1_XSTR));
                    const bf16x8 a = (bf16x8){lo[0], lo[1], lo[2], lo[3], hi[0], hi[1], hi[2], hi[3]};
                    acc = __builtin_amdgcn_mfma_f32_32x32x16_bf16(a, pb2[k2], acc, 0, 0, 0);
                }
            }
            if (d == 0) {
#pragma unroll
                for (int k = 0; k < 8; ++k) hf[1][k] = *(const v4u*)((const char*)(STR + ((size_t)(1 * NCHUNK + cc) * 16 + hd) * 8192 + (((k >> 1) * 2 + pb) * 2 + (k & 1)) * 512) + (unsigned)lane * 16u);
#pragma unroll
                for (int k = 0; k < 4; ++k) zw[k] = *(const unsigned long long*)((const char*)(P + (size_t)m0 * INP + PC_Z + hd * 64 + 32 * pb + 8 * k) + (unsigned)(lpos * INP + 4 * hh) * 2u);
            }
        }
#pragma unroll
        for (int d = 0; d < 2; ++d) { const float e = __expf(tab[d * 128 + lpos]);
#pragma unroll
            for (int k = 0; k < 8; ++k) { typedef unsigned u2 __attribute__((ext_vector_type(2)));
                const LAS unsigned char* cp = L + S3_CM + lpos * S1_CSTR + (32 * (k >> 1) + 16 * (k & 1) + 4 * hh) * 2;
                const u2 c0 = *(const LAS u2*)cp, c1 = *(const LAS u2*)(cp + 16);
                const v4u t = (v4u){cvtpk(bflo(c0.x) * e, bfhi(c0.x) * e), cvtpk(bflo(c0.y) * e, bfhi(c0.y) * e), cvtpk(bflo(c1.x) * e, bfhi(c1.x) * e), cvtpk(bflo(c1.y) * e, bfhi(c1.y) * e)};
                acc = __builtin_amdgcn_mfma_f32_32x32x16_bf16(__builtin_bit_cast(bf16x8, hf[d][k]), __builtin_bit_cast(bf16x8, t), acc, 0, 0, 0); } }
        float ss = 0.f;
        char* mixr = (char*)(MIX + (size_t)m0 * DM + 1024 + hd * 64 + 32 * pb); const unsigned mixo = (unsigned)(lpos * DM + 4 * hh) * 2u;
#pragma unroll
        for (int k = 0; k < 4; ++k) { const unsigned long long z = zw[k];
            const float y0 = acc[4 * k] * silu(bflo((unsigned)z)), y1 = acc[4 * k + 1] * silu(bfhi((unsigned)z)), y2 = acc[4 * k + 2] * silu(bflo((unsigned)(z >> 32))), y3 = acc[4 * k + 3] * silu(bfhi((unsigned)(z >> 32)));
            ss += (y0 * y0 + y1 * y1) + (y2 * y2 + y3 * y3);
            *(unsigned long long*)(mixr + 16 * k + mixo) = (unsigned long long)cvtpk(y0, y1) | ((unsigned long long)cvtpk(y2, y3) << 32); }
        ss = half_sum(ss);
        if (hh == 0) SSP[pb * 128 + lpos] = ss;
        LBAR();
        if (tid < 128) SSQ[(size_t)(m0 + tid) * 16 + hd] = SSP[tid] + SSP[128 + tid];
        u = un;
    }
    LBAR();
}
__device__ __forceinline__ void nrm_phase(Frame& F, PP p, int l) {
    unsigned char* ws = p->ws; bf16* MIX = (bf16*)(ws + WS_MIX); const float* SSQ = (const float*)(ws + WS_SSQ); const float* sn = p->in[23] + l * 1024;
    const int gw = F.vcu * NWAVES + F.wave, NGW = F.G * NWAVES, lane = F.lane;
    for (int m = gw; m < MROWS; m += NGW) {
        const int c0 = lane * 16, g = lane >> 5;
        const f32x4 s0 = *(const f32x4*)(SSQ + (size_t)m * 16 + g * 8), s1 = *(const f32x4*)(SSQ + (size_t)m * 16 + g * 8 + 4);
        const float rs = 1.0f / sqrtf(((s0.x + s0.y) + (s0.z + s0.w) + (s1.x + s1.y) + (s1.z + s1.w)) * (1.0f / 512.0f) + EPS);
        v4u* q = (v4u*)(MIX + (size_t)m * DM + 1024 + c0); v4u a = q[0], b = q[1];
        const f32x4 g0 = *(const f32x4*)(sn + c0), g1 = *(const f32x4*)(sn + c0 + 4), g2 = *(const f32x4*)(sn + c0 + 8), g3 = *(const f32x4*)(sn + c0 + 12);
        a.x = cvtpk(bflo(a.x) * rs * g0.x, bfhi(a.x) * rs * g0.y); a.y = cvtpk(bflo(a.y) * rs * g0.z, bfhi(a.y) * rs * g0.w); a.z = cvtpk(bflo(a.z) * rs * g1.x, bfhi(a.z) * rs * g1.y); a.w = cvtpk(bflo(a.w) * rs * g1.z, bfhi(a.w) * rs * g1.w);
        b.x = cvtpk(bflo(b.x) * rs * g2.x, bfhi(b.x) * rs * g2.y); b.y = cvtpk(bflo(b.y) * rs * g2.z, bfhi(b.y) * rs * g2.w); b.z = cvtpk(bflo(b.z) * rs * g3.x, bfhi(b.z) * rs * g3.y); b.w = cvtpk(bflo(b.w) * rs * g3.z, bfhi(b.w) * rs * g3.w);
        q[0] = a; q[1] = b;
    }
}
__device__ __forceinline__ void mix1_phase(Frame& F, PP p, int l) {
    unsigned char* ws = p->ws;
    const bf16* P = (const bf16*)(ws + WS_P); const bf16* QKR = (const bf16*)(ws + WS_QKR); bf16* MIX = (bf16*)(ws + WS_MIX);
    const float* lamv = (const float*)(ws + WS_TAB + 32768);
    const float lam = lamv[l], onems = 1.0f - lamv[4 + l];
    const float* dnorm = p->in[17] + l * 128;
    constexpr int U_BL = 256, U_AL = 128, U_BC = 128, U_AC = 64, U_FA = U_BL + U_AL + U_BC + U_AC;
    const float LOG2E = 1.4426950408889634f, cA = 0.08838834764831845f * LOG2E, cB = 0.125f * LOG2E;
    for (int u = blockIdx.x; u < U_FA; u += F.G) {
        int r = u;
        int mode = 1; const bf16* qp; int qstr = RCW, qpos0 = 0; bool two = true; Seg s0, s1; bf16* dst; const float* sinkp = dnorm;
        if (r < U_BL) {
            const int b = r >> 7, h = (r >> 5) & 3, qb = r & 31; const int ml = b * 4096 + qb * 128;
            s0 = Seg{QKR + (size_t)(b * 4096) * RCW + RC_KD + h * 128, P + (size_t)(4096 + b * 4096) * INP + PC_VD + h * 128, RCW, INP, 4096, 0, -1};
            s1 = Seg{p->in[4] + ((size_t)(b * DEPTH + l) * 256) * 512 + h * 128, p->in[5] + ((size_t)(b * DEPTH + l) * 256) * 512 + h * 128, 512, 512, 256, 1, -1};
            qp = QKR + (size_t)ml * RCW + RC_QD + h * 128; dst = MIX + (size_t)(4096 + ml) * DM + 512 + h * 128;
        } else if (r < U_BL + U_AL) { r -= U_BL;
            const int b = r >> 6, kv = (r >> 5) & 1, qb = r & 31; const int ml = b * 4096 + qb * 128;
            const int w0 = qb * 128 - 128 < 0 ? 0 : qb * 128 - 128, w1 = qb * 128 + 256 > 4096 ? 4096 : qb * 128 + 256;
            s0 = Seg{p->in[2] + ((size_t)(b * DEPTH + l) * 256) * 256 + kv * 128, p->in[3] + ((size_t)(b * DEPTH + l) * 256) * 256 + kv * 128, 256, 256, 256, 1, -1};
            s1 = Seg{QKR + (size_t)(b * 4096 + w0) * RCW + RC_KA + kv * 128, P + (size_t)(4096 + b * 4096 + w0) * INP + PC_VA + kv * 128, RCW, INP, w1 - w0, 0, w0};
            mode = 0; qp = QKR + (size_t)ml * RCW + RC_QA + kv * 256; qpos0 = qb * 128; sinkp = p->in[15] + l * 4 + kv * 2; dst = MIX + (size_t)(4096 + ml) * DM + kv * 256;
        } else if (r < U_BL + U_AL + U_BC) { r -= U_BL + U_AL;
            const int b = r >> 3, h = (r >> 1) & 3, qb = r & 1; const int m0 = b * 256 + qb * 128;
            s0 = Seg{P + (size_t)(b * 256) * INP + PC_KD + h * 128, P + (size_t)(b * 256) * INP + PC_VD + h * 128, INP, INP, 256, 0, -1}; s1 = s0; two = false;
            qp = P + (size_t)m0 * INP + PC_QD + h * 128; qstr = INP; dst = MIX + (size_t)m0 * DM + 512 + h * 128;
        } else { r -= U_BL + U_AL + U_BC;
            const int b = r >> 2, kv = (r >> 1) & 1, qb = r & 1; const int m0 = b * 256 + qb * 128;
            s0 = Seg{P + (size_t)(b * 256) * INP + PC_KA + kv * 128, P + (size_t)(b * 256) * INP + PC_VA + kv * 128, INP, INP, 256, 0, -1}; s1 = s0; two = false;
            mode = 0; qp = P + (size_t)m0 * INP + PC_QA + kv * 256; qstr = INP; sinkp = p->in[15] + l * 4 + kv * 2; dst = MIX + (size_t)m0 * DM + kv * 256;
        }
        if (mode) fa_unit<1>(F, qp, qstr, s0, s1, two, qpos0, cB, sinkp, lam, onems, dnorm, dst, DM);
        else fa_unit<0>(F, qp, qstr, s0, s1, two, qpos0, cA, sinkp, lam, onems, dnorm, dst, DM);
    }
    __syncthreads();
    s1_phase_units(F, p, l, blockIdx.x, F.G, NCHUNK * 16);
}
#ifndef MK_ONE_LAUNCH
#define MK_ONE_LAUNCH 1
#endif
constexpr int PH_PER_LAYER = 11, PH_TOTAL = 2 + DEPTH * PH_PER_LAYER + 1;
__global__ void __launch_bounds__(NTHR, 2) mk_fwd(Params p_) {
    extern __shared__ __attribute__((aligned(16))) unsigned char lds[];
    Frame F;
    F.lds = (LAS unsigned char*)lds;
    F.tid = threadIdx.x; F.lane = F.tid & 63; F.wave = __builtin_amdgcn_readfirstlane(F.tid >> 6); const int wave0 = F.wave;
    F.G = gridDim.x; { const int bx = blockIdx.x; F.vcu = (F.G % 8 == 0) ? (bx % 8) * (F.G / 8) + bx / 8 : bx; }
    PP p = (PP)__builtin_amdgcn_kernarg_segment_ptr();
    for (int u = F.tid; u < (LDS_BYTES - LDSCTL_OFF) / 4; u += NTHR) ((LAS unsigned*)(F.lds + LDSCTL_OFF))[u] = 0u;
    __syncthreads();
    XcdBarrier bar; bar.bar = (unsigned*)(p->ws + WS_CTL) + CW_BAR; bar.x = 0; bar.st = nullptr;
#if MK_ONE_LAUNCH
    bar = xcd_barrier_post((unsigned*)(p->ws + WS_CTL) + CW_BAR, (volatile LAS unsigned*)(F.lds + MISC_OFF) + 8, F.tid == 0);
#define GRID_BAR() xcd_barrier(bar, wave0 == 0 && __builtin_amdgcn_mbcnt_hi(~0u, __builtin_amdgcn_mbcnt_lo(~0u, 0u)) == 0u)
#else
#define GRID_BAR() do {} while (0)
#endif
    const int lo = p->ph_lo, hi = p->ph_hi;
#define IN(k) (lo <= (k) && (k) < hi)
#define SEAM(k) do { if (IN(k) && IN((k) + 1)) GRID_BAR(); } while (0)
#define ENTER() do { int wv_ = wave0; asm volatile("" : "+s"(wv_)); int t_ = wv_ * 64 + (int)__builtin_amdgcn_mbcnt_hi(~0u, __builtin_amdgcn_mbcnt_lo(~0u, 0u)); asm volatile("" : "+v"(t_)); F.tid = t_; F.lane = t_ & 63; F.wave = wv_; asm volatile("" : "+s"(p)); ws = p->ws; } while (0)
    unsigned char* ws;

    if (IN(0)) { ENTER(); p0_prologue(F, p); } SEAM(0);
    if (IN(1)) { ENTER(); mod_layer(p, 0, F.vcu * NTHR + F.tid, F.G * NTHR); } SEAM(1);
#pragma unroll 1
    for (int l = 0; l < DEPTH; ++l) {
        const int pb = 2 + l * PH_PER_LAYER;
        if (IN(pb + 0)) { ENTER(); norm_phase(F, l == 0 ? p->in[0] : (const float*)(ws + WS_H), l == 0 ? p->in[1] : (const float*)(ws + WS_H) + (size_t)4096 * DM, p->in[12] + l * DM, (const float*)(ws + WS_MOD) + (size_t)l * 3 * NMOD, 0, DM, (bf16*)(ws + WS_U)); } SEAM(pb + 0);
        if (IN(pb + 1)) { ENTER();
            pg8::Gemm g{(const bf16*)(ws + WS_U), (const bf16*)(ws + WS_WIN) + (size_t)l * INP * DM, MROWS, INP, DM, DM}; pg8::StaticOrder S; S.init(MROWS, INP, F.G, (int)blockIdx.x);
            pg8::EpiBf16 E{(bf16*)(ws + WS_P), INP};
            pg8::gemm_phase<pg8::EpiBf16, pg8::StaticOrder, true, true>(F.lds, g, S, E, F.tid);
        } SEAM(pb + 1);
        if (IN(pb + 2)) { ENTER(); prep_phase(F, p, l); } SEAM(pb + 2);
        if (IN(pb + 3)) { ENTER(); mix1_phase(F, p, l); } SEAM(pb + 3);
        if (IN(pb + 4)) { ENTER(); s2_scan(F, p, l); } SEAM(pb + 4);
        if (IN(pb + 5)) { ENTER(); s3_phase(F, p, l); } SEAM(pb + 5);
        if (IN(pb + 6)) { ENTER(); nrm_phase(F, p, l); } SEAM(pb + 6);
        if (IN(pb + 7)) { ENTER();
            pg8::Gemm g{(const bf16*)(ws + WS_MIX), (const bf16*)(ws + WS_WOUT) + (size_t)l * DM * DM, MROWS, DM, DM, DM}; pg8::StaticOrder S; S.init(MROWS, DM, F.G, (int)blockIdx.x);
            pg8::EpiResid E{l == 0 ? p->in[0] : (const float*)(ws + WS_H), l == 0 ? p->in[1] : (const float*)(ws + WS_H) + (size_t)4096 * DM, (float*)(ws + WS_H), DM, (const float*)(ws + WS_MOD) + (size_t)l * 3 * NMOD + 2 * DM, NMOD};
            pg8::gemm_phase<pg8::EpiResid, pg8::StaticOrder, true, true>(F.lds, g, S, E, F.tid);
            { const int nfull = F.G == 256 ? 128 : 0; if (l + 1 < DEPTH && (int)blockIdx.x >= nfull) adaln_layer(F, p, l + 1, (int)blockIdx.x - nfull, (int)F.G - nfull); }
        } SEAM(pb + 7);
        if (IN(pb + 8)) { ENTER(); norm_phase(F, (const float*)(ws + WS_H), (const float*)(ws + WS_H) + (size_t)4096 * DM, p->in[13] + l * DM, (const float*)(ws + WS_MOD) + (size_t)l * 3 * NMOD, 3 * DM, 4 * DM, (bf16*)(ws + WS_U)); } SEAM(pb + 8);
        if (IN(pb + 9)) { ENTER();
            pg8::Gemm g{(const bf16*)(ws + WS_U), (const bf16*)(ws + WS_WGU) + (size_t)l * GU * DM, MROWS, GU, DM, DM}; pg8::StaticOrder S; S.init(MROWS, GU, F.G, (int)blockIdx.x);
            pg8::EpiSwiGLU E{(bf16*)(ws + WS_ACT), FF};
            pg8::gemm_phase<pg8::EpiSwiGLU, pg8::StaticOrder, true, true>(F.lds, g, S, E, F.tid);
        } SEAM(pb + 9);
        if (IN(pb + 10)) { ENTER();
            pg8::Gemm g{(const bf16*)(ws + WS_ACT), (const bf16*)(ws + WS_WDN) + (size_t)l * DM * FF, MROWS, DM, FF, FF}; pg8::StaticOrder S; S.init(MROWS, DM, F.G, (int)blockIdx.x);
            if (l + 1 < DEPTH) mod_layer(p, l + 1, F.vcu * NTHR + F.tid, F.G * NTHR);
            pg8::EpiResid E{(const float*)(ws + WS_H), (const float*)(ws + WS_H) + (size_t)4096 * DM, (float*)(ws + WS_H), DM, (const float*)(ws + WS_MOD) + (size_t)l * 3 * NMOD + 5 * DM, NMOD};
            pg8::gemm_phase<pg8::EpiResid, pg8::StaticOrder, true, true>(F.lds, g, S, E, F.tid);
            { const int nfull = F.G == 256 ? 128 : 0; if (l + 1 < DEPTH && (int)blockIdx.x >= nfull) conv_layer(F, p, l + 1, ((int)blockIdx.x - nfull) * NWAVES + F.wave, ((int)F.G - nfull) * NWAVES); }
        } SEAM(pb + 10);
    }
    if (IN(PH_TOTAL - 1)) { ENTER(); final_phase(F, (const float*)(ws + WS_H), p->in[27], p->out); }
#undef IN
#undef SEAM
#undef ENTER
}

extern "C" void kernel_launch(void* const* d_in, const int* in_sizes, int n_in, void* d_out, int out_size, void* d_ws, size_t ws_size, hipStream_t stream) {
    static int grid = 0;
    if (grid == 0) {
        if (n_in != 28 || out_size != 67108864 || ws_size < WS_END) { fprintf(stderr, "kernel_launch: unexpected sizes n_in %d out %d ws %zu\n", n_in, out_size, ws_size); grid = -1; return; }
        int dev = 0, cus = 0, per_cu = 0;
        if (hipGetDevice(&dev) != hipSuccess || hipDeviceGetAttribute(&cus, hipDeviceAttributeMultiprocessorCount, dev) != hipSuccess) { grid = -1; return; }
        if (hipFuncSetAttribute((const void*)mk_fwd, hipFuncAttributeMaxDynamicSharedMemorySize, LDS_BYTES) != hipSuccess) { fprintf(stderr, "kernel_launch: hipFuncSetAttribute failed\n"); grid = -1; return; }
        if (hipOccupancyMaxActiveBlocksPerMultiprocessor(&per_cu, (const void*)mk_fwd, NTHR, LDS_BYTES) != hipSuccess || per_cu < 1)
            fprintf(stderr, "kernel_launch: occupancy query reports %d workgroups per CU\n", per_cu);
        (void)hipGetLastError();
        grid = cus;
    }
    if (grid < 0) return;
    if (hipMemsetAsync((char*)d_ws + WS_CTL, 0, CTL_ZERO_BYTES, stream) != hipSuccess) return;
    Params a{};
    for (int i = 0; i < 28; ++i) a.in[i] = (const float*)d_in[i];
    a.out = (float*)d_out; a.ws = (unsigned char*)d_ws;
#if MK_ONE_LAUNCH
    a.ph_lo = 0; a.ph_hi = PH_TOTAL;
    hipLaunchKernelGGL(mk_fwd, dim3(grid), dim3(NTHR), LDS_BYTES, stream, a);
#else
    for (int ph = 0; ph < PH_TOTAL; ++ph) { a.ph_lo = ph; a.ph_hi = ph + 1; hipLaunchKernelGGL(mk_fwd, dim3(grid), dim3(NTHR), LDS_BYTES, stream, a); }
#endif
}
```

```cpp
#include <hip/hip_runtime.h>
#include <cstdio>
#include <cstdint>
namespace pg8 {
#define PG8_LAS __attribute__((address_space(3)))
typedef unsigned short bf16_t;
typedef short bf16x8 __attribute__((ext_vector_type(8)));
typedef float f32x4 __attribute__((ext_vector_type(4)));
typedef unsigned u32x4 __attribute__((ext_vector_type(4)));
constexpr int BM = 256, BK = 64, HALF = 128, HTB = HALF * BK * 2  , STAGE_BYTES = 8 * HTB, NXCD = 8, WGM = 8;

__host__ __device__ __forceinline__ int lds_byte(int r, int c) { const int st = (r >> 4) * 2 + (c >> 5), rr = r & 15, cc = c & 31, ob = rr * 64 + cc * 2; return st * 1024 + (ob ^ (((ob >> 9) & 1) << 5)); }
__host__ __device__ __forceinline__ void stage_rc(int b, int& R, int& C) { const int st = b / 1024, sb = b % 1024, swz = sb ^ (((sb >> 9) & 1) << 5); R = (st >> 1) * 16 + swz / 64; C = (st & 1) * 32 + (swz % 64) / 2; }
__host__ __device__ __forceinline__ int perm32(int rho) { const int n = rho >> 4, i = rho & 15; return 8 * (i >> 2) + 4 * n + (i & 3); }

struct Unit { int pm, pn, pk; };
struct Gemm { const bf16_t* A; const bf16_t* Bt; int M, N, K, Ksub; };

struct StaticOrder {
    int nM, nN, nwg, G, c;
    __host__ __device__ void init(int M, int N, int G_, int c_) { nM = M / BM; nN = N / BM; nwg = nM * nN; G = G_; c = c_; }
    __host__ __device__ bool next(int i, Unit& u) const {
        const long L = (long)i * G + c; if (L >= nwg) return false;
        int wgid = (int)L; { const int q = nwg / NXCD, r = nwg % NXCD, xcd = wgid % NXCD, off = wgid / NXCD; wgid = (xcd < r ? xcd * (q + 1) : r * (q + 1) + (xcd - r) * q) + off; }
        const int nig = WGM * nN, gid = wgid / nig, fm = gid * WGM, gsz = (nM - fm) < WGM ? (nM - fm) : WGM;
        u.pm = fm + ((wgid % nig) % gsz); u.pn = (wgid % nig) / gsz; u.pk = 0; return true;
    }
    __device__ __forceinline__ void a_ready(const Unit&) const {}
    __device__ __forceinline__ void done(const Unit&) const {}
};
struct SplitOrder {
    StaticOrder s; int KS;
    __host__ __device__ void init(int M, int N, int KS_, int G_, int c_) { KS = KS_; s.init(M, N * KS_, G_, c_); }
    __host__ __device__ bool next(int i, Unit& u) const { if (!s.next(i, u)) return false; u.pk = u.pn % KS; u.pn = u.pn / KS; return true; }
    __device__ __forceinline__ void a_ready(const Unit&) const {}
    __device__ __forceinline__ void done(const Unit&) const {}
};


__device__ __forceinline__ unsigned cvt_pk_bf16(float lo, float hi) { unsigned r; asm volatile("v_cvt_pk_bf16_f32 %0, %1, %2" : "=v"(r) : "v"(lo), "v"(hi)); return r; }

struct EpiBf16 {
    static constexpr bool PERM = true, AFTER_DRAIN = false;
    bf16_t* O; int ldc;
    __device__ __forceinline__ void operator()(const f32x4 (&acc)[2][2][4][2], const Unit& u, int wr, int wc, int fr, int fq) const {
        const int row0 = u.pm * BM + wr * 64 + fr; const int col0 = u.pn * BM + wc * 32 + 8 * fq;
#pragma unroll
        for (int ai = 0; ai < 2; ++ai)
#pragma unroll
            for (int m = 0; m < 4; ++m) { bf16_t* rowp = O + (size_t)(row0 + ai * HALF + m * 16) * ldc + col0;
#pragma unroll
                for (int bj = 0; bj < 2; ++bj) { const f32x4 v0 = acc[ai][bj][m][0], v1 = acc[ai][bj][m][1];
                    u32x4 w; w.x = cvt_pk_bf16(v0[0], v0[1]); w.y = cvt_pk_bf16(v0[2], v0[3]); w.z = cvt_pk_bf16(v1[0], v1[1]); w.w = cvt_pk_bf16(v1[2], v1[3]);
                    *(u32x4*)(rowp + bj * HALF) = w; } }
    }
};
__device__ __forceinline__ int cond_of_pm(int pm) { return pm < 16 ? 0 : (pm < 32 ? 1 : 2); }
struct EpiResid {
    static constexpr bool PERM = false, AFTER_DRAIN = false;
    const float* base0; const float* base1; float* H; int ldc; const float* gate; int gstride;
    __device__ __forceinline__ void operator()(const f32x4 (&acc)[2][2][4][2], const Unit& u, int wr, int wc, int fr, int fq) const {
        const float* g = gate + (size_t)cond_of_pm(u.pm) * gstride;
        const int row0 = u.pm * BM + wr * 64 + fr; const int col0 = u.pn * BM + wc * 32 + 4 * fq;
        const float* bs = u.pm < 16 ? base0 + (size_t)row0 * ldc : base1 + (size_t)(row0 - 4096) * ldc;
        f32x4 gv[2][2];
#pragma unroll
        for (int bj = 0; bj < 2; ++bj)
#pragma unroll
            for (int n = 0; n < 2; ++n) gv[bj][n] = *(const f32x4*)(g + col0 + bj * HALF + n * 16);
#pragma unroll
        for (int ai = 0; ai < 2; ++ai)
#pragma unroll
            for (int m = 0; m < 4; ++m) { const size_t ro = (size_t)(ai * HALF + m * 16) * ldc + col0; float* rowp = H + (size_t)row0 * ldc + ro;
#pragma unroll
                for (int bj = 0; bj < 2; ++bj)
#pragma unroll
                    for (int n = 0; n < 2; ++n) { f32x4 h = *(const f32x4*)(bs + ro + bj * HALF + n * 16); h = h + gv[bj][n] * acc[ai][bj][m][n]; *(f32x4*)(rowp + bj * HALF + n * 16) = h; }
                asm volatile("" ::: "memory"); }
    }
};
__device__ __forceinline__ float silu_f(float x) { return x * __builtin_amdgcn_rcpf(1.0f + __expf(-x)); }
struct EpiSwiGLU {
    static constexpr bool PERM = true, AFTER_DRAIN = false;
    bf16_t* O; int ldc;
    __device__ __forceinline__ void operator()(const f32x4 (&acc)[2][2][4][2], const Unit& u, int wr, int wc, int fr, int fq) const {
        const int row0 = u.pm * BM + wr * 64 + fr; const int col0 = u.pn * HALF + wc * 32 + 8 * fq;
#pragma unroll
        for (int ai = 0; ai < 2; ++ai)
#pragma unroll
            for (int m = 0; m < 4; ++m) { bf16_t* rowp = O + (size_t)(row0 + ai * HALF + m * 16) * ldc + col0;
                const f32x4 g0 = acc[ai][0][m][0], g1 = acc[ai][0][m][1], u0 = acc[ai][1][m][0], u1 = acc[ai][1][m][1];
                u32x4 w;
                w.x = cvt_pk_bf16(silu_f(g0[0]) * u0[0], silu_f(g0[1]) * u0[1]); w.y = cvt_pk_bf16(silu_f(g0[2]) * u0[2], silu_f(g0[3]) * u0[3]);
                w.z = cvt_pk_bf16(silu_f(g1[0]) * u1[0], silu_f(g1[1]) * u1[1]); w.w = cvt_pk_bf16(silu_f(g1[2]) * u1[2], silu_f(g1[3]) * u1[3]);
                *(u32x4*)rowp = w; }
    }
};
template <class Epi, class Sched, bool ALIGN_EPI = false, bool SP2 = false>
__device__ __forceinline__ void gemm_phase(PG8_LAS unsigned char* lds, const Gemm g, const Sched& S, const Epi& E, int tid_in) {
    int tid_ = tid_in; asm volatile("" : "+v"(tid_));
    const int tid = tid_, wid = __builtin_amdgcn_readfirstlane(tid >> 6), lane = tid & 63, wr = wid >> 2, wc = wid & 3, fr = lane & 15, fq = lane >> 4;
    const int K = g.K, nt = g.Ksub / BK; const size_t koff = (size_t)g.Ksub * 2;
    unsigned voffA[2], voffB[2];
#pragma unroll
    for (int i = 0; i < 2; ++i) { int R, C; stage_rc(tid * 16 + i * 8192, R, C); const int Rb = Epi::PERM ? ((R & ~31) + perm32(R & 31)) : R;
        voffA[i] = (unsigned)(R * K + C) * 2u; voffB[i] = (unsigned)(Rb * K + C) * 2u; }
    const size_t kstep = (size_t)(BK * 2);
    const size_t hstep = (size_t)HALF * K * 2;
    const size_t tstep = 2 * hstep;
    const unsigned ldsw = (unsigned)wid * 1024u;
    const int aoff = lds_byte(wr * 64 + fr, fq * 8), boff = lds_byte(wc * 32 + fr, fq * 8);
#define PG8_SA(b, h) (((b) * 2 + (h)) * HTB)
#define PG8_SB(b, h) ((4 + (b) * 2 + (h)) * HTB)
#define PG8_STAGE(bufoff, gbase, voff) do { _Pragma("unroll") for (int _i = 0; _i < 2; ++_i) \
        __builtin_amdgcn_global_load_lds((const unsigned*)((const char*)(gbase) + (voff)[_i]), (PG8_LAS unsigned*)(lds + (bufoff) + ldsw + _i * 8192), 16, 0, 0); } while (0)
#define PG8_LDA(dst, b, h) do { _Pragma("unroll") for (int m = 0; m < 4; ++m) _Pragma("unroll") for (int k = 0; k < 2; ++k) dst[m][k] = *(const PG8_LAS bf16x8*)(lds + PG8_SA(b, h) + aoff + m * 2048 + k * 1024); } while (0)
#define PG8_LDB(dst, b, h) do { _Pragma("unroll") for (int n = 0; n < 2; ++n) _Pragma("unroll") for (int k = 0; k < 2; ++k) dst[n][k] = *(const PG8_LAS bf16x8*)(lds + PG8_SB(b, h) + boff + n * 2048 + k * 1024); } while (0)
#define PG8_MMA(ai, bj, At, Bt) do { __builtin_amdgcn_s_setprio(1); _Pragma("unroll") for (int m = 0; m < 4; ++m) _Pragma("unroll") for (int n = 0; n < 2; ++n) _Pragma("unroll") for (int k = 0; k < 2; ++k) \
        acc[ai][bj][m][n] = __builtin_amdgcn_mfma_f32_16x16x32_bf16(Bt[n][k], At[m][k], acc[ai][bj][m][n], 0, 0, 0); __builtin_amdgcn_s_setprio(0); } while (0)
#define PG8_WAIT_V(n) asm volatile("s_waitcnt vmcnt(" #n ")" ::: "memory")
#define PG8_WAIT_L(n) asm volatile("s_waitcnt lgkmcnt(" #n ")" ::: "memory")
#define PG8_BAR __builtin_amdgcn_s_barrier()
#define PG8_SCHED __builtin_amdgcn_sched_barrier(0)
    Unit cur, nxt; int ui = 0;
    if (!S.next(0, cur)) return;
    f32x4 acc[2][2][4][2];
#pragma unroll
    for (int a = 0; a < 2; ++a)
#pragma unroll
        for (int b = 0; b < 2; ++b)
#pragma unroll
            for (int m = 0; m < 4; ++m)
#pragma unroll
                for (int n = 0; n < 2; ++n) acc[a][b][m][n] = (f32x4){0.f, 0.f, 0.f, 0.f};
    bf16x8 At[4][2], B0[2][2], B1[2][2];
    const char* cA = (const char*)g.A + (size_t)cur.pm * tstep + cur.pk * koff; const char* cB = (const char*)g.Bt + (size_t)cur.pn * tstep + cur.pk * koff;
    S.a_ready(cur);
    if constexpr (SP2) {
        PG8_STAGE(PG8_SB(0, 0), cB, voffB); PG8_STAGE(PG8_SB(0, 1), cB + hstep, voffB); PG8_STAGE(PG8_SA(0, 0), cA, voffA); PG8_STAGE(PG8_SA(0, 1), cA + hstep, voffA);
        if (wr == 1) PG8_BAR;
        PG8_WAIT_V(2); PG8_BAR;
        PG8_STAGE(PG8_SB(1, 0), cB + kstep, voffB); PG8_STAGE(PG8_SA(1, 0), cA + kstep, voffA); PG8_STAGE(PG8_SB(1, 1), cB + hstep + kstep, voffB);
        PG8_WAIT_V(6); PG8_BAR;
    } else {
        PG8_STAGE(PG8_SB(0, 0), cB, voffB); PG8_STAGE(PG8_SA(0, 0), cA, voffA); PG8_STAGE(PG8_SB(0, 1), cB + hstep, voffB); PG8_STAGE(PG8_SA(0, 1), cA + hstep, voffA);
        if (wr == 1) PG8_BAR;
        PG8_WAIT_V(4); PG8_BAR;
        PG8_STAGE(PG8_SB(1, 0), cB + kstep, voffB); PG8_STAGE(PG8_SA(1, 0), cA + kstep, voffA); PG8_STAGE(PG8_SB(1, 1), cB + hstep + kstep, voffB);
        PG8_WAIT_V(6); PG8_BAR;
    }
    for (;;) {
        const bool has_next = S.next(ui + 1, nxt);
        const char* nA = has_next ? (const char*)g.A + (size_t)nxt.pm * tstep + nxt.pk * koff : cA; const char* nB = has_next ? (const char*)g.Bt + (size_t)nxt.pn * tstep + nxt.pk * koff : cB;
        for (int t = 0; t < nt; t += 2) {
            const bool last = (t == nt - 2);
            const char* a1 = cA + (size_t)(t + 1) * kstep;
            const char* a2 = last ? nA : cA + (size_t)(t + 2) * kstep; const char* b2 = last ? nB : cB + (size_t)(t + 2) * kstep;
            const char* a3 = a2 + kstep; const char* b3 = b2 + kstep;
            if (last && has_next) S.a_ready(nxt);
            if constexpr (SP2) {
            PG8_LDB(B0, 0, 0); PG8_LDB(B1, 0, 1); PG8_SCHED; PG8_LDA(At, 0, 0); PG8_STAGE(PG8_SA(1, 1), a1 + hstep, voffA);
            PG8_WAIT_V(8); PG8_WAIT_L(0); PG8_BAR; PG8_MMA(0, 0, At, B0); PG8_MMA(0, 1, At, B1); PG8_BAR; PG8_SCHED;
            PG8_LDA(At, 0, 1); PG8_STAGE(PG8_SB(0, 0), b2, voffB); PG8_STAGE(PG8_SB(0, 1), b2 + hstep, voffB); PG8_STAGE(PG8_SA(0, 0), a2, voffA);
            PG8_WAIT_V(8); PG8_WAIT_L(0); PG8_BAR; PG8_MMA(1, 0, At, B0); PG8_MMA(1, 1, At, B1); PG8_BAR; PG8_SCHED;
            PG8_LDB(B0, 1, 0); PG8_LDB(B1, 1, 1); PG8_SCHED; PG8_LDA(At, 1, 0); PG8_STAGE(PG8_SA(0, 1), a2 + hstep, voffA);
            PG8_WAIT_V(8); PG8_WAIT_L(0); PG8_BAR; PG8_MMA(0, 0, At, B0); PG8_MMA(0, 1, At, B1); PG8_BAR; PG8_SCHED;
            PG8_LDA(At, 1, 1); PG8_STAGE(PG8_SB(1, 0), b3, voffB); PG8_STAGE(PG8_SB(1, 1), b3 + hstep, voffB); PG8_STAGE(PG8_SA(1, 0), a3, voffA);
            PG8_WAIT_V(8); PG8_WAIT_L(0); PG8_BAR; PG8_MMA(1, 0, At, B0); PG8_MMA(1, 1, At, B1); PG8_BAR; PG8_SCHED;
            } else {
            PG8_LDB(B0, 0, 0); PG8_SCHED; PG8_LDA(At, 0, 0); PG8_STAGE(PG8_SA(1, 1), a1 + hstep, voffA);
            PG8_WAIT_L(8); PG8_BAR; PG8_WAIT_L(0); PG8_MMA(0, 0, At, B0); PG8_BAR; PG8_SCHED;
            PG8_LDB(B1, 0, 1); PG8_STAGE(PG8_SB(0, 0), b2, voffB);
            PG8_BAR; PG8_WAIT_L(0); PG8_MMA(0, 1, At, B1); PG8_BAR;
            PG8_LDA(At, 0, 1); PG8_STAGE(PG8_SA(0, 0), a2, voffA);
            PG8_BAR; PG8_WAIT_L(0); PG8_MMA(1, 0, At, B0); PG8_BAR; PG8_SCHED;
            PG8_STAGE(PG8_SB(0, 1), b2 + hstep, voffB);
            PG8_WAIT_V(6); PG8_BAR; PG8_MMA(1, 1, At, B1); PG8_BAR;
            PG8_LDB(B0, 1, 0); PG8_SCHED; PG8_LDA(At, 1, 0); PG8_STAGE(PG8_SA(0, 1), a2 + hstep, voffA);
            PG8_WAIT_L(8); PG8_BAR; PG8_WAIT_L(0); PG8_MMA(0, 0, At, B0); PG8_BAR; PG8_SCHED;
            PG8_LDB(B1, 1, 1); PG8_STAGE(PG8_SB(1, 0), b3, voffB);
            PG8_BAR; PG8_WAIT_L(0); PG8_MMA(0, 1, At, B1); PG8_BAR;
            PG8_LDA(At, 1, 1); PG8_STAGE(PG8_SA(1, 0), a3, voffA);
            PG8_BAR; PG8_WAIT_L(0); PG8_MMA(1, 0, At, B0); PG8_BAR; PG8_SCHED;
            PG8_STAGE(PG8_SB(1, 1), b3 + hstep, voffB);
            PG8_WAIT_V(6); PG8_BAR; PG8_MMA(1, 1, At, B1); PG8_BAR;
            }
        }
        if constexpr (ALIGN_EPI) { if (wr == 0) PG8_BAR; }
        if constexpr (!Epi::AFTER_DRAIN) { E(acc, cur, wr, wc, fr, fq); S.done(cur); }
        if (!has_next) break;
#pragma unroll
        for (int a = 0; a < 2; ++a)
#pragma unroll
            for (int b = 0; b < 2; ++b)
#pragma unroll
                for (int m = 0; m < 4; ++m)
#pragma unroll
                    for (int n = 0; n < 2; ++n) acc[a][b][m][n] = (f32x4){0.f, 0.f, 0.f, 0.f};
        cur = nxt; cA = nA; cB = nB; ++ui;
        if constexpr (ALIGN_EPI) { if (wr == 1) PG8_BAR; }
    }
    PG8_WAIT_V(0);
    if constexpr (!ALIGN_EPI) { if (wr == 0) PG8_BAR; }
    PG8_BAR;
    if constexpr (Epi::AFTER_DRAIN) { E.fused(acc, cur, wr, wc, fr, fq, lds, wid, lane); S.done(cur); }
#undef PG8_SA
#undef PG8_SB
#undef PG8_STAGE
#undef PG8_LDA
#undef PG8_LDB
#undef PG8_MMA
#undef PG8_WAIT_V
#undef PG8_WAIT_L
#undef PG8_BAR
#undef PG8_SCHED
}
}
#define GAS __attribute__((address_space(1)))
#define LAS __attribute__((address_space(3)))
typedef unsigned short bf16;
typedef unsigned v4u __attribute__((ext_vector_type(4)));
typedef float f32x4 __attribute__((ext_vector_type(4)));
typedef short bf16x8 __attribute__((ext_vector_type(8)));
typedef GAS unsigned gu32;
typedef GAS unsigned long long gu64;
#define RLX_AGENT __ATOMIC_RELAXED, __HIP_MEMORY_SCOPE_AGENT
#define LDS_WAIT() asm volatile("s_waitcnt lgkmcnt(0)" ::: "memory")
#define VM_WAIT() asm volatile("s_waitcnt vmcnt(0)" ::: "memory")
__device__ __forceinline__ unsigned long long rt() { return __builtin_amdgcn_s_memrealtime(); }
__device__ __forceinline__ unsigned f2bf(float f) { unsigned u = __builtin_bit_cast(unsigned, f); return (u + 0x7fffu + ((u >> 16) & 1u)) >> 16; }
__device__ __forceinline__ unsigned pk2(float lo, float hi) { return f2bf(lo) | (f2bf(hi) << 16); }

#define XB_TMO      128
#define XB_XCNT(j)  (256  + 64 * (j))
#define XB_XSUB(j)  (1280 + 64 * (j))
#define XB_XGEN(j)  (2304 + 64 * (j))
#define XB_TOP      3328
#define XB_TOPGEN   3392
#define XCD_BAR_WORDS 3456
#define XB_SPIN_CAP (1u << 18)

__device__ __forceinline__ unsigned xb_ld(unsigned* p)              { return __hip_atomic_load(p, __ATOMIC_RELAXED, __HIP_MEMORY_SCOPE_AGENT); }
__device__ __forceinline__ unsigned xb_add(unsigned* p, unsigned v) { return __hip_atomic_fetch_add(p, v, __ATOMIC_RELAXED, __HIP_MEMORY_SCOPE_AGENT); }
__device__ __forceinline__ unsigned xb_xcc_id() { return (unsigned)__builtin_amdgcn_s_getreg((3 << 11) | 20) & 0xFu; }
#define XB_SPIN(cond, bar) do { unsigned _sp = 0; while (cond) { __builtin_amdgcn_s_sleep(1); \
    if ((++_sp & 255u) == 0u) { if (xb_ld(&(bar)[XB_TMO])) break; if (_sp > XB_SPIN_CAP) { atomicAdd(&(bar)[XB_TMO], 1u); break; } } } } while (0)

struct XcdBarrier {
    unsigned* bar; unsigned x;
    volatile LAS unsigned* st;
};

__device__ __forceinline__ XcdBarrier xcd_barrier_post(unsigned* bar, volatile LAS unsigned* st, bool leader) {
    XcdBarrier b; b.bar = bar; b.x = xb_xcc_id(); b.st = st;
    if (leader) (void)xb_add(&bar[XB_XCNT(b.x)], 1u);
    return b;
}
__device__ __forceinline__ void xcd_barrier_complete(unsigned* bar, unsigned x, unsigned& nloc, unsigned& nx) {
    const unsigned G = gridDim.x * gridDim.y * gridDim.z;
    unsigned sum, cnt, mine, sp = 0u;
    for (;;) {
        sum = 0u; cnt = 0u; mine = 0u;
#pragma unroll
        for (unsigned j = 0; j < 16; ++j) { const unsigned c = xb_ld(&bar[XB_XCNT(j)]); sum += c; cnt += (c > 0u) ? 1u : 0u; mine = (j == x) ? c : mine; }
        if (sum == G) break;
        __builtin_amdgcn_s_sleep(1);
        if ((++sp & 255u) == 0u) { if (xb_ld(&bar[XB_TMO])) break; if (sp > XB_SPIN_CAP) { atomicAdd(&bar[XB_TMO], 1u); break; } }
    }
    nloc = mine > 0u ? mine : 1u; nx = cnt > 0u ? cnt : 1u;
}

__device__ __forceinline__ void xcd_barrier(const XcdBarrier& b, bool leader) {
    asm volatile("s_waitcnt vmcnt(0)" ::: "memory");
    __syncthreads();
    if (leader) {
        unsigned* bar = b.bar;
        __builtin_amdgcn_s_waitcnt(0);
        unsigned nloc = b.st[0], nx = b.st[1];
        if (nloc == 0u) { xcd_barrier_complete(bar, b.x, nloc, nx); b.st[0] = nloc; b.st[1] = nx; }
        const unsigned old = xb_add(&bar[XB_XSUB(b.x)], 1u);
        const unsigned gen = old / nloc;
        if (old + 1u == (gen + 1u) * nloc) {
            __builtin_amdgcn_fence(__ATOMIC_RELEASE, "agent");
            asm volatile("s_waitcnt vmcnt(0)" ::: "memory");
            const unsigned og = xb_add(&bar[XB_TOP], 1u);
            const unsigned tg = og / nx;
            if (og + 1u == (tg + 1u) * nx) xb_add(&bar[XB_TOPGEN], 1u);
            else XB_SPIN(xb_ld(&bar[XB_TOPGEN]) == tg, bar);
            __builtin_amdgcn_fence(__ATOMIC_ACQUIRE, "agent");
            xb_add(&bar[XB_XGEN(b.x)], 1u);
            asm volatile("s_waitcnt vmcnt(0)" ::: "memory");
        } else {
            XB_SPIN(xb_ld(&bar[XB_XGEN(b.x)]) == gen, bar);
            __builtin_amdgcn_fence(__ATOMIC_ACQUIRE, "agent");
            asm volatile("s_waitcnt vmcnt(0)" ::: "memory");
        }
    }
    __syncthreads();
}

constexpr int NWAVES = 8, NTHR = 512;
constexpr int DM = 2048, MROWS = 12288, DEPTH = 4;
constexpr int INC = 5152, INP = 5376, FF = 5632, GU = 11264;
constexpr int NMOD = 6 * DM;
constexpr float EPS = 1e-6f;
constexpr int PC_QA = 0, PC_KA = 512, PC_VA = 768, PC_QD = 1024, PC_KD = 1536, PC_VD = 2048, PC_Z = 2560, PC_XBC = 3584, PC_DT = 5120;
constexpr int RC_QA = 0, RC_KA = 512, RC_QD = 768, RC_KD = 1280, RCW = 1792;
constexpr size_t OUT_AK = 25165824, OUT_AV = OUT_AK + 4194304, OUT_DK = OUT_AV + 4194304, OUT_DV = OUT_DK + 8388608, OUT_SF = OUT_DV + 8388608, OUT_SB = OUT_SF + 8388608;
constexpr size_t MiB = 1u << 20;
constexpr size_t WS_CTL = 0, CTL_ZERO_BYTES = 1 * MiB;
constexpr size_t WS_TAB = 1 * MiB, WS_MOD = 2 * MiB, WS_MODP = 3 * MiB;
constexpr size_t WS_WIN = 8 * MiB, WS_WOUT = 92 * MiB, WS_WGU = 124 * MiB, WS_WDN = 300 * MiB;
constexpr size_t WS_H = 388 * MiB, WS_U = 484 * MiB, WS_P = 532 * MiB, WS_MIX = 658 * MiB, WS_ACT = 706 * MiB, WS_QKR = 838 * MiB;
constexpr size_t WS_XBC = 866 * MiB, WS_DT = 938 * MiB, WS_YF = 940 * MiB, WS_YB = 988 * MiB, WS_ST = 1036 * MiB, WS_EDEC = 1132 * MiB, WS_CDEC = 1134 * MiB, WS_SSQ = 1135 * MiB, WS_END = 1136 * MiB;
constexpr int CW_BAR = 4096;
constexpr int RING_BYTES = 131072, LDSCTL_OFF = RING_BYTES, MISC_OFF = LDSCTL_OFF + 320, LDS_BYTES = 147456;

struct Params { const float* in[28]; float* out; unsigned char* ws; int ph_lo, ph_hi; };
typedef __attribute__((address_space(4))) const Params* PP;
struct Frame { LAS unsigned char* lds; int tid, lane, wave, vcu, G; };

template <int M> __device__ __forceinline__ float xor_lt32(float v) { return __builtin_bit_cast(float, __builtin_amdgcn_ds_swizzle(__builtin_bit_cast(int, v), 0x1F | (M << 10))); }
__device__ __forceinline__ float half_sum(float v) { const unsigned u = __builtin_bit_cast(unsigned, v); auto r = __builtin_amdgcn_permlane32_swap(u, u, false, false); return __builtin_bit_cast(float, (unsigned)r[0]) + __builtin_bit_cast(float, (unsigned)r[1]); }
__device__ __forceinline__ float half_max(float v) { const unsigned u = __builtin_bit_cast(unsigned, v); auto r = __builtin_amdgcn_permlane32_swap(u, u, false, false); return fmaxf(__builtin_bit_cast(float, (unsigned)r[0]), __builtin_bit_cast(float, (unsigned)r[1])); }
__device__ __forceinline__ float bperm(float v, int srclane) { return __builtin_bit_cast(float, __builtin_amdgcn_ds_bpermute(srclane << 2, __builtin_bit_cast(int, v))); }
__device__ __forceinline__ float wave_sum(float v) { v += xor_lt32<1>(v); v += xor_lt32<2>(v); v += xor_lt32<4>(v); v += xor_lt32<8>(v); v += xor_lt32<16>(v); return half_sum(v); }
__device__ __forceinline__ float wave_max(float v) { v = fmaxf(v, xor_lt32<1>(v)); v = fmaxf(v, xor_lt32<2>(v)); v = fmaxf(v, xor_lt32<4>(v)); v = fmaxf(v, xor_lt32<8>(v)); v = fmaxf(v, xor_lt32<16>(v)); return half_max(v); }
__device__ __forceinline__ float bflo(unsigned w) { return __uint_as_float(w << 16); }
__device__ __forceinline__ float bfhi(unsigned w) { return __uint_as_float(w & 0xffff0000u); }
__device__ __forceinline__ float bf1(bf16 b) { return __uint_as_float((unsigned)b << 16); }
__device__ __forceinline__ float silu(float x) { return x / (1.0f + __expf(-x)); }

__device__ __forceinline__ void p0_transpose_item(const float* W, int K, int N, bf16* WT, int rowmap, LAS float* scr, int item, int lane) {
    const int nblk = N / 32, kb = item / nblk, nb = item % nblk, k0 = 64 * kb, n0 = 32 * nb;
    { float t[32]; const float* src = W + (size_t)(k0 + (lane >> 5)) * N + n0 + (lane & 31);
#pragma unroll
      for (int i = 0; i < 32; ++i) t[i] = src[(size_t)(2 * i) * N];
#pragma unroll
      for (int i = 0; i < 32; ++i) scr[(2 * i + (lane >> 5)) * 33 + (lane & 31)] = t[i]; }
    LDS_WAIT(); asm volatile("" ::: "memory");
    int r0 = n0;
    if (rowmap) r0 = (n0 < FF) ? ((n0 >> 7) * 256 + (n0 & 127)) : (((n0 - FF) >> 7) * 256 + 128 + ((n0 - FF) & 127));
    const int c = lane & 7;
#pragma unroll
    for (int j = 0; j < 4; ++j) { const int n = (lane >> 3) + 8 * j; const LAS float* s = scr + (8 * c) * 33 + n;
        v4u o; o.x = pk2(s[0 * 33], s[1 * 33]); o.y = pk2(s[2 * 33], s[3 * 33]); o.z = pk2(s[4 * 33], s[5 * 33]); o.w = pk2(s[6 * 33], s[7 * 33]);
        *(v4u*)(WT + (size_t)(r0 + n) * K + k0 + 8 * c) = o; }
    LDS_WAIT(); asm volatile("" ::: "memory");
}
__device__ __forceinline__ void conv_layer(Frame& F, PP p, int l, int wi, int nw) {
    unsigned char* ws = p->ws;
    LAS float* scr = (LAS float*)(F.lds + F.wave * 16384);
    constexpr int I_IN = 32 * (INC / 32), I_OUT = 32 * 64, I_GU = 32 * (GU / 32), I_DN = (FF / 64) * 64, I_L = I_IN + I_OUT + I_GU + I_DN;
    for (int it = wi; it < I_L; it += nw) {
        int r = it;
        if (r < I_IN) { p0_transpose_item(p->in[14] + (size_t)l * DM * INC, DM, INC, (bf16*)(ws + WS_WIN) + (size_t)l * INP * DM, 0, scr, r, F.lane); continue; } r -= I_IN;
        if (r < I_OUT) { p0_transpose_item(p->in[24] + (size_t)l * DM * DM, DM, DM, (bf16*)(ws + WS_WOUT) + (size_t)l * DM * DM, 0, scr, r, F.lane); continue; } r -= I_OUT;
        if (r < I_GU) { p0_transpose_item(p->in[25] + (size_t)l * DM * GU, DM, GU, (bf16*)(ws + WS_WGU) + (size_t)l * GU * DM, 1, scr, r, F.lane); continue; } r -= I_GU;
        p0_transpose_item(p->in[26] + (size_t)l * FF * DM, FF, DM, (bf16*)(ws + WS_WDN) + (size_t)l * DM * FF, 0, scr, r, F.lane);
    }
    constexpr int PADV = (INP - INC) * DM * 2 / 16;
    for (int i = wi * 64 + F.lane; i < PADV; i += nw * 64) *((v4u*)((bf16*)(ws + WS_WIN) + (size_t)l * INP * DM + (size_t)INC * DM) + i) = (v4u){0u, 0u, 0u, 0u};
}
__device__ __forceinline__ void adaln_layer(Frame& F, PP p, int l, int bi, int nb) {
    LAS float* sc = (LAS float*)F.lds;
    float* MODP = (float*)(p->ws + WS_MODP);
    for (int it = bi; it < 8 * 24; it += nb) {
        const int kc = it / 24, nc = it % 24;
        __syncthreads();
        if (F.tid < 256) { const int k = kc * 256 + F.tid; sc[F.tid] = silu(p->in[9][k]); sc[256 + F.tid] = silu(p->in[8][k]); sc[512 + F.tid] = silu(p->in[8][DM + k]); }
        __syncthreads();
        const int n = nc * 512 + F.tid;
        const float* w = p->in[10] + ((size_t)l * DM + (size_t)kc * 256) * NMOD + n;
        float a0 = 0.f, a1 = 0.f, a2 = 0.f;
        for (int k = 0; k < 256; k += 32) {
            float wv[32];
#pragma unroll
            for (int e = 0; e < 32; ++e) wv[e] = w[(size_t)(k + e) * NMOD];
#pragma unroll
            for (int e = 0; e < 32; ++e) { a0 += sc[k + e] * wv[e]; a1 += sc[256 + k + e] * wv[e]; a2 += sc[512 + k + e] * wv[e]; }
        }
        float* o = MODP + ((size_t)(kc * DEPTH + l) * 3) * NMOD + n;
        o[0] = a0; o[NMOD] = a1; o[2 * NMOD] = a2;
    }
    __syncthreads();
}
__device__ __forceinline__ void mod_layer(PP p, int l, int gt, int ngt) {
    const float* MODP = (const float*)(p->ws + WS_MODP); float* MOD = (float*)(p->ws + WS_MOD);
    for (int i = gt; i < 3 * NMOD; i += ngt) {
        const int n = i % NMOD; const int gi = l * 3 * NMOD + i;
        float s = p->in[11][l * NMOD + n];
#pragma unroll
        for (int kc = 0; kc < 8; ++kc) s += MODP[(size_t)kc * DEPTH * 3 * NMOD + gi];
        MOD[gi] = s;
    }
}
__device__ __forceinline__ void p0_prologue(Frame& F, PP p) {
    unsigned char* ws = p->ws;
    conv_layer(F, p, 0, F.vcu * NWAVES + F.wave, F.G * NWAVES);
    adaln_layer(F, p, 0, blockIdx.x, F.G);
    if (blockIdx.x == F.G - 1) {
        float2* tabA = (float2*)(ws + WS_TAB); float2* tabB = (float2*)(ws + WS_TAB + 16384); float* lam = (float*)(ws + WS_TAB + 32768);
        for (int i = F.tid; i < 2048 + 1024; i += NTHR) {
            const bool isA = i < 2048; const int j = isA ? i : i - 2048; const int pos = isA ? (j >> 5) : (j >> 4), k = isA ? (j & 31) : (j & 15);
            double r = 10000.0; r = sqrt(r); r = sqrt(r); r = sqrt(r); r = sqrt(r); if (isA) r = sqrt(r);
            const double ri = 1.0 / r; double inv = 1.0; for (int q = 0; q < k; ++q) inv *= ri;
            const double ang = (double)pos * inv; const double TWO_PI = 6.283185307179586476925;
            const double x = ang - TWO_PI * rint(ang / TWO_PI), x2 = x * x;
            double st = x, ss = x, ct = 1.0, cs = 1.0;
            for (int q = 1; q <= 16; ++q) { st *= -x2 / (double)((2 * q) * (2 * q + 1)); ss += st; ct *= -x2 / (double)((2 * q - 1) * (2 * q)); cs += ct; }
            const float2 v = make_float2((float)cs, (float)ss);
            if (isA) tabA[j] = v; else tabB[j] = v;
        }
        if (F.tid < DEPTH) {
            const float* lv = p->in[16] + F.tid * 256; float s01 = 0.f, s23 = 0.f;
            for (int i = 0; i < 64; ++i) { s01 += lv[i] * lv[64 + i]; s23 += lv[128 + i] * lv[192 + i]; }
            const float li = 0.8f - 0.6f * expf(-0.3f * (float)F.tid);
            lam[F.tid] = expf(s01) - expf(s23) + li; lam[4 + F.tid] = li;
        }
    }
}
__device__ __forceinline__ void norm_phase(Frame& F, const float* H0, const float* H1, const float* g, const float* modl, int shoff, int scoff, bf16* U) {
    const int gw = F.vcu * NWAVES + F.wave, NGW = F.G * NWAVES;
    for (int m = gw; m < MROWS; m += NGW) {
        const int c = m < 4096 ? 0 : (m < 8192 ? 1 : 2);
        const float* sh = modl + c * NMOD + shoff; const float* sc = modl + c * NMOD + scoff;
        const f32x4* xr = (const f32x4*)(m < 4096 ? H0 + (size_t)m * DM : H1 + (size_t)(m - 4096) * DM) + F.lane;
        f32x4 v[8]; float ss = 0.f;
#pragma unroll
        for (int j = 0; j < 8; ++j) { v[j] = xr[64 * j]; ss += (v[j].x * v[j].x + v[j].y * v[j].y) + (v[j].z * v[j].z + v[j].w * v[j].w); }
        const float rstd = 1.0f / sqrtf(wave_sum(ss) * (1.0f / DM) + EPS);
        unsigned long long* o8 = (unsigned long long*)(U + (size_t)m * DM) + F.lane;
#pragma unroll
        for (int j = 0; j < 8; ++j) { const int col = 4 * F.lane + 256 * j;
            const f32x4 gv = *(const f32x4*)(g + col), sv = *(const f32x4*)(sc + col), hv = *(const f32x4*)(sh + col);
            const f32x4 o = (v[j] * rstd) * gv * (sv + 1.0f) + hv;
            o8[64 * j] = (unsigned long long)pk2(o.x, o.y) | ((unsigned long long)pk2(o.z, o.w) << 32); }
    }
}
__device__ __forceinline__ void final_phase(Frame& F, const float* H, const float* g, float* out) {
    const int gw = F.vcu * NWAVES + F.wave, NGW = F.G * NWAVES;
    for (int m = gw; m < MROWS; m += NGW) {
        const f32x4* xr = (const f32x4*)(H + (size_t)m * DM) + F.lane;
        f32x4 v[8]; float ss = 0.f;
#pragma unroll
        for (int j = 0; j < 8; ++j) { v[j] = xr[64 * j]; ss += (v[j].x * v[j].x + v[j].y * v[j].y) + (v[j].z * v[j].z + v[j].w * v[j].w); }
        const float rstd = 1.0f / sqrtf(wave_sum(ss) * (1.0f / DM) + EPS);
        f32x4* o = (f32x4*)(out + (size_t)m * DM) + F.lane;
#pragma unroll
        for (int j = 0; j < 8; ++j) { const f32x4 gv = *(const f32x4*)(g + 4 * F.lane + 256 * j); o[64 * j] = (v[j] * rstd) * gv; }
    }
}
__device__ __forceinline__ void prep_phase(Frame& F, PP p, int l) {
    unsigned char* ws = p->ws;
    const bf16* P = (const bf16*)(ws + WS_P); bf16* QKR = (bf16*)(ws + WS_QKR); bf16* XBC = (bf16*)(ws + WS_XBC); float* DT = (float*)(ws + WS_DT);
    const float2* tabA = (const float2*)(ws + WS_TAB); const float2* tabB = (const float2*)(ws + WS_TAB + 16384);
    const float* cw = p->in[18] + (size_t)l * 5 * 1536; const float* cb = p->in[19] + (size_t)l * 1536; const float* dtb = p->in[20] + l * 32;
    const int gw = F.vcu * NWAVES + F.wave, NGW = F.G * NWAVES, lane = F.lane;
    for (int m = gw; m < MROWS; m += NGW) {
        const bf16* prow = P + (size_t)m * INP;
        const int s0 = m < 4096 ? (m & ~255) : (4096 + ((m - 4096) & ~4095)); const int len = m < 4096 ? 256 : 4096; const int t = m - s0;
#pragma unroll
        for (int j = 0; j < 3; ++j) { const int c0 = 8 * lane + 512 * j;
            f32x4 a0 = *(const f32x4*)(cb + c0), a1 = *(const f32x4*)(cb + c0 + 4);
#pragma unroll
            for (int k = 0; k < 5; ++k) { const int tt = t + k - 2;
                if (tt >= 0 && tt < len) { const v4u raw = *(const v4u*)(P + (size_t)(s0 + tt) * INP + PC_XBC + c0);
                    const f32x4 w0 = *(const f32x4*)(cw + k * 1536 + c0), w1 = *(const f32x4*)(cw + k * 1536 + c0 + 4);
                    a0.x += w0.x * bflo(raw.x); a0.y += w0.y * bfhi(raw.x); a0.z += w0.z * bflo(raw.y); a0.w += w0.w * bfhi(raw.y);
                    a1.x += w1.x * bflo(raw.z); a1.y += w1.y * bfhi(raw.z); a1.z += w1.z * bflo(raw.w); a1.w += w1.w * bfhi(raw.w); } }
            a0.x = silu(a0.x); a0.y = silu(a0.y); a0.z = silu(a0.z); a0.w = silu(a0.w); a1.x = silu(a1.x); a1.y = silu(a1.y); a1.z = silu(a1.z); a1.w = silu(a1.w);
            *(v4u*)(XBC + (size_t)m * 1536 + c0) = (v4u){pk2(a0.x, a0.y), pk2(a0.z, a0.w), pk2(a1.x, a1.y), pk2(a1.z, a1.w)}; }
        if (lane < 32) { const float v = bf1(prow[PC_DT + lane]) + dtb[lane]; DT[(size_t)m * 32 + lane] = v > 20.f ? v : log1pf(__expf(v)); }
        if (m >= 4096) {
            const int gr = t >> 6, gc = t & 63; bf16* qrow = QKR + (size_t)(m - 4096) * RCW;
#pragma unroll
            for (int i = 0; i < 6; ++i) { const int d = lane; const int src = (i < 4 ? PC_QA + i * 128 : PC_KA + (i - 4) * 128) + d, dst = (i < 4 ? RC_QA + i * 128 : RC_KA + (i - 4) * 128) + d;
                const float x1 = bf1(prow[src]), x2 = bf1(prow[src + 64]); const float2 cs = d < 32 ? tabA[gr * 32 + d] : tabA[gc * 32 + d - 32];
                qrow[dst] = (bf16)f2bf(x1 * cs.x - x2 * cs.y); qrow[dst + 64] = (bf16)f2bf(x1 * cs.y + x2 * cs.x); }
#pragma unroll
            for (int i = 0; i < 8; ++i) { const int pp = lane + 64 * i, ch = pp >> 5, d = pp & 31; const int src = (ch < 8 ? PC_QD + ch * 64 : PC_KD + (ch - 8) * 64) + d, dst = (ch < 8 ? RC_QD + ch * 64 : RC_KD + (ch - 8) * 64) + d;
                const float x1 = bf1(prow[src]), x2 = bf1(prow[src + 32]); const float2 cs = d < 16 ? tabB[gr * 16 + d] : tabB[gc * 16 + d - 16];
                qrow[dst] = (bf16)f2bf(x1 * cs.x - x2 * cs.y); qrow[dst + 32] = (bf16)f2bf(x1 * cs.y + x2 * cs.x); }
        } else {
            const int b = m >> 8, s = m & 255; const size_t r = (size_t)((b * DEPTH + l) * 256 + s);
            { const unsigned long long w = *((const unsigned long long*)(prow + PC_KA) + lane); *((f32x4*)(p->out + OUT_AK + r * 256) + lane) = (f32x4){bflo((unsigned)w), bfhi((unsigned)w), bflo((unsigned)(w >> 32)), bfhi((unsigned)(w >> 32))}; }
            { const unsigned long long w = *((const unsigned long long*)(prow + PC_VA) + lane); *((f32x4*)(p->out + OUT_AV + r * 256) + lane) = (f32x4){bflo((unsigned)w), bfhi((unsigned)w), bflo((unsigned)(w >> 32)), bfhi((unsigned)(w >> 32))}; }
            { const v4u w = *((const v4u*)(prow + PC_KD) + lane); f32x4* o = (f32x4*)(p->out + OUT_DK + r * 512) + 2 * lane; o[0] = (f32x4){bflo(w.x), bfhi(w.x), bflo(w.y), bfhi(w.y)}; o[1] = (f32x4){bflo(w.z), bfhi(w.z), bflo(w.w), bfhi(w.w)}; }
            { const v4u w = *((const v4u*)(prow + PC_VD) + lane); f32x4* o = (f32x4*)(p->out + OUT_DV + r * 512) + 2 * lane; o[0] = (f32x4){bflo(w.x), bfhi(w.x), bflo(w.y), bfhi(w.y)}; o[1] = (f32x4){bflo(w.z), bfhi(w.z), bflo(w.w), bfhi(w.w)}; }
        }
    }
}
typedef float f32x16 __attribute__((ext_vector_type(16)));
typedef short s16x4 __attribute__((ext_vector_type(4)));
constexpr int FA_KSTR = 272, FA_VSTR = 320, FA_KB = 64 * FA_KSTR, FA_VB = 64 * FA_VSTR, FA_BUF = FA_KB + FA_VB;
constexpr int FA_OSTR = 272;
struct Seg { const void* k; const void* v; int ks, vs, n, f32, pos0; };
struct FaTile { v4u k[2], v[2]; };

__device__ __forceinline__ unsigned cvtpk(float lo, float hi) { typedef float f2 __attribute__((ext_vector_type(2))); typedef __bf16 b2 __attribute__((ext_vector_type(2))); f2 v = {lo, hi}; b2 b = __builtin_convertvector(v, b2); return __builtin_bit_cast(unsigned, b); }
__device__ __forceinline__ void fa_load(FaTile& t, const Seg& sg, int key0, int tid) {
#pragma unroll
    for (int i = 0; i < 2; ++i) { const int c = tid + 512 * i, key = c >> 4, ch = c & 15;
        if (sg.f32) {
            const f32x4* ks = (const f32x4*)((const float*)sg.k + (size_t)(key0 + key) * sg.ks + ch * 8);
            const f32x4* vs = (const f32x4*)((const float*)sg.v + (size_t)(key0 + key) * sg.vs + ch * 8);
            const f32x4 a = ks[0], b = ks[1], c2 = vs[0], d = vs[1];
            t.k[i] = (v4u){cvtpk(a.x, a.y), cvtpk(a.z, a.w), cvtpk(b.x, b.y), cvtpk(b.z, b.w)};
            t.v[i] = (v4u){cvtpk(c2.x, c2.y), cvtpk(c2.z, c2.w), cvtpk(d.x, d.y), cvtpk(d.z, d.w)};
        } else {
            t.k[i] = *(const v4u*)((const bf16*)sg.k + (size_t)(key0 + key) * sg.ks + ch * 8);
            t.v[i] = *(const v4u*)((const bf16*)sg.v + (size_t)(key0 + key) * sg.vs + ch * 8);
        } }
}
__device__ __forceinline__ void fa_store(const FaTile& t, LAS unsigned char* buf, int tid) {
#pragma unroll
    for (int i = 0; i < 2; ++i) { const int c = tid + 512 * i, key = c >> 4, ch = c & 15;
        *(LAS v4u*)(buf + key * FA_KSTR + ch * 16) = t.k[i];
        *(LAS v4u*)(buf + FA_KB + key * FA_VSTR + ch * 16) = t.v[i]; }
}
template <int NKS>
__device__ __forceinline__ void fa_tile(const LAS unsigned char* buf, const bf16x8 (&q)[NKS], f32x16 (&o)[4], float& m, float& lsum, float c, int kcolb, int lane, bool masked, int dpos  ) {
    const int r32 = lane & 31, h = lane >> 5;
    f32x16 p0, p1;
#pragma unroll
    for (int r = 0; r < 16; ++r) { p0[r] = 0.f; p1[r] = 0.f; }
    const LAS unsigned char* kp = buf + r32 * FA_KSTR + kcolb + h * 16;
#pragma unroll
    for (int ks = 0; ks < NKS; ++ks) {
        const bf16x8 a0 = *(const LAS bf16x8*)(kp + ks * 32), a1 = *(const LAS bf16x8*)(kp + 32 * FA_KSTR + ks * 32);
        p0 = __builtin_amdgcn_mfma_f32_32x32x16_bf16(a0, q[ks], p0, 0, 0, 0);
        p1 = __builtin_amdgcn_mfma_f32_32x32x16_bf16(a1, q[ks], p1, 0, 0, 0);
    }
    if (masked) {
#pragma unroll
        for (int r = 0; r < 16; ++r) { const int d0 = dpos - ((r & 3) + 8 * (r >> 2) + 4 * h), d1 = d0 - 32;
            if (d0 > 128 || d0 < -128) p0[r] = -INFINITY; if (d1 > 128 || d1 < -128) p1[r] = -INFINITY; }
    }
    float mt = fmaxf(p0[0], p1[0]);
#pragma unroll
    for (int r = 1; r < 16; ++r) mt = fmaxf(mt, fmaxf(p0[r], p1[r]));
    mt = half_max(mt);
    const float mn = fmaxf(m, mt * c);
    const float alpha = __builtin_amdgcn_exp2f(m - mn);
    m = mn;
    float rs = 0.f;
#pragma unroll
    for (int r = 0; r < 16; ++r) { p0[r] = __builtin_amdgcn_exp2f(p0[r] * c - mn); p1[r] = __builtin_amdgcn_exp2f(p1[r] * c - mn); rs += p0[r] + p1[r]; }
    lsum = lsum * alpha + rs;
    if (__builtin_amdgcn_ballot_w64(alpha != 1.0f) != 0ull) {
#pragma unroll
        for (int b = 0; b < 4; ++b) o[b] = o[b] * alpha;
    }
    bf16x8 pb[4];
    { v4u w;
      w = (v4u){cvtpk(p0[0], p0[1]), cvtpk(p0[2], p0[3]), cvtpk(p0[4], p0[5]), cvtpk(p0[6], p0[7])}; pb[0] = __builtin_bit_cast(bf16x8, w);
      w = (v4u){cvtpk(p0[8], p0[9]), cvtpk(p0[10], p0[11]), cvtpk(p0[12], p0[13]), cvtpk(p0[14], p0[15])}; pb[1] = __builtin_bit_cast(bf16x8, w);
      w = (v4u){cvtpk(p1[0], p1[1]), cvtpk(p1[2], p1[3]), cvtpk(p1[4], p1[5]), cvtpk(p1[6], p1[7])}; pb[2] = __builtin_bit_cast(bf16x8, w);
      w = (v4u){cvtpk(p1[8], p1[9]), cvtpk(p1[10], p1[11]), cvtpk(p1[12], p1[13]), cvtpk(p1[14], p1[15])}; pb[3] = __builtin_bit_cast(bf16x8, w); }
    const int i16 = lane & 15, gc = (lane >> 4) & 1;
    const LAS unsigned char* vp = buf + FA_KB + (4 * h + (i16 >> 2)) * FA_VSTR + (16 * gc + 4 * (i16 & 3)) * 2;
#pragma unroll
    for (int s = 0; s < 4; ++s) {
#pragma unroll
        for (int b = 0; b < 4; ++b) {
            const s16x4 lo = __builtin_amdgcn_ds_read_tr16_b64_v4i16((LAS s16x4*)(vp + (16 * s) * FA_VSTR + b * 64));
            const s16x4 hi = __builtin_amdgcn_ds_read_tr16_b64_v4i16((LAS s16x4*)(vp + (16 * s + 8) * FA_VSTR + b * 64));
            const bf16x8 a = (bf16x8){lo[0], lo[1], lo[2], lo[3], hi[0], hi[1], hi[2], hi[3]};
            o[b] = __builtin_amdgcn_mfma_f32_32x32x16_bf16(a, pb[s], o[b], 0, 0, 0);
        }
        __builtin_amdgcn_sched_barrier(0);
    }
}
template <int MODE>
__device__ __forceinline__ void fa_unit(Frame& F, const bf16* qg, int qstride, const Seg& s0, const Seg& s1, bool two, int qpos0, float c, const float* sinkp, float lam, float onems, const float* dnorm, bf16* dst, int dstride) {
    constexpr int NKS = MODE == 0 ? 8 : 4;
    int tid_ = F.tid; asm volatile("" : "+v"(tid_));
    const int tid = tid_, lane = tid & 63, w = F.wave, r32 = lane & 31, h = lane >> 5, grp = w >> 2, qrow0 = (w & 3) * 32;
    const int kcolb = MODE == 0 ? 0 : grp * 128;
    qg += (MODE == 0 ? grp * 128 : grp * 64); if (MODE == 0) dst += grp * 128;
    bf16x8 q[NKS];
#pragma unroll
    for (int ks = 0; ks < NKS; ++ks) q[ks] = *(const bf16x8*)(qg + (size_t)(qrow0 + r32) * qstride + ks * 16 + h * 8);
    f32x16 o[4];
#pragma unroll
    for (int b = 0; b < 4; ++b)
#pragma unroll
        for (int r = 0; r < 16; ++r) o[b][r] = 0.f;
    float m = -INFINITY, lsum = 0.f;
    const int nt0 = s0.n >> 6, nt = nt0 + (two ? (s1.n >> 6) : 0);
    FaTile t;
    __syncthreads();
    fa_load(t, s0, 0, tid); fa_store(t, F.lds, tid);
    __syncthreads();
    for (int it = 0; it < nt; ++it) {
        const bool more = it + 1 < nt;
        if (more) { const int n = it + 1; if (n < nt0) fa_load(t, s0, n * 64, tid); else fa_load(t, s1, (n - nt0) * 64, tid); }
        const bool inseg1 = it >= nt0; const int pos0 = inseg1 ? s1.pos0 : s0.pos0; const int key0 = (inseg1 ? it - nt0 : it) * 64;
        fa_tile<NKS>(F.lds + (it & 1) * FA_BUF, q, o, m, lsum, c, kcolb, lane, pos0 >= 0, (qpos0 + qrow0 + r32) - (pos0 + key0));
        if (more) fa_store(t, F.lds + ((it + 1) & 1) * FA_BUF, tid);
        __syncthreads();
    }
    const float ltot = half_sum(lsum);
    if (MODE == 0) {
        const float inv = 1.0f / (ltot + __builtin_amdgcn_exp2f(sinkp[grp] * 1.4426950408889634f - m));
#pragma unroll
        for (int b = 0; b < 4; ++b) o[b] = o[b] * inv;
    } else {
        LAS float* comb = (LAS float*)(F.lds + (w & 3) * 16384);
        if (grp == 1) { const float f = lam / ltot;
#pragma unroll
            for (int b = 0; b < 4; ++b)
#pragma unroll
                for (int r = 0; r < 16; ++r) comb[(32 * b + (r & 3) + 8 * (r >> 2) + 4 * h) * 32 + r32] = o[b][r] * f; }
        __syncthreads();
        if (grp == 0) { const float inv = 1.0f / ltot; float ss = 0.f;
#pragma unroll
            for (int b = 0; b < 4; ++b)
#pragma unroll
                for (int r = 0; r < 16; ++r) { const float v = o[b][r] * inv - comb[(32 * b + (r & 3) + 8 * (r >> 2) + 4 * h) * 32 + r32]; o[b][r] = v; ss += v * v; }
            ss = half_sum(ss);
            const float rs = onems / sqrtf(ss * (1.0f / 128.0f) + EPS);
#pragma unroll
            for (int b = 0; b < 4; ++b)
#pragma unroll
                for (int r = 0; r < 16; ++r) o[b][r] = o[b][r] * rs * dnorm[32 * b + (r & 3) + 8 * (r >> 2) + 4 * h]; }
    }
    if (MODE == 0 || grp == 0) {
        LAS unsigned char* st = F.lds + (MODE == 0 ? w * (32 * FA_OSTR) : 65536 + (w & 3) * (32 * FA_OSTR));
#pragma unroll
        for (int b = 0; b < 4; ++b)
#pragma unroll
            for (int k = 0; k < 4; ++k) { typedef unsigned u2 __attribute__((ext_vector_type(2)));
                *(LAS u2*)(st + r32 * FA_OSTR + (32 * b + 8 * k + 4 * h) * 2) = (u2){cvtpk(o[b][4 * k], o[b][4 * k + 1]), cvtpk(o[b][4 * k + 2], o[b][4 * k + 3])}; }
        asm volatile("s_waitcnt lgkmcnt(0)" ::: "memory");
#pragma unroll
        for (int i = 0; i < 8; ++i) { const int cc = lane + 64 * i, row = cc >> 4, c16 = cc & 15;
            *(v4u*)(dst + (size_t)(qrow0 + row) * dstride + c16 * 8) = *(const LAS v4u*)(st + row * FA_OSTR + c16 * 16); }
    }
}
constexpr int NCHUNK = 96;
constexpr int S1_CSTR = 272, S1_XSTR = 160;
constexpr int S3_CM = 0, S3_BM = 34816, S3_XM = 69632, S3_TAB = 90112, S3_SSP = 92160;
constexpr int S1_BM = 0, S1_XM = 34816, S1_TAB = 55296;
#define LBAR() asm volatile("s_waitcnt lgkmcnt(0)\n\ts_barrier" ::: "memory")
__device__ __forceinline__ int crow16(int r, int h) { return (r & 3) + 8 * (r >> 2) + 4 * h; }

struct S1Pre { v4u b[4], x[2]; float dt, al; };
__device__ __forceinline__ void s1_load(S1Pre& q, const bf16* XB, const float* DT, const float* alog, int u, int tid, int wave) {
    const int cc = u >> 4, hd = u & 15, m0 = cc * 128, g = hd >> 3;
    const unsigned offB = (unsigned)((tid >> 4) * 1536 + (tid & 15) * 8) * 2u, offX = (unsigned)((tid >> 3) * 1536 + (tid & 7) * 8) * 2u;
#pragma unroll
    for (int i = 0; i < 4; ++i) { const char* bs = (const char*)(XB + (size_t)(m0 + 32 * i) * 1536 + 1024 + g * 128); q.b[i] = *(const v4u*)(bs + offB); }
#pragma unroll
    for (int i = 0; i < 2; ++i) { const char* xs = (const char*)(XB + (size_t)(m0 + 64 * i) * 1536 + hd * 64); q.x[i] = *(const v4u*)(xs + offX); }
    q.dt = *(const float*)((const char*)(DT + (size_t)m0 * 32 + hd) + (unsigned)((tid & 127) * 32 + ((tid >> 7) & 1) * 16) * 4u);
    q.al = alog[(wave & 1) * 16 + hd];
}
__device__ __forceinline__ void s1_store(const S1Pre& q, LAS unsigned char* L, int tid) {
#pragma unroll
    for (int i = 0; i < 4; ++i) { const int c = tid + 512 * i, row = c >> 4, ch = c & 15; *(LAS v4u*)(L + S1_BM + row * S1_CSTR + ch * 16) = q.b[i]; }
#pragma unroll
    for (int i = 0; i < 2; ++i) { const int c = tid + 512 * i, row = c >> 3, ch = c & 7; *(LAS v4u*)(L + S1_XM + row * S1_XSTR + ch * 16) = q.x[i]; }
    if (tid < 256) ((LAS float*)(L + S1_TAB))[tid] = q.dt;
}
__device__ __forceinline__ void s1_phase_units(Frame& F, PP p, int l, int ufirst, int ustride, int uend) {
    unsigned char* ws = p->ws;
    int tid_ = F.tid; asm volatile("" : "+v"(tid_));
    const int tid = tid_, lane = tid & 63, w = F.wave, r32 = lane & 31, hh = lane >> 5, i16 = lane & 15, gc = (lane >> 4) & 1;
    const bf16* XB = (const bf16*)(ws + WS_XBC); const float* DT = (const float*)(ws + WS_DT); const float* alog = p->in[21] + l * 32;
    float* CUMG = (float*)(ws + WS_EDEC); float* CDEC = (float*)(ws + WS_CDEC); bf16* STR = (bf16*)(ws + WS_ST);
    LAS unsigned char* L = F.lds; LAS float* tab = (LAS float*)(L + S1_TAB);
    int u = ufirst; if (u >= uend) return;
    S1Pre q; s1_load(q, XB, DT, alog, u, tid, w);
    while (u < uend) {
        const int cc = u >> 4, hd = u & 15; const float al = q.al;
        LBAR();
        s1_store(q, L, tid);
        LBAR();
        const int un = u + ustride; if (un < uend) s1_load(q, XB, DT, alog, un, tid, w);
        if (w < 2) {
            const float a = -__expf(al);
            const float d0 = tab[w * 128 + 2 * lane], d1 = tab[w * 128 + 2 * lane + 1];
            const float v0 = d0 * a, v1 = d1 * a, s = v0 + v1;
            float inc = s;
            if (w == 0) {
#pragma unroll
                for (int o = 1; o < 64; o <<= 1) { const float t = bperm(inc, lane - o); if (lane >= o) inc += t; }
            } else {
#pragma unroll
                for (int o = 1; o < 64; o <<= 1) { const float t = bperm(inc, lane + o); if (lane + o < 64) inc += t; }
            }
            const float exc = inc - s;
            const float c0 = (w == 0) ? exc + v0 : exc + v1 + v0, c1 = (w == 0) ? exc + v0 + v1 : exc + v1;
            const float tot = bperm(inc, w == 0 ? 63 : 0);
            tab[(2 + w) * 128 + 2 * lane] = __expf(tot - c0) * d0; tab[(2 + w) * 128 + 2 * lane + 1] = __expf(tot - c1) * d1;
            typedef float f2 __attribute__((ext_vector_type(2)));
            *(f2*)(CUMG + ((size_t)(cc * 16 + hd) * 2 + w) * 128 + 2 * lane) = (f2){c0, c1};
            if (lane == 0) CDEC[(w * NCHUNK + cc) * 16 + hd] = __expf(tot);
        }
        LBAR();
        {
            const int nb = w & 3, pb = w >> 2;
            f32x16 st[2];
#pragma unroll
            for (int d = 0; d < 2; ++d)
#pragma unroll
                for (int r = 0; r < 16; ++r) st[d][r] = 0.f;
            const LAS unsigned char* bp = L + S1_BM + (8 * hh + (i16 >> 2)) * S1_CSTR + (32 * nb + 16 * gc + 4 * (i16 & 3)) * 2;
            const LAS unsigned char* xp = L + S1_XM + (8 * hh + (i16 >> 2)) * S1_XSTR + (32 * pb + 16 * gc + 4 * (i16 & 3)) * 2;
#pragma unroll
            for (int ks = 0; ks < 8; ++ks) {
                const s16x4 alo = __builtin_amdgcn_ds_read_tr16_b64_v4i16((LAS s16x4*)(bp + (16 * ks) * S1_CSTR));
                const s16x4 ahi = __builtin_amdgcn_ds_read_tr16_b64_v4i16((LAS s16x4*)(bp + (16 * ks + 4) * S1_CSTR));
                const bf16x8 afr = (bf16x8){alo[0], alo[1], alo[2], alo[3], ahi[0], ahi[1], ahi[2], ahi[3]};
                const s16x4 lo = __builtin_amdgcn_ds_read_tr16_b64_v4i16((LAS s16x4*)(xp + (16 * ks) * S1_XSTR));
                const s16x4 hi = __builtin_amdgcn_ds_read_tr16_b64_v4i16((LAS s16x4*)(xp + (16 * ks + 4) * S1_XSTR));
                const float x0 = bf1((bf16)lo[0]), x1 = bf1((bf16)lo[1]), x2 = bf1((bf16)lo[2]), x3 = bf1((bf16)lo[3]), x4 = bf1((bf16)hi[0]), x5 = bf1((bf16)hi[1]), x6 = bf1((bf16)hi[2]), x7 = bf1((bf16)hi[3]);
#pragma unroll
                for (int d = 0; d < 2; ++d) {
                    const f32x4 w0 = *(const LAS f32x4*)(tab + (2 + d) * 128 + 16 * ks + 8 * hh), w1 = *(const LAS f32x4*)(tab + (2 + d) * 128 + 16 * ks + 8 * hh + 4);
                    const v4u t = (v4u){cvtpk(x0 * w0.x, x1 * w0.y), cvtpk(x2 * w0.z, x3 * w0.w), cvtpk(x4 * w1.x, x5 * w1.y), cvtpk(x6 * w1.z, x7 * w1.w)};
                    st[d] = __builtin_amdgcn_mfma_f32_32x32x16_bf16(afr, __builtin_bit_cast(bf16x8, t), st[d], 0, 0, 0);
                }
            }
#pragma unroll
            for (int d = 0; d < 2; ++d) { bf16* so = STR + ((size_t)(d * NCHUNK + cc) * 16 + hd) * 8192 + (size_t)((nb * 2 + pb) * 2) * 512 + lane * 8;
#pragma unroll
                for (int j = 0; j < 2; ++j) *(v4u*)(so + j * 512) = (v4u){cvtpk(st[d][8 * j], st[d][8 * j + 1]), cvtpk(st[d][8 * j + 2], st[d][8 * j + 3]), cvtpk(st[d][8 * j + 4], st[d][8 * j + 5]), cvtpk(st[d][8 * j + 6], st[d][8 * j + 7])}; }
        }
        u = un;
    }
    LBAR();
}
__device__ __forceinline__ void s2_scan(Frame& F, PP p, int l) {
    unsigned char* ws = p->ws; bf16* STR = (bf16*)(ws + WS_ST); const float* CDEC = (const float*)(ws + WS_CDEC);
    const int gt = F.vcu * NTHR + F.tid, NGT = F.G * NTHR;
    for (int idx = gt; idx < 576 * 1024; idx += NGT) {
        const int combo = idx >> 10, v = idx & 1023, seq = combo >> 5, hd = (combo >> 1) & 15, dir = combo & 1;
        const int c0 = seq < 16 ? seq * 2 : 32 + (seq - 16) * 32, nc = seq < 16 ? 2 : 32;
        const int ln = v & 63, blk = v >> 6, j = blk & 1, pb = (blk >> 1) & 1, nb = blk >> 2; const int pp = 32 * pb + (ln & 31), n0 = 32 * nb + 16 * j + 4 * (ln >> 5);
        f32x4 H0 = (f32x4){0.f, 0.f, 0.f, 0.f}, H1 = H0;
        if (seq >= 16) { const float* h0 = p->in[dir ? 7 : 6] + (((size_t)(seq - 16) * DEPTH + l) * 16 + hd) * 8192 + pp * 128 + n0; H0 = *(const f32x4*)h0; H1 = *(const f32x4*)(h0 + 8); }
        for (int k = 0; k < nc; k += 2) {
            const int ca = dir ? c0 + nc - 1 - k : c0 + k, cb = dir ? ca - 1 : ca + 1;
            v4u* pa = (v4u*)(STR + ((size_t)(dir * NCHUNK + ca) * 16 + hd) * 8192) + v; v4u* pbb = (v4u*)(STR + ((size_t)(dir * NCHUNK + cb) * 16 + hd) * 8192) + v;
            const v4u ta = *pa, tb = *pbb; const float da = CDEC[(dir * NCHUNK + ca) * 16 + hd], db = CDEC[(dir * NCHUNK + cb) * 16 + hd];
            *pa = (v4u){cvtpk(H0.x, H0.y), cvtpk(H0.z, H0.w), cvtpk(H1.x, H1.y), cvtpk(H1.z, H1.w)};
            H0 = H0 * da + (f32x4){bflo(ta.x), bfhi(ta.x), bflo(ta.y), bfhi(ta.y)}; H1 = H1 * da + (f32x4){bflo(ta.z), bfhi(ta.z), bflo(ta.w), bfhi(ta.w)};
            *pbb = (v4u){cvtpk(H0.x, H0.y), cvtpk(H0.z, H0.w), cvtpk(H1.x, H1.y), cvtpk(H1.z, H1.w)};
            H0 = H0 * db + (f32x4){bflo(tb.x), bfhi(tb.x), bflo(tb.y), bfhi(tb.y)}; H1 = H1 * db + (f32x4){bflo(tb.z), bfhi(tb.z), bflo(tb.w), bfhi(tb.w)};
        }
        if (seq < 16) { float* o = p->out + (dir ? OUT_SB : OUT_SF) + (((size_t)seq * DEPTH + l) * 16 + hd) * 8192 + pp * 128 + n0; *(f32x4*)o = H0; *(f32x4*)(o + 8) = H1; }
    }
}
struct S3Pre { v4u c[4], b[4], x[2]; float dt, cum, dk; };
__device__ __forceinline__ void s3_load(S3Pre& q, const bf16* XB, const float* DT, const float* CUMG, const float* dskip, int u, int tid) {
    const int cc = u >> 4, hd = u & 15, m0 = cc * 128, g = hd >> 3;
    const unsigned offB = (unsigned)((tid >> 4) * 1536 + (tid & 15) * 8) * 2u, offX = (unsigned)((tid >> 3) * 1536 + (tid & 7) * 8) * 2u;
#pragma unroll
    for (int i = 0; i < 4; ++i) { const char* bs = (const char*)(XB + (size_t)(m0 + 32 * i) * 1536 + g * 128); q.c[i] = *(const v4u*)(bs + 2560 + offB); q.b[i] = *(const v4u*)(bs + 2048 + offB); }
#pragma unroll
    for (int i = 0; i < 2; ++i) { const char* xs = (const char*)(XB + (size_t)(m0 + 64 * i) * 1536 + hd * 64); q.x[i] = *(const v4u*)(xs + offX); }
    q.dt = *(const float*)((const char*)(DT + (size_t)m0 * 32 + hd) + (unsigned)((tid & 127) * 32 + ((tid >> 7) & 1) * 16) * 4u);
    q.cum = *(const float*)((const char*)(CUMG + (size_t)(cc * 16 + hd) * 256) + (unsigned)(tid & 255) * 4u);
    q.dk = dskip[hd];
}
__device__ __forceinline__ void s3_store(const S3Pre& q, LAS unsigned char* L, int tid) {
#pragma unroll
    for (int i = 0; i < 4; ++i) { const int c = tid + 512 * i, row = c >> 4, ch = c & 15; *(LAS v4u*)(L + S3_CM + row * S1_CSTR + ch * 16) = q.c[i]; *(LAS v4u*)(L + S3_BM + row * S1_CSTR + ch * 16) = q.b[i]; }
#pragma unroll
    for (int i = 0; i < 2; ++i) { const int c = tid + 512 * i, row = c >> 3, ch = c & 7; *(LAS v4u*)(L + S3_XM + row * S1_XSTR + ch * 16) = q.x[i]; }
    if (tid < 256) { ((LAS float*)(L + S3_TAB))[tid] = q.cum; ((LAS float*)(L + S3_TAB))[256 + tid] = q.dt; }
}
__device__ __forceinline__ void s3_phase(Frame& F, PP p, int l) {
    unsigned char* ws = p->ws;
    int tid_ = F.tid; asm volatile("" : "+v"(tid_));
    const int tid = tid_, lane = tid & 63, w = F.wave, r32 = lane & 31, hh = lane >> 5, i16 = lane & 15, gc = (lane >> 4) & 1;
    const bf16* XB = (const bf16*)(ws + WS_XBC); const bf16* P = (const bf16*)(ws + WS_P); bf16* MIX = (bf16*)(ws + WS_MIX);
    const float* DT = (const float*)(ws + WS_DT); const float* CUMG = (const float*)(ws + WS_EDEC); const bf16* STR = (const bf16*)(ws + WS_ST); float* SSQ = (float*)(ws + WS_SSQ);
    LAS unsigned char* L = F.lds; const LAS float* tab = (const LAS float*)(L + S3_TAB); LAS float* SSP = (LAS float*)(L + S3_SSP);
    const int lb = w & 3, pb = w >> 2, lpos = 32 * lb + r32;
    const int uend = NCHUNK * 16;
    int u = blockIdx.x; if (u >= uend) return;
    const float* dskip = p->in[22] + l * 16;
    S3Pre q; s3_load(q, XB, DT, CUMG, dskip, u, tid);
    while (u < uend) {
        const int cc = u >> 4, hd = u & 15, m0 = cc * 128; const float dk = q.dk;
        LBAR();
        s3_store(q, L, tid);
        LBAR();
        const int un = u + F.G; if (un < uend) s3_load(q, XB, DT, CUMG, dskip, un, tid);
        v4u hf[2][8];
#pragma unroll
        for (int k = 0; k < 8; ++k) hf[0][k] = *(const v4u*)((const char*)(STR + ((size_t)(0 * NCHUNK + cc) * 16 + hd) * 8192 + (((k >> 1) * 2 + pb) * 2 + (k & 1)) * 512) + (unsigned)lane * 16u);
        unsigned long long zw[4];
        f32x16 acc;
#pragma unroll
        for (int r = 0; r < 16; ++r) acc[r] = 0.f;
#pragma unroll
        for (int d = 0; d < 2; ++d) {
            const LAS float* cum = tab + d * 128; const LAS float* dtv = tab + (2 + d) * 128; const float cl = cum[lpos];
            const int sb0 = d == 0 ? 0 : lb, sb1 = d == 0 ? lb : 3;
            for (int sb = sb0; sb <= sb1; ++sb) {
                f32x16 cb;
#pragma unroll
                for (int r = 0; r < 16; ++r) cb[r] = 0.f;
#pragma unroll
                for (int ks = 0; ks < 8; ++ks) { const bf16x8 a = *(const LAS bf16x8*)(L + S3_BM + (32 * sb + r32) * S1_CSTR + ks * 32 + hh * 16);
                    const bf16x8 cfr = *(const LAS bf16x8*)(L + S3_CM + lpos * S1_CSTR + ks * 32 + hh * 16);
                    cb = __builtin_amdgcn_mfma_f32_32x32x16_bf16(a, cfr, cb, 0, 0, 0);
                    if ((ks & 3) == 3) __builtin_amdgcn_sched_barrier(0); }
#pragma unroll
                for (int r = 0; r < 16; ++r) { const int s = 32 * sb + crow16(r, hh);
                    float v = cb[r] * __expf(cl - cum[s]) * dtv[s];
                    const bool ok = d == 0 ? (s <= lpos) : (s >= lpos);
                    v = ok ? v : 0.f; if (d == 0 && s == lpos) v += dk;
                    cb[r] = v; }
                bf16x8 pb2[2];
                { v4u t;
                  t = (v4u){cvtpk(cb[0], cb[1]), cvtpk(cb[2], cb[3]), cvtpk(cb[4], cb[5]), cvtpk(cb[6], cb[7])}; pb2[0] = __builtin_bit_cast(bf16x8, t);
                  t = (v4u){cvtpk(cb[8], cb[9]), cvtpk(cb[10], cb[11]), cvtpk(cb[12], cb[13]), cvtpk(cb[14], cb[15])}; pb2[1] = __builtin_bit_cast(bf16x8, t); }
                const LAS unsigned char* xp = L + S3_XM + (32 * sb + 4 * hh + (i16 >> 2)) * S1_XSTR + (32 * pb + 16 * gc + 4 * (i16 & 3)) * 2;
#pragma unroll
                for (int k2 = 0; k2 < 2; ++k2) {
                    const s16x4 lo = __builtin_amdgcn_ds_read_tr16_b64_v4i16((LAS s16x4*)(xp + (16 * k2) * S1_XSTR));
                    const s16x4 hi = __builtin_amdgcn_ds_read_tr16_b64_v4i16((LAS s16x4*)(xp + (16 * k2 + 8) * S1_XSTR));
                    const bf16x8 a = (bf16x8){lo[0], lo[1], lo[2], lo[3], hi[0], hi[1], hi[2], hi[3]};
                    acc = __builtin_amdgcn_mfma_f32_32x32x16_bf16(a, pb2[k2], acc, 0, 0, 0);
                }
            }
            if (d == 0) {
#pragma unroll
                for (int k = 0; k < 8; ++k) hf[1][k] = *(const v4u*)((const char*)(STR + ((size_t)(1 * NCHUNK + cc) * 16 + hd) * 8192 + (((k >> 1) * 2 + pb) * 2 + (k & 1)) * 512) + (unsigned)lane * 16u);
#pragma unroll
                for (int k = 0; k < 4; ++k) zw[k] = *(const unsigned long long*)((const char*)(P + (size_t)m0 * INP + PC_Z + hd * 64 + 32 * pb + 8 * k) + (unsigned)(lpos * INP + 4 * hh) * 2u);
            }
        }
#pragma unroll
        for (int d = 0; d < 2; ++d) { const float e = __expf(tab[d * 128 + lpos]);
#pragma unroll
            for (int k = 0; k < 8; ++k) { typedef unsigned u2 __attribute__((ext_vector_type(2)));
                const LAS unsigned char* cp = L + S3_CM + lpos * S1_CSTR + (32 * (k >> 1) + 16 * (k & 1) + 4 * hh) * 2;
                const u2 c0 = *(const LAS u2*)cp, c1 = *(const LAS u2*)(cp + 16);
                const v4u t = (v4u){cvtpk(bflo(c0.x) * e, bfhi(c0.x) * e), cvtpk(bflo(c0.y) * e, bfhi(c0.y) * e), cvtpk(bflo(c1.x) * e, bfhi(c1.x) * e), cvtpk(bflo(c1.y) * e, bfhi(c1.y) * e)};
                acc = __builtin_amdgcn_mfma_f32_32x32x16_bf16(__builtin_bit_cast(bf16x8, hf[d][k]), __builtin_bit_cast(bf16x8, t), acc, 0, 0, 0); } }
        float ss = 0.f;
        char* mixr = (char*)(MIX + (size_t)m0 * DM + 1024 + hd * 64 + 32 * pb); const unsigned mixo = (unsigned)(lpos * DM + 4 * hh) * 2u;
#pragma unroll
        for (int k = 0; k < 4; ++k) { const unsigned long long z = zw[k];
            const float y0 = acc[4 * k] * silu(bflo((unsigned)z)), y1 = acc[4 * k + 1] * silu(bfhi((unsigned)z)), y2 = acc[4 * k + 2] * silu(bflo((unsigned)(z >> 32))), y3 = acc[4 * k + 3] * silu(bfhi((unsigned)(z >> 32)));
            ss += (y0 * y0 + y1 * y1) + (y2 * y2 + y3 * y3);
            *(unsigned long long*)(mixr + 16 * k + mixo) = (unsigned long long)cvtpk(y0, y1) | ((unsigned long long)cvtpk(y2, y3) << 32); }
        ss = half_sum(ss);
        if (hh == 0) SSP[pb * 128 + lpos] = ss;
        LBAR();
        if (tid < 128) SSQ[(size_t)(m0 + tid) * 16 + hd] = SSP[tid] + SSP[128 + tid];
        u = un;
    }
    LBAR();
}
__device__ __forceinline__ void nrm_phase(Frame& F, PP p, int l) {
    unsigned char* ws = p->ws; bf16* MIX = (bf16*)(ws + WS_MIX); const float* SSQ = (const float*)(ws + WS_SSQ); const float* sn = p->in[23] + l * 1024;
    const int gw = F.vcu * NWAVES + F.wave, NGW = F.G * NWAVES, lane = F.lane;
    for (int m = gw; m < MROWS; m += NGW) {
        const int c0 = lane * 16, g = lane >> 5;
        const f32x4 s0 = *(const f32x4*)(SSQ + (size_t)m * 16 + g * 8), s1 = *(const f32x4*)(SSQ + (size_t)m * 16 + g * 8 + 4);
        const float rs = 1.0f / sqrtf(((s0.x + s0.y) + (s0.z + s0.w) + (s1.x + s1.y) + (s1.z + s1.w)) * (1.0f / 512.0f) + EPS);
        v4u* q = (v4u*)(MIX + (size_t)m * DM + 1024 + c0); v4u a = q[0], b = q[1];
        const f32x4 g0 = *(const f32x4*)(sn + c0), g1 = *(const f32x4*)(sn + c0 + 4), g2 = *(const f32x4*)(sn + c0 + 8), g3 = *(const f32x4*)(sn + c0 + 12);
        a.x = cvtpk(bflo(a.x) * rs * g0.x, bfhi(a.x) * rs * g0.y); a.y = cvtpk(bflo(a.y) * rs * g0.z, bfhi(a.y) * rs * g0.w); a.z = cvtpk(bflo(a.z) * rs * g1.x, bfhi(a.z) * rs * g1.y); a.w = cvtpk(bflo(a.w) * rs * g1.z, bfhi(a.w) * rs * g1.w);
        b.x = cvtpk(bflo(b.x) * rs * g2.x, bfhi(b.x) * rs * g2.y); b.y = cvtpk(bflo(b.y) * rs * g2.z, bfhi(b.y) * rs * g2.w); b.z = cvtpk(bflo(b.z) * rs * g3.x, bfhi(b.z) * rs * g3.y); b.w = cvtpk(bflo(b.w) * rs * g3.z, bfhi(b.w) * rs * g3.w);
        q[0] = a; q[1] = b;
    }
}
__device__ __forceinline__ void mix1_phase(Frame& F, PP p, int l) {
    unsigned char* ws = p->ws;
    const bf16* P = (const bf16*)(ws + WS_P); const bf16* QKR = (const bf16*)(ws + WS_QKR); bf16* MIX = (bf16*)(ws + WS_MIX);
    const float* lamv = (const float*)(ws + WS_TAB + 32768);
    const float lam = lamv[l], onems = 1.0f - lamv[4 + l];
    const float* dnorm = p->in[17] + l * 128;
    constexpr int U_BL = 256, U_AL = 128, U_BC = 128, U_AC = 64, U_FA = U_BL + U_AL + U_BC + U_AC;
    const float LOG2E = 1.4426950408889634f, cA = 0.08838834764831845f * LOG2E, cB = 0.125f * LOG2E;
    for (int u = blockIdx.x; u < U_FA; u += F.G) {
        int r = u;
        int mode = 1; const bf16* qp; int qstr = RCW, qpos0 = 0; bool two = true; Seg s0, s1; bf16* dst; const float* sinkp = dnorm;
        if (r < U_BL) {
            const int b = r >> 7, h = (r >> 5) & 3, qb = r & 31; const int ml = b * 4096 + qb * 128;
            s0 = Seg{QKR + (size_t)(b * 4096) * RCW + RC_KD + h * 128, P + (size_t)(4096 + b * 4096) * INP + PC_VD + h * 128, RCW, INP, 4096, 0, -1};
            s1 = Seg{p->in[4] + ((size_t)(b * DEPTH + l) * 256) * 512 + h * 128, p->in[5] + ((size_t)(b * DEPTH + l) * 256) * 512 + h * 128, 512, 512, 256, 1, -1};
            qp = QKR + (size_t)ml * RCW + RC_QD + h * 128; dst = MIX + (size_t)(4096 + ml) * DM + 512 + h * 128;
        } else if (r < U_BL + U_AL) { r -= U_BL;
            const int b = r >> 6, kv = (r >> 5) & 1, qb = r & 31; const int ml = b * 4096 + qb * 128;
            const int w0 = qb * 128 - 128 < 0 ? 0 : qb * 128 - 128, w1 = qb * 128 + 256 > 4096 ? 4096 : qb * 128 + 256;
            s0 = Seg{p->in[2] + ((size_t)(b * DEPTH + l) * 256) * 256 + kv * 128, p->in[3] + ((size_t)(b * DEPTH + l) * 256) * 256 + kv * 128, 256, 256, 256, 1, -1};
            s1 = Seg{QKR + (size_t)(b * 4096 + w0) * RCW + RC_KA + kv * 128, P + (size_t)(4096 + b * 4096 + w0) * INP + PC_VA + kv * 128, RCW, INP, w1 - w0, 0, w0};
            mode = 0; qp = QKR + (size_t)ml * RCW + RC_QA + kv * 256; qpos0 = qb * 128; sinkp = p->in[15] + l * 4 + kv * 2; dst = MIX + (size_t)(4096 + ml) * DM + kv * 256;
        } else if (r < U_BL + U_AL + U_BC) { r -= U_BL + U_AL;
            const int b = r >> 3, h = (r >> 1) & 3, qb = r & 1; const int m0 = b * 256 + qb * 128;
            s0 = Seg{P + (size_t)(b * 256) * INP + PC_KD + h * 128, P + (size_t)(b * 256) * INP + PC_VD + h * 128, INP, INP, 256, 0, -1}; s1 = s0; two = false;
            qp = P + (size_t)m0 * INP + PC_QD + h * 128; qstr = INP; dst = MIX + (size_t)m0 * DM + 512 + h * 128;
        } else { r -= U_BL + U_AL + U_BC;
            const int b = r >> 2, kv = (r >> 1) & 1, qb = r & 1; const int m0 = b * 256 + qb * 128;
            s0 = Seg{P + (size_t)(b * 256) * INP + PC_KA + kv * 128, P + (size_t)(b * 256) * INP + PC_VA + kv * 128, INP, INP, 256, 0, -1}; s1 = s0; two = false;
            mode = 0; qp = P + (size_t)m0 * INP + PC_QA + kv * 256; qstr = INP; sinkp = p->in[15] + l * 4 + kv * 2; dst = MIX + (size_t)m0 * DM + kv * 256;
        }
        if (mode) fa_unit<1>(F, qp, qstr, s0, s1, two, qpos0, cB, sinkp, lam, onems, dnorm, dst, DM);
        else fa_unit<0>(F, qp, qstr, s0, s1, two, qpos0, cA, sinkp, lam, onems, dnorm, dst, DM);
    }
    __syncthreads();
    s1_phase_units(F, p, l, blockIdx.x, F.G, NCHUNK * 16);
}
#ifndef MK_ONE_LAUNCH
#define MK_ONE_LAUNCH 1
#endif
constexpr int PH_PER_LAYER = 11, PH_TOTAL = 2 + DEPTH * PH_PER_LAYER + 1;
__global__ void __launch_bounds__(NTHR, 2) mk_fwd(Params p_) {
    extern __shared__ __attribute__((aligned(16))) unsigned char lds[];
    Frame F;
    F.lds = (LAS unsigned char*)lds;
    F.tid = threadIdx.x; F.lane = F.tid & 63; F.wave = __builtin_amdgcn_readfirstlane(F.tid >> 6); const int wave0 = F.wave;
    F.G = gridDim.x; { const int bx = blockIdx.x; F.vcu = (F.G % 8 == 0) ? (bx % 8) * (F.G / 8) + bx / 8 : bx; }
    PP p = (PP)__builtin_amdgcn_kernarg_segment_ptr();
    for (int u = F.tid; u < (LDS_BYTES - LDSCTL_OFF) / 4; u += NTHR) ((LAS unsigned*)(F.lds + LDSCTL_OFF))[u] = 0u;
    __syncthreads();
    XcdBarrier bar; bar.bar = (unsigned*)(p->ws + WS_CTL) + CW_BAR; bar.x = 0; bar.st = nullptr;
#if MK_ONE_LAUNCH
    bar = xcd_barrier_post((unsigned*)(p->ws + WS_CTL) + CW_BAR, (volatile LAS unsigned*)(F.lds + MISC_OFF) + 8, F.tid == 0);
#define GRID_BAR() xcd_barrier(bar, wave0 == 0 && __builtin_amdgcn_mbcnt_hi(~0u, __builtin_amdgcn_mbcnt_lo(~0u, 0u)) == 0u)
#else
#define GRID_BAR() do {} while (0)
#endif
    const int lo = p->ph_lo, hi = p->ph_hi;
#define IN(k) (lo <= (k) && (k) < hi)
#define SEAM(k) do { if (IN(k) && IN((k) + 1)) GRID_BAR(); } while (0)
#define ENTER() do { int wv_ = wave0; asm volatile("" : "+s"(wv_)); int t_ = wv_ * 64 + (int)__builtin_amdgcn_mbcnt_hi(~0u, __builtin_amdgcn_mbcnt_lo(~0u, 0u)); asm volatile("" : "+v"(t_)); F.tid = t_; F.lane = t_ & 63; F.wave = wv_; asm volatile("" : "+s"(p)); ws = p->ws; } while (0)
    unsigned char* ws;

    if (IN(0)) { ENTER(); p0_prologue(F, p); } SEAM(0);
    if (IN(1)) { ENTER(); mod_layer(p, 0, F.vcu * NTHR + F.tid, F.G * NTHR); } SEAM(1);
#pragma unroll 1
    for (int l = 0; l < DEPTH; ++l) {
        const int pb = 2 + l * PH_PER_LAYER;
        if (IN(pb + 0)) { ENTER(); norm_phase(F, l == 0 ? p->in[0] : (const float*)(ws + WS_H), l == 0 ? p->in[1] : (const float*)(ws + WS_H) + (size_t)4096 * DM, p->in[12] + l * DM, (const float*)(ws + WS_MOD) + (size_t)l * 3 * NMOD, 0, DM, (bf16*)(ws + WS_U)); } SEAM(pb + 0);
        if (IN(pb + 1)) { ENTER();
            pg8::Gemm g{(const bf16*)(ws + WS_U), (const bf16*)(ws + WS_WIN) + (size_t)l * INP * DM, MROWS, INP, DM, DM}; pg8::StaticOrder S; S.init(MROWS, INP, F.G, (int)blockIdx.x);
            pg8::EpiBf16 E{(bf16*)(ws + WS_P), INP};
            pg8::gemm_phase<pg8::EpiBf16, pg8::StaticOrder, true, true>(F.lds, g, S, E, F.tid);
        } SEAM(pb + 1);
        if (IN(pb + 2)) { ENTER(); prep_phase(F, p, l); } SEAM(pb + 2);
        if (IN(pb + 3)) { ENTER(); mix1_phase(F, p, l); } SEAM(pb + 3);
        if (IN(pb + 4)) { ENTER(); s2_scan(F, p, l); } SEAM(pb + 4);
        if (IN(pb + 5)) { ENTER(); s3_phase(F, p, l); } SEAM(pb + 5);
        if (IN(pb + 6)) { ENTER(); nrm_phase(F, p, l); } SEAM(pb + 6);
        if (IN(pb + 7)) { ENTER();
            pg8::Gemm g{(const bf16*)(ws + WS_MIX), (const bf16*)(ws + WS_WOUT) + (size_t)l * DM * DM, MROWS, DM, DM, DM}; pg8::StaticOrder S; S.init(MROWS, DM, F.G, (int)blockIdx.x);
            pg8::EpiResid E{l == 0 ? p->in[0] : (const float*)(ws + WS_H), l == 0 ? p->in[1] : (const float*)(ws + WS_H) + (size_t)4096 * DM, (float*)(ws + WS_H), DM, (const float*)(ws + WS_MOD) + (size_t)l * 3 * NMOD + 2 * DM, NMOD};
            pg8::gemm_phase<pg8::EpiResid, pg8::StaticOrder, true, true>(F.lds, g, S, E, F.tid);
            { const int nfull = F.G == 256 ? 128 : 0; if (l + 1 < DEPTH && (int)blockIdx.x >= nfull) adaln_layer(F, p, l + 1, (int)blockIdx.x - nfull, (int)F.G - nfull); }
        } SEAM(pb + 7);
        if (IN(pb + 8)) { ENTER(); norm_phase(F, (const float*)(ws + WS_H), (const float*)(ws + WS_H) + (size_t)4096 * DM, p->in[13] + l * DM, (const float*)(ws + WS_MOD) + (size_t)l * 3 * NMOD, 3 * DM, 4 * DM, (bf16*)(ws + WS_U)); } SEAM(pb + 8);
        if (IN(pb + 9)) { ENTER();
            pg8::Gemm g{(const bf16*)(ws + WS_U), (const bf16*)(ws + WS_WGU) + (size_t)l * GU * DM, MROWS, GU, DM, DM}; pg8::StaticOrder S; S.init(MROWS, GU, F.G, (int)blockIdx.x);
            pg8::EpiSwiGLU E{(bf16*)(ws + WS_ACT), FF};
            pg8::gemm_phase<pg8::EpiSwiGLU, pg8::StaticOrder, true, true>(F.lds, g, S, E, F.tid);
        } SEAM(pb + 9);
        if (IN(pb + 10)) { ENTER();
            pg8::Gemm g{(const bf16*)(ws + WS_ACT), (const bf16*)(ws + WS_WDN) + (size_t)l * DM * FF, MROWS, DM, FF, FF}; pg8::StaticOrder S; S.init(MROWS, DM, F.G, (int)blockIdx.x);
            if (l + 1 < DEPTH) mod_layer(p, l + 1, F.vcu * NTHR + F.tid, F.G * NTHR);
            pg8::EpiResid E{(const float*)(ws + WS_H), (const float*)(ws + WS_H) + (size_t)4096 * DM, (float*)(ws + WS_H), DM, (const float*)(ws + WS_MOD) + (size_t)l * 3 * NMOD + 5 * DM, NMOD};
            pg8::gemm_phase<pg8::EpiResid, pg8::StaticOrder, true, true>(F.lds, g, S, E, F.tid);
            { const int nfull = F.G == 256 ? 128 : 0; if (l + 1 < DEPTH && (int)blockIdx.x >= nfull) conv_layer(F, p, l + 1, ((int)blockIdx.x - nfull) * NWAVES + F.wave, ((int)F.G - nfull) * NWAVES); }
        } SEAM(pb + 10);
    }
    if (IN(PH_TOTAL - 1)) { ENTER(); final_phase(F, (const float*)(ws + WS_H), p->in[27], p->out); }
#undef IN
#undef SEAM
#undef ENTER
}

extern "C" void kernel_launch(void* const* d_in, const int* in_sizes, int n_in, void* d_out, int out_size, void* d_ws, size_t ws_size, hipStream_t stream) {
    static int grid = 0;
    if (grid == 0) {
        if (n_in != 28 || out_size != 67108864 || ws_size < WS_END) { fprintf(stderr, "kernel_launch: unexpected sizes n_in %d out %d ws %zu\n", n_in, out_size, ws_size); grid = -1; return; }
        int dev = 0, cus = 0, per_cu = 0;
        if (hipGetDevice(&dev) != hipSuccess || hipDeviceGetAttribute(&cus, hipDeviceAttributeMultiprocessorCount, dev) != hipSuccess) { grid = -1; return; }
        if (hipFuncSetAttribute((const void*)mk_fwd, hipFuncAttributeMaxDynamicSharedMemorySize, LDS_BYTES) != hipSuccess) { fprintf(stderr, "kernel_launch: hipFuncSetAttribute failed\n"); grid = -1; return; }
        if (hipOccupancyMaxActiveBlocksPerMultiprocessor(&per_cu, (const void*)mk_fwd, NTHR, LDS_BYTES) != hipSuccess || per_cu < 1)
            fprintf(stderr, "kernel_launch: occupancy query reports %d workgroups per CU\n", per_cu);
        (void)hipGetLastError();
        grid = cus;
    }
    if (grid < 0) return;
    if (hipMemsetAsync((char*)d_ws + WS_CTL, 0, CTL_ZERO_BYTES, stream) != hipSuccess) return;
    Params a{};
    for (int i = 0; i < 28; ++i) a.in[i] = (const float*)d_in[i];
    a.out = (float*)d_out; a.ws = (unsigned char*)d_ws;
#if MK_ONE_LAUNCH
    a.ph_lo = 0; a.ph_hi = PH_TOTAL;
    hipLaunchKernelGGL(mk_fwd, dim3(grid), dim3(NTHR), LDS_BYTES, stream, a);
#else
    for (int ph = 0; ph < PH_TOTAL; ++ph) { a.ph_lo = ph; a.ph_hi = ph + 1; hipLaunchKernelGGL(mk_fwd, dim3(grid), dim3(NTHR), LDS_BYTES, stream, a); }
#endif
}
```

```cpp
#include <hip/hip_runtime.h>
#include <cstdio>
#include <cstdint>
namespace pg8 {
#define PG8_LAS __attribute__((address_space(3)))
typedef unsigned short bf16_t;
typedef short bf16x8 __attribute__((ext_vector_type(8)));
typedef float f32x4 __attribute__((ext_vector_type(4)));
typedef unsigned u32x4 __attribute__((ext_vector_type(4)));
constexpr int BM = 256, BK = 64, HALF = 128, HTB = HALF * BK * 2  , STAGE_BYTES = 8 * HTB, NXCD = 8, WGM = 8;

__host__ __device__ __forceinline__ int lds_byte(int r, int c) { const int st = (r >> 4) * 2 + (c >> 5), rr = r & 15, cc = c & 31, ob = rr * 64 + cc * 2; return st * 1024 + (ob ^ (((ob >> 9) & 1) << 5)); }
__host__ __device__ __forceinline__ void stage_rc(int b, int& R, int& C) { const int st = b / 1024, sb = b % 1024, swz = sb ^ (((sb >> 9) & 1) << 5); R = (st >> 1) * 16 + swz / 64; C = (st & 1) * 32 + (swz % 64) / 2; }
__host__ __device__ __forceinline__ int perm32(int rho) { const int n = rho >> 4, i = rho & 15; return 8 * (i >> 2) + 4 * n + (i & 3); }

struct Unit { int pm, pn, pk; };
struct Gemm { const bf16_t* A; const bf16_t* Bt; int M, N, K, Ksub; };

struct StaticOrder {
    int nM, nN, nwg, G, c;
    __host__ __device__ void init(int M, int N, int G_, int c_) { nM = M / BM; nN = N / BM; nwg = nM * nN; G = G_; c = c_; }
    __host__ __device__ bool next(int i, Unit& u) const {
        const long L = (long)i * G + c; if (L >= nwg) return false;
        int wgid = (int)L; { const int q = nwg / NXCD, r = nwg % NXCD, xcd = wgid % NXCD, off = wgid / NXCD; wgid = (xcd < r ? xcd * (q + 1) : r * (q + 1) + (xcd - r) * q) + off; }
        const int nig = WGM * nN, gid = wgid / nig, fm = gid * WGM, gsz = (nM - fm) < WGM ? (nM - fm) : WGM;
        u.pm = fm + ((wgid % nig) % gsz); u.pn = (wgid % nig) / gsz; u.pk = 0; return true;
    }
    __device__ __forceinline__ void a_ready(const Unit&) const {}
    __device__ __forceinline__ void done(const Unit&) const {}
};
struct SplitOrder {
    StaticOrder s; int KS;
    __host__ __device__ void init(int M, int N, int KS_, int G_, int c_) { KS = KS_; s.init(M, N * KS_, G_, c_); }
    __host__ __device__ bool next(int i, Unit& u) const { if (!s.next(i, u)) return false; u.pk = u.pn % KS; u.pn = u.pn / KS; return true; }
    __device__ __forceinline__ void a_ready(const Unit&) const {}
    __device__ __forceinline__ void done(const Unit&) const {}
};


__device__ __forceinline__ unsigned cvt_pk_bf16(float lo, float hi) { unsigned r; asm volatile("v_cvt_pk_bf16_f32 %0, %1, %2" : "=v"(r) : "v"(lo), "v"(hi)); return r; }

struct EpiBf16 {
    static constexpr bool PERM = true, AFTER_DRAIN = false;
    bf16_t* O; int ldc;
    __device__ __forceinline__ void operator()(const f32x4 (&acc)[2][2][4][2], const Unit& u, int wr, int wc, int fr, int fq) const {
        const int row0 = u.pm * BM + wr * 64 + fr; const int col0 = u.pn * BM + wc * 32 + 8 * fq;
#pragma unroll
        for (int ai = 0; ai < 2; ++ai)
#pragma unroll
            for (int m = 0; m < 4; ++m) { bf16_t* rowp = O + (size_t)(row0 + ai * HALF + m * 16) * ldc + col0;
#pragma unroll
                for (int bj = 0; bj < 2; ++bj) { const f32x4 v0 = acc[ai][bj][m][0], v1 = acc[ai][bj][m][1];
                    u32x4 w; w.x = cvt_pk_bf16(v0[0], v0[1]); w.y = cvt_pk_bf16(v0[2], v0[3]); w.z = cvt_pk_bf16(v1[0], v1[1]); w.w = cvt_pk_bf16(v1[2], v1[3]);
                    *(u32x4*)(rowp + bj * HALF) = w; } }
    }
};
__device__ __forceinline__ int cond_of_pm(int pm) { return pm < 16 ? 0 : (pm < 32 ? 1 : 2); }
struct EpiResid {
    static constexpr bool PERM = false, AFTER_DRAIN = false;
    const float* base0; const float* base1; float* H; int ldc; const float* gate; int gstride;
    __device__ __forceinline__ void operator()(const f32x4 (&acc)[2][2][4][2], const Unit& u, int wr, int wc, int fr, int fq) const {
        const float* g = gate + (size_t)cond_of_pm(u.pm) * gstride;
        const int row0 = u.pm * BM + wr * 64 + fr; const int col0 = u.pn * BM + wc * 32 + 4 * fq;
        const float* bs = u.pm < 16 ? base0 + (size_t)row0 * ldc : base1 + (size_t)(row0 - 4096) * ldc;
        f32x4 gv[2][2];
#pragma unroll
        for (int bj = 0; bj < 2; ++bj)
#pragma unroll
            for (int n = 0; n < 2; ++n) gv[bj][n] = *(const f32x4*)(g + col0 + bj * HALF + n * 16);
#pragma unroll
        for (int ai = 0; ai < 2; ++ai)
#pragma unroll
            for (int m = 0; m < 4; ++m) { const size_t ro = (size_t)(ai * HALF + m * 16) * ldc + col0; float* rowp = H + (size_t)row0 * ldc + ro;
#pragma unroll
                for (int bj = 0; bj < 2; ++bj)
#pragma unroll
                    for (int n = 0; n < 2; ++n) { f32x4 h = *(const f32x4*)(bs + ro + bj * HALF + n * 16); h = h + gv[bj][n] * acc[ai][bj][m][n]; *(f32x4*)(rowp + bj * HALF + n * 16) = h; }
                asm volatile("" ::: "memory"); }
    }
};
__device__ __forceinline__ float silu_f(float x) { return x * __builtin_amdgcn_rcpf(1.0f + __expf(-x)); }
struct EpiSwiGLU {
    static constexpr bool PERM = true, AFTER_DRAIN = false;
    bf16_t* O; int ldc;
    __device__ __forceinline__ void operator()(const f32x4 (&acc)[2][2][4][2], const Unit& u, int wr, int wc, int fr, int fq) const {
        const int row0 = u.pm * BM + wr * 64 + fr; const int col0 = u.pn * HALF + wc * 32 + 8 * fq;
#pragma unroll
        for (int ai = 0; ai < 2; ++ai)
#pragma unroll
            for (int m = 0; m < 4; ++m) { bf16_t* rowp = O + (size_t)(row0 + ai * HALF + m * 16) * ldc + col0;
                const f32x4 g0 = acc[ai][0][m][0], g1 = acc[ai][0][m][1], u0 = acc[ai][1][m][0], u1 = acc[ai][1][m][1];
                u32x4 w;
                w.x = cvt_pk_bf16(silu_f(g0[0]) * u0[0], silu_f(g0[1]) * u0[1]); w.y = cvt_pk_bf16(silu_f(g0[2]) * u0[2], silu_f(g0[3]) * u0[3]);
                w.z = cvt_pk_bf16(silu_f(g1[0]) * u1[0], silu_f(g1[1]) * u1[1]); w.w = cvt_pk_bf16(silu_f(g1[2]) * u1[2], silu_f(g1[3]) * u1[3]);
                *(u32x4*)rowp = w; }
    }
};
template <class Epi, class Sched, bool ALIGN_EPI = false, bool SP2 = false>
__device__ __forceinline__ void gemm_phase(PG8_LAS unsigned char* lds, const Gemm g, const Sched& S, const Epi& E, int tid_in) {
    int tid_ = tid_in; asm volatile("" : "+v"(tid_));
    const int tid = tid_, wid = __builtin_amdgcn_readfirstlane(tid >> 6), lane = tid & 63, wr = wid >> 2, wc = wid & 3, fr = lane & 15, fq = lane >> 4;
    const int K = g.K, nt = g.Ksub / BK; const size_t koff = (size_t)g.Ksub * 2;
    unsigned voffA[2], voffB[2];
#pragma unroll
    for (int i = 0; i < 2; ++i) { int R, C; stage_rc(tid * 16 + i * 8192, R, C); const int Rb = Epi::PERM ? ((R & ~31) + perm32(R & 31)) : R;
        voffA[i] = (unsigned)(R * K + C) * 2u; voffB[i] = (unsigned)(Rb * K + C) * 2u; }
    const size_t kstep = (size_t)(BK * 2);
    const size_t hstep = (size_t)HALF * K * 2;
    const size_t tstep = 2 * hstep;
    const unsigned ldsw = (unsigned)wid * 1024u;
    const int aoff = lds_byte(wr * 64 + fr, fq * 8), boff = lds_byte(wc * 32 + fr, fq * 8);
#define PG8_SA(b, h) (((b) * 2 + (h)) * HTB)
#define PG8_SB(b, h) ((4 + (b) * 2 + (h)) * HTB)
#define PG8_STAGE(bufoff, gbase, voff) do { _Pragma("unroll") for (int _i = 0; _i < 2; ++_i) \
        __builtin_amdgcn_global_load_lds((const unsigned*)((const char*)(gbase) + (voff)[_i]), (PG8_LAS unsigned*)(lds + (bufoff) + ldsw + _i * 8192), 16, 0, 0); } while (0)
#define PG8_LDA(dst, b, h) do { _Pragma("unroll") for (int m = 0; m < 4; ++m) _Pragma("unroll") for (int k = 0; k < 2; ++k) dst[m][k] = *(const PG8_LAS bf16x8*)(lds + PG8_SA(b, h) + aoff + m * 2048 + k * 1024); } while (0)
#define PG8_LDB(dst, b, h) do { _Pragma("unroll") for (int n = 0; n < 2; ++n) _Pragma("unroll") for (int k = 0; k < 2; ++k) dst[n][k] = *(const PG8_LAS bf16x8*)(lds + PG8_SB(b, h) + boff + n * 2048 + k * 1024); } while (0)
#define PG8_MMA(ai, bj, At, Bt) do { __builtin_amdgcn_s_setprio(1); _Pragma("unroll") for (int m = 0; m < 4; ++m) _Pragma("unroll") for (int n = 0; n < 2; ++n) _Pragma("unroll") for (int k = 0; k < 2; ++k) \
        acc[ai][bj][m][n] = __builtin_amdgcn_mfma_f32_16x16x32_bf16(Bt[n][k], At[m][k], acc[ai][bj][m][n], 0, 0, 0); __builtin_amdgcn_s_setprio(0); } while (0)
#define PG8_WAIT_V(n) asm volatile("s_waitcnt vmcnt(" #n ")" ::: "memory")
#define PG8_WAIT_L(n) asm volatile("s_waitcnt lgkmcnt(" #n ")" ::: "memory")
#define PG8_BAR __builtin_amdgcn_s_barrier()
#define PG8_SCHED __builtin_amdgcn_sched_barrier(0)
    Unit cur, nxt; int ui = 0;
    if (!S.next(0, cur)) return;
    f32x4 acc[2][2][4][2];
#pragma unroll
    for (int a = 0; a < 2; ++a)
#pragma unroll
        for (int b = 0; b < 2; ++b)
#pragma unroll
            for (int m = 0; m < 4; ++m)
#pragma unroll
                for (int n = 0; n < 2; ++n) acc[a][b][m][n] = (f32x4){0.f, 0.f, 0.f, 0.f};
    bf16x8 At[4][2], B0[2][2], B1[2][2];
    const char* cA = (const char*)g.A + (size_t)cur.pm * tstep + cur.pk * koff; const char* cB = (const char*)g.Bt + (size_t)cur.pn * tstep + cur.pk * koff;
    S.a_ready(cur);
    if constexpr (SP2) {
        PG8_STAGE(PG8_SB(0, 0), cB, voffB); PG8_STAGE(PG8_SB(0, 1), cB + hstep, voffB); PG8_STAGE(PG8_SA(0, 0), cA, voffA); PG8_STAGE(PG8_SA(0, 1), cA + hstep, voffA);
        if (wr == 1) PG8_BAR;
        PG8_WAIT_V(2); PG8_BAR;
        PG8_STAGE(PG8_SB(1, 0), cB + kstep, voffB); PG8_STAGE(PG8_SA(1, 0), cA + kstep, voffA); PG8_STAGE(PG8_SB(1, 1), cB + hstep + kstep, voffB);
        PG8_WAIT_V(6); PG8_BAR;
    } else {
        PG8_STAGE(PG8_SB(0, 0), cB, voffB); PG8_STAGE(PG8_SA(0, 0), cA, voffA); PG8_STAGE(PG8_SB(0, 1), cB + hstep, voffB); PG8_STAGE(PG8_SA(0, 1), cA + hstep, voffA);
        if (wr == 1) PG8_BAR;
        PG8_WAIT_V(4); PG8_BAR;
        PG8_STAGE(PG8_SB(1, 0), cB + kstep, voffB); PG8_STAGE(PG8_SA(1, 0), cA + kstep, voffA); PG8_STAGE(PG8_SB(1, 1), cB + hstep + kstep, voffB);
        PG8_WAIT_V(6); PG8_BAR;
    }
    for (;;) {
        const bool has_next = S.next(ui + 1, nxt);
        const char* nA = has_next ? (const char*)g.A + (size_t)nxt.pm * tstep + nxt.pk * koff : cA; const char* nB = has_next ? (const char*)g.Bt + (size_t)nxt.pn * tstep + nxt.pk * koff : cB;
        for (int t = 0; t < nt; t += 2) {
            const bool last = (t == nt - 2);
            const char* a1 = cA + (size_t)(t + 1) * kstep;
            const char* a2 = last ? nA : cA + (size_t)(t + 2) * kstep; const char* b2 = last ? nB : cB + (size_t)(t + 2) * kstep;
            const char* a3 = a2 + kstep; const char* b3 = b2 + kstep;
            if (last && has_next) S.a_ready(nxt);
            if constexpr (SP2) {
            PG8_LDB(B0, 0, 0); PG8_LDB(B1, 0, 1); PG8_SCHED; PG8_LDA(At, 0, 0); PG8_STAGE(PG8_SA(1, 1), a1 + hstep, voffA);
            PG8_WAIT_V(8); PG8_WAIT_L(0); PG8_BAR; PG8_MMA(0, 0, At, B0); PG8_MMA(0, 1, At, B1); PG8_BAR; PG8_SCHED;
            PG8_LDA(At, 0, 1); PG8_STAGE(PG8_SB(0, 0), b2, voffB); PG8_STAGE(PG8_SB(0, 1), b2 + hstep, voffB); PG8_STAGE(PG8_SA(0, 0), a2, voffA);
            PG8_WAIT_V(8); PG8_WAIT_L(0); PG8_BAR; PG8_MMA(1, 0, At, B0); PG8_MMA(1, 1, At, B1); PG8_BAR; PG8_SCHED;
            PG8_LDB(B0, 1, 0); PG8_LDB(B1, 1, 1); PG8_SCHED; PG8_LDA(At, 1, 0); PG8_STAGE(PG8_SA(0, 1), a2 + hstep, voffA);
            PG8_WAIT_V(8); PG8_WAIT_L(0); PG8_BAR; PG8_MMA(0, 0, At, B0); PG8_MMA(0, 1, At, B1); PG8_BAR; PG8_SCHED;
            PG8_LDA(At, 1, 1); PG8_STAGE(PG8_SB(1, 0), b3, voffB); PG8_STAGE(PG8_SB(1, 1), b3 + hstep, voffB); PG8_STAGE(PG8_SA(1, 0), a3, voffA);
            PG8_WAIT_V(8); PG8_WAIT_L(0); PG8_BAR; PG8_MMA(1, 0, At, B0); PG8_MMA(1, 1, At, B1); PG8_BAR; PG8_SCHED;
            } else {
            PG8_LDB(B0, 0, 0); PG8_SCHED; PG8_LDA(At, 0, 0); PG8_STAGE(PG8_SA(1, 1), a1 + hstep, voffA);
            PG8_WAIT_L(8); PG8_BAR; PG8_WAIT_L(0); PG8_MMA(0, 0, At, B0); PG8_BAR; PG8_SCHED;
            PG8_LDB(B1, 0, 1); PG8_STAGE(PG8_SB(0, 0), b2, voffB);
            PG8_BAR; PG8_WAIT_L(0); PG8_MMA(0, 1, At, B1); PG8_BAR;
            PG8_LDA(At, 0, 1); PG8_STAGE(PG8_SA(0, 0), a2, voffA);
            PG8_BAR; PG8_WAIT_L(0); PG8_MMA(1, 0, At, B0); PG8_BAR; PG8_SCHED;
            PG8_STAGE(PG8_SB(0, 1), b2 + hstep, voffB);
            PG8_WAIT_V(6); PG8_BAR; PG8_MMA(1, 1, At, B1); PG8_BAR;
            PG8_LDB(B0, 1, 0); PG8_SCHED; PG8_LDA(At, 1, 0); PG8_STAGE(PG8_SA(0, 1), a2 + hstep, voffA);
            PG8_WAIT_L(8); PG8_BAR; PG8_WAIT_L(0); PG8_MMA(0, 0, At, B0); PG8_BAR; PG8_SCHED;
            PG8_LDB(B1, 1, 1); PG8_STAGE(PG8_SB(1, 0), b3, voffB);
            PG8_BAR; PG8_WAIT_L(0); PG8_MMA(0, 1, At, B1); PG8_BAR;
            PG8_LDA(At, 1, 1); PG8_STAGE(PG8_SA(1, 0), a3, voffA);
            PG8_BAR; PG8_WAIT_L(0); PG8_MMA(1, 0, At, B0); PG8_BAR; PG8_SCHED;
            PG8_STAGE(PG8_SB(1, 1), b3 + hstep, voffB);
            PG8_WAIT_V(6); PG8_BAR; PG8_MMA(1, 1, At, B1); PG8_BAR;
            }
        }
        if constexpr (ALIGN_EPI) { if (wr == 0) PG8_BAR; }
        if constexpr (!Epi::AFTER_DRAIN) { E(acc, cur, wr, wc, fr, fq); S.done(cur); }
        if (!has_next) break;
#pragma unroll
        for (int a = 0; a < 2; ++a)
#pragma unroll
            for (int b = 0; b < 2; ++b)
#pragma unroll
                for (int m = 0; m < 4; ++m)
#pragma unroll
                    for (int n = 0; n < 2; ++n) acc[a][b][m][n] = (f32x4){0.f, 0.f, 0.f, 0.f};
        cur = nxt; cA = nA; cB = nB; ++ui;
        if constexpr (ALIGN_EPI) { if (wr == 1) PG8_BAR; }
    }
    PG8_WAIT_V(0);
    if constexpr (!ALIGN_EPI) { if (wr == 0) PG8_BAR; }
    PG8_BAR;
    if constexpr (Epi::AFTER_DRAIN) { E.fused(acc, cur, wr, wc, fr, fq, lds, wid, lane); S.done(cur); }
#undef PG8_SA
#undef PG8_SB
#undef PG8_STAGE
#undef PG8_LDA
#undef PG8_LDB
#undef PG8_MMA
#undef PG8_WAIT_V
#undef PG8_WAIT_L
#undef PG8_BAR
#undef PG8_SCHED
}
}
#define GAS __attribute__((address_space(1)))
#define LAS __attribute__((address_space(3)))
typedef unsigned short bf16;
typedef unsigned v4u __attribute__((ext_vector_type(4)));
typedef float f32x4 __attribute__((ext_vector_type(4)));
typedef short bf16x8 __attribute__((ext_vector_type(8)));
typedef GAS unsigned gu32;
typedef GAS unsigned long long gu64;
#define RLX_AGENT __ATOMIC_RELAXED, __HIP_MEMORY_SCOPE_AGENT
#define LDS_WAIT() asm volatile("s_waitcnt lgkmcnt(0)" ::: "memory")
#define VM_WAIT() asm volatile("s_waitcnt vmcnt(0)" ::: "memory")
__device__ __forceinline__ unsigned long long rt() { return __builtin_amdgcn_s_memrealtime(); }
__device__ __forceinline__ unsigned f2bf(float f) { unsigned u = __builtin_bit_cast(unsigned, f); return (u + 0x7fffu + ((u >> 16) & 1u)) >> 16; }
__device__ __forceinline__ unsigned pk2(float lo, float hi) { return f2bf(lo) | (f2bf(hi) << 16); }

#define XB_TMO      128
#define XB_XCNT(j)  (256  + 64 * (j))
#define XB_XSUB(j)  (1280 + 64 * (j))
#define XB_XGEN(j)  (2304 + 64 * (j))
#define XB_TOP      3328
#define XB_TOPGEN   3392
#define XCD_BAR_WORDS 3456
#define XB_SPIN_CAP (1u << 18)

__device__ __forceinline__ unsigned xb_ld(unsigned* p)              { return __hip_atomic_load(p, __ATOMIC_RELAXED, __HIP_MEMORY_SCOPE_AGENT); }
__device__ __forceinline__ unsigned xb_add(unsigned* p, unsigned v) { return __hip_atomic_fetch_add(p, v, __ATOMIC_RELAXED, __HIP_MEMORY_SCOPE_AGENT); }
__device__ __forceinline__ unsigned xb_xcc_id() { return (unsigned)__builtin_amdgcn_s_getreg((3 << 11) | 20) & 0xFu; }
#define XB_SPIN(cond, bar) do { unsigned _sp = 0; while (cond) { __builtin_amdgcn_s_sleep(1); \
    if ((++_sp & 255u) == 0u) { if (xb_ld(&(bar)[XB_TMO])) break; if (_sp > XB_SPIN_CAP) { atomicAdd(&(bar)[XB_TMO], 1u); break; } } } } while (0)

struct XcdBarrier {
    unsigned* bar; unsigned x;
    volatile LAS unsigned* st;
};

__device__ __forceinline__ XcdBarrier xcd_barrier_post(unsigned* bar, volatile LAS unsigned* st, bool leader) {
    XcdBarrier b; b.bar = bar; b.x = xb_xcc_id(); b.st = st;
    if (leader) (void)xb_add(&bar[XB_XCNT(b.x)], 1u);
    return b;
}
__device__ __forceinline__ void xcd_barrier_complete(unsigned* bar, unsigned x, unsigned& nloc, unsigned& nx) {
    const unsigned G = gridDim.x * gridDim.y * gridDim.z;
    unsigned sum, cnt, mine, sp = 0u;
    for (;;) {
        sum = 0u; cnt = 0u; mine = 0u;
#pragma unroll
        for (unsigned j = 0; j < 16; ++j) { const unsigned c = xb_ld(&bar[XB_XCNT(j)]); sum += c; cnt += (c > 0u) ? 1u : 0u; mine = (j == x) ? c : mine; }
        if (sum == G) break;
        __builtin_amdgcn_s_sleep(1);
        if ((++sp & 255u) == 0u) { if (xb_ld(&bar[XB_TMO])) break; if (sp > XB_SPIN_CAP) { atomicAdd(&bar[XB_TMO], 1u); break; } }
    }
    nloc = mine > 0u ? mine : 1u; nx = cnt > 0u ? cnt : 1u;
}

__device__ __forceinline__ void xcd_barrier(const XcdBarrier& b, bool leader) {
    asm volatile("s_waitcnt vmcnt(0)" ::: "memory");
    __syncthreads();
    if (leader) {
        unsigned* bar = b.bar;
        __builtin_amdgcn_s_waitcnt(0);
        unsigned nloc = b.st[0], nx = b.st[1];
        if (nloc == 0u) { xcd_barrier_complete(bar, b.x, nloc, nx); b.st[0] = nloc; b.st[1] = nx; }
        const unsigned old = xb_add(&bar[XB_XSUB(b.x)], 1u);
        const unsigned gen = old / nloc;
        if (old + 1u == (gen + 1u) * nloc) {
            __builtin_amdgcn_fence(__ATOMIC_RELEASE, "agent");
            asm volatile("s_waitcnt vmcnt(0)" ::: "memory");
            const unsigned og = xb_add(&bar[XB_TOP], 1u);
            const unsigned tg = og / nx;
            if (og + 1u == (tg + 1u) * nx) xb_add(&bar[XB_TOPGEN], 1u);
            else XB_SPIN(xb_ld(&bar[XB_TOPGEN]) == tg, bar);
            __builtin_amdgcn_fence(__ATOMIC_ACQUIRE, "agent");
            xb_add(&bar[XB_XGEN(b.x)], 1u);
            asm volatile("s_waitcnt vmcnt(0)" ::: "memory");
        } else {
            XB_SPIN(xb_ld(&bar[XB_XGEN(b.x)]) == gen, bar);
            __builtin_amdgcn_fence(__ATOMIC_ACQUIRE, "agent");
            asm volatile("s_waitcnt vmcnt(0)" ::: "memory");
        }
    }
    __syncthreads();
}

constexpr int NWAVES = 8, NTHR = 512;
constexpr int DM = 2048, MROWS = 12288, DEPTH = 4;
constexpr int INC = 5152, INP = 5376, FF = 5632, GU = 11264;
constexpr int NMOD = 6 * DM;
constexpr float EPS = 1e-6f;
constexpr int PC_QA = 0, PC_KA = 512, PC_VA = 768, PC_QD = 1024, PC_KD = 1536, PC_VD = 2048, PC_Z = 2560, PC_XBC = 3584, PC_DT = 5120;
constexpr int RC_QA = 0, RC_KA = 512, RC_QD = 768, RC_KD = 1280, RCW = 1792;
constexpr size_t OUT_AK = 25165824, OUT_AV = OUT_AK + 4194304, OUT_DK = OUT_AV + 4194304, OUT_DV = OUT_DK + 8388608, OUT_SF = OUT_DV + 8388608, OUT_SB = OUT_SF + 8388608;
constexpr size_t MiB = 1u << 20;
constexpr size_t WS_CTL = 0, CTL_ZERO_BYTES = 1 * MiB;
constexpr size_t WS_TAB = 1 * MiB, WS_MOD = 2 * MiB, WS_MODP = 3 * MiB;
constexpr size_t WS_WIN = 8 * MiB, WS_WOUT = 92 * MiB, WS_WGU = 124 * MiB, WS_WDN = 300 * MiB;
constexpr size_t WS_H = 388 * MiB, WS_U = 484 * MiB, WS_P = 532 * MiB, WS_MIX = 658 * MiB, WS_ACT = 706 * MiB, WS_QKR = 838 * MiB;
constexpr size_t WS_XBC = 866 * MiB, WS_DT = 938 * MiB, WS_YF = 940 * MiB, WS_YB = 988 * MiB, WS_ST = 1036 * MiB, WS_EDEC = 1132 * MiB, WS_CDEC = 1134 * MiB, WS_SSQ = 1135 * MiB, WS_END = 1136 * MiB;
constexpr int CW_BAR = 4096;
constexpr int RING_BYTES = 131072, LDSCTL_OFF = RING_BYTES, MISC_OFF = LDSCTL_OFF + 320, LDS_BYTES = 147456;

struct Params { const float* in[28]; float* out; unsigned char* ws; int ph_lo, ph_hi; };
typedef __attribute__((address_space(4))) const Params* PP;
struct Frame { LAS unsigned char* lds; int tid, lane, wave, vcu, G; };

template <int M> __device__ __forceinline__ float xor_lt32(float v) { return __builtin_bit_cast(float, __builtin_amdgcn_ds_swizzle(__builtin_bit_cast(int, v), 0x1F | (M << 10))); }
__device__ __forceinline__ float half_sum(float v) { const unsigned u = __builtin_bit_cast(unsigned, v); auto r = __builtin_amdgcn_permlane32_swap(u, u, false, false); return __builtin_bit_cast(float, (unsigned)r[0]) + __builtin_bit_cast(float, (unsigned)r[1]); }
__device__ __forceinline__ float half_max(float v) { const unsigned u = __builtin_bit_cast(unsigned, v); auto r = __builtin_amdgcn_permlane32_swap(u, u, false, false); return fmaxf(__builtin_bit_cast(float, (unsigned)r[0]), __builtin_bit_cast(float, (unsigned)r[1])); }
__device__ __forceinline__ float bperm(float v, int srclane) { return __builtin_bit_cast(float, __builtin_amdgcn_ds_bpermute(srclane << 2, __builtin_bit_cast(int, v))); }
__device__ __forceinline__ float wave_sum(float v) { v += xor_lt32<1>(v); v += xor_lt32<2>(v); v += xor_lt32<4>(v); v += xor_lt32<8>(v); v += xor_lt32<16>(v); return half_sum(v); }
__device__ __forceinline__ float wave_max(float v) { v = fmaxf(v, xor_lt32<1>(v)); v = fmaxf(v, xor_lt32<2>(v)); v = fmaxf(v, xor_lt32<4>(v)); v = fmaxf(v, xor_lt32<8>(v)); v = fmaxf(v, xor_lt32<16>(v)); return half_max(v); }
__device__ __forceinline__ float bflo(unsigned w) { return __uint_as_float(w << 16); }
__device__ __forceinline__ float bfhi(unsigned w) { return __uint_as_float(w & 0xffff0000u); }
__device__ __forceinline__ float bf1(bf16 b) { return __uint_as_float((unsigned)b << 16); }
__device__ __forceinline__ float silu(float x) { return x / (1.0f + __expf(-x)); }

__device__ __forceinline__ void p0_transpose_item(const float* W, int K, int N, bf16* WT, int rowmap, LAS float* scr, int item, int lane) {
    const int nblk = N / 32, kb = item / nblk, nb = item % nblk, k0 = 64 * kb, n0 = 32 * nb;
    { float t[32]; const float* src = W + (size_t)(k0 + (lane >> 5)) * N + n0 + (lane & 31);
#pragma unroll
      for (int i = 0; i < 32; ++i) t[i] = src[(size_t)(2 * i) * N];
#pragma unroll
      for (int i = 0; i < 32; ++i) scr[(2 * i + (lane >> 5)) * 33 + (lane & 31)] = t[i]; }
    LDS_WAIT(); asm volatile("" ::: "memory");
    int r0 = n0;
    if (rowmap) r0 = (n0 < FF) ? ((n0 >> 7) * 256 + (n0 & 127)) : (((n0 - FF) >> 7) * 256 + 128 + ((n0 - FF) & 127));
    const int c = lane & 7;
#pragma unroll
    for (int j = 0; j < 4; ++j) { const int n = (lane >> 3) + 8 * j; const LAS float* s = scr + (8 * c) * 33 + n;
        v4u o; o.x = pk2(s[0 * 33], s[1 * 33]); o.y = pk2(s[2 * 33], s[3 * 33]); o.z = pk2(s[4 * 33], s[5 * 33]); o.w = pk2(s[6 * 33], s[7 * 33]);
        *(v4u*)(WT + (size_t)(r0 + n) * K + k0 + 8 * c) = o; }
    LDS_WAIT(); asm volatile("" ::: "memory");
}
__device__ __forceinline__ void conv_layer(Frame& F, PP p, int l, int wi, int nw) {
    unsigned char* ws = p->ws;
    LAS float* scr = (LAS float*)(F.lds + F.wave * 16384);
    constexpr int I_IN = 32 * (INC / 32), I_OUT = 32 * 64, I_GU = 32 * (GU / 32), I_DN = (FF / 64) * 64, I_L = I_IN + I_OUT + I_GU + I_DN;
    for (int it = wi; it < I_L; it += nw) {
        int r = it;
        if (r < I_IN) { p0_transpose_item(p->in[14] + (size_t)l * DM * INC, DM, INC, (bf16*)(ws + WS_WIN) + (size_t)l * INP * DM, 0, scr, r, F.lane); continue; } r -= I_IN;
        if (r < I_OUT) { p0_transpose_item(p->in[24] + (size_t)l * DM * DM, DM, DM, (bf16*)(ws + WS_WOUT) + (size_t)l * DM * DM, 0, scr, r, F.lane); continue; } r -= I_OUT;
        if (r < I_GU) { p0_transpose_item(p->in[25] + (size_t)l * DM * GU, DM, GU, (bf16*)(ws + WS_WGU) + (size_t)l * GU * DM, 1, scr, r, F.lane); continue; } r -= I_GU;
        p0_transpose_item(p->in[26] + (size_t)l * FF * DM, FF, DM, (bf16*)(ws + WS_WDN) + (size_t)l * DM * FF, 0, scr, r, F.lane);
    }
    constexpr int PADV = (INP - INC) * DM * 2 / 16;
    for (int i = wi * 64 + F.lane; i < PADV; i += nw * 64) *((v4u*)((bf16*)(ws + WS_WIN) + (size_t)l * INP * DM + (size_t)INC * DM) + i) = (v4u){0u, 0u, 0u, 0u};
}
__device__ __forceinline__ void adaln_layer(Frame& F, PP p, int l, int bi, int nb) {
    LAS float* sc = (LAS float*)F.lds;
    float* MODP = (float*)(p->ws + WS_MODP);
    for (int it = bi; it < 8 * 24; it += nb) {
        const int kc = it / 24, nc = it % 24;
        __syncthreads();
        if (F.tid < 256) { const int k = kc * 256 + F.tid; sc[F.tid] = silu(p->in[9][k]); sc[256 + F.tid] = silu(p->in[8][k]); sc[512 + F.tid] = silu(p->in[8][DM + k]); }
        __syncthreads();
        const int n = nc * 512 + F.tid;
        const float* w = p->in[10] + ((size_t)l * DM + (size_t)kc * 256) * NMOD + n;
        float a0 = 0.f, a1 = 0.f, a2 = 0.f;
        for (int k = 0; k < 256; k += 32) {
            float wv[32];
#pragma unroll
            for (int e = 0; e < 32; ++e) wv[e] = w[(size_t)(k + e) * NMOD];
#pragma unroll
            for (int e = 0; e < 32; ++e) { a0 += sc[k + e] * wv[e]; a1 += sc[256 + k + e] * wv[e]; a2 += sc[512 + k + e] * wv[e]; }
        }
        float* o = MODP + ((size_t)(kc * DEPTH + l) * 3) * NMOD + n;
        o[0] = a0; o[NMOD] = a1; o[2 * NMOD] = a2;
    }
    __syncthreads();
}
__device__ __forceinline__ void mod_layer(PP p, int l, int gt, int ngt) {
    const float* MODP = (const float*)(p->ws + WS_MODP); float* MOD = (float*)(p->ws + WS_MOD);
    for (int i = gt; i < 3 * NMOD; i += ngt) {
        const int n = i % NMOD; const int gi = l * 3 * NMOD + i;
        float s = p->in[11][l * NMOD + n];
#pragma unroll
        for (int kc = 0; kc < 8; ++kc) s += MODP[(size_t)kc * DEPTH * 3 * NMOD + gi];
        MOD[gi] = s;
    }
}
__device__ __forceinline__ void p0_prologue(Frame& F, PP p) {
    unsigned char* ws = p->ws;
    conv_layer(F, p, 0, F.vcu * NWAVES + F.wave, F.G * NWAVES);
    adaln_layer(F, p, 0, blockIdx.x, F.G);
    if (blockIdx.x == F.G - 1) {
        float2* tabA = (float2*)(ws + WS_TAB); float2* tabB = (float2*)(ws + WS_TAB + 16384); float* lam = (float*)(ws + WS_TAB + 32768);
        for (int i = F.tid; i < 2048 + 1024; i += NTHR) {
            const bool isA = i < 2048; const int j = isA ? i : i - 2048; const int pos = isA ? (j >> 5) : (j >> 4), k = isA ? (j & 31) : (j & 15);
            double r = 10000.0; r = sqrt(r); r = sqrt(r); r = sqrt(r); r = sqrt(r); if (isA) r = sqrt(r);
            const double ri = 1.0 / r; double inv = 1.0; for (int q = 0; q < k; ++q) inv *= ri;
            const double ang = (double)pos * inv; const double TWO_PI = 6.283185307179586476925;
            const double x = ang - TWO_PI * rint(ang / TWO_PI), x2 = x * x;
            double st = x, ss = x, ct = 1.0, cs = 1.0;
            for (int q = 1; q <= 16; ++q) { st *= -x2 / (double)((2 * q) * (2 * q + 1)); ss += st; ct *= -x2 / (double)((2 * q - 1) * (2 * q)); cs += ct; }
            const float2 v = make_float2((float)cs, (float)ss);
            if (isA) tabA[j] = v; else tabB[j] = v;
        }
        if (F.tid < DEPTH) {
            const float* lv = p->in[16] + F.tid * 256; float s01 = 0.f, s23 = 0.f;
            for (int i = 0; i < 64; ++i) { s01 += lv[i] * lv[64 + i]; s23 += lv[128 + i] * lv[192 + i]; }
            const float li = 0.8f - 0.6f * expf(-0.3f * (float)F.tid);
            lam[F.tid] = expf(s01) - expf(s23) + li; lam[4 + F.tid] = li;
        }
    }
}
__device__ __forceinline__ void norm_phase(Frame& F, const float* H0, const float* H1, const float* g, const float* modl, int shoff, int scoff, bf16* U) {
    const int gw = F.vcu * NWAVES + F.wave, NGW = F.G * NWAVES;
    for (int m = gw; m < MROWS; m += NGW) {
        const int c = m < 4096 ? 0 : (m < 8192 ? 1 : 2);
        const float* sh = modl + c * NMOD + shoff; const float* sc = modl + c * NMOD + scoff;
        const f32x4* xr = (const f32x4*)(m < 4096 ? H0 + (size_t)m * DM : H1 + (size_t)(m - 4096) * DM) + F.lane;
        f32x4 v[8]; float ss = 0.f;
#pragma unroll
        for (int j = 0; j < 8; ++j) { v[j] = xr[64 * j]; ss += (v[j].x * v[j].x + v[j].y * v[j].y) + (v[j].z * v[j].z + v[j].w * v[j].w); }
        const float rstd = 1.0f / sqrtf(wave_sum(ss) * (1.0f / DM) + EPS);
        unsigned long long* o8 = (unsigned long long*)(U + (size_t)m * DM) + F.lane;
#pragma unroll
        for (int j = 0; j < 8; ++j) { const int col = 4 * F.lane + 256 * j;
            const f32x4 gv = *(const f32x4*)(g + col), sv = *(const f32x4*)(sc + col), hv = *(const f32x4*)(sh + col);
            const f32x4 o = (v[j] * rstd) * gv * (sv + 1.0f) + hv;
            o8[64 * j] = (unsigned long long)pk2(o.x, o.y) | ((unsigned long long)pk2(o.z, o.w) << 32); }
    }
}
__device__ __forceinline__ void final_phase(Frame& F, const float* H, const float* g, float* out) {
    const int gw = F.vcu * NWAVES + F.wave, NGW = F.G * NWAVES;
    for (int m = gw; m < MROWS; m += NGW) {
        const f32x4* xr = (const f32x4*)(H + (size_t)m * DM) + F.lane;
        f32x4 v[8]; float ss = 0.f;
#pragma unroll
        for (int j = 0; j < 8; ++j) { v[j] = xr[64 * j]; ss += (v[j].x * v[j].x + v[j].y * v[j].y) + (v[j].z * v[j].z + v[j].w * v[j].w); }
        const float rstd = 1.0f / sqrtf(wave_sum(ss) * (1.0f / DM) + EPS);
        f32x4* o = (f32x4*)(out + (size_t)m * DM) + F.lane;
#pragma unroll
        for (int j = 0; j < 8; ++j) { const f32x4 gv = *(const f32x4*)(g + 4 * F.lane + 256 * j); o[64 * j] = (v[j] * rstd) * gv; }
    }
}
__device__ __forceinline__ void prep_phase(Frame& F, PP p, int l) {
    unsigned char* ws = p->ws;
    const bf16* P = (const bf16*)(ws + WS_P); bf16* QKR = (bf16*)(ws + WS_QKR); bf16* XBC = (bf16*)(ws + WS_XBC); float* DT = (float*)(ws + WS_DT);
    const float2* tabA = (const float2*)(ws + WS_TAB); const float2* tabB = (const float2*)(ws + WS_TAB + 16384);
    const float* cw = p->in[18] + (size_t)l * 5 * 1536; const float* cb = p->in[19] + (size_t)l * 1536; const float* dtb = p->in[20] + l * 32;
    const int gw = F.vcu * NWAVES + F.wave, NGW = F.G * NWAVES, lane = F.lane;
    for (int m = gw; m < MROWS; m += NGW) {
        const bf16* prow = P + (size_t)m * INP;
        const int s0 = m < 4096 ? (m & ~255) : (4096 + ((m - 4096) & ~4095)); const int len = m < 4096 ? 256 : 4096; const int t = m - s0;
#pragma unroll
        for (int j = 0; j < 3; ++j) { const int c0 = 8 * lane + 512 * j;
            f32x4 a0 = *(const f32x4*)(cb + c0), a1 = *(const f32x4*)(cb + c0 + 4);
#pragma unroll
            for (int k = 0; k < 5; ++k) { const int tt = t + k - 2;
                if (tt >= 0 && tt < len) { const v4u raw = *(const v4u*)(P + (size_t)(s0 + tt) * INP + PC_XBC + c0);
                    const f32x4 w0 = *(const f32x4*)(cw + k * 1536 + c0), w1 = *(const f32x4*)(cw + k * 1536 + c0 + 4);
                    a0.x += w0.x * bflo(raw.x); a0.y += w0.y * bfhi(raw.x); a0.z += w0.z * bflo(raw.y); a0.w += w0.w * bfhi(raw.y);
                    a1.x += w1.x * bflo(raw.z); a1.y += w1.y * bfhi(raw.z); a1.z += w1.z * bflo(raw.w); a1.w += w1.w * bfhi(raw.w); } }
            a0.x = silu(a0.x); a0.y = silu(a0.y); a0.z = silu(a0.z); a0.w = silu(a0.w); a1.x = silu(a1.x); a1.y = silu(a1.y); a1.z = silu(a1.z); a1.w = silu(a1.w);
            *(v4u*)(XBC + (size_t)m * 1536 + c0) = (v4u){pk2(a0.x, a0.y), pk2(a0.z, a0.w), pk2(a1.x, a1.y), pk2(a1.z, a1.w)}; }
        if (lane < 32) { const float v = bf1(prow[PC_DT + lane]) + dtb[lane]; DT[(size_t)m * 32 + lane] = v > 20.f ? v : log1pf(__expf(v)); }
        if (m >= 4096) {
            const int gr = t >> 6, gc = t & 63; bf16* qrow = QKR + (size_t)(m - 4096) * RCW;
#pragma unroll
            for (int i = 0; i < 6; ++i) { const int d = lane; const int src = (i < 4 ? PC_QA + i * 128 : PC_KA + (i - 4) * 128) + d, dst = (i < 4 ? RC_QA + i * 128 : RC_KA + (i - 4) * 128) + d;
                const float x1 = bf1(prow[src]), x2 = bf1(prow[src + 64]); const float2 cs = d < 32 ? tabA[gr * 32 + d] : tabA[gc * 32 + d - 32];
                qrow[dst] = (bf16)f2bf(x1 * cs.x - x2 * cs.y); qrow[dst + 64] = (bf16)f2bf(x1 * cs.y + x2 * cs.x); }
#pragma unroll
            for (int i = 0; i < 8; ++i) { const int pp = lane + 64 * i, ch = pp >> 5, d = pp & 31; const int src = (ch < 8 ? PC_QD + ch * 64 : PC_KD + (ch - 8) * 64) + d, dst = (ch < 8 ? RC_QD + ch * 64 : RC_KD + (ch - 8) * 64) + d;
                const float x1 = bf1(prow[src]), x2 = bf1(prow[src + 32]); const float2 cs = d < 16 ? tabB[gr * 16 + d] : tabB[gc * 16 + d - 16];
                qrow[dst] = (bf16)f2bf(x1 * cs.x - x2 * cs.y); qrow[dst + 32] = (bf16)f2bf(x1 * cs.y + x2 * cs.x); }
        } else {
            const int b = m >> 8, s = m & 255; const size_t r = (size_t)((b * DEPTH + l) * 256 + s);
            { const unsigned long long w = *((const unsigned long long*)(prow + PC_KA) + lane); *((f32x4*)(p->out + OUT_AK + r * 256) + lane) = (f32x4){bflo((unsigned)w), bfhi((unsigned)w), bflo((unsigned)(w >> 32)), bfhi((unsigned)(w >> 32))}; }
            { const unsigned long long w = *((const unsigned long long*)(prow + PC_VA) + lane); *((f32x4*)(p->out + OUT_AV + r * 256) + lane) = (f32x4){bflo((unsigned)w), bfhi((unsigned)w), bflo((unsigned)(w >> 32)), bfhi((unsigned)(w >> 32))}; }
            { const v4u w = *((const v4u*)(prow + PC_KD) + lane); f32x4* o = (f32x4*)(p->out + OUT_DK + r * 512) + 2 * lane; o[0] = (f32x4){bflo(w.x), bfhi(w.x), bflo(w.y), bfhi(w.y)}; o[1] = (f32x4){bflo(w.z), bfhi(w.z), bflo(w.w), bfhi(w.w)}; }
            { const v4u w = *((const v4u*)(prow + PC_VD) + lane); f32x4* o = (f32x4*)(p->out + OUT_DV + r * 512) + 2 * lane; o[0] = (f32x4){bflo(w.x), bfhi(w.x), bflo(w.y), bfhi(w.y)}; o[1] = (f32x4){bflo(w.z), bfhi(w.z), bflo(w.w), bfhi(w.w)}; }
        }
    }
}
typedef float f32x16 __attribute__((ext_vector_type(16)));
typedef short s16x4 __attribute__((ext_vector_type(4)));
constexpr int FA_KSTR = 272, FA_VSTR = 320, FA_KB = 64 * FA_KSTR, FA_VB = 64 * FA_VSTR, FA_BUF = FA_KB + FA_VB;
constexpr int FA_OSTR = 272;
struct Seg { const void* k; const void* v; int ks, vs, n, f32, pos0; };
struct FaTile { v4u k[2], v[2]; };

__device__ __forceinline__ unsigned cvtpk(float lo, float hi) { typedef float f2 __attribute__((ext_vector_type(2))); typedef __bf16 b2 __attribute__((ext_vector_type(2))); f2 v = {lo, hi}; b2 b = __builtin_convertvector(v, b2); return __builtin_bit_cast(unsigned, b); }
__device__ __forceinline__ void fa_load(FaTile& t, const Seg& sg, int key0, int tid) {
#pragma unroll
    for (int i = 0; i < 2; ++i) { const int c = tid + 512 * i, key = c >> 4, ch = c & 15;
        if (sg.f32) {
            const f32x4* ks = (const f32x4*)((const float*)sg.k + (size_t)(key0 + key) * sg.ks + ch * 8);
            const f32x4* vs = (const f32x4*)((const float*)sg.v + (size_t)(key0 + key) * sg.vs + ch * 8);
            const f32x4 a = ks[0], b = ks[1], c2 = vs[0], d = vs[1];
            t.k[i] = (v4u){cvtpk(a.x, a.y), cvtpk(a.z, a.w), cvtpk(b.x, b.y), cvtpk(b.z, b.w)};
            t.v[i] = (v4u){cvtpk(c2.x, c2.y), cvtpk(c2.z, c2.w), cvtpk(d.x, d.y), cvtpk(d.z, d.w)};
        } else {
            t.k[i] = *(const v4u*)((const bf16*)sg.k + (size_t)(key0 + key) * sg.ks + ch * 8);
            t.v[i] = *(const v4u*)((const bf16*)sg.v + (size_t)(key0 + key) * sg.vs + ch * 8);
        } }
}
__device__ __forceinline__ void fa_store(const FaTile& t, LAS unsigned char* buf, int tid) {
#pragma unroll
    for (int i = 0; i < 2; ++i) { const int c = tid + 512 * i, key = c >> 4, ch = c & 15;
        *(LAS v4u*)(buf + key * FA_KSTR + ch * 16) = t.k[i];
        *(LAS v4u*)(buf + FA_KB + key * FA_VSTR + ch * 16) = t.v[i]; }
}
template <int NKS>
__device__ __forceinline__ void fa_s(const LAS unsigned char* buf, const bf16x8 (&q)[NKS], f32x16& p0, f32x16& p1, int kcolb, int lane) {
    const int r32 = lane & 31, h = lane >> 5;
#pragma unroll
    for (int r = 0; r < 16; ++r) { p0[r] = 0.f; p1[r] = 0.f; }
    const LAS unsigned char* kp = buf + r32 * FA_KSTR + kcolb + h * 16;
#pragma unroll
    for (int ks = 0; ks < NKS; ++ks) {
        const bf16x8 a0 = *(const LAS bf16x8*)(kp + ks * 32), a1 = *(const LAS bf16x8*)(kp + 32 * FA_KSTR + ks * 32);
        p0 = __builtin_amdgcn_mfma_f32_32x32x16_bf16(a0, q[ks], p0, 0, 0, 0);
        p1 = __builtin_amdgcn_mfma_f32_32x32x16_bf16(a1, q[ks], p1, 0, 0, 0);
    }
}
typedef float f32x2 __attribute__((ext_vector_type(2)));
__device__ __forceinline__ float max3f(float a, float b, float c) { float r; asm("v_max3_f32 %0, %1, %2, %3" : "=v"(r) : "v"(a), "v"(b), "v"(c)); return r; }
#define FA_TR(dst, vb, off) asm volatile("ds_read_b64_tr_b16 %0, %1 offset:%c2" : "=&v"(dst) : "v"(vb), "i"(off) : "memory")
template <bool DB>
__device__ __forceinline__ void fa_smpv(const LAS unsigned char* buf, f32x16& p0, f32x16& p1, f32x16 (&o)[4], float& m, float& lsum, float c, int lane, bool masked, int dpos  ) {
    const int h = lane >> 5;
    if (masked) {
#pragma unroll
        for (int r = 0; r < 16; ++r) { const int d0 = dpos - ((r & 3) + 8 * (r >> 2) + 4 * h), d1 = d0 - 32;
            if (d0 > 128 || d0 < -128) p0[r] = -INFINITY; if (d1 > 128 || d1 < -128) p1[r] = -INFINITY; }
    }
    float ma = max3f(p0[0], p0[1], p0[2]), mb = max3f(p1[0], p1[1], p1[2]);
#pragma unroll
    for (int r = 3; r < 15; r += 2) { ma = max3f(ma, p0[r], p0[r + 1]); mb = max3f(mb, p1[r], p1[r + 1]); }
    float mt = half_max(max3f(ma, mb, fmaxf(p0[15], p1[15])));
    const float mn = fmaxf(m, mt * c);
    const float alpha = __builtin_amdgcn_exp2f(m - mn);
    m = mn;
    const f32x2 c2 = {c, c}, mn2 = {mn, mn}; f32x2 rs2 = {0.f, 0.f};
#pragma unroll
    for (int r = 0; r < 16; r += 2) {
        f32x2 u = (f32x2){p0[r], p0[r + 1]} * c2 - mn2, v = (f32x2){p1[r], p1[r + 1]} * c2 - mn2;
        u.x = __builtin_amdgcn_exp2f(u.x); u.y = __builtin_amdgcn_exp2f(u.y); v.x = __builtin_amdgcn_exp2f(v.x); v.y = __builtin_amdgcn_exp2f(v.y);
        p0[r] = u.x; p0[r + 1] = u.y; p1[r] = v.x; p1[r + 1] = v.y; rs2 += u + v;
    }
    lsum = lsum * alpha + (rs2.x + rs2.y);
    if (__builtin_amdgcn_ballot_w64(alpha != 1.0f) != 0ull) {
#pragma unroll
        for (int b = 0; b < 4; ++b) o[b] = o[b] * alpha;
    }
    bf16x8 pb[4];
    { v4u w;
      w = (v4u){cvtpk(p0[0], p0[1]), cvtpk(p0[2], p0[3]), cvtpk(p0[4], p0[5]), cvtpk(p0[6], p0[7])}; pb[0] = __builtin_bit_cast(bf16x8, w);
      w = (v4u){cvtpk(p0[8], p0[9]), cvtpk(p0[10], p0[11]), cvtpk(p0[12], p0[13]), cvtpk(p0[14], p0[15])}; pb[1] = __builtin_bit_cast(bf16x8, w);
      w = (v4u){cvtpk(p1[0], p1[1]), cvtpk(p1[2], p1[3]), cvtpk(p1[4], p1[5]), cvtpk(p1[6], p1[7])}; pb[2] = __builtin_bit_cast(bf16x8, w);
      w = (v4u){cvtpk(p1[8], p1[9]), cvtpk(p1[10], p1[11]), cvtpk(p1[12], p1[13]), cvtpk(p1[14], p1[15])}; pb[3] = __builtin_bit_cast(bf16x8, w); }
    const int i16 = lane & 15, gc = (lane >> 4) & 1;
    const unsigned vb = (unsigned)(unsigned long long)(buf + FA_KB + (4 * h + (i16 >> 2)) * FA_VSTR + (16 * gc + 4 * (i16 & 3)) * 2);
    s16x4 lo[DB ? 2 : 1][4], hi[DB ? 2 : 1][4];
#define FA_RD(S, SET) do { FA_TR(lo[SET][0], vb, (16 * (S)) * FA_VSTR); FA_TR(hi[SET][0], vb, (16 * (S) + 8) * FA_VSTR); FA_TR(lo[SET][1], vb, (16 * (S)) * FA_VSTR + 64); FA_TR(hi[SET][1], vb, (16 * (S) + 8) * FA_VSTR + 64); \
                           FA_TR(lo[SET][2], vb, (16 * (S)) * FA_VSTR + 128); FA_TR(hi[SET][2], vb, (16 * (S) + 8) * FA_VSTR + 128); FA_TR(lo[SET][3], vb, (16 * (S)) * FA_VSTR + 192); FA_TR(hi[SET][3], vb, (16 * (S) + 8) * FA_VSTR + 192); } while (0)
#define FA_MM(S, SET) do { _Pragma("unroll") for (int b = 0; b < 4; ++b) { const bf16x8 a = (bf16x8){lo[SET][b][0], lo[SET][b][1], lo[SET][b][2], lo[SET][b][3], hi[SET][b][0], hi[SET][b][1], hi[SET][b][2], hi[SET][b][3]}; \
                           o[b] = __builtin_amdgcn_mfma_f32_32x32x16_bf16(a, pb[S], o[b], 0, 0, 0); } } while (0)
    asm volatile("s_waitcnt lgkmcnt(0)" ::: "memory"); __builtin_amdgcn_sched_barrier(0);
    if (DB) {
        FA_RD(0, 0);
        FA_RD(1, 1); asm volatile("s_waitcnt lgkmcnt(8)" ::: "memory"); __builtin_amdgcn_sched_barrier(0); FA_MM(0, 0); __builtin_amdgcn_sched_barrier(0);
        FA_RD(2, 0); asm volatile("s_waitcnt lgkmcnt(8)" ::: "memory"); __builtin_amdgcn_sched_barrier(0); FA_MM(1, 1); __builtin_amdgcn_sched_barrier(0);
        FA_RD(3, 1); asm volatile("s_waitcnt lgkmcnt(8)" ::: "memory"); __builtin_amdgcn_sched_barrier(0); FA_MM(2, 0); __builtin_amdgcn_sched_barrier(0);
        asm volatile("s_waitcnt lgkmcnt(0)" ::: "memory"); __builtin_amdgcn_sched_barrier(0); FA_MM(3, 1);
    } else {
        FA_RD(0, 0); asm volatile("s_waitcnt lgkmcnt(0)" ::: "memory"); __builtin_amdgcn_sched_barrier(0); FA_MM(0, 0); __builtin_amdgcn_sched_barrier(0);
        FA_RD(1, 0); asm volatile("s_waitcnt lgkmcnt(0)" ::: "memory"); __builtin_amdgcn_sched_barrier(0); FA_MM(1, 0); __builtin_amdgcn_sched_barrier(0);
        FA_RD(2, 0); asm volatile("s_waitcnt lgkmcnt(0)" ::: "memory"); __builtin_amdgcn_sched_barrier(0); FA_MM(2, 0); __builtin_amdgcn_sched_barrier(0);
        FA_RD(3, 0); asm volatile("s_waitcnt lgkmcnt(0)" ::: "memory"); __builtin_amdgcn_sched_barrier(0); FA_MM(3, 0);
    }
#undef FA_RD
#undef FA_MM
}
template <int NKS>
__device__ __forceinline__ void fa_tile(const LAS unsigned char* buf, const bf16x8 (&q)[NKS], f32x16 (&o)[4], float& m, float& lsum, float c, int kcolb, int lane, bool masked, int dpos) {
    f32x16 p0, p1; fa_s<NKS>(buf, q, p0, p1, kcolb, lane); fa_smpv<false>(buf, p0, p1, o, m, lsum, c, lane, masked, dpos);
}
template <int MODE>
__device__ __forceinline__ void fa_unit(Frame& F, const bf16* qg, int qstride, const Seg& s0, const Seg& s1, bool two, int qpos0, float c, const float* sinkp, float lam, float onems, const float* dnorm, bf16* dst, int dstride) {
    constexpr int NKS = MODE == 0 ? 8 : 4;
    int tid_ = F.tid; asm volatile("" : "+v"(tid_));
    const int tid = tid_, lane = tid & 63, w = F.wave, r32 = lane & 31, h = lane >> 5, grp = w >> 2, qrow0 = (w & 3) * 32;
    const int kcolb = MODE == 0 ? 0 : grp * 128;
    qg += (MODE == 0 ? grp * 128 : grp * 64); if (MODE == 0) dst += grp * 128;
    bf16x8 q[NKS];
#pragma unroll
    for (int ks = 0; ks < NKS; ++ks) q[ks] = *(const bf16x8*)(qg + (size_t)(qrow0 + r32) * qstride + ks * 16 + h * 8);
    f32x16 o[4];
#pragma unroll
    for (int b = 0; b < 4; ++b)
#pragma unroll
        for (int r = 0; r < 16; ++r) o[b][r] = 0.f;
    float m = -INFINITY, lsum = 0.f;
    const int nt0 = s0.n >> 6, nt = nt0 + (two ? (s1.n >> 6) : 0);
    FaTile t;
    __syncthreads();
    if (MODE == 1) {
        fa_load(t, s0, 0, tid); fa_store(t, F.lds, tid);
        if (nt > 1) { if (1 < nt0) fa_load(t, s0, 64, tid); else fa_load(t, s1, (1 - nt0) * 64, tid); fa_store(t, F.lds + FA_BUF, tid); }
        __syncthreads();
        f32x16 pa0, pa1; fa_s<NKS>(F.lds, q, pa0, pa1, kcolb, lane);
        int b0 = 0, b1 = FA_BUF, b2 = 2 * FA_BUF;
        for (int it = 0; it < nt; ++it) {
            const bool more2 = it + 2 < nt;
            if (more2) { const int n = it + 2; if (n < nt0) fa_load(t, s0, n * 64, tid); else fa_load(t, s1, (n - nt0) * 64, tid); }
            f32x16 pn0, pn1;
            if (it + 1 < nt) fa_s<NKS>(F.lds + b1, q, pn0, pn1, kcolb, lane);
            fa_smpv<false>(F.lds + b0, pa0, pa1, o, m, lsum, c, lane, false, 0);
            if (more2) fa_store(t, F.lds + b2, tid);
            __syncthreads();
            pa0 = pn0; pa1 = pn1;
            const int tb = b0; b0 = b1; b1 = b2; b2 = tb;
        }
    } else {
    fa_load(t, s0, 0, tid); fa_store(t, F.lds, tid);
    __syncthreads();
    for (int it = 0; it < nt; ++it) {
        const bool more = it + 1 < nt;
        if (more) { const int n = it + 1; if (n < nt0) fa_load(t, s0, n * 64, tid); else fa_load(t, s1, (n - nt0) * 64, tid); }
        const bool inseg1 = it >= nt0; const int pos0 = inseg1 ? s1.pos0 : s0.pos0; const int key0 = (inseg1 ? it - nt0 : it) * 64;
        fa_tile<NKS>(F.lds + (it & 1) * FA_BUF, q, o, m, lsum, c, kcolb, lane, pos0 >= 0, (qpos0 + qrow0 + r32) - (pos0 + key0));
        if (more) fa_store(t, F.lds + ((it + 1) & 1) * FA_BUF, tid);
        __syncthreads();
    }
    }
    const float ltot = half_sum(lsum);
    if (MODE == 0) {
        const float inv = 1.0f / (ltot + __builtin_amdgcn_exp2f(sinkp[grp] * 1.4426950408889634f - m));
#pragma unroll
        for (int b = 0; b < 4; ++b) o[b] = o[b] * inv;
    } else {
        LAS float* comb = (LAS float*)(F.lds + (w & 3) * 16384);
        if (grp == 1) { const float f = lam / ltot;
#pragma unroll
            for (int b = 0; b < 4; ++b)
#pragma unroll
                for (int r = 0; r < 16; ++r) comb[(32 * b + (r & 3) + 8 * (r >> 2) + 4 * h) * 32 + r32] = o[b][r] * f; }
        __syncthreads();
        if (grp == 0) { const float inv = 1.0f / ltot; float ss = 0.f;
#pragma unroll
            for (int b = 0; b < 4; ++b)
#pragma unroll
                for (int r = 0; r < 16; ++r) { const float v = o[b][r] * inv - comb[(32 * b + (r & 3) + 8 * (r >> 2) + 4 * h) * 32 + r32]; o[b][r] = v; ss += v * v; }
            ss = half_sum(ss);
            const float rs = onems / sqrtf(ss * (1.0f / 128.0f) + EPS);
#pragma unroll
            for (int b = 0; b < 4; ++b)
#pragma unroll
                for (int r = 0; r < 16; ++r) o[b][r] = o[b][r] * rs * dnorm[32 * b + (r & 3) + 8 * (r >> 2) + 4 * h]; }
    }
    if (MODE == 0 || grp == 0) {
        LAS unsigned char* st = F.lds + (MODE == 0 ? w * (32 * FA_OSTR) : 65536 + (w & 3) * (32 * FA_OSTR));
#pragma unroll
        for (int b = 0; b < 4; ++b)
#pragma unroll
            for (int k = 0; k < 4; ++k) { typedef unsigned u2 __attribute__((ext_vector_type(2)));
                *(LAS u2*)(st + r32 * FA_OSTR + (32 * b + 8 * k + 4 * h) * 2) = (u2){cvtpk(o[b][4 * k], o[b][4 * k + 1]), cvtpk(o[b][4 * k + 2], o[b][4 * k + 3])}; }
        asm volatile("s_waitcnt lgkmcnt(0)" ::: "memory");
#pragma unroll
        for (int i = 0; i < 8; ++i) { const int cc = lane + 64 * i, row = cc >> 4, c16 = cc & 15;
            *(v4u*)(dst + (size_t)(qrow0 + row) * dstride + c16 * 8) = *(const LAS v4u*)(st + row * FA_OSTR + c16 * 16); }
    }
}
constexpr int NCHUNK = 96;
constexpr int S1_CSTR = 272, S1_XSTR = 160;
constexpr int S3_CM = 0, S3_BM = 34816, S3_XM = 69632, S3_TAB = 90112, S3_SSP = 92160;
constexpr int S1_BM = 0, S1_XM = 34816, S1_TAB = 55296;
#define LBAR() asm volatile("s_waitcnt lgkmcnt(0)\n\ts_barrier" ::: "memory")
__device__ __forceinline__ int crow16(int r, int h) { return (r & 3) + 8 * (r >> 2) + 4 * h; }

struct S1Pre { v4u b[4], x[2]; float dt, al; };
__device__ __forceinline__ void s1_load(S1Pre& q, const bf16* XB, const float* DT, const float* alog, int u, int tid, int wave) {
    const int cc = u >> 4, hd = u & 15, m0 = cc * 128, g = hd >> 3;
    const unsigned offB = (unsigned)((tid >> 4) * 1536 + (tid & 15) * 8) * 2u, offX = (unsigned)((tid >> 3) * 1536 + (tid & 7) * 8) * 2u;
#pragma unroll
    for (int i = 0; i < 4; ++i) { const char* bs = (const char*)(XB + (size_t)(m0 + 32 * i) * 1536 + 1024 + g * 128); q.b[i] = *(const v4u*)(bs + offB); }
#pragma unroll
    for (int i = 0; i < 2; ++i) { const char* xs = (const char*)(XB + (size_t)(m0 + 64 * i) * 1536 + hd * 64); q.x[i] = *(const v4u*)(xs + offX); }
    q.dt = *(const float*)((const char*)(DT + (size_t)m0 * 32 + hd) + (unsigned)((tid & 127) * 32 + ((tid >> 7) & 1) * 16) * 4u);
    q.al = alog[(wave & 1) * 16 + hd];
}
__device__ __forceinline__ void s1_store(const S1Pre& q, LAS unsigned char* L, int tid) {
#pragma unroll
    for (int i = 0; i < 4; ++i) { const int c = tid + 512 * i, row = c >> 4, ch = c & 15; *(LAS v4u*)(L + S1_BM + row * S1_CSTR + ch * 16) = q.b[i]; }
#pragma unroll
    for (int i = 0; i < 2; ++i) { const int c = tid + 512 * i, row = c >> 3, ch = c & 7; *(LAS v4u*)(L + S1_XM + row * S1_XSTR + ch * 16) = q.x[i]; }
    if (tid < 256) ((LAS float*)(L + S1_TAB))[tid] = q.dt;
}
__device__ __forceinline__ void s1_phase_units(Frame& F, PP p, int l, int ufirst, int ustride, int uend) {
    unsigned char* ws = p->ws;
    int tid_ = F.tid; asm volatile("" : "+v"(tid_));
    const int tid = tid_, lane = tid & 63, w = F.wave, r32 = lane & 31, hh = lane >> 5, i16 = lane & 15, gc = (lane >> 4) & 1;
    const bf16* XB = (const bf16*)(ws + WS_XBC); const float* DT = (const float*)(ws + WS_DT); const float* alog = p->in[21] + l * 32;
    float* CUMG = (float*)(ws + WS_EDEC); float* CDEC = (float*)(ws + WS_CDEC); bf16* STR = (bf16*)(ws + WS_ST);
    LAS unsigned char* L = F.lds; LAS float* tab = (LAS float*)(L + S1_TAB);
    int u = ufirst; if (u >= uend) return;
    S1Pre q; s1_load(q, XB, DT, alog, u, tid, w);
    while (u < uend) {
        const int cc = u >> 4, hd = u & 15; const float al = q.al;
        LBAR();
        s1_store(q, L, tid);
        LBAR();
        const int un = u + ustride; if (un < uend) s1_load(q, XB, DT, alog, un, tid, w);
        if (w < 2) {
            const float a = -__expf(al);
            const float d0 = tab[w * 128 + 2 * lane], d1 = tab[w * 128 + 2 * lane + 1];
            const float v0 = d0 * a, v1 = d1 * a, s = v0 + v1;
            float inc = s;
            if (w == 0) {
#pragma unroll
                for (int o = 1; o < 64; o <<= 1) { const float t = bperm(inc, lane - o); if (lane >= o) inc += t; }
            } else {
#pragma unroll
                for (int o = 1; o < 64; o <<= 1) { const float t = bperm(inc, lane + o); if (lane + o < 64) inc += t; }
            }
            const float exc = inc - s;
            const float c0 = (w == 0) ? exc + v0 : exc + v1 + v0, c1 = (w == 0) ? exc + v0 + v1 : exc + v1;
            const float tot = bperm(inc, w == 0 ? 63 : 0);
            tab[(2 + w) * 128 + 2 * lane] = __expf(tot - c0) * d0; tab[(2 + w) * 128 + 2 * lane + 1] = __expf(tot - c1) * d1;
            typedef float f2 __attribute__((ext_vector_type(2)));
            *(f2*)(CUMG + ((size_t)(cc * 16 + hd) * 2 + w) * 128 + 2 * lane) = (f2){c0, c1};
            if (lane == 0) CDEC[(w * NCHUNK + cc) * 16 + hd] = __expf(tot);
        }
        LBAR();
        {
            const int nb = w & 3, pb = w >> 2;
            f32x16 st[2];
#pragma unroll
            for (int d = 0; d < 2; ++d)
#pragma unroll
                for (int r = 0; r < 16; ++r) st[d][r] = 0.f;
            const LAS unsigned char* bp = L + S1_BM + (8 * hh + (i16 >> 2)) * S1_CSTR + (32 * nb + 16 * gc + 4 * (i16 & 3)) * 2;
            const LAS unsigned char* xp = L + S1_XM + (8 * hh + (i16 >> 2)) * S1_XSTR + (32 * pb + 16 * gc + 4 * (i16 & 3)) * 2;
#pragma unroll
            for (int ks = 0; ks < 8; ++ks) {
                const s16x4 alo = __builtin_amdgcn_ds_read_tr16_b64_v4i16((LAS s16x4*)(bp + (16 * ks) * S1_CSTR));
                const s16x4 ahi = __builtin_amdgcn_ds_read_tr16_b64_v4i16((LAS s16x4*)(bp + (16 * ks + 4) * S1_CSTR));
                const bf16x8 afr = (bf16x8){alo[0], alo[1], alo[2], alo[3], ahi[0], ahi[1], ahi[2], ahi[3]};
                const s16x4 lo = __builtin_amdgcn_ds_read_tr16_b64_v4i16((LAS s16x4*)(xp + (16 * ks) * S1_XSTR));
                const s16x4 hi = __builtin_amdgcn_ds_read_tr16_b64_v4i16((LAS s16x4*)(xp + (16 * ks + 4) * S1_XSTR));
                const float x0 = bf1((bf16)lo[0]), x1 = bf1((bf16)lo[1]), x2 = bf1((bf16)lo[2]), x3 = bf1((bf16)lo[3]), x4 = bf1((bf16)hi[0]), x5 = bf1((bf16)hi[1]), x6 = bf1((bf16)hi[2]), x7 = bf1((bf16)hi[3]);
#pragma unroll
                for (int d = 0; d < 2; ++d) {
                    const f32x4 w0 = *(const LAS f32x4*)(tab + (2 + d) * 128 + 16 * ks + 8 * hh), w1 = *(const LAS f32x4*)(tab + (2 + d) * 128 + 16 * ks + 8 * hh + 4);
                    const v4u t = (v4u){cvtpk(x0 * w0.x, x1 * w0.y), cvtpk(x2 * w0.z, x3 * w0.w), cvtpk(x4 * w1.x, x5 * w1.y), cvtpk(x6 * w1.z, x7 * w1.w)};
                    st[d] = __builtin_amdgcn_mfma_f32_32x32x16_bf16(afr, __builtin_bit_cast(bf16x8, t), st[d], 0, 0, 0);
                }
            }
#pragma unroll
            for (int d = 0; d < 2; ++d) { bf16* so = STR + ((size_t)(d * NCHUNK + cc) * 16 + hd) * 8192 + (size_t)((nb * 2 + pb) * 2) * 512 + lane * 8;
#pragma unroll
                for (int j = 0; j < 2; ++j) *(v4u*)(so + j * 512) = (v4u){cvtpk(st[d][8 * j], st[d][8 * j + 1]), cvtpk(st[d][8 * j + 2], st[d][8 * j + 3]), cvtpk(st[d][8 * j + 4], st[d][8 * j + 5]), cvtpk(st[d][8 * j + 6], st[d][8 * j + 7])}; }
        }
        u = un;
    }
    LBAR();
}
__device__ __forceinline__ void s2_scan(Frame& F, PP p, int l) {
    unsigned char* ws = p->ws; bf16* STR = (bf16*)(ws + WS_ST); const float* CDEC = (const float*)(ws + WS_CDEC);
    const int gt = F.vcu * NTHR + F.tid, NGT = F.G * NTHR;
    for (int idx = gt; idx < 576 * 1024; idx += NGT) {
        const int combo = idx >> 10, v = idx & 1023, seq = combo >> 5, hd = (combo >> 1) & 15, dir = combo & 1;
        const int c0 = seq < 16 ? seq * 2 : 32 + (seq - 16) * 32, nc = seq < 16 ? 2 : 32;
        const int ln = v & 63, blk = v >> 6, j = blk & 1, pb = (blk >> 1) & 1, nb = blk >> 2; const int pp = 32 * pb + (ln & 31), n0 = 32 * nb + 16 * j + 4 * (ln >> 5);
        f32x4 H0 = (f32x4){0.f, 0.f, 0.f, 0.f}, H1 = H0;
        if (seq >= 16) { const float* h0 = p->in[dir ? 7 : 6] + (((size_t)(seq - 16) * DEPTH + l) * 16 + hd) * 8192 + pp * 128 + n0; H0 = *(const f32x4*)h0; H1 = *(const f32x4*)(h0 + 8); }
        for (int k = 0; k < nc; k += 2) {
            const int ca = dir ? c0 + nc - 1 - k : c0 + k, cb = dir ? ca - 1 : ca + 1;
            v4u* pa = (v4u*)(STR + ((size_t)(dir * NCHUNK + ca) * 16 + hd) * 8192) + v; v4u* pbb = (v4u*)(STR + ((size_t)(dir * NCHUNK + cb) * 16 + hd) * 8192) + v;
            const v4u ta = *pa, tb = *pbb; const float da = CDEC[(dir * NCHUNK + ca) * 16 + hd], db = CDEC[(dir * NCHUNK + cb) * 16 + hd];
            *pa = (v4u){cvtpk(H0.x, H0.y), cvtpk(H0.z, H0.w), cvtpk(H1.x, H1.y), cvtpk(H1.z, H1.w)};
            H0 = H0 * da + (f32x4){bflo(ta.x), bfhi(ta.x), bflo(ta.y), bfhi(ta.y)}; H1 = H1 * da + (f32x4){bflo(ta.z), bfhi(ta.z), bflo(ta.w), bfhi(ta.w)};
            *pbb = (v4u){cvtpk(H0.x, H0.y), cvtpk(H0.z, H0.w), cvtpk(H1.x, H1.y), cvtpk(H1.z, H1.w)};
            H0 = H0 * db + (f32x4){bflo(tb.x), bfhi(tb.x), bflo(tb.y), bfhi(tb.y)}; H1 = H1 * db + (f32x4){bflo(tb.z), bfhi(tb.z), bflo(tb.w), bfhi(tb.w)};
        }
        if (seq < 16) { float* o = p->out + (dir ? OUT_SB : OUT_SF) + (((size_t)seq * DEPTH + l) * 16 + hd) * 8192 + pp * 128 + n0; *(f32x4*)o = H0; *(f32x4*)(o + 8) = H1; }
    }
}
struct S3Pre { v4u c[4], b[4], x[2]; float dt, cum, dk; };
__device__ __forceinline__ void s3_load(S3Pre& q, const bf16* XB, const float* DT, const float* CUMG, const float* dskip, int u, int tid) {
    const int cc = u >> 4, hd = u & 15, m0 = cc * 128, g = hd >> 3;
    const unsigned offB = (unsigned)((tid >> 4) * 1536 + (tid & 15) * 8) * 2u, offX = (unsigned)((tid >> 3) * 1536 + (tid & 7) * 8) * 2u;
#pragma unroll
    for (int i = 0; i < 4; ++i) { const char* bs = (const char*)(XB + (size_t)(m0 + 32 * i) * 1536 + g * 128); q.c[i] = *(const v4u*)(bs + 2560 + offB); q.b[i] = *(const v4u*)(bs + 2048 + offB); }
#pragma unroll
    for (int i = 0; i < 2; ++i) { const char* xs = (const char*)(XB + (size_t)(m0 + 64 * i) * 1536 + hd * 64); q.x[i] = *(const v4u*)(xs + offX); }
    q.dt = *(const float*)((const char*)(DT + (size_t)m0 * 32 + hd) + (unsigned)((tid & 127) * 32 + ((tid >> 7) & 1) * 16) * 4u);
    q.cum = *(const float*)((const char*)(CUMG + (size_t)(cc * 16 + hd) * 256) + (unsigned)(tid & 255) * 4u);
    q.dk = dskip[hd];
}
__device__ __forceinline__ void s3_store(const S3Pre& q, LAS unsigned char* L, int tid) {
#pragma unroll
    for (int i = 0; i < 4; ++i) { const int c = tid + 512 * i, row = c >> 4, ch = c & 15; *(LAS v4u*)(L + S3_CM + row * S1_CSTR + ch * 16) = q.c[i]; *(LAS v4u*)(L + S3_BM + row * S1_CSTR + ch * 16) = q.b[i]; }
#pragma unroll
    for (int i = 0; i < 2; ++i) { const int c = tid + 512 * i, row = c >> 3, ch = c & 7; *(LAS v4u*)(L + S3_XM + row * S1_XSTR + ch * 16) = q.x[i]; }
    if (tid < 256) { ((LAS float*)(L + S3_TAB))[tid] = q.cum; ((LAS float*)(L + S3_TAB))[256 + tid] = q.dt; }
}
__device__ __forceinline__ void s3_phase(Frame& F, PP p, int l) {
    unsigned char* ws = p->ws;
    int tid_ = F.tid; asm volatile("" : "+v"(tid_));
    const int tid = tid_, lane = tid & 63, w = F.wave, r32 = lane & 31, hh = lane >> 5, i16 = lane & 15, gc = (lane >> 4) & 1;
    const bf16* XB = (const bf16*)(ws + WS_XBC); const bf16* P = (const bf16*)(ws + WS_P); bf16* MIX = (bf16*)(ws + WS_MIX);
    const float* DT = (const float*)(ws + WS_DT); const float* CUMG = (const float*)(ws + WS_EDEC); const bf16* STR = (const bf16*)(ws + WS_ST); float* SSQ = (float*)(ws + WS_SSQ);
    LAS unsigned char* L = F.lds; const LAS float* tab = (const LAS float*)(L + S3_TAB); LAS float* SSP = (LAS float*)(L + S3_SSP);
    const int lb = w & 3, pb = w >> 2, lpos = 32 * lb + r32;
    const int uend = NCHUNK * 16;
    int u = blockIdx.x; if (u >= uend) return;
    const float* dskip = p->in[22] + l * 16;
    S3Pre q; s3_load(q, XB, DT, CUMG, dskip, u, tid);
    while (u < uend) {
        const int cc = u >> 4, hd = u & 15, m0 = cc * 128; const float dk = q.dk;
        LBAR();
        s3_store(q, L, tid);
        LBAR();
        const int un = u + F.G; if (un < uend) s3_load(q, XB, DT, CUMG, dskip, un, tid);
        v4u hf[2][8];
#pragma unroll
        for (int k = 0; k < 8; ++k) hf[0][k] = *(const v4u*)((const char*)(STR + ((size_t)(0 * NCHUNK + cc) * 16 + hd) * 8192 + (((k >> 1) * 2 + pb) * 2 + (k & 1)) * 512) + (unsigned)lane * 16u);
        unsigned long long zw[4];
        f32x16 acc;
#pragma unroll
        for (int r = 0; r < 16; ++r) acc[r] = 0.f;
#pragma unroll
        for (int d = 0; d < 2; ++d) {
            const LAS float* cum = tab + d * 128; const LAS float* dtv = tab + (2 + d) * 128; const float cl = cum[lpos];
            const int sb0 = d == 0 ? 0 : lb, sb1 = d == 0 ? lb : 3;
            for (int sb = sb0; sb <= sb1; ++sb) {
                f32x16 cb;
#pragma unroll
                for (int r = 0; r < 16; ++r) cb[r] = 0.f;
#pragma unroll
                for (int ks = 0; ks < 8; ++ks) { const bf16x8 a = *(const LAS bf16x8*)(L + S3_BM + (32 * sb + r32) * S1_CSTR + ks * 32 + hh * 16);
                    const bf16x8 cfr = *(const LAS bf16x8*)(L + S3_CM + lpos * S1_CSTR + ks * 32 + hh * 16);
                    cb = __builtin_amdgcn_mfma_f32_32x32x16_bf16(a, cfr, cb, 0, 0, 0);
                    if ((ks & 3) == 3) __builtin_amdgcn_sched_barrier(0); }
#pragma unroll
                for (int r = 0; r < 16; ++r) { const int s = 32 * sb + crow16(r, hh);
                    float v = cb[r] * __expf(cl - cum[s]) * dtv[s];
                    const bool ok = d == 0 ? (s <= lpos) : (s >= lpos);
                    v = ok ? v : 0.f; if (d == 0 && s == lpos) v += dk;
                    cb[r] = v; }
                bf16x8 pb2[2];
                { v4u t;
                  t = (v4u){cvtpk(cb[0], cb[1]), cvtpk(cb[2], cb[3]), cvtpk(cb[4], cb[5]), cvtpk(cb[6], cb[7])}; pb2[0] = __builtin_bit_cast(bf16x8, t);
                  t = (v4u){cvtpk(cb[8], cb[9]), cvtpk(cb[10], cb[11]), cvtpk(cb[12], cb[13]), cvtpk(cb[14], cb[15])}; pb2[1] = __builtin_bit_cast(bf16x8, t); }
                const LAS unsigned char* xp = L + S3_XM + (32 * sb + 4 * hh + (i16 >> 2)) * S1_XSTR + (32 * pb + 16 * gc + 4 * (i16 & 3)) * 2;
#pragma unroll
                for (int k2 = 0; k2 < 2; ++k2) {
                    const s16x4 lo = __builtin_amdgcn_ds_read_tr16_b64_v4i16((LAS s16x4*)(xp + (16 * k2) * S1_XSTR));
                    const s16x4 hi = __builtin_amdgcn_ds_read_tr16_b64_v4i16((LAS s16x4*)(xp + (16 * k2 + 8) * S1_XSTR));
                    const bf16x8 a = (bf16x8){lo[0], lo[1], lo[2], lo[3], hi[0], hi[1], hi[2], hi[3]};
                    acc = __builtin_amdgcn_mfma_f32_32x32x16_bf16(a, pb2[k2], acc, 0, 0, 0);
                }
            }
            if (d == 0) {
#pragma unroll
                for (int k = 0; k < 8; ++k) hf[1][k] = *(const v4u*)((const char*)(STR + ((size_t)(1 * NCHUNK + cc) * 16 + hd) * 8192 + (((k >> 1) * 2 + pb) * 2 + (k & 1)) * 512) + (unsigned)lane * 16u);
#pragma unroll
                for (int k = 0; k < 4; ++k) zw[k] = *(const unsigned long long*)((const char*)(P + (size_t)m0 * INP + PC_Z + hd * 64 + 32 * pb + 8 * k) + (unsigned)(lpos * INP + 4 * hh) * 2u);
            }
        }
#pragma unroll
        for (int d = 0; d < 2; ++d) { const float e = __expf(tab[d * 128 + lpos]);
#pragma unroll
            for (int k = 0; k < 8; ++k) { typedef unsigned u2 __attribute__((ext_vector_type(2)));
                const LAS unsigned char* cp = L + S3_CM + lpos * S1_CSTR + (32 * (k >> 1) + 16 * (k & 1) + 4 * hh) * 2;
                const u2 c0 = *(const LAS u2*)cp, c1 = *(const LAS u2*)(cp + 16);
                const v4u t = (v4u){cvtpk(bflo(c0.x) * e, bfhi(c0.x) * e), cvtpk(bflo(c0.y) * e, bfhi(c0.y) * e), cvtpk(bflo(c1.x) * e, bfhi(c1.x) * e), cvtpk(bflo(c1.y) * e, bfhi(c1.y) * e)};
                acc = __builtin_amdgcn_mfma_f32_32x32x16_bf16(__builtin_bit_cast(bf16x8, hf[d][k]), __builtin_bit_cast(bf16x8, t), acc, 0, 0, 0); } }
        float ss = 0.f;
        char* mixr = (char*)(MIX + (size_t)m0 * DM + 1024 + hd * 64 + 32 * pb); const unsigned mixo = (unsigned)(lpos * DM + 4 * hh) * 2u;
#pragma unroll
        for (int k = 0; k < 4; ++k) { const unsigned long long z = zw[k];
            const float y0 = acc[4 * k] * silu(bflo((unsigned)z)), y1 = acc[4 * k + 1] * silu(bfhi((unsigned)z)), y2 = acc[4 * k + 2] * silu(bflo((unsigned)(z >> 32))), y3 = acc[4 * k + 3] * silu(bfhi((unsigned)(z >> 32)));
            ss += (y0 * y0 + y1 * y1) + (y2 * y2 + y3 * y3);
            *(unsigned long long*)(mixr + 16 * k + mixo) = (unsigned long long)cvtpk(y0, y1) | ((unsigned long long)cvtpk(y2, y3) << 32); }
        ss = half_sum(ss);
        if (hh == 0) SSP[pb * 128 + lpos] = ss;
        LBAR();
        if (tid < 128) SSQ[(size_t)(m0 + tid) * 16 + hd] = SSP[tid] + SSP[128 + tid];
        u = un;
    }
    LBAR();
}
__device__ __forceinline__ void nrm_phase(Frame& F, PP p, int l) {
    unsigned char* ws = p->ws; bf16* MIX = (bf16*)(ws + WS_MIX); const float* SSQ = (const float*)(ws + WS_SSQ); const float* sn = p->in[23] + l * 1024;
    const int gw = F.vcu * NWAVES + F.wave, NGW = F.G * NWAVES, lane = F.lane;
    for (int m = gw; m < MROWS; m += NGW) {
        const int c0 = lane * 16, g = lane >> 5;
        const f32x4 s0 = *(const f32x4*)(SSQ + (size_t)m * 16 + g * 8), s1 = *(const f32x4*)(SSQ + (size_t)m * 16 + g * 8 + 4);
        const float rs = 1.0f / sqrtf(((s0.x + s0.y) + (s0.z + s0.w) + (s1.x + s1.y) + (s1.z + s1.w)) * (1.0f / 512.0f) + EPS);
        v4u* q = (v4u*)(MIX + (size_t)m * DM + 1024 + c0); v4u a = q[0], b = q[1];
        const f32x4 g0 = *(const f32x4*)(sn + c0), g1 = *(const f32x4*)(sn + c0 + 4), g2 = *(const f32x4*)(sn + c0 + 8), g3 = *(const f32x4*)(sn + c0 + 12);
        a.x = cvtpk(bflo(a.x) * rs * g0.x, bfhi(a.x) * rs * g0.y); a.y = cvtpk(bflo(a.y) * rs * g0.z, bfhi(a.y) * rs * g0.w); a.z = cvtpk(bflo(a.z) * rs * g1.x, bfhi(a.z) * rs * g1.y); a.w = cvtpk(bflo(a.w) * rs * g1.z, bfhi(a.w) * rs * g1.w);
        b.x = cvtpk(bflo(b.x) * rs * g2.x, bfhi(b.x) * rs * g2.y); b.y = cvtpk(bflo(b.y) * rs * g2.z, bfhi(b.y) * rs * g2.w); b.z = cvtpk(bflo(b.z) * rs * g3.x, bfhi(b.z) * rs * g3.y); b.w = cvtpk(bflo(b.w) * rs * g3.z, bfhi(b.w) * rs * g3.w);
        q[0] = a; q[1] = b;
    }
}
__device__ __forceinline__ void mix1_phase(Frame& F, PP p, int l) {
    unsigned char* ws = p->ws;
    const bf16* P = (const bf16*)(ws + WS_P); const bf16* QKR = (const bf16*)(ws + WS_QKR); bf16* MIX = (bf16*)(ws + WS_MIX);
    const float* lamv = (const float*)(ws + WS_TAB + 32768);
    const float lam = lamv[l], onems = 1.0f - lamv[4 + l];
    const float* dnorm = p->in[17] + l * 128;
    constexpr int U_BL = 256, U_AL = 128, U_BC = 128, U_AC = 64, U_FA = U_BL + U_AL + U_BC + U_AC;
    const float LOG2E = 1.4426950408889634f, cA = 0.08838834764831845f * LOG2E, cB = 0.125f * LOG2E;
    for (int u = blockIdx.x; u < U_FA; u += F.G) {
        int r = u;
        int mode = 1; const bf16* qp; int qstr = RCW, qpos0 = 0; bool two = true; Seg s0, s1; bf16* dst; const float* sinkp = dnorm;
        if (r < U_BL) {
            const int b = r >> 7, h = (r >> 5) & 3, qb = r & 31; const int ml = b * 4096 + qb * 128;
            s0 = Seg{QKR + (size_t)(b * 4096) * RCW + RC_KD + h * 128, P + (size_t)(4096 + b * 4096) * INP + PC_VD + h * 128, RCW, INP, 4096, 0, -1};
            s1 = Seg{p->in[4] + ((size_t)(b * DEPTH + l) * 256) * 512 + h * 128, p->in[5] + ((size_t)(b * DEPTH + l) * 256) * 512 + h * 128, 512, 512, 256, 1, -1};
            qp = QKR + (size_t)ml * RCW + RC_QD + h * 128; dst = MIX + (size_t)(4096 + ml) * DM + 512 + h * 128;
        } else if (r < U_BL + U_AL) { r -= U_BL;
            const int b = r >> 6, kv = (r >> 5) & 1, qb = r & 31; const int ml = b * 4096 + qb * 128;
            const int w0 = qb * 128 - 128 < 0 ? 0 : qb * 128 - 128, w1 = qb * 128 + 256 > 4096 ? 4096 : qb * 128 + 256;
            s0 = Seg{p->in[2] + ((size_t)(b * DEPTH + l) * 256) * 256 + kv * 128, p->in[3] + ((size_t)(b * DEPTH + l) * 256) * 256 + kv * 128, 256, 256, 256, 1, -1};
            s1 = Seg{QKR + (size_t)(b * 4096 + w0) * RCW + RC_KA + kv * 128, P + (size_t)(4096 + b * 4096 + w0) * INP + PC_VA + kv * 128, RCW, INP, w1 - w0, 0, w0};
            mode = 0; qp = QKR + (size_t)ml * RCW + RC_QA + kv * 256; qpos0 = qb * 128; sinkp = p->in[15] + l * 4 + kv * 2; dst = MIX + (size_t)(4096 + ml) * DM + kv * 256;
        } else if (r < U_BL + U_AL + U_BC) { r -= U_BL + U_AL;
            const int b = r >> 3, h = (r >> 1) & 3, qb = r & 1; const int m0 = b * 256 + qb * 128;
            s0 = Seg{P + (size_t)(b * 256) * INP + PC_KD + h * 128, P + (size_t)(b * 256) * INP + PC_VD + h * 128, INP, INP, 256, 0, -1}; s1 = s0; two = false;
            qp = P + (size_t)m0 * INP + PC_QD + h * 128; qstr = INP; dst = MIX + (size_t)m0 * DM + 512 + h * 128;
        } else { r -= U_BL + U_AL + U_BC;
            const int b = r >> 2, kv = (r >> 1) & 1, qb = r & 1; const int m0 = b * 256 + qb * 128;
            s0 = Seg{P + (size_t)(b * 256) * INP + PC_KA + kv * 128, P + (size_t)(b * 256) * INP + PC_VA + kv * 128, INP, INP, 256, 0, -1}; s1 = s0; two = false;
            mode = 0; qp = P + (size_t)m0 * INP + PC_QA + kv * 256; qstr = INP; sinkp = p->in[15] + l * 4 + kv * 2; dst = MIX + (size_t)m0 * DM + kv * 256;
        }
        if (mode) fa_unit<1>(F, qp, qstr, s0, s1, two, qpos0, cB, sinkp, lam, onems, dnorm, dst, DM);
        else fa_unit<0>(F, qp, qstr, s0, s1, two, qpos0, cA, sinkp, lam, onems, dnorm, dst, DM);
    }
    __syncthreads();
    s1_phase_units(F, p, l, blockIdx.x, F.G, NCHUNK * 16);
}
#ifndef MK_ONE_LAUNCH
#define MK_ONE_LAUNCH 1
#endif
constexpr int PH_PER_LAYER = 11, PH_TOTAL = 2 + DEPTH * PH_PER_LAYER + 1;
__global__ void __launch_bounds__(NTHR, 2) mk_fwd(Params p_) {
    extern __shared__ __attribute__((aligned(16))) unsigned char lds[];
    Frame F;
    F.lds = (LAS unsigned char*)lds;
    F.tid = threadIdx.x; F.lane = F.tid & 63; F.wave = __builtin_amdgcn_readfirstlane(F.tid >> 6); const int wave0 = F.wave;
    F.G = gridDim.x; { const int bx = blockIdx.x; F.vcu = (F.G % 8 == 0) ? (bx % 8) * (F.G / 8) + bx / 8 : bx; }
    PP p = (PP)__builtin_amdgcn_kernarg_segment_ptr();
    for (int u = F.tid; u < (LDS_BYTES - LDSCTL_OFF) / 4; u += NTHR) ((LAS unsigned*)(F.lds + LDSCTL_OFF))[u] = 0u;
    __syncthreads();
    XcdBarrier bar; bar.bar = (unsigned*)(p->ws + WS_CTL) + CW_BAR; bar.x = 0; bar.st = nullptr;
#if MK_ONE_LAUNCH
    bar = xcd_barrier_post((unsigned*)(p->ws + WS_CTL) + CW_BAR, (volatile LAS unsigned*)(F.lds + MISC_OFF) + 8, F.tid == 0);
#define GRID_BAR() do { unsigned on_ = ~0u; asm volatile("" : "+s"(on_)); xcd_barrier(bar, wave0 == 0 && __builtin_amdgcn_mbcnt_hi(on_, __builtin_amdgcn_mbcnt_lo(on_, 0u)) == 0u); } while (0)
#else
#define GRID_BAR() do {} while (0)
#endif
    const int lo = p->ph_lo, hi = p->ph_hi;
#define IN(k) (lo <= (k) && (k) < hi)
#define SEAM(k) do { if (IN(k) && IN((k) + 1)) GRID_BAR(); } while (0)
#define ENTER() do { int wv_ = wave0; asm volatile("" : "+s"(wv_)); unsigned on_ = ~0u; asm volatile("" : "+s"(on_)); int t_ = wv_ * 64 + (int)__builtin_amdgcn_mbcnt_hi(on_, __builtin_amdgcn_mbcnt_lo(on_, 0u)); asm volatile("" : "+v"(t_)); F.tid = t_; F.lane = t_ & 63; F.wave = wv_; asm volatile("" : "+s"(p)); ws = p->ws; } while (0)
    unsigned char* ws;

    if (IN(0)) { ENTER(); p0_prologue(F, p); } SEAM(0);
    if (IN(1)) { ENTER(); mod_layer(p, 0, F.vcu * NTHR + F.tid, F.G * NTHR); } SEAM(1);
#pragma unroll 1
    for (int l = 0; l < DEPTH; ++l) {
        const int pb = 2 + l * PH_PER_LAYER;
        if (IN(pb + 0)) { ENTER(); norm_phase(F, l == 0 ? p->in[0] : (const float*)(ws + WS_H), l == 0 ? p->in[1] : (const float*)(ws + WS_H) + (size_t)4096 * DM, p->in[12] + l * DM, (const float*)(ws + WS_MOD) + (size_t)l * 3 * NMOD, 0, DM, (bf16*)(ws + WS_U)); } SEAM(pb + 0);
        if (IN(pb + 1)) { ENTER();
            pg8::Gemm g{(const bf16*)(ws + WS_U), (const bf16*)(ws + WS_WIN) + (size_t)l * INP * DM, MROWS, INP, DM, DM}; pg8::StaticOrder S; S.init(MROWS, INP, F.G, (int)blockIdx.x);
            pg8::EpiBf16 E{(bf16*)(ws + WS_P), INP};
            pg8::gemm_phase<pg8::EpiBf16, pg8::StaticOrder, true, true>(F.lds, g, S, E, F.tid);
        } SEAM(pb + 1);
        if (IN(pb + 2)) { ENTER(); prep_phase(F, p, l); } SEAM(pb + 2);
        if (IN(pb + 3)) { ENTER(); mix1_phase(F, p, l); } SEAM(pb + 3);
        if (IN(pb + 4)) { ENTER(); s2_scan(F, p, l); } SEAM(pb + 4);
        if (IN(pb + 5)) { ENTER(); s3_phase(F, p, l); } SEAM(pb + 5);
        if (IN(pb + 6)) { ENTER(); nrm_phase(F, p, l); } SEAM(pb + 6);
        if (IN(pb + 7)) { ENTER();
            pg8::Gemm g{(const bf16*)(ws + WS_MIX), (const bf16*)(ws + WS_WOUT) + (size_t)l * DM * DM, MROWS, DM, DM, DM}; pg8::StaticOrder S; S.init(MROWS, DM, F.G, (int)blockIdx.x);
            pg8::EpiResid E{l == 0 ? p->in[0] : (const float*)(ws + WS_H), l == 0 ? p->in[1] : (const float*)(ws + WS_H) + (size_t)4096 * DM, (float*)(ws + WS_H), DM, (const float*)(ws + WS_MOD) + (size_t)l * 3 * NMOD + 2 * DM, NMOD};
            pg8::gemm_phase<pg8::EpiResid, pg8::StaticOrder, true, true>(F.lds, g, S, E, F.tid);
            { const int nfull = F.G == 256 ? 128 : 0; if (l + 1 < DEPTH && (int)blockIdx.x >= nfull) adaln_layer(F, p, l + 1, (int)blockIdx.x - nfull, (int)F.G - nfull); }
        } SEAM(pb + 7);
        if (IN(pb + 8)) { ENTER(); norm_phase(F, (const float*)(ws + WS_H), (const float*)(ws + WS_H) + (size_t)4096 * DM, p->in[13] + l * DM, (const float*)(ws + WS_MOD) + (size_t)l * 3 * NMOD, 3 * DM, 4 * DM, (bf16*)(ws + WS_U)); } SEAM(pb + 8);
        if (IN(pb + 9)) { ENTER();
            pg8::Gemm g{(const bf16*)(ws + WS_U), (const bf16*)(ws + WS_WGU) + (size_t)l * GU * DM, MROWS, GU, DM, DM}; pg8::StaticOrder S; S.init(MROWS, GU, F.G, (int)blockIdx.x);
            pg8::EpiSwiGLU E{(bf16*)(ws + WS_ACT), FF};
            pg8::gemm_phase<pg8::EpiSwiGLU, pg8::StaticOrder, true, true>(F.lds, g, S, E, F.tid);
        } SEAM(pb + 9);
        if (IN(pb + 10)) { ENTER();
            pg8::Gemm g{(const bf16*)(ws + WS_ACT), (const bf16*)(ws + WS_WDN) + (size_t)l * DM * FF, MROWS, DM, FF, FF}; pg8::StaticOrder S; S.init(MROWS, DM, F.G, (int)blockIdx.x);
            if (l + 1 < DEPTH) mod_layer(p, l + 1, F.vcu * NTHR + F.tid, F.G * NTHR);
            pg8::EpiResid E{(const float*)(ws + WS_H), (const float*)(ws + WS_H) + (size_t)4096 * DM, (float*)(ws + WS_H), DM, (const float*)(ws + WS_MOD) + (size_t)l * 3 * NMOD + 5 * DM, NMOD};
            pg8::gemm_phase<pg8::EpiResid, pg8::StaticOrder, true, true>(F.lds, g, S, E, F.tid);
            { const int nfull = F.G == 256 ? 128 : 0; if (l + 1 < DEPTH && (int)blockIdx.x >= nfull) conv_layer(F, p, l + 1, ((int)blockIdx.x - nfull) * NWAVES + F.wave, ((int)F.G - nfull) * NWAVES); }
        } SEAM(pb + 10);
    }
    if (IN(PH_TOTAL - 1)) { ENTER(); final_phase(F, (const float*)(ws + WS_H), p->in[27], p->out); }
#undef IN
#undef SEAM
#undef ENTER
}

extern "C" void kernel_launch(void* const* d_in, const int* in_sizes, int n_in, void* d_out, int out_size, void* d_ws, size_t ws_size, hipStream_t stream) {
    static int grid = 0;
    if (grid == 0) {
        if (n_in != 28 || out_size != 67108864 || ws_size < WS_END) { fprintf(stderr, "kernel_launch: unexpected sizes n_in %d out %d ws %zu\n", n_in, out_size, ws_size); grid = -1; return; }
        int dev = 0, cus = 0, per_cu = 0;
        if (hipGetDevice(&dev) != hipSuccess || hipDeviceGetAttribute(&cus, hipDeviceAttributeMultiprocessorCount, dev) != hipSuccess) { grid = -1; return; }
        if (hipFuncSetAttribute((const void*)mk_fwd, hipFuncAttributeMaxDynamicSharedMemorySize, LDS_BYTES) != hipSuccess) { fprintf(stderr, "kernel_launch: hipFuncSetAttribute failed\n"); grid = -1; return; }
        if (hipOccupancyMaxActiveBlocksPerMultiprocessor(&per_cu, (const void*)mk_fwd, NTHR, LDS_BYTES) != hipSuccess || per_cu < 1)
            fprintf(stderr, "kernel_launch: occupancy query reports %d workgroups per CU\n", per_cu);
        (void)hipGetLastError();
        grid = cus;
    }
    if (grid < 0) return;
    if (hipMemsetAsync((char*)d_ws + WS_CTL, 0, CTL_ZERO_BYTES, stream) != hipSuccess) return;
    Params a{};
    for (int i = 0; i < 28; ++i) a.in[i] = (const float*)d_in[i];
    a.out = (float*)d_out; a.ws = (unsigned char*)d_ws;
#if MK_ONE_LAUNCH
    a.ph_lo = 0; a.ph_hi = PH_TOTAL;
    hipLaunchKernelGGL(mk_fwd, dim3(grid), dim3(NTHR), LDS_BYTES, stream, a);
#else
    for (int ph = 0; ph < PH_TOTAL; ++ph) { a.ph_lo = ph; a.ph_hi = ph + 1; hipLaunchKernelGGL(mk_fwd, dim3(grid), dim3(NTHR), LDS_BYTES, stream, a); }
#endif
}
```

```cpp
#include <hip/hip_runtime.h>
#include <cstdio>
#include <cstdint>
namespace pg8 {
#define PG8_LAS __attribute__((address_space(3)))
typedef unsigned short bf16_t;
typedef short bf16x8 __attribute__((ext_vector_type(8)));
typedef float f32x4 __attribute__((ext_vector_type(4)));
typedef unsigned u32x4 __attribute__((ext_vector_type(4)));
constexpr int BM = 256, BK = 64, HALF = 128, HTB = HALF * BK * 2  , STAGE_BYTES = 8 * HTB, NXCD = 8, WGM = 8;

__host__ __device__ __forceinline__ int lds_byte(int r, int c) { const int st = (r >> 4) * 2 + (c >> 5), rr = r & 15, cc = c & 31, ob = rr * 64 + cc * 2; return st * 1024 + (ob ^ (((ob >> 9) & 1) << 5)); }
__host__ __device__ __forceinline__ void stage_rc(int b, int& R, int& C) { const int st = b / 1024, sb = b % 1024, swz = sb ^ (((sb >> 9) & 1) << 5); R = (st >> 1) * 16 + swz / 64; C = (st & 1) * 32 + (swz % 64) / 2; }
__host__ __device__ __forceinline__ int perm32(int rho) { const int n = rho >> 4, i = rho & 15; return 8 * (i >> 2) + 4 * n + (i & 3); }

struct Unit { int pm, pn, pk; };
struct Gemm { const bf16_t* A; const bf16_t* Bt; int M, N, K, Ksub; };

struct StaticOrder {
    int nM, nN, nwg, G, c;
    __host__ __device__ void init(int M, int N, int G_, int c_) { nM = M / BM; nN = N / BM; nwg = nM * nN; G = G_; c = c_; }
    __host__ __device__ bool next(int i, Unit& u) const {
        const long L = (long)i * G + c; if (L >= nwg) return false;
        int wgid = (int)L; { const int q = nwg / NXCD, r = nwg % NXCD, xcd = wgid % NXCD, off = wgid / NXCD; wgid = (xcd < r ? xcd * (q + 1) : r * (q + 1) + (xcd - r) * q) + off; }
        const int nig = WGM * nN, gid = wgid / nig, fm = gid * WGM, gsz = (nM - fm) < WGM ? (nM - fm) : WGM;
        u.pm = fm + ((wgid % nig) % gsz); u.pn = (wgid % nig) / gsz; u.pk = 0; return true;
    }
    __device__ __forceinline__ void a_ready(const Unit&) const {}
    __device__ __forceinline__ void done(const Unit&) const {}
};
struct SplitOrder {
    StaticOrder s; int KS;
    __host__ __device__ void init(int M, int N, int KS_, int G_, int c_) { KS = KS_; s.init(M, N * KS_, G_, c_); }
    __host__ __device__ bool next(int i, Unit& u) const { if (!s.next(i, u)) return false; u.pk = u.pn % KS; u.pn = u.pn / KS; return true; }
    __device__ __forceinline__ void a_ready(const Unit&) const {}
    __device__ __forceinline__ void done(const Unit&) const {}
};


__device__ __forceinline__ unsigned cvt_pk_bf16(float lo, float hi) { unsigned r; asm volatile("v_cvt_pk_bf16_f32 %0, %1, %2" : "=v"(r) : "v"(lo), "v"(hi)); return r; }

struct EpiBf16 {
    static constexpr bool PERM = true, AFTER_DRAIN = false;
    bf16_t* O; int ldc;
    __device__ __forceinline__ void operator()(const f32x4 (&acc)[2][2][4][2], const Unit& u, int wr, int wc, int fr, int fq) const {
        const int row0 = u.pm * BM + wr * 64 + fr; const int col0 = u.pn * BM + wc * 32 + 8 * fq;
#pragma unroll
        for (int ai = 0; ai < 2; ++ai)
#pragma unroll
            for (int m = 0; m < 4; ++m) { bf16_t* rowp = O + (size_t)(row0 + ai * HALF + m * 16) * ldc + col0;
#pragma unroll
                for (int bj = 0; bj < 2; ++bj) { const f32x4 v0 = acc[ai][bj][m][0], v1 = acc[ai][bj][m][1];
                    u32x4 w; w.x = cvt_pk_bf16(v0[0], v0[1]); w.y = cvt_pk_bf16(v0[2], v0[3]); w.z = cvt_pk_bf16(v1[0], v1[1]); w.w = cvt_pk_bf16(v1[2], v1[3]);
                    *(u32x4*)(rowp + bj * HALF) = w; } }
    }
};
__device__ __forceinline__ int cond_of_pm(int pm) { return pm < 16 ? 0 : (pm < 32 ? 1 : 2); }
struct EpiResid {
    static constexpr bool PERM = false, AFTER_DRAIN = false;
    const float* base0; const float* base1; float* H; int ldc; const float* gate; int gstride;
    __device__ __forceinline__ void operator()(const f32x4 (&acc)[2][2][4][2], const Unit& u, int wr, int wc, int fr, int fq) const {
        const float* g = gate + (size_t)cond_of_pm(u.pm) * gstride;
        const int row0 = u.pm * BM + wr * 64 + fr; const int col0 = u.pn * BM + wc * 32 + 4 * fq;
        const float* bs = u.pm < 16 ? base0 + (size_t)row0 * ldc : base1 + (size_t)(row0 - 4096) * ldc;
        f32x4 gv[2][2];
#pragma unroll
        for (int bj = 0; bj < 2; ++bj)
#pragma unroll
            for (int n = 0; n < 2; ++n) gv[bj][n] = *(const f32x4*)(g + col0 + bj * HALF + n * 16);
#pragma unroll
        for (int ai = 0; ai < 2; ++ai)
#pragma unroll
            for (int m = 0; m < 4; ++m) { const size_t ro = (size_t)(ai * HALF + m * 16) * ldc + col0; float* rowp = H + (size_t)row0 * ldc + ro;
#pragma unroll
                for (int bj = 0; bj < 2; ++bj)
#pragma unroll
                    for (int n = 0; n < 2; ++n) { f32x4 h = *(const f32x4*)(bs + ro + bj * HALF + n * 16); h = h + gv[bj][n] * acc[ai][bj][m][n]; *(f32x4*)(rowp + bj * HALF + n * 16) = h; }
                asm volatile("" ::: "memory"); }
    }
};
__device__ __forceinline__ float silu_f(float x) { return x * __builtin_amdgcn_rcpf(1.0f + __expf(-x)); }
struct EpiSwiGLU {
    static constexpr bool PERM = true, AFTER_DRAIN = false;
    bf16_t* O; int ldc;
    __device__ __forceinline__ void operator()(const f32x4 (&acc)[2][2][4][2], const Unit& u, int wr, int wc, int fr, int fq) const {
        const int row0 = u.pm * BM + wr * 64 + fr; const int col0 = u.pn * HALF + wc * 32 + 8 * fq;
#pragma unroll
        for (int ai = 0; ai < 2; ++ai)
#pragma unroll
            for (int m = 0; m < 4; ++m) { bf16_t* rowp = O + (size_t)(row0 + ai * HALF + m * 16) * ldc + col0;
                const f32x4 g0 = acc[ai][0][m][0], g1 = acc[ai][0][m][1], u0 = acc[ai][1][m][0], u1 = acc[ai][1][m][1];
                u32x4 w;
                w.x = cvt_pk_bf16(silu_f(g0[0]) * u0[0], silu_f(g0[1]) * u0[1]); w.y = cvt_pk_bf16(silu_f(g0[2]) * u0[2], silu_f(g0[3]) * u0[3]);
                w.z = cvt_pk_bf16(silu_f(g1[0]) * u1[0], silu_f(g1[1]) * u1[1]); w.w = cvt_pk_bf16(silu_f(g1[2]) * u1[2], silu_f(g1[3]) * u1[3]);
                *(u32x4*)rowp = w; }
    }
};
template <class Epi, class Sched, bool ALIGN_EPI = false, bool SP2 = false>
__device__ __forceinline__ void gemm_phase(PG8_LAS unsigned char* lds, const Gemm g, const Sched& S, const Epi& E, int tid_in) {
    int tid_ = tid_in; asm volatile("" : "+v"(tid_));
    const int tid = tid_, wid = __builtin_amdgcn_readfirstlane(tid >> 6), lane = tid & 63, wr = wid >> 2, wc = wid & 3, fr = lane & 15, fq = lane >> 4;
    const int K = g.K, nt = g.Ksub / BK; const size_t koff = (size_t)g.Ksub * 2;
    unsigned voffA[2], voffB[2];
#pragma unroll
    for (int i = 0; i < 2; ++i) { int R, C; stage_rc(tid * 16 + i * 8192, R, C); const int Rb = Epi::PERM ? ((R & ~31) + perm32(R & 31)) : R;
        voffA[i] = (unsigned)(R * K + C) * 2u; voffB[i] = (unsigned)(Rb * K + C) * 2u; }
    const size_t kstep = (size_t)(BK * 2);
    const size_t hstep = (size_t)HALF * K * 2;
    const size_t tstep = 2 * hstep;
    const unsigned ldsw = (unsigned)wid * 1024u;
    const int aoff = lds_byte(wr * 64 + fr, fq * 8), boff = lds_byte(wc * 32 + fr, fq * 8);
#define PG8_SA(b, h) (((b) * 2 + (h)) * HTB)
#define PG8_SB(b, h) ((4 + (b) * 2 + (h)) * HTB)
#define PG8_STAGE(bufoff, gbase, voff) do { _Pragma("unroll") for (int _i = 0; _i < 2; ++_i) \
        __builtin_amdgcn_global_load_lds((const unsigned*)((const char*)(gbase) + (voff)[_i]), (PG8_LAS unsigned*)(lds + (bufoff) + ldsw + _i * 8192), 16, 0, 0); } while (0)
#define PG8_LDA(dst, b, h) do { _Pragma("unroll") for (int m = 0; m < 4; ++m) _Pragma("unroll") for (int k = 0; k < 2; ++k) dst[m][k] = *(const PG8_LAS bf16x8*)(lds + PG8_SA(b, h) + aoff + m * 2048 + k * 1024); } while (0)
#define PG8_LDB(dst, b, h) do { _Pragma("unroll") for (int n = 0; n < 2; ++n) _Pragma("unroll") for (int k = 0; k < 2; ++k) dst[n][k] = *(const PG8_LAS bf16x8*)(lds + PG8_SB(b, h) + boff + n * 2048 + k * 1024); } while (0)
#define PG8_MMA(ai, bj, At, Bt) do { __builtin_amdgcn_s_setprio(1); _Pragma("unroll") for (int m = 0; m < 4; ++m) _Pragma("unroll") for (int n = 0; n < 2; ++n) _Pragma("unroll") for (int k = 0; k < 2; ++k) \
        acc[ai][bj][m][n] = __builtin_amdgcn_mfma_f32_16x16x32_bf16(Bt[n][k], At[m][k], acc[ai][bj][m][n], 0, 0, 0); __builtin_amdgcn_s_setprio(0); } while (0)
#define PG8_WAIT_V(n) asm volatile("s_waitcnt vmcnt(" #n ")" ::: "memory")
#define PG8_WAIT_L(n) asm volatile("s_waitcnt lgkmcnt(" #n ")" ::: "memory")
#define PG8_BAR __builtin_amdgcn_s_barrier()
#define PG8_SCHED __builtin_amdgcn_sched_barrier(0)
    Unit cur, nxt; int ui = 0;
    if (!S.next(0, cur)) return;
    f32x4 acc[2][2][4][2];
#pragma unroll
    for (int a = 0; a < 2; ++a)
#pragma unroll
        for (int b = 0; b < 2; ++b)
#pragma unroll
            for (int m = 0; m < 4; ++m)
#pragma unroll
                for (int n = 0; n < 2; ++n) acc[a][b][m][n] = (f32x4){0.f, 0.f, 0.f, 0.f};
    bf16x8 At[4][2], B0[2][2], B1[2][2];
    const char* cA = (const char*)g.A + (size_t)cur.pm * tstep + cur.pk * koff; const char* cB = (const char*)g.Bt + (size_t)cur.pn * tstep + cur.pk * koff;
    S.a_ready(cur);
    if constexpr (SP2) {
        PG8_STAGE(PG8_SB(0, 0), cB, voffB); PG8_STAGE(PG8_SB(0, 1), cB + hstep, voffB); PG8_STAGE(PG8_SA(0, 0), cA, voffA); PG8_STAGE(PG8_SA(0, 1), cA + hstep, voffA);
        if (wr == 1) PG8_BAR;
        PG8_WAIT_V(2); PG8_BAR;
        PG8_STAGE(PG8_SB(1, 0), cB + kstep, voffB); PG8_STAGE(PG8_SA(1, 0), cA + kstep, voffA); PG8_STAGE(PG8_SB(1, 1), cB + hstep + kstep, voffB);
        PG8_WAIT_V(6); PG8_BAR;
    } else {
        PG8_STAGE(PG8_SB(0, 0), cB, voffB); PG8_STAGE(PG8_SA(0, 0), cA, voffA); PG8_STAGE(PG8_SB(0, 1), cB + hstep, voffB); PG8_STAGE(PG8_SA(0, 1), cA + hstep, voffA);
        if (wr == 1) PG8_BAR;
        PG8_WAIT_V(4); PG8_BAR;
        PG8_STAGE(PG8_SB(1, 0), cB + kstep, voffB); PG8_STAGE(PG8_SA(1, 0), cA + kstep, voffA); PG8_STAGE(PG8_SB(1, 1), cB + hstep + kstep, voffB);
        PG8_WAIT_V(6); PG8_BAR;
    }
    for (;;) {
        const bool has_next = S.next(ui + 1, nxt);
        const char* nA = has_next ? (const char*)g.A + (size_t)nxt.pm * tstep + nxt.pk * koff : cA; const char* nB = has_next ? (const char*)g.Bt + (size_t)nxt.pn * tstep + nxt.pk * koff : cB;
        for (int t = 0; t < nt; t += 2) {
            const bool last = (t == nt - 2);
            const char* a1 = cA + (size_t)(t + 1) * kstep;
            const char* a2 = last ? nA : cA + (size_t)(t + 2) * kstep; const char* b2 = last ? nB : cB + (size_t)(t + 2) * kstep;
            const char* a3 = a2 + kstep; const char* b3 = b2 + kstep;
            if (last && has_next) S.a_ready(nxt);
            if constexpr (SP2) {
            PG8_LDB(B0, 0, 0); PG8_LDB(B1, 0, 1); PG8_SCHED; PG8_LDA(At, 0, 0); PG8_STAGE(PG8_SA(1, 1), a1 + hstep, voffA);
            PG8_WAIT_V(8); PG8_WAIT_L(0); PG8_BAR; PG8_MMA(0, 0, At, B0); PG8_MMA(0, 1, At, B1); PG8_BAR; PG8_SCHED;
            PG8_LDA(At, 0, 1); PG8_STAGE(PG8_SB(0, 0), b2, voffB); PG8_STAGE(PG8_SB(0, 1), b2 + hstep, voffB); PG8_STAGE(PG8_SA(0, 0), a2, voffA);
            PG8_WAIT_V(8); PG8_WAIT_L(0); PG8_BAR; PG8_MMA(1, 0, At, B0); PG8_MMA(1, 1, At, B1); PG8_BAR; PG8_SCHED;
            PG8_LDB(B0, 1, 0); PG8_LDB(B1, 1, 1); PG8_SCHED; PG8_LDA(At, 1, 0); PG8_STAGE(PG8_SA(0, 1), a2 + hstep, voffA);
            PG8_WAIT_V(8); PG8_WAIT_L(0); PG8_BAR; PG8_MMA(0, 0, At, B0); PG8_MMA(0, 1, At, B1); PG8_BAR; PG8_SCHED;
            PG8_LDA(At, 1, 1); PG8_STAGE(PG8_SB(1, 0), b3, voffB); PG8_STAGE(PG8_SB(1, 1), b3 + hstep, voffB); PG8_STAGE(PG8_SA(1, 0), a3, voffA);
            PG8_WAIT_V(8); PG8_WAIT_L(0); PG8_BAR; PG8_MMA(1, 0, At, B0); PG8_MMA(1, 1, At, B1); PG8_BAR; PG8_SCHED;
            } else {
            PG8_LDB(B0, 0, 0); PG8_SCHED; PG8_LDA(At, 0, 0); PG8_STAGE(PG8_SA(1, 1), a1 + hstep, voffA);
            PG8_WAIT_L(8); PG8_BAR; PG8_WAIT_L(0); PG8_MMA(0, 0, At, B0); PG8_BAR; PG8_SCHED;
            PG8_LDB(B1, 0, 1); PG8_STAGE(PG8_SB(0, 0), b2, voffB);
            PG8_BAR; PG8_WAIT_L(0); PG8_MMA(0, 1, At, B1); PG8_BAR;
            PG8_LDA(At, 0, 1); PG8_STAGE(PG8_SA(0, 0), a2, voffA);
            PG8_BAR; PG8_WAIT_L(0); PG8_MMA(1, 0, At, B0); PG8_BAR; PG8_SCHED;
            PG8_STAGE(PG8_SB(0, 1), b2 + hstep, voffB);
            PG8_WAIT_V(6); PG8_BAR; PG8_MMA(1, 1, At, B1); PG8_BAR;
            PG8_LDB(B0, 1, 0); PG8_SCHED; PG8_LDA(At, 1, 0); PG8_STAGE(PG8_SA(0, 1), a2 + hstep, voffA);
            PG8_WAIT_L(8); PG8_BAR; PG8_WAIT_L(0); PG8_MMA(0, 0, At, B0); PG8_BAR; PG8_SCHED;
            PG8_LDB(B1, 1, 1); PG8_STAGE(PG8_SB(1, 0), b3, voffB);
            PG8_BAR; PG8_WAIT_L(0); PG8_MMA(0, 1, At, B1); PG8_BAR;
            PG8_LDA(At, 1, 1); PG8_STAGE(PG8_SA(1, 0), a3, voffA);
            PG8_BAR; PG8_WAIT_L(0); PG8_MMA(1, 0, At, B0); PG8_BAR; PG8_SCHED;
            PG8_STAGE(PG8_SB(1, 1), b3 + hstep, voffB);
            PG8_WAIT_V(6); PG8_BAR; PG8_MMA(1, 1, At, B1); PG8_BAR;
            }
        }
        if constexpr (ALIGN_EPI) { if (wr == 0) PG8_BAR; }
        if constexpr (!Epi::AFTER_DRAIN) { E(acc, cur, wr, wc, fr, fq); S.done(cur); }
        if (!has_next) break;
#pragma unroll
        for (int a = 0; a < 2; ++a)
#pragma unroll
            for (int b = 0; b < 2; ++b)
#pragma unroll
                for (int m = 0; m < 4; ++m)
#pragma unroll
                    for (int n = 0; n < 2; ++n) acc[a][b][m][n] = (f32x4){0.f, 0.f, 0.f, 0.f};
        cur = nxt; cA = nA; cB = nB; ++ui;
        if constexpr (ALIGN_EPI) { if (wr == 1) PG8_BAR; }
    }
    PG8_WAIT_V(0);
    if constexpr (!ALIGN_EPI) { if (wr == 0) PG8_BAR; }
    PG8_BAR;
    if constexpr (Epi::AFTER_DRAIN) { E.fused(acc, cur, wr, wc, fr, fq, lds, wid, lane); S.done(cur); }
#undef PG8_SA
#undef PG8_SB
#undef PG8_STAGE
#undef PG8_LDA
#undef PG8_LDB
#undef PG8_MMA
#undef PG8_WAIT_V
#undef PG8_WAIT_L
#undef PG8_BAR
#undef PG8_SCHED
}
}
#define GAS __attribute__((address_space(1)))
#define LAS __attribute__((address_space(3)))
typedef unsigned short bf16;
typedef unsigned v4u __attribute__((ext_vector_type(4)));
typedef float f32x4 __attribute__((ext_vector_type(4)));
typedef short bf16x8 __attribute__((ext_vector_type(8)));
typedef GAS unsigned gu32;
typedef GAS unsigned long long gu64;
#define RLX_AGENT __ATOMIC_RELAXED, __HIP_MEMORY_SCOPE_AGENT
#define LDS_WAIT() asm volatile("s_waitcnt lgkmcnt(0)" ::: "memory")
#define VM_WAIT() asm volatile("s_waitcnt vmcnt(0)" ::: "memory")
__device__ __forceinline__ unsigned long long rt() { return __builtin_amdgcn_s_memrealtime(); }
__device__ __forceinline__ unsigned f2bf(float f) { unsigned u = __builtin_bit_cast(unsigned, f); return (u + 0x7fffu + ((u >> 16) & 1u)) >> 16; }
__device__ __forceinline__ unsigned pk2(float lo, float hi) { return f2bf(lo) | (f2bf(hi) << 16); }

#define XB_TMO      128
#define XB_XCNT(j)  (256  + 64 * (j))
#define XB_XSUB(j)  (1280 + 64 * (j))
#define XB_XGEN(j)  (2304 + 64 * (j))
#define XB_TOP      3328
#define XB_TOPGEN   3392
#define XCD_BAR_WORDS 3456
#define XB_SPIN_CAP (1u << 18)

__device__ __forceinline__ unsigned xb_ld(unsigned* p)              { return __hip_atomic_load(p, __ATOMIC_RELAXED, __HIP_MEMORY_SCOPE_AGENT); }
__device__ __forceinline__ unsigned xb_add(unsigned* p, unsigned v) { return __hip_atomic_fetch_add(p, v, __ATOMIC_RELAXED, __HIP_MEMORY_SCOPE_AGENT); }
__device__ __forceinline__ unsigned xb_xcc_id() { return (unsigned)__builtin_amdgcn_s_getreg((3 << 11) | 20) & 0xFu; }
#define XB_SPIN(cond, bar) do { unsigned _sp = 0; while (cond) { __builtin_amdgcn_s_sleep(1); \
    if ((++_sp & 255u) == 0u) { if (xb_ld(&(bar)[XB_TMO])) break; if (_sp > XB_SPIN_CAP) { atomicAdd(&(bar)[XB_TMO], 1u); break; } } } } while (0)

struct XcdBarrier {
    unsigned* bar; unsigned x;
    volatile LAS unsigned* st;
};

__device__ __forceinline__ XcdBarrier xcd_barrier_post(unsigned* bar, volatile LAS unsigned* st, bool leader) {
    XcdBarrier b; b.bar = bar; b.x = xb_xcc_id(); b.st = st;
    if (leader) (void)xb_add(&bar[XB_XCNT(b.x)], 1u);
    return b;
}
__device__ __forceinline__ void xcd_barrier_complete(unsigned* bar, unsigned x, unsigned& nloc, unsigned& nx) {
    const unsigned G = gridDim.x * gridDim.y * gridDim.z;
    unsigned sum, cnt, mine, sp = 0u;
    for (;;) {
        sum = 0u; cnt = 0u; mine = 0u;
#pragma unroll
        for (unsigned j = 0; j < 16; ++j) { const unsigned c = xb_ld(&bar[XB_XCNT(j)]); sum += c; cnt += (c > 0u) ? 1u : 0u; mine = (j == x) ? c : mine; }
        if (sum == G) break;
        __builtin_amdgcn_s_sleep(1);
        if ((++sp & 255u) == 0u) { if (xb_ld(&bar[XB_TMO])) break; if (sp > XB_SPIN_CAP) { atomicAdd(&bar[XB_TMO], 1u); break; } }
    }
    nloc = mine > 0u ? mine : 1u; nx = cnt > 0u ? cnt : 1u;
}

__device__ __forceinline__ void xcd_barrier(const XcdBarrier& b, bool leader) {
    asm volatile("s_waitcnt vmcnt(0)" ::: "memory");
    __syncthreads();
    if (leader) {
        unsigned* bar = b.bar;
        __builtin_amdgcn_s_waitcnt(0);
        unsigned nloc = b.st[0], nx = b.st[1];
        if (nloc == 0u) { xcd_barrier_complete(bar, b.x, nloc, nx); b.st[0] = nloc; b.st[1] = nx; }
        const unsigned old = xb_add(&bar[XB_XSUB(b.x)], 1u);
        const unsigned gen = old / nloc;
        if (old + 1u == (gen + 1u) * nloc) {
            __builtin_amdgcn_fence(__ATOMIC_RELEASE, "agent");
            asm volatile("s_waitcnt vmcnt(0)" ::: "memory");
            const unsigned og = xb_add(&bar[XB_TOP], 1u);
            const unsigned tg = og / nx;
            if (og + 1u == (tg + 1u) * nx) xb_add(&bar[XB_TOPGEN], 1u);
            else XB_SPIN(xb_ld(&bar[XB_TOPGEN]) == tg, bar);
            __builtin_amdgcn_fence(__ATOMIC_ACQUIRE, "agent");
            xb_add(&bar[XB_XGEN(b.x)], 1u);
            asm volatile("s_waitcnt vmcnt(0)" ::: "memory");
        } else {
            XB_SPIN(xb_ld(&bar[XB_XGEN(b.x)]) == gen, bar);
            __builtin_amdgcn_fence(__ATOMIC_ACQUIRE, "agent");
            asm volatile("s_waitcnt vmcnt(0)" ::: "memory");
        }
    }
    __syncthreads();
}

constexpr int NWAVES = 8, NTHR = 512;
constexpr int DM = 2048, MROWS = 12288, DEPTH = 4;
constexpr int INC = 5152, INP = 5376, FF = 5632, GU = 11264;
constexpr int NMOD = 6 * DM;
constexpr float EPS = 1e-6f;
constexpr int PC_QA = 0, PC_KA = 512, PC_VA = 768, PC_QD = 1024, PC_KD = 1536, PC_VD = 2048, PC_Z = 2560, PC_XBC = 3584, PC_DT = 5120;
constexpr int RC_QA = 0, RC_KA = 512, RC_QD = 768, RC_KD = 1280, RCW = 1792;
constexpr size_t OUT_AK = 25165824, OUT_AV = OUT_AK + 4194304, OUT_DK = OUT_AV + 4194304, OUT_DV = OUT_DK + 8388608, OUT_SF = OUT_DV + 8388608, OUT_SB = OUT_SF + 8388608;
constexpr size_t MiB = 1u << 20;
constexpr size_t WS_CTL = 0, CTL_ZERO_BYTES = 1 * MiB;
constexpr size_t WS_TAB = 1 * MiB, WS_MOD = 2 * MiB, WS_MODP = 3 * MiB;
constexpr size_t WS_WIN = 8 * MiB, WS_WOUT = 92 * MiB, WS_WGU = 124 * MiB, WS_WDN = 300 * MiB;
constexpr size_t WS_H = 388 * MiB, WS_U = 484 * MiB, WS_P = 532 * MiB, WS_MIX = 658 * MiB, WS_ACT = 706 * MiB, WS_QKR = 838 * MiB;
constexpr size_t WS_XBC = 866 * MiB, WS_DT = 938 * MiB, WS_YF = 940 * MiB, WS_YB = 988 * MiB, WS_ST = 1036 * MiB, WS_EDEC = 1132 * MiB, WS_CDEC = 1134 * MiB, WS_SSQ = 1135 * MiB, WS_END = 1136 * MiB;
constexpr int CW_BAR = 4096;
constexpr int RING_BYTES = 131072, LDSCTL_OFF = RING_BYTES, MISC_OFF = LDSCTL_OFF + 320, LDS_BYTES = 147456;

struct Params { const float* in[28]; float* out; unsigned char* ws; int ph_lo, ph_hi; };
typedef __attribute__((address_space(4))) const Params* PP;
struct Frame { LAS unsigned char* lds; int tid, lane, wave, vcu, G; };

template <int M> __device__ __forceinline__ float xor_lt32(float v) { return __builtin_bit_cast(float, __builtin_amdgcn_ds_swizzle(__builtin_bit_cast(int, v), 0x1F | (M << 10))); }
__device__ __forceinline__ float half_sum(float v) { const unsigned u = __builtin_bit_cast(unsigned, v); auto r = __builtin_amdgcn_permlane32_swap(u, u, false, false); return __builtin_bit_cast(float, (unsigned)r[0]) + __builtin_bit_cast(float, (unsigned)r[1]); }
__device__ __forceinline__ float half_max(float v) { const unsigned u = __builtin_bit_cast(unsigned, v); auto r = __builtin_amdgcn_permlane32_swap(u, u, false, false); return fmaxf(__builtin_bit_cast(float, (unsigned)r[0]), __builtin_bit_cast(float, (unsigned)r[1])); }
__device__ __forceinline__ float bperm(float v, int srclane) { return __builtin_bit_cast(float, __builtin_amdgcn_ds_bpermute(srclane << 2, __builtin_bit_cast(int, v))); }
__device__ __forceinline__ float wave_sum(float v) { v += xor_lt32<1>(v); v += xor_lt32<2>(v); v += xor_lt32<4>(v); v += xor_lt32<8>(v); v += xor_lt32<16>(v); return half_sum(v); }
__device__ __forceinline__ float wave_max(float v) { v = fmaxf(v, xor_lt32<1>(v)); v = fmaxf(v, xor_lt32<2>(v)); v = fmaxf(v, xor_lt32<4>(v)); v = fmaxf(v, xor_lt32<8>(v)); v = fmaxf(v, xor_lt32<16>(v)); return half_max(v); }
__device__ __forceinline__ float bflo(unsigned w) { return __uint_as_float(w << 16); }
__device__ __forceinline__ float bfhi(unsigned w) { return __uint_as_float(w & 0xffff0000u); }
__device__ __forceinline__ float bf1(bf16 b) { return __uint_as_float((unsigned)b << 16); }
__device__ __forceinline__ float silu(float x) { return x / (1.0f + __expf(-x)); }

__device__ __forceinline__ void p0_transpose_item(const float* W, int K, int N, bf16* WT, int rowmap, LAS float* scr, int item, int lane) {
    const int nblk = N / 32, kb = item / nblk, nb = item % nblk, k0 = 64 * kb, n0 = 32 * nb;
    { float t[32]; const float* src = W + (size_t)(k0 + (lane >> 5)) * N + n0 + (lane & 31);
#pragma unroll
      for (int i = 0; i < 32; ++i) t[i] = src[(size_t)(2 * i) * N];
#pragma unroll
      for (int i = 0; i < 32; ++i) scr[(2 * i + (lane >> 5)) * 33 + (lane & 31)] = t[i]; }
    LDS_WAIT(); asm volatile("" ::: "memory");
    int r0 = n0;
    if (rowmap) r0 = (n0 < FF) ? ((n0 >> 7) * 256 + (n0 & 127)) : (((n0 - FF) >> 7) * 256 + 128 + ((n0 - FF) & 127));
    const int c = lane & 7;
#pragma unroll
    for (int j = 0; j < 4; ++j) { const int n = (lane >> 3) + 8 * j; const LAS float* s = scr + (8 * c) * 33 + n;
        v4u o; o.x = pk2(s[0 * 33], s[1 * 33]); o.y = pk2(s[2 * 33], s[3 * 33]); o.z = pk2(s[4 * 33], s[5 * 33]); o.w = pk2(s[6 * 33], s[7 * 33]);
        *(v4u*)(WT + (size_t)(r0 + n) * K + k0 + 8 * c) = o; }
    LDS_WAIT(); asm volatile("" ::: "memory");
}
__device__ __forceinline__ void conv_layer(Frame& F, PP p, int l, int wi, int nw) {
    unsigned char* ws = p->ws;
    LAS float* scr = (LAS float*)(F.lds + F.wave * 16384);
    constexpr int I_IN = 32 * (INC / 32), I_OUT = 32 * 64, I_GU = 32 * (GU / 32), I_DN = (FF / 64) * 64, I_L = I_IN + I_OUT + I_GU + I_DN;
    for (int it = wi; it < I_L; it += nw) {
        int r = it;
        if (r < I_IN) { p0_transpose_item(p->in[14] + (size_t)l * DM * INC, DM, INC, (bf16*)(ws + WS_WIN) + (size_t)l * INP * DM, 0, scr, r, F.lane); continue; } r -= I_IN;
        if (r < I_OUT) { p0_transpose_item(p->in[24] + (size_t)l * DM * DM, DM, DM, (bf16*)(ws + WS_WOUT) + (size_t)l * DM * DM, 0, scr, r, F.lane); continue; } r -= I_OUT;
        if (r < I_GU) { p0_transpose_item(p->in[25] + (size_t)l * DM * GU, DM, GU, (bf16*)(ws + WS_WGU) + (size_t)l * GU * DM, 1, scr, r, F.lane); continue; } r -= I_GU;
        p0_transpose_item(p->in[26] + (size_t)l * FF * DM, FF, DM, (bf16*)(ws + WS_WDN) + (size_t)l * DM * FF, 0, scr, r, F.lane);
    }
    constexpr int PADV = (INP - INC) * DM * 2 / 16;
    for (int i = wi * 64 + F.lane; i < PADV; i += nw * 64) *((v4u*)((bf16*)(ws + WS_WIN) + (size_t)l * INP * DM + (size_t)INC * DM) + i) = (v4u){0u, 0u, 0u, 0u};
}
__device__ __forceinline__ void adaln_layer(Frame& F, PP p, int l, int bi, int nb) {
    LAS float* sc = (LAS float*)F.lds;
    float* MODP = (float*)(p->ws + WS_MODP);
    for (int it = bi; it < 8 * 24; it += nb) {
        const int kc = it / 24, nc = it % 24;
        __syncthreads();
        if (F.tid < 256) { const int k = kc * 256 + F.tid; sc[F.tid] = silu(p->in[9][k]); sc[256 + F.tid] = silu(p->in[8][k]); sc[512 + F.tid] = silu(p->in[8][DM + k]); }
        __syncthreads();
        const int n = nc * 512 + F.tid;
        const float* w = p->in[10] + ((size_t)l * DM + (size_t)kc * 256) * NMOD + n;
        float a0 = 0.f, a1 = 0.f, a2 = 0.f;
        for (int k = 0; k < 256; k += 32) {
            float wv[32];
#pragma unroll
            for (int e = 0; e < 32; ++e) wv[e] = w[(size_t)(k + e) * NMOD];
#pragma unroll
            for (int e = 0; e < 32; ++e) { a0 += sc[k + e] * wv[e]; a1 += sc[256 + k + e] * wv[e]; a2 += sc[512 + k + e] * wv[e]; }
        }
        float* o = MODP + ((size_t)(kc * DEPTH + l) * 3) * NMOD + n;
        o[0] = a0; o[NMOD] = a1; o[2 * NMOD] = a2;
    }
    __syncthreads();
}
__device__ __forceinline__ void mod_layer(PP p, int l, int gt, int ngt) {
    const float* MODP = (const float*)(p->ws + WS_MODP); float* MOD = (float*)(p->ws + WS_MOD);
    for (int i = gt; i < 3 * NMOD; i += ngt) {
        const int n = i % NMOD; const int gi = l * 3 * NMOD + i;
        float s = p->in[11][l * NMOD + n];
#pragma unroll
        for (int kc = 0; kc < 8; ++kc) s += MODP[(size_t)kc * DEPTH * 3 * NMOD + gi];
        MOD[gi] = s;
    }
}
__device__ __forceinline__ void p0_prologue(Frame& F, PP p) {
    unsigned char* ws = p->ws;
    conv_layer(F, p, 0, F.vcu * NWAVES + F.wave, F.G * NWAVES);
    adaln_layer(F, p, 0, blockIdx.x, F.G);
    if (blockIdx.x == F.G - 1) {
        float2* tabA = (float2*)(ws + WS_TAB); float2* tabB = (float2*)(ws + WS_TAB + 16384); float* lam = (float*)(ws + WS_TAB + 32768);
        for (int i = F.tid; i < 2048 + 1024; i += NTHR) {
            const bool isA = i < 2048; const int j = isA ? i : i - 2048; const int pos = isA ? (j >> 5) : (j >> 4), k = isA ? (j & 31) : (j & 15);
            double r = 10000.0; r = sqrt(r); r = sqrt(r); r = sqrt(r); r = sqrt(r); if (isA) r = sqrt(r);
            const double ri = 1.0 / r; double inv = 1.0; for (int q = 0; q < k; ++q) inv *= ri;
            const double ang = (double)pos * inv; const double TWO_PI = 6.283185307179586476925;
            const double x = ang - TWO_PI * rint(ang / TWO_PI), x2 = x * x;
            double st = x, ss = x, ct = 1.0, cs = 1.0;
            for (int q = 1; q <= 16; ++q) { st *= -x2 / (double)((2 * q) * (2 * q + 1)); ss += st; ct *= -x2 / (double)((2 * q - 1) * (2 * q)); cs += ct; }
            const float2 v = make_float2((float)cs, (float)ss);
            if (isA) tabA[j] = v; else tabB[j] = v;
        }
        if (F.tid < DEPTH) {
            const float* lv = p->in[16] + F.tid * 256; float s01 = 0.f, s23 = 0.f;
            for (int i = 0; i < 64; ++i) { s01 += lv[i] * lv[64 + i]; s23 += lv[128 + i] * lv[192 + i]; }
            const float li = 0.8f - 0.6f * expf(-0.3f * (float)F.tid);
            lam[F.tid] = expf(s01) - expf(s23) + li; lam[4 + F.tid] = li;
        }
    }
}
__device__ __forceinline__ void norm_phase(Frame& F, const float* H0, const float* H1, const float* g, const float* modl, int shoff, int scoff, bf16* U) {
    const int gw = F.vcu * NWAVES + F.wave, NGW = F.G * NWAVES;
    for (int m = gw; m < MROWS; m += NGW) {
        const int c = m < 4096 ? 0 : (m < 8192 ? 1 : 2);
        const float* sh = modl + c * NMOD + shoff; const float* sc = modl + c * NMOD + scoff;
        const f32x4* xr = (const f32x4*)(m < 4096 ? H0 + (size_t)m * DM : H1 + (size_t)(m - 4096) * DM) + F.lane;
        f32x4 v[8]; float ss = 0.f;
#pragma unroll
        for (int j = 0; j < 8; ++j) { v[j] = xr[64 * j]; ss += (v[j].x * v[j].x + v[j].y * v[j].y) + (v[j].z * v[j].z + v[j].w * v[j].w); }
        const float rstd = 1.0f / sqrtf(wave_sum(ss) * (1.0f / DM) + EPS);
        unsigned long long* o8 = (unsigned long long*)(U + (size_t)m * DM) + F.lane;
#pragma unroll
        for (int j = 0; j < 8; ++j) { const int col = 4 * F.lane + 256 * j;
            const f32x4 gv = *(const f32x4*)(g + col), sv = *(const f32x4*)(sc + col), hv = *(const f32x4*)(sh + col);
            const f32x4 o = (v[j] * rstd) * gv * (sv + 1.0f) + hv;
            o8[64 * j] = (unsigned long long)pk2(o.x, o.y) | ((unsigned long long)pk2(o.z, o.w) << 32); }
    }
}
__device__ __forceinline__ void final_phase(Frame& F, const float* H, const float* g, float* out) {
    const int gw = F.vcu * NWAVES + F.wave, NGW = F.G * NWAVES;
    for (int m = gw; m < MROWS; m += NGW) {
        const f32x4* xr = (const f32x4*)(H + (size_t)m * DM) + F.lane;
        f32x4 v[8]; float ss = 0.f;
#pragma unroll
        for (int j = 0; j < 8; ++j) { v[j] = xr[64 * j]; ss += (v[j].x * v[j].x + v[j].y * v[j].y) + (v[j].z * v[j].z + v[j].w * v[j].w); }
        const float rstd = 1.0f / sqrtf(wave_sum(ss) * (1.0f / DM) + EPS);
        f32x4* o = (f32x4*)(out + (size_t)m * DM) + F.lane;
#pragma unroll
        for (int j = 0; j < 8; ++j) { const f32x4 gv = *(const f32x4*)(g + 4 * F.lane + 256 * j); o[64 * j] = (v[j] * rstd) * gv; }
    }
}
__device__ __forceinline__ void prep_phase(Frame& F, PP p, int l) {
    unsigned char* ws = p->ws;
    const bf16* P = (const bf16*)(ws + WS_P); bf16* QKR = (bf16*)(ws + WS_QKR); bf16* XBC = (bf16*)(ws + WS_XBC); float* DT = (float*)(ws + WS_DT);
    const float2* tabA = (const float2*)(ws + WS_TAB); const float2* tabB = (const float2*)(ws + WS_TAB + 16384);
    const float* cw = p->in[18] + (size_t)l * 5 * 1536; const float* cb = p->in[19] + (size_t)l * 1536; const float* dtb = p->in[20] + l * 32;
    const int gw = F.vcu * NWAVES + F.wave, NGW = F.G * NWAVES, lane = F.lane;
    for (int m = gw; m < MROWS; m += NGW) {
        const bf16* prow = P + (size_t)m * INP;
        const int s0 = m < 4096 ? (m & ~255) : (4096 + ((m - 4096) & ~4095)); const int len = m < 4096 ? 256 : 4096; const int t = m - s0;
#pragma unroll
        for (int j = 0; j < 3; ++j) { const int c0 = 8 * lane + 512 * j;
            f32x4 a0 = *(const f32x4*)(cb + c0), a1 = *(const f32x4*)(cb + c0 + 4);
#pragma unroll
            for (int k = 0; k < 5; ++k) { const int tt = t + k - 2;
                if (tt >= 0 && tt < len) { const v4u raw = *(const v4u*)(P + (size_t)(s0 + tt) * INP + PC_XBC + c0);
                    const f32x4 w0 = *(const f32x4*)(cw + k * 1536 + c0), w1 = *(const f32x4*)(cw + k * 1536 + c0 + 4);
                    a0.x += w0.x * bflo(raw.x); a0.y += w0.y * bfhi(raw.x); a0.z += w0.z * bflo(raw.y); a0.w += w0.w * bfhi(raw.y);
                    a1.x += w1.x * bflo(raw.z); a1.y += w1.y * bfhi(raw.z); a1.z += w1.z * bflo(raw.w); a1.w += w1.w * bfhi(raw.w); } }
            a0.x = silu(a0.x); a0.y = silu(a0.y); a0.z = silu(a0.z); a0.w = silu(a0.w); a1.x = silu(a1.x); a1.y = silu(a1.y); a1.z = silu(a1.z); a1.w = silu(a1.w);
            *(v4u*)(XBC + (size_t)m * 1536 + c0) = (v4u){pk2(a0.x, a0.y), pk2(a0.z, a0.w), pk2(a1.x, a1.y), pk2(a1.z, a1.w)}; }
        if (lane < 32) { const float v = bf1(prow[PC_DT + lane]) + dtb[lane]; DT[(size_t)m * 32 + lane] = v > 20.f ? v : log1pf(__expf(v)); }
        if (m >= 4096) {
            const int gr = t >> 6, gc = t & 63; bf16* qrow = QKR + (size_t)(m - 4096) * RCW;
#pragma unroll
            for (int i = 0; i < 6; ++i) { const int d = lane; const int src = (i < 4 ? PC_QA + i * 128 : PC_KA + (i - 4) * 128) + d, dst = (i < 4 ? RC_QA + i * 128 : RC_KA + (i - 4) * 128) + d;
                const float x1 = bf1(prow[src]), x2 = bf1(prow[src + 64]); const float2 cs = d < 32 ? tabA[gr * 32 + d] : tabA[gc * 32 + d - 32];
                qrow[dst] = (bf16)f2bf(x1 * cs.x - x2 * cs.y); qrow[dst + 64] = (bf16)f2bf(x1 * cs.y + x2 * cs.x); }
#pragma unroll
            for (int i = 0; i < 8; ++i) { const int pp = lane + 64 * i, ch = pp >> 5, d = pp & 31; const int src = (ch < 8 ? PC_QD + ch * 64 : PC_KD + (ch - 8) * 64) + d, dst = (ch < 8 ? RC_QD + ch * 64 : RC_KD + (ch - 8) * 64) + d;
                const float x1 = bf1(prow[src]), x2 = bf1(prow[src + 32]); const float2 cs = d < 16 ? tabB[gr * 16 + d] : tabB[gc * 16 + d - 16];
                qrow[dst] = (bf16)f2bf(x1 * cs.x - x2 * cs.y); qrow[dst + 32] = (bf16)f2bf(x1 * cs.y + x2 * cs.x); }
        } else {
            const int b = m >> 8, s = m & 255; const size_t r = (size_t)((b * DEPTH + l) * 256 + s);
            { const unsigned long long w = *((const unsigned long long*)(prow + PC_KA) + lane); *((f32x4*)(p->out + OUT_AK + r * 256) + lane) = (f32x4){bflo((unsigned)w), bfhi((unsigned)w), bflo((unsigned)(w >> 32)), bfhi((unsigned)(w >> 32))}; }
            { const unsigned long long w = *((const unsigned long long*)(prow + PC_VA) + lane); *((f32x4*)(p->out + OUT_AV + r * 256) + lane) = (f32x4){bflo((unsigned)w), bfhi((unsigned)w), bflo((unsigned)(w >> 32)), bfhi((unsigned)(w >> 32))}; }
            { const v4u w = *((const v4u*)(prow + PC_KD) + lane); f32x4* o = (f32x4*)(p->out + OUT_DK + r * 512) + 2 * lane; o[0] = (f32x4){bflo(w.x), bfhi(w.x), bflo(w.y), bfhi(w.y)}; o[1] = (f32x4){bflo(w.z), bfhi(w.z), bflo(w.w), bfhi(w.w)}; }
            { const v4u w = *((const v4u*)(prow + PC_VD) + lane); f32x4* o = (f32x4*)(p->out + OUT_DV + r * 512) + 2 * lane; o[0] = (f32x4){bflo(w.x), bfhi(w.x), bflo(w.y), bfhi(w.y)}; o[1] = (f32x4){bflo(w.z), bfhi(w.z), bflo(w.w), bfhi(w.w)}; }
        }
    }
}
typedef float f32x16 __attribute__((ext_vector_type(16)));
typedef short s16x4 __attribute__((ext_vector_type(4)));
constexpr int FA_KSTR = 272, FA_VSTR = 320, FA_KB = 64 * FA_KSTR, FA_VB = 64 * FA_VSTR, FA_BUF = FA_KB + FA_VB;
constexpr int FA_OSTR = 272;
struct Seg { const void* k; const void* v; int ks, vs, n, f32, pos0; };
struct FaTile { v4u k[2], v[2]; };

__device__ __forceinline__ unsigned cvtpk(float lo, float hi) { typedef float f2 __attribute__((ext_vector_type(2))); typedef __bf16 b2 __attribute__((ext_vector_type(2))); f2 v = {lo, hi}; b2 b = __builtin_convertvector(v, b2); return __builtin_bit_cast(unsigned, b); }
__device__ __forceinline__ void fa_load(FaTile& t, const Seg& sg, int key0, int tid) {
#pragma unroll
    for (int i = 0; i < 2; ++i) { const int c = tid + 512 * i, key = c >> 4, ch = c & 15;
        if (sg.f32) {
            const f32x4* ks = (const f32x4*)((const float*)sg.k + (size_t)(key0 + key) * sg.ks + ch * 8);
            const f32x4* vs = (const f32x4*)((const float*)sg.v + (size_t)(key0 + key) * sg.vs + ch * 8);
            const f32x4 a = ks[0], b = ks[1], c2 = vs[0], d = vs[1];
            t.k[i] = (v4u){cvtpk(a.x, a.y), cvtpk(a.z, a.w), cvtpk(b.x, b.y), cvtpk(b.z, b.w)};
            t.v[i] = (v4u){cvtpk(c2.x, c2.y), cvtpk(c2.z, c2.w), cvtpk(d.x, d.y), cvtpk(d.z, d.w)};
        } else {
            t.k[i] = *(const v4u*)((const bf16*)sg.k + (size_t)(key0 + key) * sg.ks + ch * 8);
            t.v[i] = *(const v4u*)((const bf16*)sg.v + (size_t)(key0 + key) * sg.vs + ch * 8);
        } }
}
__device__ __forceinline__ void fa_store(const FaTile& t, LAS unsigned char* buf, int tid) {
#pragma unroll
    for (int i = 0; i < 2; ++i) { const int c = tid + 512 * i, key = c >> 4, ch = c & 15;
        *(LAS v4u*)(buf + key * FA_KSTR + ch * 16) = t.k[i];
        *(LAS v4u*)(buf + FA_KB + key * FA_VSTR + ch * 16) = t.v[i]; }
}
template <int NKS>
__device__ __forceinline__ void fa_s(const LAS unsigned char* buf, const bf16x8 (&q)[NKS], f32x16& p0, f32x16& p1, int kcolb, int lane) {
    const int r32 = lane & 31, h = lane >> 5;
#pragma unroll
    for (int r = 0; r < 16; ++r) { p0[r] = 0.f; p1[r] = 0.f; }
    const LAS unsigned char* kp = buf + r32 * FA_KSTR + kcolb + h * 16;
#pragma unroll
    for (int ks = 0; ks < NKS; ++ks) {
        const bf16x8 a0 = *(const LAS bf16x8*)(kp + ks * 32), a1 = *(const LAS bf16x8*)(kp + 32 * FA_KSTR + ks * 32);
        p0 = __builtin_amdgcn_mfma_f32_32x32x16_bf16(a0, q[ks], p0, 0, 0, 0);
        p1 = __builtin_amdgcn_mfma_f32_32x32x16_bf16(a1, q[ks], p1, 0, 0, 0);
    }
}
typedef float f32x2 __attribute__((ext_vector_type(2)));
__device__ __forceinline__ float max3f(float a, float b, float c) { float r; asm("v_max3_f32 %0, %1, %2, %3" : "=v"(r) : "v"(a), "v"(b), "v"(c)); return r; }
#define FA_TR(dst, vb, off) asm volatile("ds_read_b64_tr_b16 %0, %1 offset:%c2" : "=&v"(dst) : "v"(vb), "i"(off) : "memory")
template <bool DB>
__device__ __forceinline__ void fa_smpv(const LAS unsigned char* buf, f32x16& p0, f32x16& p1, f32x16 (&o)[4], float& m, float& lsum, float c, int lane, bool masked, int dpos  ) {
    const int h = lane >> 5;
    if (masked) {
#pragma unroll
        for (int r = 0; r < 16; ++r) { const int d0 = dpos - ((r & 3) + 8 * (r >> 2) + 4 * h), d1 = d0 - 32;
            if (d0 > 128 || d0 < -128) p0[r] = -INFINITY; if (d1 > 128 || d1 < -128) p1[r] = -INFINITY; }
    }
    float ma = max3f(p0[0], p0[1], p0[2]), mb = max3f(p1[0], p1[1], p1[2]);
#pragma unroll
    for (int r = 3; r < 15; r += 2) { ma = max3f(ma, p0[r], p0[r + 1]); mb = max3f(mb, p1[r], p1[r + 1]); }
    float mt = half_max(max3f(ma, mb, fmaxf(p0[15], p1[15])));
    const float mn = fmaxf(m, mt * c);
    const float alpha = __builtin_amdgcn_exp2f(m - mn);
    m = mn;
    const f32x2 c2 = {c, c}, mn2 = {mn, mn}; f32x2 rs2 = {0.f, 0.f};
#pragma unroll
    for (int r = 0; r < 16; r += 2) {
        f32x2 u = (f32x2){p0[r], p0[r + 1]} * c2 - mn2, v = (f32x2){p1[r], p1[r + 1]} * c2 - mn2;
        u.x = __builtin_amdgcn_exp2f(u.x); u.y = __builtin_amdgcn_exp2f(u.y); v.x = __builtin_amdgcn_exp2f(v.x); v.y = __builtin_amdgcn_exp2f(v.y);
        p0[r] = u.x; p0[r + 1] = u.y; p1[r] = v.x; p1[r + 1] = v.y; rs2 += u + v;
    }
    lsum = lsum * alpha + (rs2.x + rs2.y);
    if (__builtin_amdgcn_ballot_w64(alpha != 1.0f) != 0ull) {
#pragma unroll
        for (int b = 0; b < 4; ++b) o[b] = o[b] * alpha;
    }
    bf16x8 pb[4];
    { v4u w;
      w = (v4u){cvtpk(p0[0], p0[1]), cvtpk(p0[2], p0[3]), cvtpk(p0[4], p0[5]), cvtpk(p0[6], p0[7])}; pb[0] = __builtin_bit_cast(bf16x8, w);
      w = (v4u){cvtpk(p0[8], p0[9]), cvtpk(p0[10], p0[11]), cvtpk(p0[12], p0[13]), cvtpk(p0[14], p0[15])}; pb[1] = __builtin_bit_cast(bf16x8, w);
      w = (v4u){cvtpk(p1[0], p1[1]), cvtpk(p1[2], p1[3]), cvtpk(p1[4], p1[5]), cvtpk(p1[6], p1[7])}; pb[2] = __builtin_bit_cast(bf16x8, w);
      w = (v4u){cvtpk(p1[8], p1[9]), cvtpk(p1[10], p1[11]), cvtpk(p1[12], p1[13]), cvtpk(p1[14], p1[15])}; pb[3] = __builtin_bit_cast(bf16x8, w); }
    const int i16 = lane & 15, gc = (lane >> 4) & 1;
    const unsigned vb = (unsigned)(unsigned long long)(buf + FA_KB + (4 * h + (i16 >> 2)) * FA_VSTR + (16 * gc + 4 * (i16 & 3)) * 2);
    s16x4 lo[DB ? 2 : 1][4], hi[DB ? 2 : 1][4];
#define FA_RD(S, SET) do { FA_TR(lo[SET][0], vb, (16 * (S)) * FA_VSTR); FA_TR(hi[SET][0], vb, (16 * (S) + 8) * FA_VSTR); FA_TR(lo[SET][1], vb, (16 * (S)) * FA_VSTR + 64); FA_TR(hi[SET][1], vb, (16 * (S) + 8) * FA_VSTR + 64); \
                           FA_TR(lo[SET][2], vb, (16 * (S)) * FA_VSTR + 128); FA_TR(hi[SET][2], vb, (16 * (S) + 8) * FA_VSTR + 128); FA_TR(lo[SET][3], vb, (16 * (S)) * FA_VSTR + 192); FA_TR(hi[SET][3], vb, (16 * (S) + 8) * FA_VSTR + 192); } while (0)
#define FA_MM(S, SET) do { _Pragma("unroll") for (int b = 0; b < 4; ++b) { const bf16x8 a = (bf16x8){lo[SET][b][0], lo[SET][b][1], lo[SET][b][2], lo[SET][b][3], hi[SET][b][0], hi[SET][b][1], hi[SET][b][2], hi[SET][b][3]}; \
                           o[b] = __builtin_amdgcn_mfma_f32_32x32x16_bf16(a, pb[S], o[b], 0, 0, 0); } } while (0)
    asm volatile("s_waitcnt lgkmcnt(0)" ::: "memory"); __builtin_amdgcn_sched_barrier(0);
    if (DB) {
        FA_RD(0, 0);
        FA_RD(1, 1); asm volatile("s_waitcnt lgkmcnt(8)" ::: "memory"); __builtin_amdgcn_sched_barrier(0); FA_MM(0, 0); __builtin_amdgcn_sched_barrier(0);
        FA_RD(2, 0); asm volatile("s_waitcnt lgkmcnt(8)" ::: "memory"); __builtin_amdgcn_sched_barrier(0); FA_MM(1, 1); __builtin_amdgcn_sched_barrier(0);
        FA_RD(3, 1); asm volatile("s_waitcnt lgkmcnt(8)" ::: "memory"); __builtin_amdgcn_sched_barrier(0); FA_MM(2, 0); __builtin_amdgcn_sched_barrier(0);
        asm volatile("s_waitcnt lgkmcnt(0)" ::: "memory"); __builtin_amdgcn_sched_barrier(0); FA_MM(3, 1);
    } else {
        FA_RD(0, 0); asm volatile("s_waitcnt lgkmcnt(0)" ::: "memory"); __builtin_amdgcn_sched_barrier(0); FA_MM(0, 0); __builtin_amdgcn_sched_barrier(0);
        FA_RD(1, 0); asm volatile("s_waitcnt lgkmcnt(0)" ::: "memory"); __builtin_amdgcn_sched_barrier(0); FA_MM(1, 0); __builtin_amdgcn_sched_barrier(0);
        FA_RD(2, 0); asm volatile("s_waitcnt lgkmcnt(0)" ::: "memory"); __builtin_amdgcn_sched_barrier(0); FA_MM(2, 0); __builtin_amdgcn_sched_barrier(0);
        FA_RD(3, 0); asm volatile("s_waitcnt lgkmcnt(0)" ::: "memory"); __builtin_amdgcn_sched_barrier(0); FA_MM(3, 0);
    }
#undef FA_RD
#undef FA_MM
}
template <int NKS>
__device__ __forceinline__ void fa_tile(const LAS unsigned char* buf, const bf16x8 (&q)[NKS], f32x16 (&o)[4], float& m, float& lsum, float c, int kcolb, int lane, bool masked, int dpos) {
    f32x16 p0, p1; fa_s<NKS>(buf, q, p0, p1, kcolb, lane); fa_smpv<false>(buf, p0, p1, o, m, lsum, c, lane, masked, dpos);
}
template <int MODE>
__device__ __forceinline__ void fa_unit(Frame& F, const bf16* qg, int qstride, const Seg& s0, const Seg& s1, bool two, int qpos0, float c, const float* sinkp, float lam, float onems, const float* dnorm, bf16* dst, int dstride) {
    constexpr int NKS = MODE == 0 ? 8 : 4;
    int tid_ = F.tid; asm volatile("" : "+v"(tid_));
    const int tid = tid_, lane = tid & 63, w = F.wave, r32 = lane & 31, h = lane >> 5, grp = w >> 2, qrow0 = (w & 3) * 32;
    const int kcolb = MODE == 0 ? 0 : grp * 128;
    qg += (MODE == 0 ? grp * 128 : grp * 64); if (MODE == 0) dst += grp * 128;
    bf16x8 q[NKS];
#pragma unroll
    for (int ks = 0; ks < NKS; ++ks) q[ks] = *(const bf16x8*)(qg + (size_t)(qrow0 + r32) * qstride + ks * 16 + h * 8);
    f32x16 o[4];
#pragma unroll
    for (int b = 0; b < 4; ++b)
#pragma unroll
        for (int r = 0; r < 16; ++r) o[b][r] = 0.f;
    float m = -INFINITY, lsum = 0.f;
    const int nt0 = s0.n >> 6, nt = nt0 + (two ? (s1.n >> 6) : 0);
    FaTile t;
    __syncthreads();
    if (MODE == 1) {
        fa_load(t, s0, 0, tid); fa_store(t, F.lds, tid);
        if (nt > 1) { if (1 < nt0) fa_load(t, s0, 64, tid); else fa_load(t, s1, (1 - nt0) * 64, tid); fa_store(t, F.lds + FA_BUF, tid); }
        __syncthreads();
        f32x16 pa0, pa1; fa_s<NKS>(F.lds, q, pa0, pa1, kcolb, lane);
        int b0 = 0, b1 = FA_BUF, b2 = 2 * FA_BUF;
        for (int it = 0; it < nt; ++it) {
            const bool more2 = it + 2 < nt;
            if (more2) { const int n = it + 2; if (n < nt0) fa_load(t, s0, n * 64, tid); else fa_load(t, s1, (n - nt0) * 64, tid); }
            f32x16 pn0, pn1;
            if (it + 1 < nt) fa_s<NKS>(F.lds + b1, q, pn0, pn1, kcolb, lane);
            fa_smpv<false>(F.lds + b0, pa0, pa1, o, m, lsum, c, lane, false, 0);
            if (more2) fa_store(t, F.lds + b2, tid);
            __syncthreads();
            pa0 = pn0; pa1 = pn1;
            const int tb = b0; b0 = b1; b1 = b2; b2 = tb;
        }
    } else {
    fa_load(t, s0, 0, tid); fa_store(t, F.lds, tid);
    __syncthreads();
    for (int it = 0; it < nt; ++it) {
        const bool more = it + 1 < nt;
        if (more) { const int n = it + 1; if (n < nt0) fa_load(t, s0, n * 64, tid); else fa_load(t, s1, (n - nt0) * 64, tid); }
        const bool inseg1 = it >= nt0; const int pos0 = inseg1 ? s1.pos0 : s0.pos0; const int key0 = (inseg1 ? it - nt0 : it) * 64;
        fa_tile<NKS>(F.lds + (it & 1) * FA_BUF, q, o, m, lsum, c, kcolb, lane, pos0 >= 0, (qpos0 + qrow0 + r32) - (pos0 + key0));
        if (more) fa_store(t, F.lds + ((it + 1) & 1) * FA_BUF, tid);
        __syncthreads();
    }
    }
    const float ltot = half_sum(lsum);
    if (MODE == 0) {
        const float inv = 1.0f / (ltot + __builtin_amdgcn_exp2f(sinkp[grp] * 1.4426950408889634f - m));
#pragma unroll
        for (int b = 0; b < 4; ++b) o[b] = o[b] * inv;
    } else {
        LAS float* comb = (LAS float*)(F.lds + (w & 3) * 16384);
        if (grp == 1) { const float f = lam / ltot;
#pragma unroll
            for (int b = 0; b < 4; ++b)
#pragma unroll
                for (int r = 0; r < 16; ++r) comb[(32 * b + (r & 3) + 8 * (r >> 2) + 4 * h) * 32 + r32] = o[b][r] * f; }
        __syncthreads();
        if (grp == 0) { const float inv = 1.0f / ltot; float ss = 0.f;
#pragma unroll
            for (int b = 0; b < 4; ++b)
#pragma unroll
                for (int r = 0; r < 16; ++r) { const float v = o[b][r] * inv - comb[(32 * b + (r & 3) + 8 * (r >> 2) + 4 * h) * 32 + r32]; o[b][r] = v; ss += v * v; }
            ss = half_sum(ss);
            const float rs = onems / sqrtf(ss * (1.0f / 128.0f) + EPS);
#pragma unroll
            for (int b = 0; b < 4; ++b)
#pragma unroll
                for (int r = 0; r < 16; ++r) o[b][r] = o[b][r] * rs * dnorm[32 * b + (r & 3) + 8 * (r >> 2) + 4 * h]; }
    }
    if (MODE == 0 || grp == 0) {
        LAS unsigned char* st = F.lds + (MODE == 0 ? w * (32 * FA_OSTR) : 65536 + (w & 3) * (32 * FA_OSTR));
#pragma unroll
        for (int b = 0; b < 4; ++b)
#pragma unroll
            for (int k = 0; k < 4; ++k) { typedef unsigned u2 __attribute__((ext_vector_type(2)));
                *(LAS u2*)(st + r32 * FA_OSTR + (32 * b + 8 * k + 4 * h) * 2) = (u2){cvtpk(o[b][4 * k], o[b][4 * k + 1]), cvtpk(o[b][4 * k + 2], o[b][4 * k + 3])}; }
        asm volatile("s_waitcnt lgkmcnt(0)" ::: "memory");
#pragma unroll
        for (int i = 0; i < 8; ++i) { const int cc = lane + 64 * i, row = cc >> 4, c16 = cc & 15;
            *(v4u*)(dst + (size_t)(qrow0 + row) * dstride + c16 * 8) = *(const LAS v4u*)(st + row * FA_OSTR + c16 * 16); }
    }
}
constexpr int NCHUNK = 96;
constexpr int S1_CSTR = 272, S1_XSTR = 160;
constexpr int S3_CM = 0, S3_BM = 34816, S3_XM = 69632, S3_TAB = 90112, S3_SSP = 92160;
constexpr int S1_BM = 0, S1_XM = 34816, S1_TAB = 55296;
#define LBAR() asm volatile("s_waitcnt lgkmcnt(0)\n\ts_barrier" ::: "memory")
__device__ __forceinline__ int crow16(int r, int h) { return (r & 3) + 8 * (r >> 2) + 4 * h; }

struct S1Pre { v4u b[4], x[2]; float dt; };
__device__ __forceinline__ void s1_load(S1Pre& q, const bf16* XB, const float* DT, int cc, int hd, int dir, int tid) {
    const int m0 = cc * 128, g = hd >> 3;
    const unsigned offB = (unsigned)((tid >> 4) * 1536 + (tid & 15) * 8) * 2u, offX = (unsigned)((tid >> 3) * 1536 + (tid & 7) * 8) * 2u;
#pragma unroll
    for (int i = 0; i < 4; ++i) { const char* bs = (const char*)(XB + (size_t)(m0 + 32 * i) * 1536 + 1024 + g * 128); q.b[i] = *(const v4u*)(bs + offB); }
#pragma unroll
    for (int i = 0; i < 2; ++i) { const char* xs = (const char*)(XB + (size_t)(m0 + 64 * i) * 1536 + hd * 64); q.x[i] = *(const v4u*)(xs + offX); }
    q.dt = *(const float*)((const char*)(DT + (size_t)m0 * 32 + dir * 16 + hd) + (unsigned)((tid & 127) * 32) * 4u);
}
__device__ __forceinline__ void s1_store(const S1Pre& q, LAS unsigned char* L, int tid) {
#pragma unroll
    for (int i = 0; i < 4; ++i) { const int c = tid + 512 * i, row = c >> 4, ch = c & 15; *(LAS v4u*)(L + S1_BM + row * S1_CSTR + ch * 16) = q.b[i]; }
#pragma unroll
    for (int i = 0; i < 2; ++i) { const int c = tid + 512 * i, row = c >> 3, ch = c & 7; *(LAS v4u*)(L + S1_XM + row * S1_XSTR + ch * 16) = q.x[i]; }
    if (tid < 128) ((LAS float*)(L + S1_TAB))[tid] = q.dt;
}
__device__ __forceinline__ void ssd_chain(Frame& F, PP p, int l, int seq, int hd, int dir) {
    unsigned char* ws = p->ws;
    int tid_ = F.tid; asm volatile("" : "+v"(tid_));
    const int tid = tid_, lane = tid & 63, w = F.wave, r32 = lane & 31, hh = lane >> 5, i16 = lane & 15, gc = (lane >> 4) & 1;
    const bf16* XB = (const bf16*)(ws + WS_XBC); const float* DT = (const float*)(ws + WS_DT);
    float* CUMG = (float*)(ws + WS_EDEC); bf16* STR = (bf16*)(ws + WS_ST);
    LAS unsigned char* L = F.lds; LAS float* tab = (LAS float*)(L + S1_TAB);
    const int nc = seq < 16 ? 2 : 32, c0 = seq < 16 ? seq * 2 : 32 + (seq - 16) * 32;
    const int nb = w & 3, pb = w >> 2;
    const float a = -__expf(p->in[21][(l * 2 + dir) * 16 + hd]);
    f32x16 st;
    if (seq >= 16) { const float* h0 = p->in[dir ? 7 : 6] + (((size_t)(seq - 16) * DEPTH + l) * 16 + hd) * 8192 + (32 * pb + r32) * 128 + 32 * nb + 4 * hh;
#pragma unroll
        for (int k = 0; k < 4; ++k) { const f32x4 v = *(const f32x4*)(h0 + 8 * k); st[4 * k] = v.x; st[4 * k + 1] = v.y; st[4 * k + 2] = v.z; st[4 * k + 3] = v.w; } }
    else {
#pragma unroll
        for (int r = 0; r < 16; ++r) st[r] = 0.f; }
    S1Pre q; s1_load(q, XB, DT, dir ? c0 + nc - 1 : c0, hd, dir, tid);
    const LAS unsigned char* bp = L + S1_BM + (8 * hh + (i16 >> 2)) * S1_CSTR + (32 * nb + 16 * gc + 4 * (i16 & 3)) * 2;
    const LAS unsigned char* xp = L + S1_XM + (8 * hh + (i16 >> 2)) * S1_XSTR + (32 * pb + 16 * gc + 4 * (i16 & 3)) * 2;
    for (int k = 0; k < nc; ++k) {
        const int cc = dir ? c0 + nc - 1 - k : c0 + k;
        LBAR();
        s1_store(q, L, tid);
        LBAR();
        if (k + 1 < nc) s1_load(q, XB, DT, dir ? cc - 1 : cc + 1, hd, dir, tid);
        if (w == 0) {
            const float d0 = tab[2 * lane], d1 = tab[2 * lane + 1];
            const float v0 = d0 * a, v1 = d1 * a, s = v0 + v1;
            float inc = s;
            if (dir == 0) {
#pragma unroll
                for (int o = 1; o < 64; o <<= 1) { const float t = bperm(inc, lane - o); if (lane >= o) inc += t; }
            } else {
#pragma unroll
                for (int o = 1; o < 64; o <<= 1) { const float t = bperm(inc, lane + o); if (lane + o < 64) inc += t; }
            }
            const float exc = inc - s;
            const float cA = (dir == 0) ? exc + v0 : exc + v1 + v0, cB = (dir == 0) ? exc + v0 + v1 : exc + v1;
            const float tot = bperm(inc, dir == 0 ? 63 : 0);
            tab[128 + 2 * lane] = __expf(tot - cA) * d0; tab[128 + 2 * lane + 1] = __expf(tot - cB) * d1;
            if (lane == 0) tab[256] = __expf(tot);
            typedef float f2 __attribute__((ext_vector_type(2)));
            *(f2*)(CUMG + ((size_t)(cc * 16 + hd) * 2 + dir) * 128 + 2 * lane) = (f2){cA, cB};
        }
        {
            bf16* so = STR + ((size_t)(dir * NCHUNK + cc) * 16 + hd) * 8192 + (size_t)((nb * 2 + pb) * 2) * 512 + lane * 8;
#pragma unroll
            for (int j = 0; j < 2; ++j) *(v4u*)(so + j * 512) = (v4u){cvtpk(st[8 * j], st[8 * j + 1]), cvtpk(st[8 * j + 2], st[8 * j + 3]), cvtpk(st[8 * j + 4], st[8 * j + 5]), cvtpk(st[8 * j + 6], st[8 * j + 7])};
        }
        LBAR();
        { const float dec = tab[256];
#pragma unroll
          for (int r = 0; r < 16; ++r) st[r] *= dec; }
#pragma unroll
        for (int ks = 0; ks < 8; ++ks) {
            const s16x4 alo = __builtin_amdgcn_ds_read_tr16_b64_v4i16((LAS s16x4*)(bp + (16 * ks) * S1_CSTR));
            const s16x4 ahi = __builtin_amdgcn_ds_read_tr16_b64_v4i16((LAS s16x4*)(bp + (16 * ks + 4) * S1_CSTR));
            const bf16x8 afr = (bf16x8){alo[0], alo[1], alo[2], alo[3], ahi[0], ahi[1], ahi[2], ahi[3]};
            const s16x4 lo = __builtin_amdgcn_ds_read_tr16_b64_v4i16((LAS s16x4*)(xp + (16 * ks) * S1_XSTR));
            const s16x4 hi = __builtin_amdgcn_ds_read_tr16_b64_v4i16((LAS s16x4*)(xp + (16 * ks + 4) * S1_XSTR));
            const f32x4 w0 = *(const LAS f32x4*)(tab + 128 + 16 * ks + 8 * hh), w1 = *(const LAS f32x4*)(tab + 128 + 16 * ks + 8 * hh + 4);
            const v4u t = (v4u){cvtpk(bf1((bf16)lo[0]) * w0.x, bf1((bf16)lo[1]) * w0.y), cvtpk(bf1((bf16)lo[2]) * w0.z, bf1((bf16)lo[3]) * w0.w), cvtpk(bf1((bf16)hi[0]) * w1.x, bf1((bf16)hi[1]) * w1.y), cvtpk(bf1((bf16)hi[2]) * w1.z, bf1((bf16)hi[3]) * w1.w)};
            st = __builtin_amdgcn_mfma_f32_32x32x16_bf16(afr, __builtin_bit_cast(bf16x8, t), st, 0, 0, 0);
        }
    }
    if (seq < 16) { float* o = p->out + (dir ? OUT_SB : OUT_SF) + (((size_t)seq * DEPTH + l) * 16 + hd) * 8192 + (32 * pb + r32) * 128 + 32 * nb + 4 * hh;
#pragma unroll
        for (int k = 0; k < 4; ++k) *(f32x4*)(o + 8 * k) = (f32x4){st[4 * k], st[4 * k + 1], st[4 * k + 2], st[4 * k + 3]}; }
    LBAR();
}
struct S3Pre { v4u c[4], b[4], x[2]; float dt, cum, dk; };
__device__ __forceinline__ void s3_load(S3Pre& q, const bf16* XB, const float* DT, const float* CUMG, const float* dskip, int u, int tid) {
    const int cc = u >> 4, hd = u & 15, m0 = cc * 128, g = hd >> 3;
    const unsigned offB = (unsigned)((tid >> 4) * 1536 + (tid & 15) * 8) * 2u, offX = (unsigned)((tid >> 3) * 1536 + (tid & 7) * 8) * 2u;
#pragma unroll
    for (int i = 0; i < 4; ++i) { const char* bs = (const char*)(XB + (size_t)(m0 + 32 * i) * 1536 + g * 128); q.c[i] = *(const v4u*)(bs + 2560 + offB); q.b[i] = *(const v4u*)(bs + 2048 + offB); }
#pragma unroll
    for (int i = 0; i < 2; ++i) { const char* xs = (const char*)(XB + (size_t)(m0 + 64 * i) * 1536 + hd * 64); q.x[i] = *(const v4u*)(xs + offX); }
    q.dt = *(const float*)((const char*)(DT + (size_t)m0 * 32 + hd) + (unsigned)((tid & 127) * 32 + ((tid >> 7) & 1) * 16) * 4u);
    q.cum = *(const float*)((const char*)(CUMG + (size_t)(cc * 16 + hd) * 256) + (unsigned)(tid & 255) * 4u);
    q.dk = dskip[hd];
}
__device__ __forceinline__ void s3_store(const S3Pre& q, LAS unsigned char* L, int tid) {
#pragma unroll
    for (int i = 0; i < 4; ++i) { const int c = tid + 512 * i, row = c >> 4, ch = c & 15; *(LAS v4u*)(L + S3_CM + row * S1_CSTR + ch * 16) = q.c[i]; *(LAS v4u*)(L + S3_BM + row * S1_CSTR + ch * 16) = q.b[i]; }
#pragma unroll
    for (int i = 0; i < 2; ++i) { const int c = tid + 512 * i, row = c >> 3, ch = c & 7; *(LAS v4u*)(L + S3_XM + row * S1_XSTR + ch * 16) = q.x[i]; }
    if (tid < 256) { ((LAS float*)(L + S3_TAB))[tid] = q.cum; ((LAS float*)(L + S3_TAB))[256 + tid] = q.dt; }
}
__device__ __forceinline__ void s3_phase(Frame& F, PP p, int l) {
    unsigned char* ws = p->ws;
    int tid_ = F.tid; asm volatile("" : "+v"(tid_));
    const int tid = tid_, lane = tid & 63, w = F.wave, r32 = lane & 31, hh = lane >> 5, i16 = lane & 15, gc = (lane >> 4) & 1;
    const bf16* XB = (const bf16*)(ws + WS_XBC); const bf16* P = (const bf16*)(ws + WS_P); bf16* MIX = (bf16*)(ws + WS_MIX);
    const float* DT = (const float*)(ws + WS_DT); const float* CUMG = (const float*)(ws + WS_EDEC); const bf16* STR = (const bf16*)(ws + WS_ST); float* SSQ = (float*)(ws + WS_SSQ);
    LAS unsigned char* L = F.lds; const LAS float* tab = (const LAS float*)(L + S3_TAB); LAS float* SSP = (LAS float*)(L + S3_SSP);
    const int lb = w & 3, pb = w >> 2, lpos = 32 * lb + r32;
    const int uend = NCHUNK * 16;
    int u = blockIdx.x; if (u >= uend) return;
    const float* dskip = p->in[22] + l * 16;
    S3Pre q; s3_load(q, XB, DT, CUMG, dskip, u, tid);
    while (u < uend) {
        const int cc = u >> 4, hd = u & 15, m0 = cc * 128; const float dk = q.dk;
        LBAR();
        s3_store(q, L, tid);
        LBAR();
        const int un = u + F.G; if (un < uend) s3_load(q, XB, DT, CUMG, dskip, un, tid);
        v4u hf[2][8];
#pragma unroll
        for (int k = 0; k < 8; ++k) hf[0][k] = *(const v4u*)((const char*)(STR + ((size_t)(0 * NCHUNK + cc) * 16 + hd) * 8192 + (((k >> 1) * 2 + pb) * 2 + (k & 1)) * 512) + (unsigned)lane * 16u);
        unsigned long long zw[4];
        f32x16 acc;
#pragma unroll
        for (int r = 0; r < 16; ++r) acc[r] = 0.f;
#pragma unroll
        for (int d = 0; d < 2; ++d) {
            const LAS float* cum = tab + d * 128; const LAS float* dtv = tab + (2 + d) * 128; const float cl = cum[lpos];
            const int sb0 = d == 0 ? 0 : lb, sb1 = d == 0 ? lb : 3;
            for (int sb = sb0; sb <= sb1; ++sb) {
                f32x16 cb;
#pragma unroll
                for (int r = 0; r < 16; ++r) cb[r] = 0.f;
#pragma unroll
                for (int ks = 0; ks < 8; ++ks) { const bf16x8 a = *(const LAS bf16x8*)(L + S3_BM + (32 * sb + r32) * S1_CSTR + ks * 32 + hh * 16);
                    const bf16x8 cfr = *(const LAS bf16x8*)(L + S3_CM + lpos * S1_CSTR + ks * 32 + hh * 16);
                    cb = __builtin_amdgcn_mfma_f32_32x32x16_bf16(a, cfr, cb, 0, 0, 0);
                    if ((ks & 3) == 3) __builtin_amdgcn_sched_barrier(0); }
#pragma unroll
                for (int r = 0; r < 16; ++r) { const int s = 32 * sb + crow16(r, hh);
                    float v = cb[r] * __expf(cl - cum[s]) * dtv[s];
                    const bool ok = d == 0 ? (s <= lpos) : (s >= lpos);
                    v = ok ? v : 0.f; if (d == 0 && s == lpos) v += dk;
                    cb[r] = v; }
                bf16x8 pb2[2];
                { v4u t;
                  t = (v4u){cvtpk(cb[0], cb[1]), cvtpk(cb[2], cb[3]), cvtpk(cb[4], cb[5]), cvtpk(cb[6], cb[7])}; pb2[0] = __builtin_bit_cast(bf16x8, t);
                  t = (v4u){cvtpk(cb[8], cb[9]), cvtpk(cb[10], cb[11]), cvtpk(cb[12], cb[13]), cvtpk(cb[14], cb[15])}; pb2[1] = __builtin_bit_cast(bf16x8, t); }
                const LAS unsigned char* xp = L + S3_XM + (32 * sb + 4 * hh + (i16 >> 2)) * S1_XSTR + (32 * pb + 16 * gc + 4 * (i16 & 3)) * 2;
#pragma unroll
                for (int k2 = 0; k2 < 2; ++k2) {
                    const s16x4 lo = __builtin_amdgcn_ds_read_tr16_b64_v4i16((LAS s16x4*)(xp + (16 * k2) * S1_XSTR));
                    const s16x4 hi = __builtin_amdgcn_ds_read_tr16_b64_v4i16((LAS s16x4*)(xp + (16 * k2 + 8) * S1_XSTR));
                    const bf16x8 a = (bf16x8){lo[0], lo[1], lo[2], lo[3], hi[0], hi[1], hi[2], hi[3]};
                    acc = __builtin_amdgcn_mfma_f32_32x32x16_bf16(a, pb2[k2], acc, 0, 0, 0);
                }
            }
            if (d == 0) {
#pragma unroll
                for (int k = 0; k < 8; ++k) hf[1][k] = *(const v4u*)((const char*)(STR + ((size_t)(1 * NCHUNK + cc) * 16 + hd) * 8192 + (((k >> 1) * 2 + pb) * 2 + (k & 1)) * 512) + (unsigned)lane * 16u);
#pragma unroll
                for (int k = 0; k < 4; ++k) zw[k] = *(const unsigned long long*)((const char*)(P + (size_t)m0 * INP + PC_Z + hd * 64 + 32 * pb + 8 * k) + (unsigned)(lpos * INP + 4 * hh) * 2u);
            }
        }
#pragma unroll
        for (int d = 0; d < 2; ++d) { const float e = __expf(tab[d * 128 + lpos]);
#pragma unroll
            for (int k = 0; k < 8; ++k) { typedef unsigned u2 __attribute__((ext_vector_type(2)));
                const LAS unsigned char* cp = L + S3_CM + lpos * S1_CSTR + (32 * (k >> 1) + 16 * (k & 1) + 4 * hh) * 2;
                const u2 c0 = *(const LAS u2*)cp, c1 = *(const LAS u2*)(cp + 16);
                const v4u t = (v4u){cvtpk(bflo(c0.x) * e, bfhi(c0.x) * e), cvtpk(bflo(c0.y) * e, bfhi(c0.y) * e), cvtpk(bflo(c1.x) * e, bfhi(c1.x) * e), cvtpk(bflo(c1.y) * e, bfhi(c1.y) * e)};
                acc = __builtin_amdgcn_mfma_f32_32x32x16_bf16(__builtin_bit_cast(bf16x8, hf[d][k]), __builtin_bit_cast(bf16x8, t), acc, 0, 0, 0); } }
        float ss = 0.f;
        char* mixr = (char*)(MIX + (size_t)m0 * DM + 1024 + hd * 64 + 32 * pb); const unsigned mixo = (unsigned)(lpos * DM + 4 * hh) * 2u;
#pragma unroll
        for (int k = 0; k < 4; ++k) { const unsigned long long z = zw[k];
            const float y0 = acc[4 * k] * silu(bflo((unsigned)z)), y1 = acc[4 * k + 1] * silu(bfhi((unsigned)z)), y2 = acc[4 * k + 2] * silu(bflo((unsigned)(z >> 32))), y3 = acc[4 * k + 3] * silu(bfhi((unsigned)(z >> 32)));
            ss += (y0 * y0 + y1 * y1) + (y2 * y2 + y3 * y3);
            *(unsigned long long*)(mixr + 16 * k + mixo) = (unsigned long long)cvtpk(y0, y1) | ((unsigned long long)cvtpk(y2, y3) << 32); }
        ss = half_sum(ss);
        if (hh == 0) SSP[pb * 128 + lpos] = ss;
        LBAR();
        if (tid < 128) SSQ[(size_t)(m0 + tid) * 16 + hd] = SSP[tid] + SSP[128 + tid];
        u = un;
    }
    LBAR();
}
__device__ __forceinline__ void nrm_phase(Frame& F, PP p, int l) {
    unsigned char* ws = p->ws; bf16* MIX = (bf16*)(ws + WS_MIX); const float* SSQ = (const float*)(ws + WS_SSQ); const float* sn = p->in[23] + l * 1024;
    const int gw = F.vcu * NWAVES + F.wave, NGW = F.G * NWAVES, lane = F.lane;
    for (int m = gw; m < MROWS; m += NGW) {
        const int c0 = lane * 16, g = lane >> 5;
        const f32x4 s0 = *(const f32x4*)(SSQ + (size_t)m * 16 + g * 8), s1 = *(const f32x4*)(SSQ + (size_t)m * 16 + g * 8 + 4);
        const float rs = 1.0f / sqrtf(((s0.x + s0.y) + (s0.z + s0.w) + (s1.x + s1.y) + (s1.z + s1.w)) * (1.0f / 512.0f) + EPS);
        v4u* q = (v4u*)(MIX + (size_t)m * DM + 1024 + c0); v4u a = q[0], b = q[1];
        const f32x4 g0 = *(const f32x4*)(sn + c0), g1 = *(const f32x4*)(sn + c0 + 4), g2 = *(const f32x4*)(sn + c0 + 8), g3 = *(const f32x4*)(sn + c0 + 12);
        a.x = cvtpk(bflo(a.x) * rs * g0.x, bfhi(a.x) * rs * g0.y); a.y = cvtpk(bflo(a.y) * rs * g0.z, bfhi(a.y) * rs * g0.w); a.z = cvtpk(bflo(a.z) * rs * g1.x, bfhi(a.z) * rs * g1.y); a.w = cvtpk(bflo(a.w) * rs * g1.z, bfhi(a.w) * rs * g1.w);
        b.x = cvtpk(bflo(b.x) * rs * g2.x, bfhi(b.x) * rs * g2.y); b.y = cvtpk(bflo(b.y) * rs * g2.z, bfhi(b.y) * rs * g2.w); b.z = cvtpk(bflo(b.z) * rs * g3.x, bfhi(b.z) * rs * g3.y); b.w = cvtpk(bflo(b.w) * rs * g3.z, bfhi(b.w) * rs * g3.w);
        q[0] = a; q[1] = b;
    }
}
__device__ __forceinline__ void mix1_phase(Frame& F, PP p, int l) {
    unsigned char* ws = p->ws;
    const bf16* P = (const bf16*)(ws + WS_P); const bf16* QKR = (const bf16*)(ws + WS_QKR); bf16* MIX = (bf16*)(ws + WS_MIX);
    const float* lamv = (const float*)(ws + WS_TAB + 32768);
    const float lam = lamv[l], onems = 1.0f - lamv[4 + l];
    const float* dnorm = p->in[17] + l * 128;
    constexpr int U_BL = 256, U_AL = 128, U_BC = 128, U_AC = 64, U_CC = 512, U_REST = U_AL + U_BC + U_AC + U_CC;
    const float LOG2E = 1.4426950408889634f, cA = 0.08838834764831845f * LOG2E, cB = 0.125f * LOG2E;
    const int NLC = F.G > 64 ? 64 : 0;
    const int bx = (int)blockIdx.x;
    const int nB = (U_BL - bx + F.G - 1) / F.G;
    int nR = 0, rfirst = 0, rstride = 1;
    if (bx >= NLC) { rfirst = bx - NLC; rstride = F.G - NLC; nR = rfirst < U_REST ? (U_REST - rfirst + rstride - 1) / rstride : 0; }
    for (int ui = 0; ui < nB + nR; ++ui) {
        int r;
        if (ui < nB) r = bx + ui * F.G;
        else { r = rfirst + (ui - nB) * rstride;
               if (r >= U_AL + U_BC + U_AC) { r -= U_AL + U_BC + U_AC; __syncthreads(); ssd_chain(F, p, l, r >> 5, (r >> 1) & 15, r & 1); continue; }
               r += U_BL; }
        int mode = 1; const bf16* qp; int qstr = RCW, qpos0 = 0; bool two = true; Seg s0, s1; bf16* dst; const float* sinkp = dnorm;
        if (r < U_BL) {
            const int b = r >> 7, h = (r >> 5) & 3, qb = r & 31; const int ml = b * 4096 + qb * 128;
            s0 = Seg{QKR + (size_t)(b * 4096) * RCW + RC_KD + h * 128, P + (size_t)(4096 + b * 4096) * INP + PC_VD + h * 128, RCW, INP, 4096, 0, -1};
            s1 = Seg{p->in[4] + ((size_t)(b * DEPTH + l) * 256) * 512 + h * 128, p->in[5] + ((size_t)(b * DEPTH + l) * 256) * 512 + h * 128, 512, 512, 256, 1, -1};
            qp = QKR + (size_t)ml * RCW + RC_QD + h * 128; dst = MIX + (size_t)(4096 + ml) * DM + 512 + h * 128;
        } else if (r < U_BL + U_AL) { r -= U_BL;
            const int b = r >> 6, kv = (r >> 5) & 1, qb = r & 31; const int ml = b * 4096 + qb * 128;
            const int w0 = qb * 128 - 128 < 0 ? 0 : qb * 128 - 128, w1 = qb * 128 + 256 > 4096 ? 4096 : qb * 128 + 256;
            s0 = Seg{p->in[2] + ((size_t)(b * DEPTH + l) * 256) * 256 + kv * 128, p->in[3] + ((size_t)(b * DEPTH + l) * 256) * 256 + kv * 128, 256, 256, 256, 1, -1};
            s1 = Seg{QKR + (size_t)(b * 4096 + w0) * RCW + RC_KA + kv * 128, P + (size_t)(4096 + b * 4096 + w0) * INP + PC_VA + kv * 128, RCW, INP, w1 - w0, 0, w0};
            mode = 0; qp = QKR + (size_t)ml * RCW + RC_QA + kv * 256; qpos0 = qb * 128; sinkp = p->in[15] + l * 4 + kv * 2; dst = MIX + (size_t)(4096 + ml) * DM + kv * 256;
        } else if (r < U_BL + U_AL + U_BC) { r -= U_BL + U_AL;
            const int b = r >> 3, h = (r >> 1) & 3, qb = r & 1; const int m0 = b * 256 + qb * 128;
            s0 = Seg{P + (size_t)(b * 256) * INP + PC_KD + h * 128, P + (size_t)(b * 256) * INP + PC_VD + h * 128, INP, INP, 256, 0, -1}; s1 = s0; two = false;
            qp = P + (size_t)m0 * INP + PC_QD + h * 128; qstr = INP; dst = MIX + (size_t)m0 * DM + 512 + h * 128;
        } else { r -= U_BL + U_AL + U_BC;
            const int b = r >> 2, kv = (r >> 1) & 1, qb = r & 1; const int m0 = b * 256 + qb * 128;
            s0 = Seg{P + (size_t)(b * 256) * INP + PC_KA + kv * 128, P + (size_t)(b * 256) * INP + PC_VA + kv * 128, INP, INP, 256, 0, -1}; s1 = s0; two = false;
            mode = 0; qp = P + (size_t)m0 * INP + PC_QA + kv * 256; qstr = INP; sinkp = p->in[15] + l * 4 + kv * 2; dst = MIX + (size_t)m0 * DM + kv * 256;
        }
        if (mode) fa_unit<1>(F, qp, qstr, s0, s1, two, qpos0, cB, sinkp, lam, onems, dnorm, dst, DM);
        else fa_unit<0>(F, qp, qstr, s0, s1, two, qpos0, cA, sinkp, lam, onems, dnorm, dst, DM);
    }
    __syncthreads();
    if (NLC == 0) { for (int c = bx; c < 64; c += F.G) ssd_chain(F, p, l, 16 + (c >> 5), (c >> 1) & 15, c & 1); }
    else if (bx < NLC) ssd_chain(F, p, l, 16 + (bx >> 5), (bx >> 1) & 15, bx & 1);
}
#ifndef MK_ONE_LAUNCH
#define MK_ONE_LAUNCH 1
#endif
constexpr int PH_PER_LAYER = 10, PH_TOTAL = 2 + DEPTH * PH_PER_LAYER + 1;
__global__ void __launch_bounds__(NTHR, 2) mk_fwd(Params p_) {
    extern __shared__ __attribute__((aligned(16))) unsigned char lds[];
    Frame F;
    F.lds = (LAS unsigned char*)lds;
    F.tid = threadIdx.x; F.lane = F.tid & 63; F.wave = __builtin_amdgcn_readfirstlane(F.tid >> 6); const int wave0 = F.wave;
    F.G = gridDim.x; { const int bx = blockIdx.x; F.vcu = (F.G % 8 == 0) ? (bx % 8) * (F.G / 8) + bx / 8 : bx; }
    PP p = (PP)__builtin_amdgcn_kernarg_segment_ptr();
    for (int u = F.tid; u < (LDS_BYTES - LDSCTL_OFF) / 4; u += NTHR) ((LAS unsigned*)(F.lds + LDSCTL_OFF))[u] = 0u;
    __syncthreads();
    XcdBarrier bar; bar.bar = (unsigned*)(p->ws + WS_CTL) + CW_BAR; bar.x = 0; bar.st = nullptr;
#if MK_ONE_LAUNCH
    bar = xcd_barrier_post((unsigned*)(p->ws + WS_CTL) + CW_BAR, (volatile LAS unsigned*)(F.lds + MISC_OFF) + 8, F.tid == 0);
#define GRID_BAR() do { unsigned on_ = ~0u; asm volatile("" : "+s"(on_)); xcd_barrier(bar, wave0 == 0 && __builtin_amdgcn_mbcnt_hi(on_, __builtin_amdgcn_mbcnt_lo(on_, 0u)) == 0u); } while (0)
#else
#define GRID_BAR() do {} while (0)
#endif
    const int lo = p->ph_lo, hi = p->ph_hi;
#define IN(k) (lo <= (k) && (k) < hi)
#define SEAM(k) do { if (IN(k) && IN((k) + 1)) GRID_BAR(); } while (0)
#define ENTER() do { int wv_ = wave0; asm volatile("" : "+s"(wv_)); unsigned on_ = ~0u; asm volatile("" : "+s"(on_)); int t_ = wv_ * 64 + (int)__builtin_amdgcn_mbcnt_hi(on_, __builtin_amdgcn_mbcnt_lo(on_, 0u)); asm volatile("" : "+v"(t_)); F.tid = t_; F.lane = t_ & 63; F.wave = wv_; asm volatile("" : "+s"(p)); ws = p->ws; } while (0)
    unsigned char* ws;

    if (IN(0)) { ENTER(); p0_prologue(F, p); } SEAM(0);
    if (IN(1)) { ENTER(); mod_layer(p, 0, F.vcu * NTHR + F.tid, F.G * NTHR); } SEAM(1);
#pragma unroll 1
    for (int l = 0; l < DEPTH; ++l) {
        const int pb = 2 + l * PH_PER_LAYER;
        if (IN(pb + 0)) { ENTER(); norm_phase(F, l == 0 ? p->in[0] : (const float*)(ws + WS_H), l == 0 ? p->in[1] : (const float*)(ws + WS_H) + (size_t)4096 * DM, p->in[12] + l * DM, (const float*)(ws + WS_MOD) + (size_t)l * 3 * NMOD, 0, DM, (bf16*)(ws + WS_U)); } SEAM(pb + 0);
        if (IN(pb + 1)) { ENTER();
            pg8::Gemm g{(const bf16*)(ws + WS_U), (const bf16*)(ws + WS_WIN) + (size_t)l * INP * DM, MROWS, INP, DM, DM}; pg8::StaticOrder S; S.init(MROWS, INP, F.G, (int)blockIdx.x);
            pg8::EpiBf16 E{(bf16*)(ws + WS_P), INP};
            pg8::gemm_phase<pg8::EpiBf16, pg8::StaticOrder, true, true>(F.lds, g, S, E, F.tid);
        } SEAM(pb + 1);
        if (IN(pb + 2)) { ENTER(); prep_phase(F, p, l); } SEAM(pb + 2);
        if (IN(pb + 3)) { ENTER(); mix1_phase(F, p, l); } SEAM(pb + 3);
        if (IN(pb + 4)) { ENTER(); s3_phase(F, p, l); } SEAM(pb + 4);
        if (IN(pb + 5)) { ENTER(); nrm_phase(F, p, l); } SEAM(pb + 5);
        if (IN(pb + 6)) { ENTER();
            pg8::Gemm g{(const bf16*)(ws + WS_MIX), (const bf16*)(ws + WS_WOUT) + (size_t)l * DM * DM, MROWS, DM, DM, DM}; pg8::StaticOrder S; S.init(MROWS, DM, F.G, (int)blockIdx.x);
            pg8::EpiResid E{l == 0 ? p->in[0] : (const float*)(ws + WS_H), l == 0 ? p->in[1] : (const float*)(ws + WS_H) + (size_t)4096 * DM, (float*)(ws + WS_H), DM, (const float*)(ws + WS_MOD) + (size_t)l * 3 * NMOD + 2 * DM, NMOD};
            pg8::gemm_phase<pg8::EpiResid, pg8::StaticOrder, true, true>(F.lds, g, S, E, F.tid);
            { const int nfull = F.G == 256 ? 128 : 0; if (l + 1 < DEPTH && (int)blockIdx.x >= nfull) adaln_layer(F, p, l + 1, (int)blockIdx.x - nfull, (int)F.G - nfull); }
        } SEAM(pb + 6);
        if (IN(pb + 7)) { ENTER(); norm_phase(F, (const float*)(ws + WS_H), (const float*)(ws + WS_H) + (size_t)4096 * DM, p->in[13] + l * DM, (const float*)(ws + WS_MOD) + (size_t)l * 3 * NMOD, 3 * DM, 4 * DM, (bf16*)(ws + WS_U)); } SEAM(pb + 7);
        if (IN(pb + 8)) { ENTER();
            pg8::Gemm g{(const bf16*)(ws + WS_U), (const bf16*)(ws + WS_WGU) + (size_t)l * GU * DM, MROWS, GU, DM, DM}; pg8::StaticOrder S; S.init(MROWS, GU, F.G, (int)blockIdx.x);
            pg8::EpiSwiGLU E{(bf16*)(ws + WS_ACT), FF};
            pg8::gemm_phase<pg8::EpiSwiGLU, pg8::StaticOrder, true, true>(F.lds, g, S, E, F.tid);
        } SEAM(pb + 8);
        if (IN(pb + 9)) { ENTER();
            pg8::Gemm g{(const bf16*)(ws + WS_ACT), (const bf16*)(ws + WS_WDN) + (size_t)l * DM * FF, MROWS, DM, FF, FF}; pg8::StaticOrder S; S.init(MROWS, DM, F.G, (int)blockIdx.x);
            if (l + 1 < DEPTH) mod_layer(p, l + 1, F.vcu * NTHR + F.tid, F.G * NTHR);
            pg8::EpiResid E{(const float*)(ws + WS_H), (const float*)(ws + WS_H) + (size_t)4096 * DM, (float*)(ws + WS_H), DM, (const float*)(ws + WS_MOD) + (size_t)l * 3 * NMOD + 5 * DM, NMOD};
            pg8::gemm_phase<pg8::EpiResid, pg8::StaticOrder, true, true>(F.lds, g, S, E, F.tid);
            { const int nfull = F.G == 256 ? 128 : 0; if (l + 1 < DEPTH && (int)blockIdx.x >= nfull) conv_layer(F, p, l + 1, ((int)blockIdx.x - nfull) * NWAVES + F.wave, ((int)F.G - nfull) * NWAVES); }
        } SEAM(pb + 9);
    }
    if (IN(PH_TOTAL - 1)) { ENTER(); final_phase(F, (const float*)(ws + WS_H), p->in[27], p->out); }
#undef IN
#undef SEAM
#undef ENTER
}

extern "C" void kernel_launch(void* const* d_in, const int* in_sizes, int n_in, void* d_out, int out_size, void* d_ws, size_t ws_size, hipStream_t stream) {
    static int grid = 0;
    if (grid == 0) {
        if (n_in != 28 || out_size != 67108864 || ws_size < WS_END) { fprintf(stderr, "kernel_launch: unexpected sizes n_in %d out %d ws %zu\n", n_in, out_size, ws_size); grid = -1; return; }
        int dev = 0, cus = 0, per_cu = 0;
        if (hipGetDevice(&dev) != hipSuccess || hipDeviceGetAttribute(&cus, hipDeviceAttributeMultiprocessorCount, dev) != hipSuccess) { grid = -1; return; }
        if (hipFuncSetAttribute((const void*)mk_fwd, hipFuncAttributeMaxDynamicSharedMemorySize, LDS_BYTES) != hipSuccess) { fprintf(stderr, "kernel_launch: hipFuncSetAttribute failed\n"); grid = -1; return; }
        if (hipOccupancyMaxActiveBlocksPerMultiprocessor(&per_cu, (const void*)mk_fwd, NTHR, LDS_BYTES) != hipSuccess || per_cu < 1)
            fprintf(stderr, "kernel_launch: occupancy query reports %d workgroups per CU\n", per_cu);
        (void)hipGetLastError();
        grid = cus;
    }
    if (grid < 0) return;
    if (hipMemsetAsync((char*)d_ws + WS_CTL, 0, CTL_ZERO_BYTES, stream) != hipSuccess) return;
    Params a{};
    for (int i = 0; i < 28; ++i) a.in[i] = (const float*)d_in[i];
    a.out = (float*)d_out; a.ws = (unsigned char*)d_ws;
#if MK_ONE_LAUNCH
    a.ph_lo = 0; a.ph_hi = PH_TOTAL;
    hipLaunchKernelGGL(mk_fwd, dim3(grid), dim3(NTHR), LDS_BYTES, stream, a);
#else
    for (int ph = 0; ph < PH_TOTAL; ++ph) { a.ph_lo = ph; a.ph_hi = ph + 1; hipLaunchKernelGGL(mk_fwd, dim3(grid), dim3(NTHR), LDS_BYTES, stream, a); }
#endif
}
```

```cpp
#include <hip/hip_runtime.h>
#include <cstdio>
#include <cstdint>
namespace pg8 {
#define PG8_LAS __attribute__((address_space(3)))
typedef unsigned short bf16_t;
typedef short bf16x8 __attribute__((ext_vector_type(8)));
typedef float f32x4 __attribute__((ext_vector_type(4)));
typedef unsigned u32x4 __attribute__((ext_vector_type(4)));
constexpr int BM = 256, BK = 64, HALF = 128, HTB = HALF * BK * 2  , STAGE_BYTES = 8 * HTB, NXCD = 8, WGM = 8;

__host__ __device__ __forceinline__ int lds_byte(int r, int c) { const int st = (r >> 4) * 2 + (c >> 5), rr = r & 15, cc = c & 31, ob = rr * 64 + cc * 2; return st * 1024 + (ob ^ (((ob >> 9) & 1) << 5)); }
__host__ __device__ __forceinline__ void stage_rc(int b, int& R, int& C) { const int st = b / 1024, sb = b % 1024, swz = sb ^ (((sb >> 9) & 1) << 5); R = (st >> 1) * 16 + swz / 64; C = (st & 1) * 32 + (swz % 64) / 2; }
__host__ __device__ __forceinline__ int perm32(int rho) { const int n = rho >> 4, i = rho & 15; return 8 * (i >> 2) + 4 * n + (i & 3); }

struct Unit { int pm, pn, pk; };
struct Gemm { const bf16_t* A; const bf16_t* Bt; int M, N, K, Ksub; };

struct StaticOrder {
    int nM, nN, nwg, G, c;
    __host__ __device__ void init(int M, int N, int G_, int c_) { nM = M / BM; nN = N / BM; nwg = nM * nN; G = G_; c = c_; }
    __host__ __device__ bool next(int i, Unit& u) const {
        const long L = (long)i * G + c; if (L >= nwg) return false;
        int wgid = (int)L; { const int q = nwg / NXCD, r = nwg % NXCD, xcd = wgid % NXCD, off = wgid / NXCD; wgid = (xcd < r ? xcd * (q + 1) : r * (q + 1) + (xcd - r) * q) + off; }
        const int nig = WGM * nN, gid = wgid / nig, fm = gid * WGM, gsz = (nM - fm) < WGM ? (nM - fm) : WGM;
        u.pm = fm + ((wgid % nig) % gsz); u.pn = (wgid % nig) / gsz; u.pk = 0; return true;
    }
    __device__ __forceinline__ void a_ready(const Unit&) const {}
    __device__ __forceinline__ void done(const Unit&) const {}
};
struct SplitOrder {
    StaticOrder s; int KS;
    __host__ __device__ void init(int M, int N, int KS_, int G_, int c_) { KS = KS_; s.init(M, N * KS_, G_, c_); }
    __host__ __device__ bool next(int i, Unit& u) const { if (!s.next(i, u)) return false; u.pk = u.pn % KS; u.pn = u.pn / KS; return true; }
    __device__ __forceinline__ void a_ready(const Unit&) const {}
    __device__ __forceinline__ void done(const Unit&) const {}
};


__device__ __forceinline__ unsigned cvt_pk_bf16(float lo, float hi) { unsigned r; asm volatile("v_cvt_pk_bf16_f32 %0, %1, %2" : "=v"(r) : "v"(lo), "v"(hi)); return r; }

struct EpiBf16 {
    static constexpr bool PERM = true, AFTER_DRAIN = false;
    bf16_t* O; int ldc;
    __device__ __forceinline__ void operator()(const f32x4 (&acc)[2][2][4][2], const Unit& u, int wr, int wc, int fr, int fq) const {
        const int row0 = u.pm * BM + wr * 64 + fr; const int col0 = u.pn * BM + wc * 32 + 8 * fq;
#pragma unroll
        for (int ai = 0; ai < 2; ++ai)
#pragma unroll
            for (int m = 0; m < 4; ++m) { bf16_t* rowp = O + (size_t)(row0 + ai * HALF + m * 16) * ldc + col0;
#pragma unroll
                for (int bj = 0; bj < 2; ++bj) { const f32x4 v0 = acc[ai][bj][m][0], v1 = acc[ai][bj][m][1];
                    u32x4 w; w.x = cvt_pk_bf16(v0[0], v0[1]); w.y = cvt_pk_bf16(v0[2], v0[3]); w.z = cvt_pk_bf16(v1[0], v1[1]); w.w = cvt_pk_bf16(v1[2], v1[3]);
                    *(u32x4*)(rowp + bj * HALF) = w; } }
    }
};
__device__ __forceinline__ int cond_of_pm(int pm) { return pm < 16 ? 0 : (pm < 32 ? 1 : 2); }
struct EpiResid {
    static constexpr bool PERM = false, AFTER_DRAIN = false;
    const float* base0; const float* base1; float* H; int ldc; const float* gate; int gstride;
    __device__ __forceinline__ void operator()(const f32x4 (&acc)[2][2][4][2], const Unit& u, int wr, int wc, int fr, int fq) const {
        const float* g = gate + (size_t)cond_of_pm(u.pm) * gstride;
        const int row0 = u.pm * BM + wr * 64 + fr; const int col0 = u.pn * BM + wc * 32 + 4 * fq;
        const float* bs = u.pm < 16 ? base0 + (size_t)row0 * ldc : base1 + (size_t)(row0 - 4096) * ldc;
        f32x4 gv[2][2];
#pragma unroll
        for (int bj = 0; bj < 2; ++bj)
#pragma unroll
            for (int n = 0; n < 2; ++n) gv[bj][n] = *(const f32x4*)(g + col0 + bj * HALF + n * 16);
#pragma unroll
        for (int ai = 0; ai < 2; ++ai)
#pragma unroll
            for (int m = 0; m < 4; ++m) { const size_t ro = (size_t)(ai * HALF + m * 16) * ldc + col0; float* rowp = H + (size_t)row0 * ldc + ro;
#pragma unroll
                for (int bj = 0; bj < 2; ++bj)
#pragma unroll
                    for (int n = 0; n < 2; ++n) { f32x4 h = *(const f32x4*)(bs + ro + bj * HALF + n * 16); h = h + gv[bj][n] * acc[ai][bj][m][n]; *(f32x4*)(rowp + bj * HALF + n * 16) = h; }
                asm volatile("" ::: "memory"); }
    }
};
__device__ __forceinline__ float silu_f(float x) { return x * __builtin_amdgcn_rcpf(1.0f + __expf(-x)); }
struct EpiSwiGLU {
    static constexpr bool PERM = true, AFTER_DRAIN = false;
    bf16_t* O; int ldc;
    __device__ __forceinline__ void operator()(const f32x4 (&acc)[2][2][4][2], const Unit& u, int wr, int wc, int fr, int fq) const {
        const int row0 = u.pm * BM + wr * 64 + fr; const int col0 = u.pn * HALF + wc * 32 + 8 * fq;
#pragma unroll
        for (int ai = 0; ai < 2; ++ai)
#pragma unroll
            for (int m = 0; m < 4; ++m) { bf16_t* rowp = O + (size_t)(row0 + ai * HALF + m * 16) * ldc + col0;
                const f32x4 g0 = acc[ai][0][m][0], g1 = acc[ai][0][m][1], u0 = acc[ai][1][m][0], u1 = acc[ai][1][m][1];
                u32x4 w;
                w.x = cvt_pk_bf16(silu_f(g0[0]) * u0[0], silu_f(g0[1]) * u0[1]); w.y = cvt_pk_bf16(silu_f(g0[2]) * u0[2], silu_f(g0[3]) * u0[3]);
                w.z = cvt_pk_bf16(silu_f(g1[0]) * u1[0], silu_f(g1[1]) * u1[1]); w.w = cvt_pk_bf16(silu_f(g1[2]) * u1[2], silu_f(g1[3]) * u1[3]);
                *(u32x4*)rowp = w; }
    }
};
template <class Epi, class Sched, bool ALIGN_EPI = false, bool SP2 = false>
__device__ __forceinline__ void gemm_phase(PG8_LAS unsigned char* lds, const Gemm g, const Sched& S, const Epi& E, int tid_in) {
    int tid_ = tid_in; asm volatile("" : "+v"(tid_));
    const int tid = tid_, wid = __builtin_amdgcn_readfirstlane(tid >> 6), lane = tid & 63, wr = wid >> 2, wc = wid & 3, fr = lane & 15, fq = lane >> 4;
    const int K = g.K, nt = g.Ksub / BK; const size_t koff = (size_t)g.Ksub * 2;
    unsigned voffA[2], voffB[2];
#pragma unroll
    for (int i = 0; i < 2; ++i) { int R, C; stage_rc(tid * 16 + i * 8192, R, C); const int Rb = Epi::PERM ? ((R & ~31) + perm32(R & 31)) : R;
        voffA[i] = (unsigned)(R * K + C) * 2u; voffB[i] = (unsigned)(Rb * K + C) * 2u; }
    const size_t kstep = (size_t)(BK * 2);
    const size_t hstep = (size_t)HALF * K * 2;
    const size_t tstep = 2 * hstep;
    const unsigned ldsw = (unsigned)wid * 1024u;
    const int aoff = lds_byte(wr * 64 + fr, fq * 8), boff = lds_byte(wc * 32 + fr, fq * 8);
#define PG8_SA(b, h) (((b) * 2 + (h)) * HTB)
#define PG8_SB(b, h) ((4 + (b) * 2 + (h)) * HTB)
#define PG8_STAGE(bufoff, gbase, voff) do { _Pragma("unroll") for (int _i = 0; _i < 2; ++_i) \
        __builtin_amdgcn_global_load_lds((const unsigned*)((const char*)(gbase) + (voff)[_i]), (PG8_LAS unsigned*)(lds + (bufoff) + ldsw + _i * 8192), 16, 0, 0); } while (0)
#define PG8_LDA(dst, b, h) do { _Pragma("unroll") for (int m = 0; m < 4; ++m) _Pragma("unroll") for (int k = 0; k < 2; ++k) dst[m][k] = *(const PG8_LAS bf16x8*)(lds + PG8_SA(b, h) + aoff + m * 2048 + k * 1024); } while (0)
#define PG8_LDB(dst, b, h) do { _Pragma("unroll") for (int n = 0; n < 2; ++n) _Pragma("unroll") for (int k = 0; k < 2; ++k) dst[n][k] = *(const PG8_LAS bf16x8*)(lds + PG8_SB(b, h) + boff + n * 2048 + k * 1024); } while (0)
#define PG8_MMA(ai, bj, At, Bt) do { __builtin_amdgcn_s_setprio(1); _Pragma("unroll") for (int m = 0; m < 4; ++m) _Pragma("unroll") for (int n = 0; n < 2; ++n) _Pragma("unroll") for (int k = 0; k < 2; ++k) \
        acc[ai][bj][m][n] = __builtin_amdgcn_mfma_f32_16x16x32_bf16(Bt[n][k], At[m][k], acc[ai][bj][m][n], 0, 0, 0); __builtin_amdgcn_s_setprio(0); } while (0)
#define PG8_WAIT_V(n) asm volatile("s_waitcnt vmcnt(" #n ")" ::: "memory")
#define PG8_WAIT_L(n) asm volatile("s_waitcnt lgkmcnt(" #n ")" ::: "memory")
#define PG8_BAR __builtin_amdgcn_s_barrier()
#define PG8_SCHED __builtin_amdgcn_sched_barrier(0)
    Unit cur, nxt; int ui = 0;
    if (!S.next(0, cur)) return;
    f32x4 acc[2][2][4][2];
#pragma unroll
    for (int a = 0; a < 2; ++a)
#pragma unroll
        for (int b = 0; b < 2; ++b)
#pragma unroll
            for (int m = 0; m < 4; ++m)
#pragma unroll
                for (int n = 0; n < 2; ++n) acc[a][b][m][n] = (f32x4){0.f, 0.f, 0.f, 0.f};
    bf16x8 At[4][2], B0[2][2], B1[2][2];
    const char* cA = (const char*)g.A + (size_t)cur.pm * tstep + cur.pk * koff; const char* cB = (const char*)g.Bt + (size_t)cur.pn * tstep + cur.pk * koff;
    S.a_ready(cur);
    if constexpr (SP2) {
        PG8_STAGE(PG8_SB(0, 0), cB, voffB); PG8_STAGE(PG8_SB(0, 1), cB + hstep, voffB); PG8_STAGE(PG8_SA(0, 0), cA, voffA); PG8_STAGE(PG8_SA(0, 1), cA + hstep, voffA);
        if (wr == 1) PG8_BAR;
        PG8_WAIT_V(2); PG8_BAR;
        PG8_STAGE(PG8_SB(1, 0), cB + kstep, voffB); PG8_STAGE(PG8_SA(1, 0), cA + kstep, voffA); PG8_STAGE(PG8_SB(1, 1), cB + hstep + kstep, voffB);
        PG8_WAIT_V(6); PG8_BAR;
    } else {
        PG8_STAGE(PG8_SB(0, 0), cB, voffB); PG8_STAGE(PG8_SA(0, 0), cA, voffA); PG8_STAGE(PG8_SB(0, 1), cB + hstep, voffB); PG8_STAGE(PG8_SA(0, 1), cA + hstep, voffA);
        if (wr == 1) PG8_BAR;
        PG8_WAIT_V(4); PG8_BAR;
        PG8_STAGE(PG8_SB(1, 0), cB + kstep, voffB); PG8_STAGE(PG8_SA(1, 0), cA + kstep, voffA); PG8_STAGE(PG8_SB(1, 1), cB + hstep + kstep, voffB);
        PG8_WAIT_V(6); PG8_BAR;
    }
    for (;;) {
        const bool has_next = S.next(ui + 1, nxt);
        const char* nA = has_next ? (const char*)g.A + (size_t)nxt.pm * tstep + nxt.pk * koff : cA; const char* nB = has_next ? (const char*)g.Bt + (size_t)nxt.pn * tstep + nxt.pk * koff : cB;
        for (int t = 0; t < nt; t += 2) {
            const bool last = (t == nt - 2);
            const char* a1 = cA + (size_t)(t + 1) * kstep;
            const char* a2 = last ? nA : cA + (size_t)(t + 2) * kstep; const char* b2 = last ? nB : cB + (size_t)(t + 2) * kstep;
            const char* a3 = a2 + kstep; const char* b3 = b2 + kstep;
            if (last && has_next) S.a_ready(nxt);
            if constexpr (SP2) {
            PG8_LDB(B0, 0, 0); PG8_LDB(B1, 0, 1); PG8_SCHED; PG8_LDA(At, 0, 0); PG8_STAGE(PG8_SA(1, 1), a1 + hstep, voffA);
            PG8_WAIT_V(8); PG8_WAIT_L(0); PG8_BAR; PG8_MMA(0, 0, At, B0); PG8_MMA(0, 1, At, B1); PG8_BAR; PG8_SCHED;
            PG8_LDA(At, 0, 1); PG8_STAGE(PG8_SB(0, 0), b2, voffB); PG8_STAGE(PG8_SB(0, 1), b2 + hstep, voffB); PG8_STAGE(PG8_SA(0, 0), a2, voffA);
            PG8_WAIT_V(8); PG8_WAIT_L(0); PG8_BAR; PG8_MMA(1, 0, At, B0); PG8_MMA(1, 1, At, B1); PG8_BAR; PG8_SCHED;
            PG8_LDB(B0, 1, 0); PG8_LDB(B1, 1, 1); PG8_SCHED; PG8_LDA(At, 1, 0); PG8_STAGE(PG8_SA(0, 1), a2 + hstep, voffA);
            PG8_WAIT_V(8); PG8_WAIT_L(0); PG8_BAR; PG8_MMA(0, 0, At, B0); PG8_MMA(0, 1, At, B1); PG8_BAR; PG8_SCHED;
            PG8_LDA(At, 1, 1); PG8_STAGE(PG8_SB(1, 0), b3, voffB); PG8_STAGE(PG8_SB(1, 1), b3 + hstep, voffB); PG8_STAGE(PG8_SA(1, 0), a3, voffA);
            PG8_WAIT_V(8); PG8_WAIT_L(0); PG8_BAR; PG8_MMA(1, 0, At, B0); PG8_MMA(1, 1, At, B1); PG8_BAR; PG8_SCHED;
            } else {
            PG8_LDB(B0, 0, 0); PG8_SCHED; PG8_LDA(At, 0, 0); PG8_STAGE(PG8_SA(1, 1), a1 + hstep, voffA);
            PG8_WAIT_L(8); PG8_BAR; PG8_WAIT_L(0); PG8_MMA(0, 0, At, B0); PG8_BAR; PG8_SCHED;
            PG8_LDB(B1, 0, 1); PG8_STAGE(PG8_SB(0, 0), b2, voffB);
            PG8_BAR; PG8_WAIT_L(0); PG8_MMA(0, 1, At, B1); PG8_BAR;
            PG8_LDA(At, 0, 1); PG8_STAGE(PG8_SA(0, 0), a2, voffA);
            PG8_BAR; PG8_WAIT_L(0); PG8_MMA(1, 0, At, B0); PG8_BAR; PG8_SCHED;
            PG8_STAGE(PG8_SB(0, 1), b2 + hstep, voffB);
            PG8_WAIT_V(6); PG8_BAR; PG8_MMA(1, 1, At, B1); PG8_BAR;
            PG8_LDB(B0, 1, 0); PG8_SCHED; PG8_LDA(At, 1, 0); PG8_STAGE(PG8_SA(0, 1), a2 + hstep, voffA);
            PG8_WAIT_L(8); PG8_BAR; PG8_WAIT_L(0); PG8_MMA(0, 0, At, B0); PG8_BAR; PG8_SCHED;
            PG8_LDB(B1, 1, 1); PG8_STAGE(PG8_SB(1, 0), b3, voffB);
            PG8_BAR; PG8_WAIT_L(0); PG8_MMA(0, 1, At, B1); PG8_BAR;
            PG8_LDA(At, 1, 1); PG8_STAGE(PG8_SA(1, 0), a3, voffA);
            PG8_BAR; PG8_WAIT_L(0); PG8_MMA(1, 0, At, B0); PG8_BAR; PG8_SCHED;
            PG8_STAGE(PG8_SB(1, 1), b3 + hstep, voffB);
            PG8_WAIT_V(6); PG8_BAR; PG8_MMA(1, 1, At, B1); PG8_BAR;
            }
        }
        if constexpr (ALIGN_EPI) { if (wr == 0) PG8_BAR; }
        if constexpr (!Epi::AFTER_DRAIN) { E(acc, cur, wr, wc, fr, fq); S.done(cur); }
        if (!has_next) break;
#pragma unroll
        for (int a = 0; a < 2; ++a)
#pragma unroll
            for (int b = 0; b < 2; ++b)
#pragma unroll
                for (int m = 0; m < 4; ++m)
#pragma unroll
                    for (int n = 0; n < 2; ++n) acc[a][b][m][n] = (f32x4){0.f, 0.f, 0.f, 0.f};
        cur = nxt; cA = nA; cB = nB; ++ui;
        if constexpr (ALIGN_EPI) { if (wr == 1) PG8_BAR; }
    }
    PG8_WAIT_V(0);
    if constexpr (!ALIGN_EPI) { if (wr == 0) PG8_BAR; }
    PG8_BAR;
    if constexpr (Epi::AFTER_DRAIN) { E.fused(acc, cur, wr, wc, fr, fq, lds, wid, lane); S.done(cur); }
#undef PG8_SA
#undef PG8_SB
#undef PG8_STAGE
#undef PG8_LDA
#undef PG8_LDB
#undef PG8_MMA
#undef PG8_WAIT_V
#undef PG8_WAIT_L
#undef PG8_BAR
#undef PG8_SCHED
}
}
#define GAS __attribute__((address_space(1)))
#define LAS __attribute__((address_space(3)))
typedef unsigned short bf16;
typedef unsigned v4u __attribute__((ext_vector_type(4)));
typedef float f32x4 __attribute__((ext_vector_type(4)));
typedef short bf16x8 __attribute__((ext_vector_type(8)));
typedef GAS unsigned gu32;
typedef GAS unsigned long long gu64;
#define RLX_AGENT __ATOMIC_RELAXED, __HIP_MEMORY_SCOPE_AGENT
#define LDS_WAIT() asm volatile("s_waitcnt lgkmcnt(0)" ::: "memory")
#define VM_WAIT() asm volatile("s_waitcnt vmcnt(0)" ::: "memory")
__device__ __forceinline__ unsigned long long rt() { return __builtin_amdgcn_s_memrealtime(); }
__device__ __forceinline__ unsigned f2bf(float f) { unsigned u = __builtin_bit_cast(unsigned, f); return (u + 0x7fffu + ((u >> 16) & 1u)) >> 16; }
__device__ __forceinline__ unsigned pk2(float lo, float hi) { return f2bf(lo) | (f2bf(hi) << 16); }

#define XB_TMO      128
#define XB_XCNT(j)  (256  + 64 * (j))
#define XB_XSUB(j)  (1280 + 64 * (j))
#define XB_XGEN(j)  (2304 + 64 * (j))
#define XB_TOP      3328
#define XB_TOPGEN   3392
#define XCD_BAR_WORDS 3456
#define XB_SPIN_CAP (1u << 18)

__device__ __forceinline__ unsigned xb_ld(unsigned* p)              { return __hip_atomic_load(p, __ATOMIC_RELAXED, __HIP_MEMORY_SCOPE_AGENT); }
__device__ __forceinline__ unsigned xb_add(unsigned* p, unsigned v) { return __hip_atomic_fetch_add(p, v, __ATOMIC_RELAXED, __HIP_MEMORY_SCOPE_AGENT); }
__device__ __forceinline__ unsigned xb_xcc_id() { return (unsigned)__builtin_amdgcn_s_getreg((3 << 11) | 20) & 0xFu; }
#define XB_SPIN(cond, bar) do { unsigned _sp = 0; while (cond) { __builtin_amdgcn_s_sleep(1); \
    if ((++_sp & 255u) == 0u) { if (xb_ld(&(bar)[XB_TMO])) break; if (_sp > XB_SPIN_CAP) { atomicAdd(&(bar)[XB_TMO], 1u); break; } } } } while (0)

struct XcdBarrier {
    unsigned* bar; unsigned x;
    volatile LAS unsigned* st;
};

__device__ __forceinline__ XcdBarrier xcd_barrier_post(unsigned* bar, volatile LAS unsigned* st, bool leader) {
    XcdBarrier b; b.bar = bar; b.x = xb_xcc_id(); b.st = st;
    if (leader) (void)xb_add(&bar[XB_XCNT(b.x)], 1u);
    return b;
}
__device__ __forceinline__ void xcd_barrier_complete(unsigned* bar, unsigned x, unsigned& nloc, unsigned& nx) {
    const unsigned G = gridDim.x * gridDim.y * gridDim.z;
    unsigned sum, cnt, mine, sp = 0u;
    for (;;) {
        sum = 0u; cnt = 0u; mine = 0u;
#pragma unroll
        for (unsigned j = 0; j < 16; ++j) { const unsigned c = xb_ld(&bar[XB_XCNT(j)]); sum += c; cnt += (c > 0u) ? 1u : 0u; mine = (j == x) ? c : mine; }
        if (sum == G) break;
        __builtin_amdgcn_s_sleep(1);
        if ((++sp & 255u) == 0u) { if (xb_ld(&bar[XB_TMO])) break; if (sp > XB_SPIN_CAP) { atomicAdd(&bar[XB_TMO], 1u); break; } }
    }
    nloc = mine > 0u ? mine : 1u; nx = cnt > 0u ? cnt : 1u;
}

__device__ __forceinline__ void xcd_barrier(const XcdBarrier& b, bool leader) {
    asm volatile("s_waitcnt vmcnt(0)" ::: "memory");
    __syncthreads();
    if (leader) {
        unsigned* bar = b.bar;
        __builtin_amdgcn_s_waitcnt(0);
        unsigned nloc = b.st[0], nx = b.st[1];
        if (nloc == 0u) { xcd_barrier_complete(bar, b.x, nloc, nx); b.st[0] = nloc; b.st[1] = nx; }
        const unsigned old = xb_add(&bar[XB_XSUB(b.x)], 1u);
        const unsigned gen = old / nloc;
        if (old + 1u == (gen + 1u) * nloc) {
            __builtin_amdgcn_fence(__ATOMIC_RELEASE, "agent");
            asm volatile("s_waitcnt vmcnt(0)" ::: "memory");
            const unsigned og = xb_add(&bar[XB_TOP], 1u);
            const unsigned tg = og / nx;
            if (og + 1u == (tg + 1u) * nx) xb_add(&bar[XB_TOPGEN], 1u);
            else XB_SPIN(xb_ld(&bar[XB_TOPGEN]) == tg, bar);
            __builtin_amdgcn_fence(__ATOMIC_ACQUIRE, "agent");
            xb_add(&bar[XB_XGEN(b.x)], 1u);
            asm volatile("s_waitcnt vmcnt(0)" ::: "memory");
        } else {
            XB_SPIN(xb_ld(&bar[XB_XGEN(b.x)]) == gen, bar);
            __builtin_amdgcn_fence(__ATOMIC_ACQUIRE, "agent");
            asm volatile("s_waitcnt vmcnt(0)" ::: "memory");
        }
    }
    __syncthreads();
}

constexpr int NWAVES = 8, NTHR = 512;
constexpr int DM = 2048, MROWS = 12288, DEPTH = 4;
constexpr int INC = 5152, INP = 5376, FF = 5632, GU = 11264;
constexpr int NMOD = 6 * DM;
constexpr float EPS = 1e-6f;
constexpr int PC_QA = 0, PC_KA = 512, PC_VA = 768, PC_QD = 1024, PC_KD = 1536, PC_VD = 2048, PC_Z = 2560, PC_XBC = 3584, PC_DT = 5120;
constexpr int RC_QA = 0, RC_KA = 512, RC_QD = 768, RC_KD = 1280, RCW = 1792;
constexpr size_t OUT_AK = 25165824, OUT_AV = OUT_AK + 4194304, OUT_DK = OUT_AV + 4194304, OUT_DV = OUT_DK + 8388608, OUT_SF = OUT_DV + 8388608, OUT_SB = OUT_SF + 8388608;
constexpr size_t MiB = 1u << 20;
constexpr size_t WS_CTL = 0, CTL_ZERO_BYTES = 1 * MiB;
constexpr size_t WS_TAB = 1 * MiB, WS_MOD = 2 * MiB, WS_MODP = 3 * MiB;
constexpr size_t WS_WIN = 8 * MiB, WS_WOUT = 92 * MiB, WS_WGU = 124 * MiB, WS_WDN = 300 * MiB;
constexpr size_t WS_H = 388 * MiB, WS_U = 484 * MiB, WS_P = 532 * MiB, WS_MIX = 658 * MiB, WS_ACT = 706 * MiB, WS_QKR = 838 * MiB;
constexpr size_t WS_XBC = 866 * MiB, WS_DT = 938 * MiB, WS_YF = 940 * MiB, WS_YB = 988 * MiB, WS_ST = 1036 * MiB, WS_EDEC = 1132 * MiB, WS_CDEC = 1134 * MiB, WS_SSQ = 1135 * MiB, WS_END = 1136 * MiB;
constexpr int CW_BAR = 4096;
constexpr int RING_BYTES = 131072, LDSCTL_OFF = RING_BYTES, MISC_OFF = LDSCTL_OFF + 320, LDS_BYTES = 147456;

struct Params { const float* in[28]; float* out; unsigned char* ws; int ph_lo, ph_hi; };
typedef __attribute__((address_space(4))) const Params* PP;
struct Frame { LAS unsigned char* lds; int tid, lane, wave, vcu, G; };

template <int M> __device__ __forceinline__ float xor_lt32(float v) { return __builtin_bit_cast(float, __builtin_amdgcn_ds_swizzle(__builtin_bit_cast(int, v), 0x1F | (M << 10))); }
__device__ __forceinline__ float half_sum(float v) { const unsigned u = __builtin_bit_cast(unsigned, v); auto r = __builtin_amdgcn_permlane32_swap(u, u, false, false); return __builtin_bit_cast(float, (unsigned)r[0]) + __builtin_bit_cast(float, (unsigned)r[1]); }
__device__ __forceinline__ float half_max(float v) { const unsigned u = __builtin_bit_cast(unsigned, v); auto r = __builtin_amdgcn_permlane32_swap(u, u, false, false); return fmaxf(__builtin_bit_cast(float, (unsigned)r[0]), __builtin_bit_cast(float, (unsigned)r[1])); }
__device__ __forceinline__ float bperm(float v, int srclane) { return __builtin_bit_cast(float, __builtin_amdgcn_ds_bpermute(srclane << 2, __builtin_bit_cast(int, v))); }
__device__ __forceinline__ float wave_sum(float v) { v += xor_lt32<1>(v); v += xor_lt32<2>(v); v += xor_lt32<4>(v); v += xor_lt32<8>(v); v += xor_lt32<16>(v); return half_sum(v); }
__device__ __forceinline__ float wave_max(float v) { v = fmaxf(v, xor_lt32<1>(v)); v = fmaxf(v, xor_lt32<2>(v)); v = fmaxf(v, xor_lt32<4>(v)); v = fmaxf(v, xor_lt32<8>(v)); v = fmaxf(v, xor_lt32<16>(v)); return half_max(v); }
__device__ __forceinline__ float bflo(unsigned w) { return __uint_as_float(w << 16); }
__device__ __forceinline__ float bfhi(unsigned w) { return __uint_as_float(w & 0xffff0000u); }
__device__ __forceinline__ float bf1(bf16 b) { return __uint_as_float((unsigned)b << 16); }
__device__ __forceinline__ float silu(float x) { return x / (1.0f + __expf(-x)); }

__device__ __forceinline__ void p0_transpose_item(const float* W, int K, int N, bf16* WT, int rowmap, LAS float* scr, int item, int lane) {
    const int nblk = N / 32, kb = item / nblk, nb = item % nblk, k0 = 64 * kb, n0 = 32 * nb;
    { float t[32]; const float* src = W + (size_t)(k0 + (lane >> 5)) * N + n0 + (lane & 31);
#pragma unroll
      for (int i = 0; i < 32; ++i) t[i] = src[(size_t)(2 * i) * N];
#pragma unroll
      for (int i = 0; i < 32; ++i) scr[(2 * i + (lane >> 5)) * 33 + (lane & 31)] = t[i]; }
    LDS_WAIT(); asm volatile("" ::: "memory");
    int r0 = n0;
    if (rowmap) r0 = (n0 < FF) ? ((n0 >> 7) * 256 + (n0 & 127)) : (((n0 - FF) >> 7) * 256 + 128 + ((n0 - FF) & 127));
    const int c = lane & 7;
#pragma unroll
    for (int j = 0; j < 4; ++j) { const int n = (lane >> 3) + 8 * j; const LAS float* s = scr + (8 * c) * 33 + n;
        v4u o; o.x = pk2(s[0 * 33], s[1 * 33]); o.y = pk2(s[2 * 33], s[3 * 33]); o.z = pk2(s[4 * 33], s[5 * 33]); o.w = pk2(s[6 * 33], s[7 * 33]);
        *(v4u*)(WT + (size_t)(r0 + n) * K + k0 + 8 * c) = o; }
    LDS_WAIT(); asm volatile("" ::: "memory");
}
__device__ __forceinline__ void conv_layer(Frame& F, PP p, int l, int wi, int nw) {
    unsigned char* ws = p->ws;
    LAS float* scr = (LAS float*)(F.lds + F.wave * 16384);
    constexpr int I_IN = 32 * (INC / 32), I_OUT = 32 * 64, I_GU = 32 * (GU / 32), I_DN = (FF / 64) * 64, I_L = I_IN + I_OUT + I_GU + I_DN;
    for (int it = wi; it < I_L; it += nw) {
        int r = it;
        if (r < I_IN) { p0_transpose_item(p->in[14] + (size_t)l * DM * INC, DM, INC, (bf16*)(ws + WS_WIN) + (size_t)l * INP * DM, 0, scr, r, F.lane); continue; } r -= I_IN;
        if (r < I_OUT) { p0_transpose_item(p->in[24] + (size_t)l * DM * DM, DM, DM, (bf16*)(ws + WS_WOUT) + (size_t)l * DM * DM, 0, scr, r, F.lane); continue; } r -= I_OUT;
        if (r < I_GU) { p0_transpose_item(p->in[25] + (size_t)l * DM * GU, DM, GU, (bf16*)(ws + WS_WGU) + (size_t)l * GU * DM, 1, scr, r, F.lane); continue; } r -= I_GU;
        p0_transpose_item(p->in[26] + (size_t)l * FF * DM, FF, DM, (bf16*)(ws + WS_WDN) + (size_t)l * DM * FF, 0, scr, r, F.lane);
    }
    constexpr int PADV = (INP - INC) * DM * 2 / 16;
    for (int i = wi * 64 + F.lane; i < PADV; i += nw * 64) *((v4u*)((bf16*)(ws + WS_WIN) + (size_t)l * INP * DM + (size_t)INC * DM) + i) = (v4u){0u, 0u, 0u, 0u};
}
__device__ __forceinline__ void adaln_layer(Frame& F, PP p, int l, int bi, int nb) {
    LAS float* sc = (LAS float*)F.lds;
    float* MODP = (float*)(p->ws + WS_MODP);
    for (int it = bi; it < 8 * 24; it += nb) {
        const int kc = it / 24, nc = it % 24;
        __syncthreads();
        if (F.tid < 256) { const int k = kc * 256 + F.tid; sc[F.tid] = silu(p->in[9][k]); sc[256 + F.tid] = silu(p->in[8][k]); sc[512 + F.tid] = silu(p->in[8][DM + k]); }
        __syncthreads();
        const int n = nc * 512 + F.tid;
        const float* w = p->in[10] + ((size_t)l * DM + (size_t)kc * 256) * NMOD + n;
        float a0 = 0.f, a1 = 0.f, a2 = 0.f;
        for (int k = 0; k < 256; k += 32) {
            float wv[32];
#pragma unroll
            for (int e = 0; e < 32; ++e) wv[e] = w[(size_t)(k + e) * NMOD];
#pragma unroll
            for (int e = 0; e < 32; ++e) { a0 += sc[k + e] * wv[e]; a1 += sc[256 + k + e] * wv[e]; a2 += sc[512 + k + e] * wv[e]; }
        }
        float* o = MODP + ((size_t)(kc * DEPTH + l) * 3) * NMOD + n;
        o[0] = a0; o[NMOD] = a1; o[2 * NMOD] = a2;
    }
    __syncthreads();
}
__device__ __forceinline__ void mod_layer(PP p, int l, int gt, int ngt) {
    const float* MODP = (const float*)(p->ws + WS_MODP); float* MOD = (float*)(p->ws + WS_MOD);
    for (int i = gt; i < 3 * NMOD; i += ngt) {
        const int n = i % NMOD; const int gi = l * 3 * NMOD + i;
        float s = p->in[11][l * NMOD + n];
#pragma unroll
        for (int kc = 0; kc < 8; ++kc) s += MODP[(size_t)kc * DEPTH * 3 * NMOD + gi];
        MOD[gi] = s;
    }
}
__device__ __forceinline__ void p0_prologue(Frame& F, PP p) {
    unsigned char* ws = p->ws;
    conv_layer(F, p, 0, F.vcu * NWAVES + F.wave, F.G * NWAVES);
    adaln_layer(F, p, 0, blockIdx.x, F.G);
    if (blockIdx.x == F.G - 1) {
        float2* tabA = (float2*)(ws + WS_TAB); float2* tabB = (float2*)(ws + WS_TAB + 16384); float* lam = (float*)(ws + WS_TAB + 32768);
        for (int i = F.tid; i < 2048 + 1024; i += NTHR) {
            const bool isA = i < 2048; const int j = isA ? i : i - 2048; const int pos = isA ? (j >> 5) : (j >> 4), k = isA ? (j & 31) : (j & 15);
            double r = 10000.0; r = sqrt(r); r = sqrt(r); r = sqrt(r); r = sqrt(r); if (isA) r = sqrt(r);
            const double ri = 1.0 / r; double inv = 1.0; for (int q = 0; q < k; ++q) inv *= ri;
            const double ang = (double)pos * inv; const double TWO_PI = 6.283185307179586476925;
            const double x = ang - TWO_PI * rint(ang / TWO_PI), x2 = x * x;
            double st = x, ss = x, ct = 1.0, cs = 1.0;
            for (int q = 1; q <= 16; ++q) { st *= -x2 / (double)((2 * q) * (2 * q + 1)); ss += st; ct *= -x2 / (double)((2 * q - 1) * (2 * q)); cs += ct; }
            const float2 v = make_float2((float)cs, (float)ss);
            if (isA) tabA[j] = v; else tabB[j] = v;
        }
        if (F.tid < DEPTH) {
            const float* lv = p->in[16] + F.tid * 256; float s01 = 0.f, s23 = 0.f;
            for (int i = 0; i < 64; ++i) { s01 += lv[i] * lv[64 + i]; s23 += lv[128 + i] * lv[192 + i]; }
            const float li = 0.8f - 0.6f * expf(-0.3f * (float)F.tid);
            lam[F.tid] = expf(s01) - expf(s23) + li; lam[4 + F.tid] = li;
        }
    }
}
__device__ __forceinline__ void norm_phase(Frame& F, const float* H0, const float* H1, const float* g, const float* modl, int shoff, int scoff, bf16* U) {
    const int gw = F.vcu * NWAVES + F.wave, NGW = F.G * NWAVES;
    for (int m = gw; m < MROWS; m += NGW) {
        const int c = m < 4096 ? 0 : (m < 8192 ? 1 : 2);
        const float* sh = modl + c * NMOD + shoff; const float* sc = modl + c * NMOD + scoff;
        const f32x4* xr = (const f32x4*)(m < 4096 ? H0 + (size_t)m * DM : H1 + (size_t)(m - 4096) * DM) + F.lane;
        f32x4 v[8]; float ss = 0.f;
#pragma unroll
        for (int j = 0; j < 8; ++j) { v[j] = xr[64 * j]; ss += (v[j].x * v[j].x + v[j].y * v[j].y) + (v[j].z * v[j].z + v[j].w * v[j].w); }
        const float rstd = 1.0f / sqrtf(wave_sum(ss) * (1.0f / DM) + EPS);
        unsigned long long* o8 = (unsigned long long*)(U + (size_t)m * DM) + F.lane;
#pragma unroll
        for (int j = 0; j < 8; ++j) { const int col = 4 * F.lane + 256 * j;
            const f32x4 gv = *(const f32x4*)(g + col), sv = *(const f32x4*)(sc + col), hv = *(const f32x4*)(sh + col);
            const f32x4 o = (v[j] * rstd) * gv * (sv + 1.0f) + hv;
            o8[64 * j] = (unsigned long long)pk2(o.x, o.y) | ((unsigned long long)pk2(o.z, o.w) << 32); }
    }
}
__device__ __forceinline__ void final_phase(Frame& F, const float* H, const float* g, float* out) {
    const int gw = F.vcu * NWAVES + F.wave, NGW = F.G * NWAVES;
    for (int m = gw; m < MROWS; m += NGW) {
        const f32x4* xr = (const f32x4*)(H + (size_t)m * DM) + F.lane;
        f32x4 v[8]; float ss = 0.f;
#pragma unroll
        for (int j = 0; j < 8; ++j) { v[j] = xr[64 * j]; ss += (v[j].x * v[j].x + v[j].y * v[j].y) + (v[j].z * v[j].z + v[j].w * v[j].w); }
        const float rstd = 1.0f / sqrtf(wave_sum(ss) * (1.0f / DM) + EPS);
        f32x4* o = (f32x4*)(out + (size_t)m * DM) + F.lane;
#pragma unroll
        for (int j = 0; j < 8; ++j) { const f32x4 gv = *(const f32x4*)(g + 4 * F.lane + 256 * j); o[64 * j] = (v[j] * rstd) * gv; }
    }
}
__device__ __forceinline__ void rope8(v4u x1, v4u x2, const float2* tab, v4u* o1, v4u* o2) {
    const f32x4 t0 = *(const f32x4*)tab, t1 = *((const f32x4*)tab + 1), t2 = *((const f32x4*)tab + 2), t3 = *((const f32x4*)tab + 3);
    v4u a, b;
#define ROPE2(W, T) { const float xa = bflo(x1.W), xb = bfhi(x1.W), ya = bflo(x2.W), yb = bfhi(x2.W); a.W = pk2(xa * T.x - ya * T.y, xb * T.z - yb * T.w); b.W = pk2(xa * T.y + ya * T.x, xb * T.w + yb * T.z); }
    ROPE2(x, t0) ROPE2(y, t1) ROPE2(z, t2) ROPE2(w, t3)
#undef ROPE2
    *o1 = a; *o2 = b;
}
__device__ __forceinline__ void prep_phase(Frame& F, PP p, int l) {
    unsigned char* ws = p->ws;
    const bf16* P = (const bf16*)(ws + WS_P); bf16* QKR = (bf16*)(ws + WS_QKR); bf16* XBC = (bf16*)(ws + WS_XBC); float* DT = (float*)(ws + WS_DT);
    const float2* tabA = (const float2*)(ws + WS_TAB); const float2* tabB = (const float2*)(ws + WS_TAB + 16384);
    const float* cw = p->in[18] + (size_t)l * 5 * 1536; const float* cb = p->in[19] + (size_t)l * 1536; const float* dtb = p->in[20] + l * 32;
    const int gw = F.vcu * NWAVES + F.wave, NGW = F.G * NWAVES, lane = F.lane;
    for (int m = gw; m < MROWS; m += NGW) {
        const bf16* prow = P + (size_t)m * INP;
        const int s0 = m < 4096 ? (m & ~255) : (4096 + ((m - 4096) & ~4095)); const int len = m < 4096 ? 256 : 4096; const int t = m - s0;
#pragma unroll
        for (int j = 0; j < 3; ++j) { const int c0 = 8 * lane + 512 * j;
            f32x4 a0 = *(const f32x4*)(cb + c0), a1 = *(const f32x4*)(cb + c0 + 4);
#pragma unroll
            for (int k = 0; k < 5; ++k) { const int tt = t + k - 2;
                if (tt >= 0 && tt < len) { const v4u raw = *(const v4u*)(P + (size_t)(s0 + tt) * INP + PC_XBC + c0);
                    const f32x4 w0 = *(const f32x4*)(cw + k * 1536 + c0), w1 = *(const f32x4*)(cw + k * 1536 + c0 + 4);
                    a0.x += w0.x * bflo(raw.x); a0.y += w0.y * bfhi(raw.x); a0.z += w0.z * bflo(raw.y); a0.w += w0.w * bfhi(raw.y);
                    a1.x += w1.x * bflo(raw.z); a1.y += w1.y * bfhi(raw.z); a1.z += w1.z * bflo(raw.w); a1.w += w1.w * bfhi(raw.w); } }
            a0.x = silu(a0.x); a0.y = silu(a0.y); a0.z = silu(a0.z); a0.w = silu(a0.w); a1.x = silu(a1.x); a1.y = silu(a1.y); a1.z = silu(a1.z); a1.w = silu(a1.w);
            *(v4u*)(XBC + (size_t)m * 1536 + c0) = (v4u){pk2(a0.x, a0.y), pk2(a0.z, a0.w), pk2(a1.x, a1.y), pk2(a1.z, a1.w)}; }
        if (lane < 32) { const float v = bf1(prow[PC_DT + lane]) + dtb[lane]; DT[(size_t)m * 32 + lane] = v > 20.f ? v : log1pf(__expf(v)); }
        if (m >= 4096) {
            const int gr = t >> 6, gc = t & 63; bf16* qrow = QKR + (size_t)(m - 4096) * RCW;
            if (lane < 48) {
                const int i = lane >> 3, d0 = (lane & 7) * 8; const int src = (i < 4 ? PC_QA + i * 128 : PC_KA + (i - 4) * 128) + d0, dst = (i < 4 ? RC_QA + i * 128 : RC_KA + (i - 4) * 128) + d0;
                rope8(*(const v4u*)(prow + src), *(const v4u*)(prow + src + 64), d0 < 32 ? tabA + gr * 32 + d0 : tabA + gc * 32 + d0 - 32, (v4u*)(qrow + dst), (v4u*)(qrow + dst + 64));
            }
            {
                const int ch = lane >> 2, d0 = (lane & 3) * 8; const int src = (ch < 8 ? PC_QD + ch * 64 : PC_KD + (ch - 8) * 64) + d0, dst = (ch < 8 ? RC_QD + ch * 64 : RC_KD + (ch - 8) * 64) + d0;
                rope8(*(const v4u*)(prow + src), *(const v4u*)(prow + src + 32), d0 < 16 ? tabB + gr * 16 + d0 : tabB + gc * 16 + d0 - 16, (v4u*)(qrow + dst), (v4u*)(qrow + dst + 32));
            }
        } else {
            const int b = m >> 8, s = m & 255; const size_t r = (size_t)((b * DEPTH + l) * 256 + s);
            { const unsigned long long w = *((const unsigned long long*)(prow + PC_KA) + lane); *((f32x4*)(p->out + OUT_AK + r * 256) + lane) = (f32x4){bflo((unsigned)w), bfhi((unsigned)w), bflo((unsigned)(w >> 32)), bfhi((unsigned)(w >> 32))}; }
            { const unsigned long long w = *((const unsigned long long*)(prow + PC_VA) + lane); *((f32x4*)(p->out + OUT_AV + r * 256) + lane) = (f32x4){bflo((unsigned)w), bfhi((unsigned)w), bflo((unsigned)(w >> 32)), bfhi((unsigned)(w >> 32))}; }
            { const v4u w = *((const v4u*)(prow + PC_KD) + lane); f32x4* o = (f32x4*)(p->out + OUT_DK + r * 512) + 2 * lane; o[0] = (f32x4){bflo(w.x), bfhi(w.x), bflo(w.y), bfhi(w.y)}; o[1] = (f32x4){bflo(w.z), bfhi(w.z), bflo(w.w), bfhi(w.w)}; }
            { const v4u w = *((const v4u*)(prow + PC_VD) + lane); f32x4* o = (f32x4*)(p->out + OUT_DV + r * 512) + 2 * lane; o[0] = (f32x4){bflo(w.x), bfhi(w.x), bflo(w.y), bfhi(w.y)}; o[1] = (f32x4){bflo(w.z), bfhi(w.z), bflo(w.w), bfhi(w.w)}; }
        }
    }
}
typedef float f32x16 __attribute__((ext_vector_type(16)));
typedef short s16x4 __attribute__((ext_vector_type(4)));
constexpr int FA_KSTR = 272, FA_VSTR = 320, FA_KB = 64 * FA_KSTR, FA_VB = 64 * FA_VSTR, FA_BUF = FA_KB + FA_VB;
constexpr int FA_OSTR = 272;
struct Seg { const void* k; const void* v; int ks, vs, n, f32, pos0; };
struct FaTile { v4u k[2], v[2]; };

__device__ __forceinline__ unsigned cvtpk(float lo, float hi) { typedef float f2 __attribute__((ext_vector_type(2))); typedef __bf16 b2 __attribute__((ext_vector_type(2))); f2 v = {lo, hi}; b2 b = __builtin_convertvector(v, b2); return __builtin_bit_cast(unsigned, b); }
__device__ __forceinline__ void fa_load(FaTile& t, const Seg& sg, int key0, int tid) {
#pragma unroll
    for (int i = 0; i < 2; ++i) { const int c = tid + 512 * i, key = c >> 4, ch = c & 15;
        if (sg.f32) {
            const f32x4* ks = (const f32x4*)((const float*)sg.k + (size_t)(key0 + key) * sg.ks + ch * 8);
            const f32x4* vs = (const f32x4*)((const float*)sg.v + (size_t)(key0 + key) * sg.vs + ch * 8);
            const f32x4 a = ks[0], b = ks[1], c2 = vs[0], d = vs[1];
            t.k[i] = (v4u){cvtpk(a.x, a.y), cvtpk(a.z, a.w), cvtpk(b.x, b.y), cvtpk(b.z, b.w)};
            t.v[i] = (v4u){cvtpk(c2.x, c2.y), cvtpk(c2.z, c2.w), cvtpk(d.x, d.y), cvtpk(d.z, d.w)};
        } else {
            t.k[i] = *(const v4u*)((const bf16*)sg.k + (size_t)(key0 + key) * sg.ks + ch * 8);
            t.v[i] = *(const v4u*)((const bf16*)sg.v + (size_t)(key0 + key) * sg.vs + ch * 8);
        } }
}
__device__ __forceinline__ void fa_store(const FaTile& t, LAS unsigned char* buf, int tid) {
#pragma unroll
    for (int i = 0; i < 2; ++i) { const int c = tid + 512 * i, key = c >> 4, ch = c & 15;
        *(LAS v4u*)(buf + key * FA_KSTR + ch * 16) = t.k[i];
        *(LAS v4u*)(buf + FA_KB + key * FA_VSTR + ch * 16) = t.v[i]; }
}
template <int NKS>
__device__ __forceinline__ void fa_s(const LAS unsigned char* buf, const bf16x8 (&q)[NKS], f32x16& p0, f32x16& p1, int kcolb, int lane) {
    const int r32 = lane & 31, h = lane >> 5;
#pragma unroll
    for (int r = 0; r < 16; ++r) { p0[r] = 0.f; p1[r] = 0.f; }
    const LAS unsigned char* kp = buf + r32 * FA_KSTR + kcolb + h * 16;
#pragma unroll
    for (int ks = 0; ks < NKS; ++ks) {
        const bf16x8 a0 = *(const LAS bf16x8*)(kp + ks * 32), a1 = *(const LAS bf16x8*)(kp + 32 * FA_KSTR + ks * 32);
        p0 = __builtin_amdgcn_mfma_f32_32x32x16_bf16(a0, q[ks], p0, 0, 0, 0);
        p1 = __builtin_amdgcn_mfma_f32_32x32x16_bf16(a1, q[ks], p1, 0, 0, 0);
    }
}
typedef float f32x2 __attribute__((ext_vector_type(2)));
__device__ __forceinline__ float max3f(float a, float b, float c) { float r; asm("v_max3_f32 %0, %1, %2, %3" : "=v"(r) : "v"(a), "v"(b), "v"(c)); return r; }
#define FA_TR(dst, vb, off) asm volatile("ds_read_b64_tr_b16 %0, %1 offset:%c2" : "=&v"(dst) : "v"(vb), "i"(off) : "memory")
template <bool DB>
__device__ __forceinline__ void fa_smpv(const LAS unsigned char* buf, f32x16& p0, f32x16& p1, f32x16 (&o)[4], float& m, float& lsum, float c, int lane, bool masked, int dpos  ) {
    const int h = lane >> 5;
    if (masked) {
#pragma unroll
        for (int r = 0; r < 16; ++r) { const int d0 = dpos - ((r & 3) + 8 * (r >> 2) + 4 * h), d1 = d0 - 32;
            if (d0 > 128 || d0 < -128) p0[r] = -INFINITY; if (d1 > 128 || d1 < -128) p1[r] = -INFINITY; }
    }
    float ma = max3f(p0[0], p0[1], p0[2]), mb = max3f(p1[0], p1[1], p1[2]);
#pragma unroll
    for (int r = 3; r < 15; r += 2) { ma = max3f(ma, p0[r], p0[r + 1]); mb = max3f(mb, p1[r], p1[r + 1]); }
    float mt = half_max(max3f(ma, mb, fmaxf(p0[15], p1[15])));
    const float mn = fmaxf(m, mt * c);
    const float alpha = __builtin_amdgcn_exp2f(m - mn);
    m = mn;
    const f32x2 c2 = {c, c}, mn2 = {mn, mn}; f32x2 rs2 = {0.f, 0.f};
#pragma unroll
    for (int r = 0; r < 16; r += 2) {
        f32x2 u = (f32x2){p0[r], p0[r + 1]} * c2 - mn2, v = (f32x2){p1[r], p1[r + 1]} * c2 - mn2;
        u.x = __builtin_amdgcn_exp2f(u.x); u.y = __builtin_amdgcn_exp2f(u.y); v.x = __builtin_amdgcn_exp2f(v.x); v.y = __builtin_amdgcn_exp2f(v.y);
        p0[r] = u.x; p0[r + 1] = u.y; p1[r] = v.x; p1[r + 1] = v.y; rs2 += u + v;
    }
    lsum = lsum * alpha + (rs2.x + rs2.y);
    if (__builtin_amdgcn_ballot_w64(alpha != 1.0f) != 0ull) {
#pragma unroll
        for (int b = 0; b < 4; ++b) o[b] = o[b] * alpha;
    }
    bf16x8 pb[4];
    { v4u w;
      w = (v4u){cvtpk(p0[0], p0[1]), cvtpk(p0[2], p0[3]), cvtpk(p0[4], p0[5]), cvtpk(p0[6], p0[7])}; pb[0] = __builtin_bit_cast(bf16x8, w);
      w = (v4u){cvtpk(p0[8], p0[9]), cvtpk(p0[10], p0[11]), cvtpk(p0[12], p0[13]), cvtpk(p0[14], p0[15])}; pb[1] = __builtin_bit_cast(bf16x8, w);
      w = (v4u){cvtpk(p1[0], p1[1]), cvtpk(p1[2], p1[3]), cvtpk(p1[4], p1[5]), cvtpk(p1[6], p1[7])}; pb[2] = __builtin_bit_cast(bf16x8, w);
      w = (v4u){cvtpk(p1[8], p1[9]), cvtpk(p1[10], p1[11]), cvtpk(p1[12], p1[13]), cvtpk(p1[14], p1[15])}; pb[3] = __builtin_bit_cast(bf16x8, w); }
    const int i16 = lane & 15, gc = (lane >> 4) & 1;
    const unsigned vb = (unsigned)(unsigned long long)(buf + FA_KB + (4 * h + (i16 >> 2)) * FA_VSTR + (16 * gc + 4 * (i16 & 3)) * 2);
    s16x4 lo[DB ? 2 : 1][4], hi[DB ? 2 : 1][4];
#define FA_RD(S, SET) do { FA_TR(lo[SET][0], vb, (16 * (S)) * FA_VSTR); FA_TR(hi[SET][0], vb, (16 * (S) + 8) * FA_VSTR); FA_TR(lo[SET][1], vb, (16 * (S)) * FA_VSTR + 64); FA_TR(hi[SET][1], vb, (16 * (S) + 8) * FA_VSTR + 64); \
                           FA_TR(lo[SET][2], vb, (16 * (S)) * FA_VSTR + 128); FA_TR(hi[SET][2], vb, (16 * (S) + 8) * FA_VSTR + 128); FA_TR(lo[SET][3], vb, (16 * (S)) * FA_VSTR + 192); FA_TR(hi[SET][3], vb, (16 * (S) + 8) * FA_VSTR + 192); } while (0)
#define FA_MM(S, SET) do { _Pragma("unroll") for (int b = 0; b < 4; ++b) { const bf16x8 a = (bf16x8){lo[SET][b][0], lo[SET][b][1], lo[SET][b][2], lo[SET][b][3], hi[SET][b][0], hi[SET][b][1], hi[SET][b][2], hi[SET][b][3]}; \
                           o[b] = __builtin_amdgcn_mfma_f32_32x32x16_bf16(a, pb[S], o[b], 0, 0, 0); } } while (0)
    asm volatile("s_waitcnt lgkmcnt(0)" ::: "memory"); __builtin_amdgcn_sched_barrier(0);
    if (DB) {
        FA_RD(0, 0);
        FA_RD(1, 1); asm volatile("s_waitcnt lgkmcnt(8)" ::: "memory"); __builtin_amdgcn_sched_barrier(0); FA_MM(0, 0); __builtin_amdgcn_sched_barrier(0);
        FA_RD(2, 0); asm volatile("s_waitcnt lgkmcnt(8)" ::: "memory"); __builtin_amdgcn_sched_barrier(0); FA_MM(1, 1); __builtin_amdgcn_sched_barrier(0);
        FA_RD(3, 1); asm volatile("s_waitcnt lgkmcnt(8)" ::: "memory"); __builtin_amdgcn_sched_barrier(0); FA_MM(2, 0); __builtin_amdgcn_sched_barrier(0);
        asm volatile("s_waitcnt lgkmcnt(0)" ::: "memory"); __builtin_amdgcn_sched_barrier(0); FA_MM(3, 1);
    } else {
        FA_RD(0, 0); asm volatile("s_waitcnt lgkmcnt(0)" ::: "memory"); __builtin_amdgcn_sched_barrier(0); FA_MM(0, 0); __builtin_amdgcn_sched_barrier(0);
        FA_RD(1, 0); asm volatile("s_waitcnt lgkmcnt(0)" ::: "memory"); __builtin_amdgcn_sched_barrier(0); FA_MM(1, 0); __builtin_amdgcn_sched_barrier(0);
        FA_RD(2, 0); asm volatile("s_waitcnt lgkmcnt(0)" ::: "memory"); __builtin_amdgcn_sched_barrier(0); FA_MM(2, 0); __builtin_amdgcn_sched_barrier(0);
        FA_RD(3, 0); asm volatile("s_waitcnt lgkmcnt(0)" ::: "memory"); __builtin_amdgcn_sched_barrier(0); FA_MM(3, 0);
    }
#undef FA_RD
#undef FA_MM
}
template <int NKS>
__device__ __forceinline__ void fa_tile(const LAS unsigned char* buf, const bf16x8 (&q)[NKS], f32x16 (&o)[4], float& m, float& lsum, float c, int kcolb, int lane, bool masked, int dpos) {
    f32x16 p0, p1; fa_s<NKS>(buf, q, p0, p1, kcolb, lane); fa_smpv<false>(buf, p0, p1, o, m, lsum, c, lane, masked, dpos);
}
template <int MODE>
__device__ __forceinline__ void fa_unit(Frame& F, const bf16* qg, int qstride, const Seg& s0, const Seg& s1, bool two, int qpos0, float c, const float* sinkp, float lam, float onems, const float* dnorm, bf16* dst, int dstride) {
    constexpr int NKS = MODE == 0 ? 8 : 4;
    int tid_ = F.tid; asm volatile("" : "+v"(tid_));
    const int tid = tid_, lane = tid & 63, w = F.wave, r32 = lane & 31, h = lane >> 5, grp = w >> 2, qrow0 = (w & 3) * 32;
    const int kcolb = MODE == 0 ? 0 : grp * 128;
    qg += (MODE == 0 ? grp * 128 : grp * 64); if (MODE == 0) dst += grp * 128;
    bf16x8 q[NKS];
#pragma unroll
    for (int ks = 0; ks < NKS; ++ks) q[ks] = *(const bf16x8*)(qg + (size_t)(qrow0 + r32) * qstride + ks * 16 + h * 8);
    f32x16 o[4];
#pragma unroll
    for (int b = 0; b < 4; ++b)
#pragma unroll
        for (int r = 0; r < 16; ++r) o[b][r] = 0.f;
    float m = -INFINITY, lsum = 0.f;
    const int nt0 = s0.n >> 6, nt = nt0 + (two ? (s1.n >> 6) : 0);
    FaTile t;
    __syncthreads();
    if (MODE == 1) {
        fa_load(t, s0, 0, tid); fa_store(t, F.lds, tid);
        if (nt > 1) { if (1 < nt0) fa_load(t, s0, 64, tid); else fa_load(t, s1, (1 - nt0) * 64, tid); fa_store(t, F.lds + FA_BUF, tid); }
        __syncthreads();
        f32x16 pa0, pa1; fa_s<NKS>(F.lds, q, pa0, pa1, kcolb, lane);
        int b0 = 0, b1 = FA_BUF, b2 = 2 * FA_BUF;
        for (int it = 0; it < nt; ++it) {
            const bool more2 = it + 2 < nt;
            if (more2) { const int n = it + 2; if (n < nt0) fa_load(t, s0, n * 64, tid); else fa_load(t, s1, (n - nt0) * 64, tid); }
            f32x16 pn0, pn1;
            if (it + 1 < nt) fa_s<NKS>(F.lds + b1, q, pn0, pn1, kcolb, lane);
            fa_smpv<false>(F.lds + b0, pa0, pa1, o, m, lsum, c, lane, false, 0);
            if (more2) fa_store(t, F.lds + b2, tid);
            __syncthreads();
            pa0 = pn0; pa1 = pn1;
            const int tb = b0; b0 = b1; b1 = b2; b2 = tb;
        }
    } else {
    fa_load(t, s0, 0, tid); fa_store(t, F.lds, tid);
    __syncthreads();
    for (int it = 0; it < nt; ++it) {
        const bool more = it + 1 < nt;
        if (more) { const int n = it + 1; if (n < nt0) fa_load(t, s0, n * 64, tid); else fa_load(t, s1, (n - nt0) * 64, tid); }
        const bool inseg1 = it >= nt0; const int pos0 = inseg1 ? s1.pos0 : s0.pos0; const int key0 = (inseg1 ? it - nt0 : it) * 64;
        fa_tile<NKS>(F.lds + (it & 1) * FA_BUF, q, o, m, lsum, c, kcolb, lane, pos0 >= 0, (qpos0 + qrow0 + r32) - (pos0 + key0));
        if (more) fa_store(t, F.lds + ((it + 1) & 1) * FA_BUF, tid);
        __syncthreads();
    }
    }
    const float ltot = half_sum(lsum);
    if (MODE == 0) {
        const float inv = 1.0f / (ltot + __builtin_amdgcn_exp2f(sinkp[grp] * 1.4426950408889634f - m));
#pragma unroll
        for (int b = 0; b < 4; ++b) o[b] = o[b] * inv;
    } else {
        LAS float* comb = (LAS float*)(F.lds + (w & 3) * 16384);
        if (grp == 1) { const float f = lam / ltot;
#pragma unroll
            for (int b = 0; b < 4; ++b)
#pragma unroll
                for (int r = 0; r < 16; ++r) comb[(32 * b + (r & 3) + 8 * (r >> 2) + 4 * h) * 32 + r32] = o[b][r] * f; }
        __syncthreads();
        if (grp == 0) { const float inv = 1.0f / ltot; float ss = 0.f;
#pragma unroll
            for (int b = 0; b < 4; ++b)
#pragma unroll
                for (int r = 0; r < 16; ++r) { const float v = o[b][r] * inv - comb[(32 * b + (r & 3) + 8 * (r >> 2) + 4 * h) * 32 + r32]; o[b][r] = v; ss += v * v; }
            ss = half_sum(ss);
            const float rs = onems / sqrtf(ss * (1.0f / 128.0f) + EPS);
#pragma unroll
            for (int b = 0; b < 4; ++b)
#pragma unroll
                for (int r = 0; r < 16; ++r) o[b][r] = o[b][r] * rs * dnorm[32 * b + (r & 3) + 8 * (r >> 2) + 4 * h]; }
    }
    if (MODE == 0 || grp == 0) {
        LAS unsigned char* st = F.lds + (MODE == 0 ? w * (32 * FA_OSTR) : 65536 + (w & 3) * (32 * FA_OSTR));
#pragma unroll
        for (int b = 0; b < 4; ++b)
#pragma unroll
            for (int k = 0; k < 4; ++k) { typedef unsigned u2 __attribute__((ext_vector_type(2)));
                *(LAS u2*)(st + r32 * FA_OSTR + (32 * b + 8 * k + 4 * h) * 2) = (u2){cvtpk(o[b][4 * k], o[b][4 * k + 1]), cvtpk(o[b][4 * k + 2], o[b][4 * k + 3])}; }
        asm volatile("s_waitcnt lgkmcnt(0)" ::: "memory");
#pragma unroll
        for (int i = 0; i < 8; ++i) { const int cc = lane + 64 * i, row = cc >> 4, c16 = cc & 15;
            *(v4u*)(dst + (size_t)(qrow0 + row) * dstride + c16 * 8) = *(const LAS v4u*)(st + row * FA_OSTR + c16 * 16); }
    }
}
constexpr int NCHUNK = 96;
constexpr int S1_CSTR = 272, S1_XSTR = 160;
constexpr int S3_CM = 0, S3_BM = 34816, S3_XM = 69632, S3_TAB = 90112, S3_SSP = 92160;
constexpr int S1_BM = 0, S1_XM = 34816, S1_TAB = 55296;
#define LBAR() asm volatile("s_waitcnt lgkmcnt(0)\n\ts_barrier" ::: "memory")
__device__ __forceinline__ int crow16(int r, int h) { return (r & 3) + 8 * (r >> 2) + 4 * h; }

struct S1Pre { v4u b[4], x[2]; };
__device__ __forceinline__ void s1_load(S1Pre& q, const bf16* XB, int cc, int hd, int tid) {
    const int m0 = cc * 128, g = hd >> 3;
    const unsigned offB = (unsigned)((tid >> 4) * 1536 + (tid & 15) * 8) * 2u, offX = (unsigned)((tid >> 3) * 1536 + (tid & 7) * 8) * 2u;
#pragma unroll
    for (int i = 0; i < 4; ++i) { const char* bs = (const char*)(XB + (size_t)(m0 + 32 * i) * 1536 + 1024 + g * 128); q.b[i] = *(const v4u*)(bs + offB); }
#pragma unroll
    for (int i = 0; i < 2; ++i) { const char* xs = (const char*)(XB + (size_t)(m0 + 64 * i) * 1536 + hd * 64); q.x[i] = *(const v4u*)(xs + offX); }
}
__device__ __forceinline__ void s1_store(const S1Pre& q, LAS unsigned char* L, int tid) {
#pragma unroll
    for (int i = 0; i < 4; ++i) { const int c = tid + 512 * i, row = c >> 4, ch = c & 15; *(LAS v4u*)(L + S1_BM + row * S1_CSTR + ch * 16) = q.b[i]; }
#pragma unroll
    for (int i = 0; i < 2; ++i) { const int c = tid + 512 * i, row = c >> 3, ch = c & 7; *(LAS v4u*)(L + S1_XM + row * S1_XSTR + ch * 16) = q.x[i]; }
}
constexpr int S1_WT = 55296, S1_DEC = S1_WT + 32 * 512;
__device__ __forceinline__ void ssd_step(LAS unsigned char* L, S1Pre& q, f32x16& st, const bf16* XB, bf16* STR, int k, int nc, int c0, int hd, int dir, int tid, int lane, int nb, int pb, const LAS unsigned char* bp, const LAS unsigned char* xp, int hh) {
    const int cc = dir ? c0 + nc - 1 - k : c0 + k;
    LBAR();
    s1_store(q, L, tid);
    LBAR();
    if (k + 2 < nc) s1_load(q, XB, dir ? cc - 2 : cc + 2, hd, tid);
    {
        bf16* so = STR + ((size_t)(dir * NCHUNK + cc) * 16 + hd) * 8192 + (size_t)((nb * 2 + pb) * 2) * 512 + lane * 8;
#pragma unroll
        for (int j = 0; j < 2; ++j) *(v4u*)(so + j * 512) = (v4u){cvtpk(st[8 * j], st[8 * j + 1]), cvtpk(st[8 * j + 2], st[8 * j + 3]), cvtpk(st[8 * j + 4], st[8 * j + 5]), cvtpk(st[8 * j + 6], st[8 * j + 7])};
    }
    const LAS float* wt = (const LAS float*)(L + S1_WT) + k * 128;
    { const float dec = ((const LAS float*)(L + S1_DEC))[k];
#pragma unroll
      for (int r = 0; r < 16; ++r) st[r] *= dec; }
#pragma unroll
    for (int ks = 0; ks < 8; ++ks) {
        const s16x4 alo = __builtin_amdgcn_ds_read_tr16_b64_v4i16((LAS s16x4*)(bp + (16 * ks) * S1_CSTR));
        const s16x4 ahi = __builtin_amdgcn_ds_read_tr16_b64_v4i16((LAS s16x4*)(bp + (16 * ks + 4) * S1_CSTR));
        const bf16x8 afr = (bf16x8){alo[0], alo[1], alo[2], alo[3], ahi[0], ahi[1], ahi[2], ahi[3]};
        const s16x4 lo = __builtin_amdgcn_ds_read_tr16_b64_v4i16((LAS s16x4*)(xp + (16 * ks) * S1_XSTR));
        const s16x4 hi = __builtin_amdgcn_ds_read_tr16_b64_v4i16((LAS s16x4*)(xp + (16 * ks + 4) * S1_XSTR));
        const f32x4 w0 = *(const LAS f32x4*)(wt + 16 * ks + 8 * hh), w1 = *(const LAS f32x4*)(wt + 16 * ks + 8 * hh + 4);
        const v4u t = (v4u){cvtpk(bf1((bf16)lo[0]) * w0.x, bf1((bf16)lo[1]) * w0.y), cvtpk(bf1((bf16)lo[2]) * w0.z, bf1((bf16)lo[3]) * w0.w), cvtpk(bf1((bf16)hi[0]) * w1.x, bf1((bf16)hi[1]) * w1.y), cvtpk(bf1((bf16)hi[2]) * w1.z, bf1((bf16)hi[3]) * w1.w)};
        st = __builtin_amdgcn_mfma_f32_32x32x16_bf16(afr, __builtin_bit_cast(bf16x8, t), st, 0, 0, 0);
    }
}
__device__ __forceinline__ void ssd_chain(Frame& F, PP p, int l, int seq, int hd, int dir) {
    unsigned char* ws = p->ws;
    int tid_ = F.tid; asm volatile("" : "+v"(tid_));
    const int tid = tid_, lane = tid & 63, w = F.wave, r32 = lane & 31, hh = lane >> 5, i16 = lane & 15, gc = (lane >> 4) & 1;
    const bf16* XB = (const bf16*)(ws + WS_XBC); const float* DT = (const float*)(ws + WS_DT);
    float* CUMG = (float*)(ws + WS_EDEC); bf16* STR = (bf16*)(ws + WS_ST);
    LAS unsigned char* L = F.lds;
    const int nc = seq < 16 ? 2 : 32, c0 = seq < 16 ? seq * 2 : 32 + (seq - 16) * 32;
    const int nb = w & 3, pb = w >> 2;
    S1Pre qa, qb; s1_load(qa, XB, dir ? c0 + nc - 1 : c0, hd, tid); s1_load(qb, XB, dir ? c0 + nc - 2 : c0 + 1, hd, tid);
    const float a = -__expf(p->in[21][(l * 2 + dir) * 16 + hd]);
    f32x16 st;
    if (seq >= 16) { const float* h0 = p->in[dir ? 7 : 6] + (((size_t)(seq - 16) * DEPTH + l) * 16 + hd) * 8192 + (32 * pb + r32) * 128 + 32 * nb + 4 * hh;
#pragma unroll
        for (int k = 0; k < 4; ++k) { const f32x4 v = *(const f32x4*)(h0 + 8 * k); st[4 * k] = v.x; st[4 * k + 1] = v.y; st[4 * k + 2] = v.z; st[4 * k + 3] = v.w; } }
    else {
#pragma unroll
        for (int r = 0; r < 16; ++r) st[r] = 0.f; }
    LBAR();
    for (int k = w; k < nc; k += NWAVES) {
        const int cc = dir ? c0 + nc - 1 - k : c0 + k;
        const float* dp = DT + (size_t)(cc * 128 + 2 * lane) * 32 + dir * 16 + hd;
        const float d0 = dp[0], d1 = dp[32];
        const float v0 = d0 * a, v1 = d1 * a, s = v0 + v1;
        float inc = s;
        if (dir == 0) {
#pragma unroll
            for (int o = 1; o < 64; o <<= 1) { const float t = bperm(inc, lane - o); if (lane >= o) inc += t; }
        } else {
#pragma unroll
            for (int o = 1; o < 64; o <<= 1) { const float t = bperm(inc, lane + o); if (lane + o < 64) inc += t; }
        }
        const float exc = inc - s;
        const float cA = (dir == 0) ? exc + v0 : exc + v1 + v0, cB = (dir == 0) ? exc + v0 + v1 : exc + v1;
        const float tot = bperm(inc, dir == 0 ? 63 : 0);
        typedef float f2 __attribute__((ext_vector_type(2)));
        *(LAS f2*)((LAS float*)(L + S1_WT) + k * 128 + 2 * lane) = (f2){__expf(tot - cA) * d0, __expf(tot - cB) * d1};
        if (lane == 0) ((LAS float*)(L + S1_DEC))[k] = __expf(tot);
        *(f2*)(CUMG + ((size_t)(cc * 16 + hd) * 2 + dir) * 128 + 2 * lane) = (f2){cA, cB};
    }
    const LAS unsigned char* bp = L + S1_BM + (8 * hh + (i16 >> 2)) * S1_CSTR + (32 * nb + 16 * gc + 4 * (i16 & 3)) * 2;
    const LAS unsigned char* xp = L + S1_XM + (8 * hh + (i16 >> 2)) * S1_XSTR + (32 * pb + 16 * gc + 4 * (i16 & 3)) * 2;
    for (int k = 0; k < nc; k += 2) {
        ssd_step(L, qa, st, XB, STR, k, nc, c0, hd, dir, tid, lane, nb, pb, bp, xp, hh);
        ssd_step(L, qb, st, XB, STR, k + 1, nc, c0, hd, dir, tid, lane, nb, pb, bp, xp, hh);
    }
    if (seq < 16) { float* o = p->out + (dir ? OUT_SB : OUT_SF) + (((size_t)seq * DEPTH + l) * 16 + hd) * 8192 + (32 * pb + r32) * 128 + 32 * nb + 4 * hh;
#pragma unroll
        for (int k = 0; k < 4; ++k) *(f32x4*)(o + 8 * k) = (f32x4){st[4 * k], st[4 * k + 1], st[4 * k + 2], st[4 * k + 3]}; }
    LBAR();
}
struct S3Pre { v4u c[4], b[4], x[2]; float dt, cum, dk; };
__device__ __forceinline__ void s3_load(S3Pre& q, const bf16* XB, const float* DT, const float* CUMG, const float* dskip, int u, int tid) {
    const int cc = u >> 4, hd = u & 15, m0 = cc * 128, g = hd >> 3;
    const unsigned offB = (unsigned)((tid >> 4) * 1536 + (tid & 15) * 8) * 2u, offX = (unsigned)((tid >> 3) * 1536 + (tid & 7) * 8) * 2u;
#pragma unroll
    for (int i = 0; i < 4; ++i) { const char* bs = (const char*)(XB + (size_t)(m0 + 32 * i) * 1536 + g * 128); q.c[i] = *(const v4u*)(bs + 2560 + offB); q.b[i] = *(const v4u*)(bs + 2048 + offB); }
#pragma unroll
    for (int i = 0; i < 2; ++i) { const char* xs = (const char*)(XB + (size_t)(m0 + 64 * i) * 1536 + hd * 64); q.x[i] = *(const v4u*)(xs + offX); }
    q.dt = *(const float*)((const char*)(DT + (size_t)m0 * 32 + hd) + (unsigned)((tid & 127) * 32 + ((tid >> 7) & 1) * 16) * 4u);
    q.cum = *(const float*)((const char*)(CUMG + (size_t)(cc * 16 + hd) * 256) + (unsigned)(tid & 255) * 4u);
    q.dk = dskip[hd];
}
__device__ __forceinline__ void s3_store(const S3Pre& q, LAS unsigned char* L, int tid) {
#pragma unroll
    for (int i = 0; i < 4; ++i) { const int c = tid + 512 * i, row = c >> 4, ch = c & 15; *(LAS v4u*)(L + S3_CM + row * S1_CSTR + ch * 16) = q.c[i]; *(LAS v4u*)(L + S3_BM + row * S1_CSTR + ch * 16) = q.b[i]; }
#pragma unroll
    for (int i = 0; i < 2; ++i) { const int c = tid + 512 * i, row = c >> 3, ch = c & 7; *(LAS v4u*)(L + S3_XM + row * S1_XSTR + ch * 16) = q.x[i]; }
    if (tid < 256) { ((LAS float*)(L + S3_TAB))[tid] = q.cum; ((LAS float*)(L + S3_TAB))[256 + tid] = q.dt; }
}
__device__ __forceinline__ void s3_phase(Frame& F, PP p, int l) {
    unsigned char* ws = p->ws;
    int tid_ = F.tid; asm volatile("" : "+v"(tid_));
    const int tid = tid_, lane = tid & 63, w = F.wave, r32 = lane & 31, hh = lane >> 5, i16 = lane & 15, gc = (lane >> 4) & 1;
    const bf16* XB = (const bf16*)(ws + WS_XBC); const bf16* P = (const bf16*)(ws + WS_P); bf16* MIX = (bf16*)(ws + WS_MIX);
    const float* DT = (const float*)(ws + WS_DT); const float* CUMG = (const float*)(ws + WS_EDEC); const bf16* STR = (const bf16*)(ws + WS_ST); float* SSQ = (float*)(ws + WS_SSQ);
    LAS unsigned char* L = F.lds; const LAS float* tab = (const LAS float*)(L + S3_TAB); LAS float* SSP = (LAS float*)(L + S3_SSP);
    const int lb = w & 3, pb = w >> 2, lpos = 32 * lb + r32;
    const int uend = NCHUNK * 16;
    int u = blockIdx.x; if (u >= uend) return;
    const float* dskip = p->in[22] + l * 16;
    S3Pre q; s3_load(q, XB, DT, CUMG, dskip, u, tid);
    while (u < uend) {
        const int cc = u >> 4, hd = u & 15, m0 = cc * 128; const float dk = q.dk;
        LBAR();
        s3_store(q, L, tid);
        LBAR();
        const int un = u + F.G; if (un < uend) s3_load(q, XB, DT, CUMG, dskip, un, tid);
        v4u hf[2][8];
#pragma unroll
        for (int k = 0; k < 8; ++k) hf[0][k] = *(const v4u*)((const char*)(STR + ((size_t)(0 * NCHUNK + cc) * 16 + hd) * 8192 + (((k >> 1) * 2 + pb) * 2 + (k & 1)) * 512) + (unsigned)lane * 16u);
        unsigned long long zw[4];
        f32x16 acc;
#pragma unroll
        for (int r = 0; r < 16; ++r) acc[r] = 0.f;
#pragma unroll
        for (int d = 0; d < 2; ++d) {
            const LAS float* cum = tab + d * 128; const LAS float* dtv = tab + (2 + d) * 128; const float cl = cum[lpos];
            const int sb0 = d == 0 ? 0 : lb, sb1 = d == 0 ? lb : 3;
            for (int sb = sb0; sb <= sb1; ++sb) {
                f32x16 cb;
#pragma unroll
                for (int r = 0; r < 16; ++r) cb[r] = 0.f;
#pragma unroll
                for (int ks = 0; ks < 8; ++ks) { const bf16x8 a = *(const LAS bf16x8*)(L + S3_BM + (32 * sb + r32) * S1_CSTR + ks * 32 + hh * 16);
                    const bf16x8 cfr = *(const LAS bf16x8*)(L + S3_CM + lpos * S1_CSTR + ks * 32 + hh * 16);
                    cb = __builtin_amdgcn_mfma_f32_32x32x16_bf16(a, cfr, cb, 0, 0, 0);
                    if ((ks & 3) == 3) __builtin_amdgcn_sched_barrier(0); }
#pragma unroll
                for (int r = 0; r < 16; ++r) { const int s = 32 * sb + crow16(r, hh);
                    float v = cb[r] * __expf(cl - cum[s]) * dtv[s];
                    const bool ok = d == 0 ? (s <= lpos) : (s >= lpos);
                    v = ok ? v : 0.f; if (d == 0 && s == lpos) v += dk;
                    cb[r] = v; }
                bf16x8 pb2[2];
                { v4u t;
                  t = (v4u){cvtpk(cb[0], cb[1]), cvtpk(cb[2], cb[3]), cvtpk(cb[4], cb[5]), cvtpk(cb[6], cb[7])}; pb2[0] = __builtin_bit_cast(bf16x8, t);
                  t = (v4u){cvtpk(cb[8], cb[9]), cvtpk(cb[10], cb[11]), cvtpk(cb[12], cb[13]), cvtpk(cb[14], cb[15])}; pb2[1] = __builtin_bit_cast(bf16x8, t); }
                const LAS unsigned char* xp = L + S3_XM + (32 * sb + 4 * hh + (i16 >> 2)) * S1_XSTR + (32 * pb + 16 * gc + 4 * (i16 & 3)) * 2;
#pragma unroll
                for (int k2 = 0; k2 < 2; ++k2) {
                    const s16x4 lo = __builtin_amdgcn_ds_read_tr16_b64_v4i16((LAS s16x4*)(xp + (16 * k2) * S1_XSTR));
                    const s16x4 hi = __builtin_amdgcn_ds_read_tr16_b64_v4i16((LAS s16x4*)(xp + (16 * k2 + 8) * S1_XSTR));
                    const bf16x8 a = (bf16x8){lo[0], lo[1], lo[2], lo[3], hi[0], hi[1], hi[2], hi[3]};
                    acc = __builtin_amdgcn_mfma_f32_32x32x16_bf16(a, pb2[k2], acc, 0, 0, 0);
                }
            }
            if (d == 0) {
#pragma unroll
                for (int k = 0; k < 8; ++k) hf[1][k] = *(const v4u*)((const char*)(STR + ((size_t)(1 * NCHUNK + cc) * 16 + hd) * 8192 + (((k >> 1) * 2 + pb) * 2 + (k & 1)) * 512) + (unsigned)lane * 16u);
#pragma unroll
                for (int k = 0; k < 4; ++k) zw[k] = *(const unsigned long long*)((const char*)(P + (size_t)m0 * INP + PC_Z + hd * 64 + 32 * pb + 8 * k) + (unsigned)(lpos * INP + 4 * hh) * 2u);
            }
        }
#pragma unroll
        for (int d = 0; d < 2; ++d) { const float e = __expf(tab[d * 128 + lpos]);
#pragma unroll
            for (int k = 0; k < 8; ++k) { typedef unsigned u2 __attribute__((ext_vector_type(2)));
                const LAS unsigned char* cp = L + S3_CM + lpos * S1_CSTR + (32 * (k >> 1) + 16 * (k & 1) + 4 * hh) * 2;
                const u2 c0 = *(const LAS u2*)cp, c1 = *(const LAS u2*)(cp + 16);
                const v4u t = (v4u){cvtpk(bflo(c0.x) * e, bfhi(c0.x) * e), cvtpk(bflo(c0.y) * e, bfhi(c0.y) * e), cvtpk(bflo(c1.x) * e, bfhi(c1.x) * e), cvtpk(bflo(c1.y) * e, bfhi(c1.y) * e)};
                acc = __builtin_amdgcn_mfma_f32_32x32x16_bf16(__builtin_bit_cast(bf16x8, hf[d][k]), __builtin_bit_cast(bf16x8, t), acc, 0, 0, 0); } }
        float ss = 0.f;
        char* mixr = (char*)(MIX + (size_t)m0 * DM + 1024 + hd * 64 + 32 * pb); const unsigned mixo = (unsigned)(lpos * DM + 4 * hh) * 2u;
#pragma unroll
        for (int k = 0; k < 4; ++k) { const unsigned long long z = zw[k];
            const float y0 = acc[4 * k] * silu(bflo((unsigned)z)), y1 = acc[4 * k + 1] * silu(bfhi((unsigned)z)), y2 = acc[4 * k + 2] * silu(bflo((unsigned)(z >> 32))), y3 = acc[4 * k + 3] * silu(bfhi((unsigned)(z >> 32)));
            ss += (y0 * y0 + y1 * y1) + (y2 * y2 + y3 * y3);
            *(unsigned long long*)(mixr + 16 * k + mixo) = (unsigned long long)cvtpk(y0, y1) | ((unsigned long long)cvtpk(y2, y3) << 32); }
        ss = half_sum(ss);
        if (hh == 0) SSP[pb * 128 + lpos] = ss;
        LBAR();
        if (tid < 128) SSQ[(size_t)(m0 + tid) * 16 + hd] = SSP[tid] + SSP[128 + tid];
        u = un;
    }
    LBAR();
}
__device__ __forceinline__ void nrm_phase(Frame& F, PP p, int l) {
    unsigned char* ws = p->ws; bf16* MIX = (bf16*)(ws + WS_MIX); const float* SSQ = (const float*)(ws + WS_SSQ); const float* sn = p->in[23] + l * 1024;
    const int gw = F.vcu * NWAVES + F.wave, NGW = F.G * NWAVES, lane = F.lane;
    for (int m = gw; m < MROWS; m += NGW) {
        const int c0 = lane * 16, g = lane >> 5;
        const f32x4 s0 = *(const f32x4*)(SSQ + (size_t)m * 16 + g * 8), s1 = *(const f32x4*)(SSQ + (size_t)m * 16 + g * 8 + 4);
        const float rs = 1.0f / sqrtf(((s0.x + s0.y) + (s0.z + s0.w) + (s1.x + s1.y) + (s1.z + s1.w)) * (1.0f / 512.0f) + EPS);
        v4u* q = (v4u*)(MIX + (size_t)m * DM + 1024 + c0); v4u a = q[0], b = q[1];
        const f32x4 g0 = *(const f32x4*)(sn + c0), g1 = *(const f32x4*)(sn + c0 + 4), g2 = *(const f32x4*)(sn + c0 + 8), g3 = *(const f32x4*)(sn + c0 + 12);
        a.x = cvtpk(bflo(a.x) * rs * g0.x, bfhi(a.x) * rs * g0.y); a.y = cvtpk(bflo(a.y) * rs * g0.z, bfhi(a.y) * rs * g0.w); a.z = cvtpk(bflo(a.z) * rs * g1.x, bfhi(a.z) * rs * g1.y); a.w = cvtpk(bflo(a.w) * rs * g1.z, bfhi(a.w) * rs * g1.w);
        b.x = cvtpk(bflo(b.x) * rs * g2.x, bfhi(b.x) * rs * g2.y); b.y = cvtpk(bflo(b.y) * rs * g2.z, bfhi(b.y) * rs * g2.w); b.z = cvtpk(bflo(b.z) * rs * g3.x, bfhi(b.z) * rs * g3.y); b.w = cvtpk(bflo(b.w) * rs * g3.z, bfhi(b.w) * rs * g3.w);
        q[0] = a; q[1] = b;
    }
}
__device__ __forceinline__ void mix1_phase(Frame& F, PP p, int l) {
    unsigned char* ws = p->ws;
    const bf16* P = (const bf16*)(ws + WS_P); const bf16* QKR = (const bf16*)(ws + WS_QKR); bf16* MIX = (bf16*)(ws + WS_MIX);
    const float* lamv = (const float*)(ws + WS_TAB + 32768);
    const float lam = lamv[l], onems = 1.0f - lamv[4 + l];
    const float* dnorm = p->in[17] + l * 128;
    constexpr int U_BL = 256, U_AL = 128, U_BC = 128, U_AC = 64, U_CC = 512, U_REST = U_AL + U_BC + U_AC + U_CC;
    const float LOG2E = 1.4426950408889634f, cA = 0.08838834764831845f * LOG2E, cB = 0.125f * LOG2E;
    const int NLC = F.G > 64 ? 64 : 0;
    const int bx = (int)blockIdx.x;
    const int nB = (U_BL - bx + F.G - 1) / F.G;
    int nR = 0, rfirst = 0, rstride = 1;
    if (bx >= NLC) { rfirst = bx - NLC; rstride = F.G - NLC; nR = rfirst < U_REST ? (U_REST - rfirst + rstride - 1) / rstride : 0; }
    for (int ui = 0; ui < nB + nR; ++ui) {
        int r;
        if (ui < nB) r = bx + ui * F.G;
        else { r = rfirst + (ui - nB) * rstride;
               if (r >= U_AL + U_BC + U_AC) { r -= U_AL + U_BC + U_AC; __syncthreads(); ssd_chain(F, p, l, r >> 5, (r >> 1) & 15, r & 1); continue; }
               r += U_BL; }
        int mode = 1; const bf16* qp; int qstr = RCW, qpos0 = 0; bool two = true; Seg s0, s1; bf16* dst; const float* sinkp = dnorm;
        if (r < U_BL) {
            const int b = r >> 7, h = (r >> 5) & 3, qb = r & 31; const int ml = b * 4096 + qb * 128;
            s0 = Seg{QKR + (size_t)(b * 4096) * RCW + RC_KD + h * 128, P + (size_t)(4096 + b * 4096) * INP + PC_VD + h * 128, RCW, INP, 4096, 0, -1};
            s1 = Seg{p->in[4] + ((size_t)(b * DEPTH + l) * 256) * 512 + h * 128, p->in[5] + ((size_t)(b * DEPTH + l) * 256) * 512 + h * 128, 512, 512, 256, 1, -1};
            qp = QKR + (size_t)ml * RCW + RC_QD + h * 128; dst = MIX + (size_t)(4096 + ml) * DM + 512 + h * 128;
        } else if (r < U_BL + U_AL) { r -= U_BL;
            const int b = r >> 6, kv = (r >> 5) & 1, qb = r & 31; const int ml = b * 4096 + qb * 128;
            const int w0 = qb * 128 - 128 < 0 ? 0 : qb * 128 - 128, w1 = qb * 128 + 256 > 4096 ? 4096 : qb * 128 + 256;
            s0 = Seg{p->in[2] + ((size_t)(b * DEPTH + l) * 256) * 256 + kv * 128, p->in[3] + ((size_t)(b * DEPTH + l) * 256) * 256 + kv * 128, 256, 256, 256, 1, -1};
            s1 = Seg{QKR + (size_t)(b * 4096 + w0) * RCW + RC_KA + kv * 128, P + (size_t)(4096 + b * 4096 + w0) * INP + PC_VA + kv * 128, RCW, INP, w1 - w0, 0, w0};
            mode = 0; qp = QKR + (size_t)ml * RCW + RC_QA + kv * 256; qpos0 = qb * 128; sinkp = p->in[15] + l * 4 + kv * 2; dst = MIX + (size_t)(4096 + ml) * DM + kv * 256;
        } else if (r < U_BL + U_AL + U_BC) { r -= U_BL + U_AL;
            const int b = r >> 3, h = (r >> 1) & 3, qb = r & 1; const int m0 = b * 256 + qb * 128;
            s0 = Seg{P + (size_t)(b * 256) * INP + PC_KD + h * 128, P + (size_t)(b * 256) * INP + PC_VD + h * 128, INP, INP, 256, 0, -1}; s1 = s0; two = false;
            qp = P + (size_t)m0 * INP + PC_QD + h * 128; qstr = INP; dst = MIX + (size_t)m0 * DM + 512 + h * 128;
        } else { r -= U_BL + U_AL + U_BC;
            const int b = r >> 2, kv = (r >> 1) & 1, qb = r & 1; const int m0 = b * 256 + qb * 128;
            s0 = Seg{P + (size_t)(b * 256) * INP + PC_KA + kv * 128, P + (size_t)(b * 256) * INP + PC_VA + kv * 128, INP, INP, 256, 0, -1}; s1 = s0; two = false;
            mode = 0; qp = P + (size_t)m0 * INP + PC_QA + kv * 256; qstr = INP; sinkp = p->in[15] + l * 4 + kv * 2; dst = MIX + (size_t)m0 * DM + kv * 256;
        }
        if (mode) fa_unit<1>(F, qp, qstr, s0, s1, two, qpos0, cB, sinkp, lam, onems, dnorm, dst, DM);
        else fa_unit<0>(F, qp, qstr, s0, s1, two, qpos0, cA, sinkp, lam, onems, dnorm, dst, DM);
    }
    __syncthreads();
    if (NLC == 0) { for (int c = bx; c < 64; c += F.G) ssd_chain(F, p, l, 16 + (c >> 5), (c >> 1) & 15, c & 1); }
    else if (bx < NLC) ssd_chain(F, p, l, 16 + (bx >> 5), (bx >> 1) & 15, bx & 1);
}
#ifndef MK_ONE_LAUNCH
#define MK_ONE_LAUNCH 1
#endif
constexpr int PH_PER_LAYER = 10, PH_TOTAL = 2 + DEPTH * PH_PER_LAYER + 1;
__global__ void __launch_bounds__(NTHR, 2) mk_fwd(Params p_) {
    extern __shared__ __attribute__((aligned(16))) unsigned char lds[];
    Frame F;
    F.lds = (LAS unsigned char*)lds;
    F.tid = threadIdx.x; F.lane = F.tid & 63; F.wave = __builtin_amdgcn_readfirstlane(F.tid >> 6); const int wave0 = F.wave;
    F.G = gridDim.x; { const int bx = blockIdx.x; F.vcu = (F.G % 8 == 0) ? (bx % 8) * (F.G / 8) + bx / 8 : bx; }
    PP p = (PP)__builtin_amdgcn_kernarg_segment_ptr();
    for (int u = F.tid; u < (LDS_BYTES - LDSCTL_OFF) / 4; u += NTHR) ((LAS unsigned*)(F.lds + LDSCTL_OFF))[u] = 0u;
    __syncthreads();
    XcdBarrier bar; bar.bar = (unsigned*)(p->ws + WS_CTL) + CW_BAR; bar.x = 0; bar.st = nullptr;
#if MK_ONE_LAUNCH
    bar = xcd_barrier_post((unsigned*)(p->ws + WS_CTL) + CW_BAR, (volatile LAS unsigned*)(F.lds + MISC_OFF) + 8, F.tid == 0);
#define GRID_BAR() do { unsigned on_ = ~0u; asm volatile("" : "+s"(on_)); xcd_barrier(bar, wave0 == 0 && __builtin_amdgcn_mbcnt_hi(on_, __builtin_amdgcn_mbcnt_lo(on_, 0u)) == 0u); } while (0)
#else
#define GRID_BAR() do {} while (0)
#endif
    const int lo = p->ph_lo, hi = p->ph_hi;
#define IN(k) (lo <= (k) && (k) < hi)
#define SEAM(k) do { if (IN(k) && IN((k) + 1)) GRID_BAR(); } while (0)
#define ENTER() do { int wv_ = wave0; asm volatile("" : "+s"(wv_)); unsigned on_ = ~0u; asm volatile("" : "+s"(on_)); int t_ = wv_ * 64 + (int)__builtin_amdgcn_mbcnt_hi(on_, __builtin_amdgcn_mbcnt_lo(on_, 0u)); asm volatile("" : "+v"(t_)); F.tid = t_; F.lane = t_ & 63; F.wave = wv_; asm volatile("" : "+s"(p)); ws = p->ws; } while (0)
    unsigned char* ws;

    if (IN(0)) { ENTER(); p0_prologue(F, p); } SEAM(0);
    if (IN(1)) { ENTER(); mod_layer(p, 0, F.vcu * NTHR + F.tid, F.G * NTHR); } SEAM(1);
#pragma unroll 1
    for (int l = 0; l < DEPTH; ++l) {
        const int pb = 2 + l * PH_PER_LAYER;
        if (IN(pb + 0)) { ENTER(); norm_phase(F, l == 0 ? p->in[0] : (const float*)(ws + WS_H), l == 0 ? p->in[1] : (const float*)(ws + WS_H) + (size_t)4096 * DM, p->in[12] + l * DM, (const float*)(ws + WS_MOD) + (size_t)l * 3 * NMOD, 0, DM, (bf16*)(ws + WS_U)); } SEAM(pb + 0);
        if (IN(pb + 1)) { ENTER();
            pg8::Gemm g{(const bf16*)(ws + WS_U), (const bf16*)(ws + WS_WIN) + (size_t)l * INP * DM, MROWS, INP, DM, DM}; pg8::StaticOrder S; S.init(MROWS, INP, F.G, (int)blockIdx.x);
            pg8::EpiBf16 E{(bf16*)(ws + WS_P), INP};
            pg8::gemm_phase<pg8::EpiBf16, pg8::StaticOrder, true, true>(F.lds, g, S, E, F.tid);
        } SEAM(pb + 1);
        if (IN(pb + 2)) { ENTER(); prep_phase(F, p, l); } SEAM(pb + 2);
        if (IN(pb + 3)) { ENTER(); mix1_phase(F, p, l); } SEAM(pb + 3);
        if (IN(pb + 4)) { ENTER(); s3_phase(F, p, l); } SEAM(pb + 4);
        if (IN(pb + 5)) { ENTER(); nrm_phase(F, p, l); } SEAM(pb + 5);
        if (IN(pb + 6)) { ENTER();
            pg8::Gemm g{(const bf16*)(ws + WS_MIX), (const bf16*)(ws + WS_WOUT) + (size_t)l * DM * DM, MROWS, DM, DM, DM}; pg8::StaticOrder S; S.init(MROWS, DM, F.G, (int)blockIdx.x);
            pg8::EpiResid E{l == 0 ? p->in[0] : (const float*)(ws + WS_H), l == 0 ? p->in[1] : (const float*)(ws + WS_H) + (size_t)4096 * DM, (float*)(ws + WS_H), DM, (const float*)(ws + WS_MOD) + (size_t)l * 3 * NMOD + 2 * DM, NMOD};
            pg8::gemm_phase<pg8::EpiResid, pg8::StaticOrder, true, true>(F.lds, g, S, E, F.tid);
            { const int nfull = F.G == 256 ? 128 : 0; if (l + 1 < DEPTH && (int)blockIdx.x >= nfull) adaln_layer(F, p, l + 1, (int)blockIdx.x - nfull, (int)F.G - nfull); }
        } SEAM(pb + 6);
        if (IN(pb + 7)) { ENTER(); norm_phase(F, (const float*)(ws + WS_H), (const float*)(ws + WS_H) + (size_t)4096 * DM, p->in[13] + l * DM, (const float*)(ws + WS_MOD) + (size_t)l * 3 * NMOD, 3 * DM, 4 * DM, (bf16*)(ws + WS_U)); } SEAM(pb + 7);
        if (IN(pb + 8)) { ENTER();
            pg8::Gemm g{(const bf16*)(ws + WS_U), (const bf16*)(ws + WS_WGU) + (size_t)l * GU * DM, MROWS, GU, DM, DM}; pg8::StaticOrder S; S.init(MROWS, GU, F.G, (int)blockIdx.x);
            pg8::EpiSwiGLU E{(bf16*)(ws + WS_ACT), FF};
            pg8::gemm_phase<pg8::EpiSwiGLU, pg8::StaticOrder, true, true>(F.lds, g, S, E, F.tid);
        } SEAM(pb + 8);
        if (IN(pb + 9)) { ENTER();
            pg8::Gemm g{(const bf16*)(ws + WS_ACT), (const bf16*)(ws + WS_WDN) + (size_t)l * DM * FF, MROWS, DM, FF, FF}; pg8::StaticOrder S; S.init(MROWS, DM, F.G, (int)blockIdx.x);
            if (l + 1 < DEPTH) mod_layer(p, l + 1, F.vcu * NTHR + F.tid, F.G * NTHR);
            pg8::EpiResid E{(const float*)(ws + WS_H), (const float*)(ws + WS_H) + (size_t)4096 * DM, (float*)(ws + WS_H), DM, (const float*)(ws + WS_MOD) + (size_t)l * 3 * NMOD + 5 * DM, NMOD};
            pg8::gemm_phase<pg8::EpiResid, pg8::StaticOrder, true, true>(F.lds, g, S, E, F.tid);
            { const int nfull = F.G == 256 ? 128 : 0; if (l + 1 < DEPTH && (int)blockIdx.x >= nfull) conv_layer(F, p, l + 1, ((int)blockIdx.x - nfull) * NWAVES + F.wave, ((int)F.G - nfull) * NWAVES); }
        } SEAM(pb + 9);
    }
    if (IN(PH_TOTAL - 1)) { ENTER(); final_phase(F, (const float*)(ws + WS_H), p->in[27], p->out); }
#undef IN
#undef SEAM
#undef ENTER
}

extern "C" void kernel_launch(void* const* d_in, const int* in_sizes, int n_in, void* d_out, int out_size, void* d_ws, size_t ws_size, hipStream_t stream) {
    static int grid = 0;
    if (grid == 0) {
        if (n_in != 28 || out_size != 67108864 || ws_size < WS_END) { fprintf(stderr, "kernel_launch: unexpected sizes n_in %d out %d ws %zu\n", n_in, out_size, ws_size); grid = -1; return; }
        int dev = 0, cus = 0, per_cu = 0;
        if (hipGetDevice(&dev) != hipSuccess || hipDeviceGetAttribute(&cus, hipDeviceAttributeMultiprocessorCount, dev) != hipSuccess) { grid = -1; return; }
        if (hipFuncSetAttribute((const void*)mk_fwd, hipFuncAttributeMaxDynamicSharedMemorySize, LDS_BYTES) != hipSuccess) { fprintf(stderr, "kernel_launch: hipFuncSetAttribute failed\n"); grid = -1; return; }
        if (hipOccupancyMaxActiveBlocksPerMultiprocessor(&per_cu, (const void*)mk_fwd, NTHR, LDS_BYTES) != hipSuccess || per_cu < 1)
            fprintf(stderr, "kernel_launch: occupancy query reports %d workgroups per CU\n", per_cu);
        (void)hipGetLastError();
        grid = cus;
    }
    if (grid < 0) return;
    if (hipMemsetAsync((char*)d_ws + WS_CTL, 0, CTL_ZERO_BYTES, stream) != hipSuccess) return;
    Params a{};
    for (int i = 0; i < 28; ++i) a.in[i] = (const float*)d_in[i];
    a.out = (float*)d_out; a.ws = (unsigned char*)d_ws;
#if MK_ONE_LAUNCH
    a.ph_lo = 0; a.ph_hi = PH_TOTAL;
    hipLaunchKernelGGL(mk_fwd, dim3(grid), dim3(NTHR), LDS_BYTES, stream, a);
#else
    for (int ph = 0; ph < PH_TOTAL; ++ph) { a.ph_lo = ph; a.ph_hi = ph + 1; hipLaunchKernelGGL(mk_fwd, dim3(grid), dim3(NTHR), LDS_BYTES, stream, a); }
#endif
}
```
